# Optimizing an MI355X kernel written in HIP

```python
import math
import jax
import jax.numpy as jnp
from jax import lax
import numpy as np

D_MODEL = 1024
BATCH = 4
SEQ = 8192
DEPTH = 2

GRID_W = 64
CTX_LEN = 256
N_MOD = 6
BRANCH_WIDTH = 512
N_BRANCH = 3
DA_HEADS = 4
DA_QK_DIM = 64
DA_V_DIM = 2 * DA_QK_DIM
DA_QK_WIDTH = DA_HEADS * 2 * DA_QK_DIM
ROPE_BASE = 10000.0
Q_BLOCK = 128
LRU_BLOCKS = 8
LRU_BLOCK_DIM = BRANCH_WIDTH // LRU_BLOCKS
LRU_C = 8.0
CONV_K = 4
GDN_HEADS = 4
GDN_DK = 128
GDN_DV = 128
GDN_QKV_WIDTH = GDN_HEADS * (2 * GDN_DK + GDN_DV)
GDN_CHUNK = 64
N_DIR = 2
D_FF = 4 * D_MODEL
EPS = 1e-6
IN_SPLITS = (DA_QK_WIDTH, DA_QK_WIDTH, BRANCH_WIDTH,
             BRANCH_WIDTH, BRANCH_WIDTH,
             GDN_QKV_WIDTH, BRANCH_WIDTH,
             N_DIR * GDN_HEADS, N_DIR * GDN_HEADS,
             N_BRANCH * D_MODEL)
N_IN = sum(IN_SPLITS)

kernel_name = 'hybrid_prefix_dit_block'


def rms_norm(x, g):
    xf = x.astype(jnp.float32)
    y = xf * lax.rsqrt(jnp.mean(xf * xf, axis=-1, keepdims=True) + EPS)
    return (y * g.astype(jnp.float32)).astype(x.dtype)


def l2_norm(x):
    xf = x.astype(jnp.float32)
    return (xf * lax.rsqrt(jnp.sum(xf * xf, axis=-1, keepdims=True) + EPS)).astype(x.dtype)


def modulate(h, shift, scale):
    return h * (1 + scale) + shift


def flip_t(t):
    return t[:, ::-1]


def dwconv_centred(x, w, b=None):
    K = w.shape[0]
    T = x.shape[1]
    lo = (K - 1) // 2
    xp = jnp.pad(x, ((0, 0), (lo, K - 1 - lo), (0, 0)))
    y = sum(xp[:, k:k + T] * w[k] for k in range(K))
    return y if b is None else y + b


def split_proj(p):
    offs = np.cumsum(IN_SPLITS)[:-1].tolist()
    return jnp.split(p, offs, axis=-1)


def axial_rope_tables(row, col):
    n_freq = DA_QK_DIM // 4
    inv = ROPE_BASE ** (-jnp.arange(n_freq, dtype=jnp.float32) / n_freq)
    ang_r = row.astype(jnp.float32)[:, None] * inv
    ang_c = col.astype(jnp.float32)[:, None] * inv
    ang = jnp.concatenate([ang_r, ang_r, ang_c, ang_c], axis=-1)
    return jnp.cos(ang), jnp.sin(ang)


def apply_axial_rope(x, cos, sin):
    xf = x.astype(jnp.float32)
    xs = xf.reshape(x.shape[:-1] + (2, 2, DA_QK_DIM // 4))
    rot = jnp.stack([-xs[..., 1, :], xs[..., 0, :]], axis=-2).reshape(x.shape)
    c = cos[None, :, None, None, :]
    s = sin[None, :, None, None, :]
    return (xf * c + rot * s).astype(x.dtype)


def diff_attend(q, k, v, lam):
    s = jnp.einsum('bqhcd,bkhcd->bhcqk', q, k, preferred_element_type=jnp.float32) * (DA_QK_DIM ** -0.5)
    p = jax.nn.softmax(s, axis=-1)
    w = p[:, :, 0] - lam * p[:, :, 1]
    return jnp.einsum('bhqk,bkhv->bqhv', w.astype(v.dtype), v)


def diff_attend_blocks(q, k, v, lam):
    B, T = q.shape[:2]
    nb = T // Q_BLOCK
    qb = jnp.moveaxis(q.reshape((B, nb, Q_BLOCK) + q.shape[2:]), 1, 0)
    ob = lax.map(lambda qq: diff_attend(qq, k, v, lam), qb)
    return jnp.moveaxis(ob, 0, 1).reshape((B, T) + ob.shape[3:])


def da_branch(q_l, k_l, v_l, q_c, k_c, v_c, q_g, k_g, lam_vec, sub_g, lam_init, cos, sin, need_ctx):
    def heads(q, k, v):
        B, T, _ = q.shape
        q = rms_norm(q.reshape(B, T, DA_HEADS, 2, DA_QK_DIM), q_g)
        k = rms_norm(k.reshape(B, T, DA_HEADS, 2, DA_QK_DIM), k_g)
        return q, k, v.reshape(B, T, DA_HEADS, DA_V_DIM)

    def post(o):
        B, T = o.shape[:2]
        return (rms_norm(o, sub_g) * (1.0 - lam_init)).reshape(B, T, BRANCH_WIDTH)

    ql, kl, vl = heads(q_l, k_l, v_l)
    ql = apply_axial_rope(ql, cos, sin)
    kl = apply_axial_rope(kl, cos, sin)
    qc, kc, vc = heads(q_c, k_c, v_c)
    lv = lam_vec.astype(jnp.float32)
    lam = jnp.exp(jnp.sum(lv[0] * lv[1])) - jnp.exp(jnp.sum(lv[2] * lv[3])) + lam_init
    k_all = jnp.concatenate([kl, kc], axis=1)
    v_all = jnp.concatenate([vl, vc], axis=1)
    out_l = post(diff_attend_blocks(ql, k_all, v_all, lam))
    out_c = post(diff_attend(qc, kc, vc, lam)) if need_ctx else None
    return out_l, out_c


def rglru_coeffs(xc, gate_w, gate_b, lam):
    B, T, W = xc.shape
    xf = xc.astype(jnp.float32)
    xb = xf.reshape(B, T, LRU_BLOCKS, LRU_BLOCK_DIM)
    g = jnp.einsum('btnd,gnde->gbtne', xb, gate_w.astype(jnp.float32)).reshape(2, B, T, W)
    g = g + gate_b.astype(jnp.float32)[:, None, None, :]
    r = jax.nn.sigmoid(g[0])
    i = jax.nn.sigmoid(g[1])
    log_a = -LRU_C * r * jax.nn.softplus(-lam.astype(jnp.float32))
    a = jnp.exp(log_a)
    b = jnp.sqrt(-jnp.expm1(2.0 * log_a)) * (i * xf)
    return a, b


def linear_scan(a, b, h0):
    b = b.at[:, 0].add(a[:, 0] * h0)

    def combine(e1, e2):
        return e1[0] * e2[0], e2[0] * e1[1] + e2[1]

    _, h = lax.associative_scan(combine, (a, b), axis=1)
    return h


def rglru_branch(x_l, y_l, x_c, y_c, conv_w, conv_b, gate_w, gate_b, lam, need_ctx):
    x_l = dwconv_centred(x_l, conv_w, conv_b)
    x_c = dwconv_centred(x_c, conv_w, conv_b)
    h0 = jnp.zeros((x_c.shape[0], BRANCH_WIDTH), jnp.float32)
    h_l = 0.0
    h_c = 0.0
    for d in range(N_DIR):
        a_l, b_l = rglru_coeffs(x_l, gate_w[d], gate_b[d], lam[d])
        a_c, b_c = rglru_coeffs(x_c, gate_w[d], gate_b[d], lam[d])
        if d == 1:
            a_l, b_l, a_c, b_c = flip_t(a_l), flip_t(b_l), flip_t(a_c), flip_t(b_c)
        hc = linear_scan(a_c, b_c, h0)
        hl = linear_scan(a_l, b_l, hc[:, -1])
        if d == 1:
            hc, hl = flip_t(hc), flip_t(hl)
        h_l = h_l + hl
        h_c = h_c + hc
    out_l = jax.nn.gelu(y_l) * h_l.astype(y_l.dtype)
    out_c = jax.nn.gelu(y_c) * h_c.astype(y_c.dtype) if need_ctx else None
    return out_l, out_c


def gdn_chunked(q, k, v, g, beta, s0):
    B, T, H, dk = q.shape
    dv = v.shape[-1]
    C = GDN_CHUNK
    N = T // C
    f32 = jnp.float32

    def chunks(t):
        t = t.astype(f32).reshape((B, N, C, H) + t.shape[3:])
        return jnp.moveaxis(t, (1, 3), (0, 2))

    qc, kc, vc = chunks(q), chunks(k), chunks(v)
    gc = jnp.cumsum(chunks(g), axis=-1)
    bc = chunks(beta)
    idx = jnp.arange(C)
    incl = idx[:, None] >= idx[None, :]
    strict = (idx[:, None] > idx[None, :]).astype(f32)
    decay = jnp.exp(jnp.where(incl, gc[..., :, None] - gc[..., None, :], -jnp.inf))
    kb = kc * bc[..., None]
    lower = jnp.einsum('nbhid,nbhjd->nbhij', kb, kc) * decay * strict
    a_mat = lower + jnp.eye(C, dtype=f32)
    rhs = jnp.concatenate([vc * bc[..., None], kb * jnp.exp(gc)[..., None]], axis=-1)
    sol = lax.linalg.triangular_solve(a_mat, rhs, left_side=True, lower=True, unit_diagonal=True)
    u, w = sol[..., :dv], sol[..., dv:]
    attn = jnp.einsum('nbhid,nbhjd->nbhij', qc, kc) * decay
    q_dec = qc * jnp.exp(gc)[..., None]
    k_dec = kc * jnp.exp(gc[..., -1:] - gc)[..., None]
    g_end = jnp.exp(gc[..., -1])

    def step(s, xs):
        u_n, w_n, qd_n, kd_n, at_n, ge_n = xs
        v_new = u_n - jnp.einsum('bhcd,bhdv->bhcv', w_n, s)
        o_n = jnp.einsum('bhcd,bhdv->bhcv', qd_n, s) + jnp.einsum('bhij,bhjv->bhiv', at_n, v_new)
        s = s * ge_n[..., None, None] + jnp.einsum('bhcd,bhcv->bhdv', kd_n, v_new)
        return s, o_n

    s_fin, o = lax.scan(step, s0.astype(f32), (u, w, q_dec, k_dec, attn, g_end))
    o = jnp.moveaxis(o, (0, 2), (1, 3)).reshape(B, T, H, dv)
    return o, s_fin


def gdn_branch(qkv_l, z_l, b_l, a_l, qkv_c, z_c, b_c, a_c, conv_w, a_log, dt_bias, norm_g, need_ctx):
    def prep(qkv, b_raw, a_raw):
        B, T, _ = qkv.shape
        qkv = jax.nn.silu(dwconv_centred(qkv, conv_w))
        q, k, v = jnp.split(qkv, [GDN_HEADS * GDN_DK, 2 * GDN_HEADS * GDN_DK], axis=-1)
        q = l2_norm(q.reshape(B, T, GDN_HEADS, GDN_DK)) * (GDN_DK ** -0.5)
        k = l2_norm(k.reshape(B, T, GDN_HEADS, GDN_DK))
        v = v.reshape(B, T, GDN_HEADS, GDN_DV)
        b_raw = b_raw.astype(jnp.float32).reshape(B, T, N_DIR, GDN_HEADS)
        a_raw = a_raw.astype(jnp.float32).reshape(B, T, N_DIR, GDN_HEADS)
        return q, k, v, b_raw, a_raw

    def gates(b_raw, a_raw, d):
        rate = jnp.exp(a_log[d].astype(jnp.float32))
        g = -rate * jax.nn.softplus(a_raw[:, :, d] + dt_bias[d].astype(jnp.float32))
        return g, jax.nn.sigmoid(b_raw[:, :, d])

    def out(o, z):
        B, T = z.shape[:2]
        zh = z.astype(jnp.float32).reshape(B, T, GDN_HEADS, GDN_DV)
        return (rms_norm(o, norm_g) * jax.nn.silu(zh)).reshape(B, T, BRANCH_WIDTH).astype(z.dtype)

    ql, kl, vl, bl, al = prep(qkv_l, b_l, a_l)
    qc, kc, vc, bc, ac = prep(qkv_c, b_c, a_c)
    s0 = jnp.zeros((qc.shape[0], GDN_HEADS, GDN_DK, GDN_DV), jnp.float32)
    o_l = 0.0
    o_c = 0.0
    for d in range(N_DIR):
        g_l, beta_l = gates(bl, al, d)
        g_c, beta_c = gates(bc, ac, d)
        args_l = (ql, kl, vl, g_l, beta_l)
        args_c = (qc, kc, vc, g_c, beta_c)
        if d == 1:
            args_l = tuple(flip_t(t) for t in args_l)
            args_c = tuple(flip_t(t) for t in args_c)
        oc, s_ctx = gdn_chunked(*args_c, s0)
        ol, _ = gdn_chunked(*args_l, s_ctx)
        if d == 1:
            oc, ol = flip_t(oc), flip_t(ol)
        o_l = o_l + ol
        o_c = o_c + oc
    out_l = out(o_l, z_l)
    out_c = out(o_c, z_c) if need_ctx else None
    return out_l, out_c


def merge_branches(outs, gate_cols, w_branch, w_out):
    gates = jax.nn.sigmoid(gate_cols.astype(jnp.float32)).astype(gate_cols.dtype)
    gates = gates.reshape(gates.shape[:-1] + (N_BRANCH, D_MODEL))
    merged = sum(gates[..., i, :] * (outs[i] @ w_branch[i]) for i in range(N_BRANCH))
    return merged @ w_out


def sq_relu_mlp(h, w1, w2):
    return jnp.square(jax.nn.relu(h @ w1)) @ w2


def hybrid_layer(x, ctx, c_act, cctx_act, ada_w, ada_b, norm1_g, norm2_g, w_in,
                 da_q_norm_g, da_k_norm_g, da_lambda, da_sub_norm_g,
                 lru_conv_w, lru_conv_b, lru_gate_w, lru_gate_b, lru_lambda,
                 gdn_conv_w, gdn_A_log, gdn_dt_bias, gdn_norm_g,
                 w_branch, w_out, mlp_w1, mlp_w2, cos, sin, lam_init, need_ctx):
    mod_l = (c_act @ ada_w + ada_b)[:, None, :]
    mod_c = cctx_act @ ada_w + ada_b
    sh1_l, sc1_l, g1_l, sh2_l, sc2_l, g2_l = jnp.split(mod_l, N_MOD, axis=-1)
    sh1_c, sc1_c, g1_c, sh2_c, sc2_c, g2_c = jnp.split(mod_c, N_MOD, axis=-1)

    h_l = modulate(rms_norm(x, norm1_g), sh1_l, sc1_l)
    h_c = modulate(rms_norm(ctx, norm1_g), sh1_c, sc1_c)
    daq_l, dak_l, dav_l, lx_l, ly_l, gqkv_l, gz_l, gb_l, ga_l, gate_l = split_proj(h_l @ w_in)
    daq_c, dak_c, dav_c, lx_c, ly_c, gqkv_c, gz_c, gb_c, ga_c, gate_c = split_proj(h_c @ w_in)

    da_l, da_c = da_branch(daq_l, dak_l, dav_l, daq_c, dak_c, dav_c, da_q_norm_g, da_k_norm_g,
                           da_lambda, da_sub_norm_g, lam_init, cos, sin, need_ctx)
    lru_l, lru_c = rglru_branch(lx_l, ly_l, lx_c, ly_c, lru_conv_w, lru_conv_b, lru_gate_w,
                                lru_gate_b, lru_lambda, need_ctx)
    gdn_l, gdn_c = gdn_branch(gqkv_l, gz_l, gb_l, ga_l, gqkv_c, gz_c, gb_c, ga_c, gdn_conv_w,
                              gdn_A_log, gdn_dt_bias, gdn_norm_g, need_ctx)

    x = x + g1_l * merge_branches((da_l, lru_l, gdn_l), gate_l, w_branch, w_out)
    h2_l = modulate(rms_norm(x, norm2_g), sh2_l, sc2_l)
    x = x + g2_l * sq_relu_mlp(h2_l, mlp_w1, mlp_w2)
    if need_ctx:
        ctx = ctx + g1_c * merge_branches((da_c, lru_c, gdn_c), gate_c, w_branch, w_out)
        h2_c = modulate(rms_norm(ctx, norm2_g), sh2_c, sc2_c)
        ctx = ctx + g2_c * sq_relu_mlp(h2_c, mlp_w1, mlp_w2)
    return x, ctx


def setup_inputs(seed: int = 0) -> dict:
    key = jax.random.key(seed)
    ks = jax.random.split(key, 32)
    f32 = jnp.float32
    L = DEPTH

    def nrm(k, shape, scale):
        return jax.random.normal(k, shape, f32) * scale

    x = nrm(ks[0], (BATCH, SEQ, D_MODEL), 1.0)
    c = nrm(ks[1], (BATCH, D_MODEL), 1.0)
    ctx = nrm(ks[2], (BATCH, CTX_LEN, D_MODEL), 1.0)
    c_ctx = nrm(ks[3], (D_MODEL,), 1.0)
    ada_w = nrm(ks[4], (L, D_MODEL, N_MOD * D_MODEL), 0.5 * D_MODEL ** -0.5)
    ada_b = nrm(ks[5], (L, N_MOD * D_MODEL), 0.02)
    norm1_g = 1.0 + nrm(ks[6], (L, D_MODEL), 0.02)
    norm2_g = 1.0 + nrm(ks[7], (L, D_MODEL), 0.02)
    w_in = nrm(ks[8], (L, D_MODEL, N_IN), D_MODEL ** -0.5)
    da_q_norm_g = 1.0 + nrm(ks[9], (L, DA_QK_DIM), 0.02)
    da_k_norm_g = 1.0 + nrm(ks[10], (L, DA_QK_DIM), 0.02)
    da_lambda = nrm(ks[11], (L, 4, DA_QK_DIM), 0.1)
    da_sub_norm_g = 1.0 + nrm(ks[12], (L, DA_V_DIM), 0.02)
    lru_conv_w = nrm(ks[13], (L, CONV_K, BRANCH_WIDTH), CONV_K ** -0.5)
    lru_conv_b = nrm(ks[14], (L, BRANCH_WIDTH), 0.02)
    lru_gate_w = nrm(ks[15], (L, N_DIR, 2, LRU_BLOCKS, LRU_BLOCK_DIM, LRU_BLOCK_DIM), LRU_BLOCK_DIM ** -0.5)
    lru_gate_b = nrm(ks[16], (L, N_DIR, 2, BRANCH_WIDTH), 0.1)
    a0 = jax.random.uniform(ks[17], (L, N_DIR, BRANCH_WIDTH), f32, 0.9, 0.999) ** (1.0 / LRU_C)
    lru_lambda = jnp.log(a0) - jnp.log1p(-a0)
    gdn_conv_w = nrm(ks[18], (L, CONV_K, GDN_QKV_WIDTH), CONV_K ** -0.5)
    gdn_A_log = jnp.log(jax.random.uniform(ks[19], (L, N_DIR, GDN_HEADS), f32, 1.0, 16.0))
    dt = jnp.exp(jax.random.uniform(ks[20], (L, N_DIR, GDN_HEADS), f32, math.log(1e-3), math.log(1e-1)))
    gdn_dt_bias = dt + jnp.log(-jnp.expm1(-dt))
    gdn_norm_g = 1.0 + nrm(ks[21], (L, GDN_DV), 0.02)
    w_branch = nrm(ks[22], (L, N_BRANCH, BRANCH_WIDTH, D_MODEL), BRANCH_WIDTH ** -0.5)
    w_out = nrm(ks[23], (L, D_MODEL, D_MODEL), D_MODEL ** -0.5)
    mlp_w1 = nrm(ks[24], (L, D_MODEL, D_FF), D_MODEL ** -0.5)
    mlp_w2 = nrm(ks[25], (L, D_FF, D_MODEL), D_FF ** -0.5)
    return {'x': x, 'c': c, 'ctx': ctx, 'c_ctx': c_ctx, 'ada_w': ada_w, 'ada_b': ada_b,
            'norm1_g': norm1_g, 'norm2_g': norm2_g, 'w_in': w_in,
            'da_q_norm_g': da_q_norm_g, 'da_k_norm_g': da_k_norm_g, 'da_lambda': da_lambda,
            'da_sub_norm_g': da_sub_norm_g, 'lru_conv_w': lru_conv_w, 'lru_conv_b': lru_conv_b,
            'lru_gate_w': lru_gate_w, 'lru_gate_b': lru_gate_b, 'lru_lambda': lru_lambda,
            'gdn_conv_w': gdn_conv_w, 'gdn_A_log': gdn_A_log, 'gdn_dt_bias': gdn_dt_bias,
            'gdn_norm_g': gdn_norm_g, 'w_branch': w_branch, 'w_out': w_out,
            'mlp_w1': mlp_w1, 'mlp_w2': mlp_w2}


def reference(x, c, ctx, c_ctx, ada_w, ada_b, norm1_g, norm2_g, w_in,
              da_q_norm_g, da_k_norm_g, da_lambda, da_sub_norm_g,
              lru_conv_w, lru_conv_b, lru_gate_w, lru_gate_b, lru_lambda,
              gdn_conv_w, gdn_A_log, gdn_dt_bias, gdn_norm_g,
              w_branch, w_out, mlp_w1, mlp_w2):
    ROWS = x.shape[1] // GRID_W
    row = jnp.repeat(jnp.arange(ROWS, dtype=jnp.int32), GRID_W)
    col = jnp.tile(jnp.arange(GRID_W, dtype=jnp.int32), ROWS)
    cos, sin = axial_rope_tables(row, col)
    c_act = jax.nn.silu(c)
    cctx_act = jax.nn.silu(c_ctx)
    for layer in range(DEPTH):
        lam_init = 0.8 - 0.6 * math.exp(-0.3 * layer)
        x, ctx = hybrid_layer(x, ctx, c_act, cctx_act, ada_w[layer], ada_b[layer],
                              norm1_g[layer], norm2_g[layer], w_in[layer],
                              da_q_norm_g[layer], da_k_norm_g[layer], da_lambda[layer], da_sub_norm_g[layer],
                              lru_conv_w[layer], lru_conv_b[layer], lru_gate_w[layer], lru_gate_b[layer],
                              lru_lambda[layer], gdn_conv_w[layer], gdn_A_log[layer], gdn_dt_bias[layer],
                              gdn_norm_g[layer], w_branch[layer], w_out[layer], mlp_w1[layer], mlp_w2[layer],
                              cos, sin, lam_init, layer < DEPTH - 1)
    return x
```

```cpp
#include <hip/hip_runtime.h>
#include <hip/hip_cooperative_groups.h>
#include <cstdint>
#include <cstdio>
namespace cg = cooperative_groups;

#define DI __device__ __forceinline__
typedef unsigned short bf16_t;
typedef short bf16x8 __attribute__((ext_vector_type(8)));
typedef float f32x4 __attribute__((ext_vector_type(4)));
typedef float f32x2 __attribute__((ext_vector_type(2)));
typedef unsigned u32x4 __attribute__((ext_vector_type(4)));
typedef unsigned u32x2 __attribute__((ext_vector_type(2)));
typedef __bf16 bf16x2_t __attribute__((ext_vector_type(2)));

constexpr int DM = 1024, NB = 4, TL = 8192, TC = 256, TT = 8448, MR = NB * TT;
constexpr int LDP = 4736;
constexpr int C_DAQ = 0, C_DAK = 512, C_DAV = 1024, C_LX = 1536, C_LY = 2048, C_GQKV = 2560, C_GZ = 4096, C_GBA = 4608;
constexpr int NCH = 132;
constexpr float EPS = 1e-6f;
constexpr int LDS_BYTES = 77824;

constexpr size_t al256(size_t x) { return (x + 255) & ~(size_t)255; }
constexpr size_t OFF_WIN = 0;
constexpr size_t OFF_WBR = OFF_WIN + al256((size_t)7808 * 1024 * 2);
constexpr size_t OFF_WO = OFF_WBR + al256((size_t)3 * 1024 * 512 * 2);
constexpr size_t OFF_W1 = OFF_WO + al256((size_t)1024 * 1024 * 2);
constexpr size_t OFF_W2 = OFF_W1 + al256((size_t)4096 * 1024 * 2);
constexpr size_t OFF_LG = OFF_W2 + al256((size_t)4096 * 1024 * 2);
constexpr size_t OFF_P = OFF_LG + al256((size_t)32 * 4096 * 2);
constexpr size_t OFF_H = OFF_P + al256((size_t)MR * LDP * 2);
constexpr size_t OFF_VT = OFF_H + al256((size_t)MR * 1024 * 2);
constexpr size_t OFF_OB = OFF_VT + al256((size_t)MR * 512 * 2);
constexpr size_t OFF_HALO = OFF_OB + al256((size_t)MR * 512 * 2);
constexpr size_t OFF_GBA = OFF_HALO + al256((size_t)528 * 3 * 1536 * 2);
constexpr size_t OFF_GSC = OFF_GBA + al256((size_t)MR * 16 * 4);
constexpr size_t OFF_LC = OFF_GSC + al256((size_t)4224 * 192 * 4);
constexpr size_t OFF_CTX = OFF_LC + al256((size_t)4 * NCH * 8 * 2 * 64 * 8);
constexpr size_t OFF_MOD = OFF_CTX + al256((size_t)4 * 256 * 1024 * 4);
constexpr size_t OFF_ROPE = OFF_MOD + al256((size_t)2 * 5 * 6144 * 4);
constexpr size_t OFF_CTR = OFF_ROPE + al256((size_t)8192 * 32 * 8);
constexpr size_t WS_TOTAL = OFF_CTR + 256 + 16384;
static_assert(WS_TOTAL <= (size_t)536870912, "workspace map too large");

struct Params {
  const float *x, *c, *ctx, *cctx, *ada_w, *ada_b, *n1g, *n2g, *w_in, *daqg, *dakg, *dalam, *dasub, *lcw, *lcb, *lgw, *lgb, *llam,
      *gcw, *galog, *gdtb, *gng, *wbr, *wout, *w1, *w2;
  float* out;
  char* ws;
  int probe;
  int pad_;
};

DI unsigned pk2(float lo, float hi) { f32x2 v = {lo, hi}; bf16x2_t b = __builtin_convertvector(v, bf16x2_t); return __builtin_bit_cast(unsigned, b); }
DI bf16_t f2bf(float f) { return (bf16_t)(pk2(f, 0.f) & 0xffffu); }
DI float bf2f(bf16_t u) { return __uint_as_float(((unsigned)u) << 16); }
DI float bflo(unsigned w) { return __uint_as_float(w << 16); }
DI float bfhi(unsigned w) { return __uint_as_float(w & 0xffff0000u); }
DI int otid() { int t = __builtin_amdgcn_workitem_id_x(); asm volatile("" : "+v"(t)); return t; }
template <int M> DI float shx(float v) { return __int_as_float(__builtin_amdgcn_ds_swizzle(__float_as_int(v), (M << 10) | 0x1f)); }
DI float add32(float v) { auto r = __builtin_amdgcn_permlane32_swap(__float_as_uint(v), __float_as_uint(v), false, false); return __uint_as_float(r[0]) + __uint_as_float(r[1]); }
DI float max32(float v) { auto r = __builtin_amdgcn_permlane32_swap(__float_as_uint(v), __float_as_uint(v), false, false); return fmaxf(__uint_as_float(r[0]), __uint_as_float(r[1])); }
DI float wsum(float v) { v += shx<1>(v); v += shx<2>(v); v += shx<4>(v); v += shx<8>(v); v += shx<16>(v); return add32(v); }
DI float wmax(float v) { v = fmaxf(v, shx<1>(v)); v = fmaxf(v, shx<2>(v)); v = fmaxf(v, shx<4>(v)); v = fmaxf(v, shx<8>(v)); v = fmaxf(v, shx<16>(v)); return max32(v); }
DI float sigm(float x) { return 1.f / (1.f + __expf(-x)); }
DI float softplusf(float x) { return x > 20.f ? x : log1pf(expf(x)); }
DI f32x4 mfma16(bf16x8 a, bf16x8 b, f32x4 c) { return __builtin_amdgcn_mfma_f32_16x16x32_bf16(a, b, c, 0, 0, 0); }

DI const float* res_in_row(const Params& p, int layer, int r) {
  const int b = r / TT, s = r % TT;
  if (layer == 0) return s < TC ? p.ctx + ((size_t)b * TC + s) * DM : p.x + ((size_t)b * TL + (s - TC)) * DM;
  return s < TC ? (const float*)(p.ws + OFF_CTX) + ((size_t)b * TC + s) * DM : p.out + ((size_t)b * TL + (s - TC)) * DM;
}
DI float* res_out_row(const Params& p, int r) {
  const int b = r / TT, s = r % TT;
  return s < TC ? (float*)(p.ws + OFF_CTX) + ((size_t)b * TC + s) * DM : p.out + ((size_t)b * TL + (s - TC)) * DM;
}
DI const float* mod_vec(const Params& p, int layer, int r) {
  const int b = r / TT, s = r % TT;
  return (const float*)(p.ws + OFF_MOD) + (size_t)(layer * 5 + (s < TC ? 4 : b)) * 6144;
}

template <int WN>
DI void gemm_core(const bf16_t* __restrict__ A, int lda, int a_ks, const bf16_t* __restrict__ Bt, int ldb, int b_ks, int K, f32x4 (&acc)[4][WN], char* lds) {
  constexpr int BN = 32 * WN, AST = 72, NBP = BN * 8 / 256;
  bf16_t* As = (bf16_t*)lds;
  bf16_t* Bs = As + 2 * 128 * AST;
  const int tid = otid(), lane = tid & 63, wid = tid >> 6, wr = wid >> 1, wc = wid & 1;
  u32x4 ra[4], rb[NBP];
  const int nk = K / 64;
#define GLOAD(k0)                                                                                                            \
  {                                                                                                                          \
    _Pragma("unroll") for (int i = 0; i < 4; ++i) { const int q = tid + 256 * i; ra[i] = *(const u32x4*)(A + (size_t)(q >> 3) * lda + (size_t)(((k0) >> 5) + ((q & 7) >> 2)) * a_ks + (q & 3) * 8); } \
    _Pragma("unroll") for (int i = 0; i < NBP; ++i) { const int q = tid + 256 * i; rb[i] = *(const u32x4*)(Bt + (size_t)(q >> 3) * ldb + (size_t)(((k0) >> 5) + ((q & 7) >> 2)) * b_ks + (q & 3) * 8); } \
  }
#define SSTORE(buf)                                                                                                          \
  {                                                                                                                          \
    _Pragma("unroll") for (int i = 0; i < 4; ++i) { const int q = tid + 256 * i; *(u32x4*)(As + ((buf) * 128 + (q >> 3)) * AST + (q & 7) * 8) = ra[i]; } \
    _Pragma("unroll") for (int i = 0; i < NBP; ++i) { const int q = tid + 256 * i; *(u32x4*)(Bs + ((buf) * BN + (q >> 3)) * AST + (q & 7) * 8) = rb[i]; } \
  }
  GLOAD(0);
  SSTORE(0);
  __syncthreads();
  for (int t = 0; t < nk; ++t) {
    if (t + 1 < nk) GLOAD((t + 1) * 64);
    const bf16_t* a = As + ((t & 1) * 128 + wr * 64 + (lane & 15)) * AST + (lane >> 4) * 8;
    const bf16_t* b = Bs + ((t & 1) * BN + wc * 16 * WN + (lane & 15)) * AST + (lane >> 4) * 8;
#pragma unroll
    for (int ks = 0; ks < 2; ++ks) {
      bf16x8 af[4], bfr[WN];
#pragma unroll
      for (int i = 0; i < 4; ++i) af[i] = *(const bf16x8*)(a + i * 16 * AST + ks * 32);
#pragma unroll
      for (int j = 0; j < WN; ++j) bfr[j] = *(const bf16x8*)(b + j * 16 * AST + ks * 32);
      __builtin_amdgcn_sched_barrier(0);
#pragma unroll
      for (int i = 0; i < 4; ++i)
#pragma unroll
        for (int j = 0; j < WN; ++j) acc[i][j] = mfma16(bfr[j], af[i], acc[i][j]);
      __builtin_amdgcn_sched_barrier(0);
    }
    if (t + 1 < nk) SSTORE((t + 1) & 1);
    __syncthreads();
  }
#undef GLOAD
#undef SSTORE
}
DI void tile_mn(int t, int nm, int nn, int& mi, int& ni) {
  const int nig = 16 * nn, g = t / nig, rem = t % nig, fm = g * 16;
  const int gsz = (nm - fm) < 16 ? (nm - fm) : 16;
  mi = fm + rem % gsz;
  ni = rem / gsz;
}
template <int WN, class Epi>
DI void gemm_emit(const f32x4 (&acc)[4][WN], int m0, int n0, Epi epi) {
  const int lane = otid() & 63, wid = otid() >> 6, wr = wid >> 1, wc = wid & 1;
#pragma unroll
  for (int i = 0; i < 4; ++i)
#pragma unroll
    for (int j = 0; j < WN; ++j) epi(m0 + wr * 64 + i * 16 + (lane & 15), n0 + wc * 16 * WN + j * 16 + (lane >> 4) * 4, acc[i][j]);
}
template <int WN>
DI void zero_acc(f32x4 (&acc)[4][WN]) {
#pragma unroll
  for (int i = 0; i < 4; ++i)
#pragma unroll
    for (int j = 0; j < WN; ++j) acc[i][j] = (f32x4){0.f, 0.f, 0.f, 0.f};
}

DI void gemm_core2(const bf16_t* __restrict__ A, int lda, int a_ks, const bf16_t* __restrict__ Bt, int ldb, int b_ks, int K, f32x4 (&acc)[8][4], char* lds) {
  constexpr int AST = 48;
  bf16_t* As = (bf16_t*)lds;
  bf16_t* Bs = As + 2 * 256 * AST;
  const int tid = otid(), lane = tid & 63, wid = tid >> 6, wr = wid >> 1, wc = wid & 1;
  u32x4 s0a[4], s0b[2], s1a[4], s1b[2];
  const int nk = K / 32;
  const bf16_t* ag = A + (size_t)(tid >> 2) * lda + (tid & 3) * 8;
  const bf16_t* bg = Bt + (size_t)(tid >> 2) * ldb + (tid & 3) * 8;
  const int bc_ = tid >> 2, brow = ((bc_ >> 5) * 2 + ((bc_ >> 2) & 1)) * 16 + ((bc_ >> 3) & 3) * 4 + (bc_ & 3);
#define LBAR() { asm volatile("s_waitcnt lgkmcnt(0)" ::: "memory"); __builtin_amdgcn_s_barrier(); asm volatile("" ::: "memory"); }
#define GLOAD2(ra, rb, k0)                                                                                                   \
  {                                                                                                                          \
    _Pragma("unroll") for (int i = 0; i < 4; ++i) ra[i] = *(const u32x4*)(ag + (size_t)(64 * i) * lda + (size_t)((k0) >> 5) * a_ks);               \
    _Pragma("unroll") for (int i = 0; i < 2; ++i) rb[i] = *(const u32x4*)(bg + (size_t)(64 * i) * ldb + (size_t)((k0) >> 5) * b_ks);               \
  }
#define SSTORE2(ra, rb, buf)                                                                                                 \
  {                                                                                                                          \
    _Pragma("unroll") for (int i = 0; i < 4; ++i) *(u32x4*)(As + ((buf) * 256 + 64 * i + (tid >> 2)) * AST + (tid & 3) * 8) = ra[i]; \
    _Pragma("unroll") for (int i = 0; i < 2; ++i) *(u32x4*)(Bs + ((buf) * 128 + 64 * i + brow) * AST + (tid & 3) * 8) = rb[i]; \
  }
#define STEP2(t, la, lb, sa, sb)                                                                                             \
  {                                                                                                                          \
    if ((t) + 2 < nk) GLOAD2(la, lb, ((t) + 2) * 32);                                                                        \
    const bf16_t* a = As + (((t) & 1) * 256 + wr * 128 + (lane & 15)) * AST + (lane >> 4) * 8;                               \
    const bf16_t* b = Bs + (((t) & 1) * 128 + wc * 64 + (lane & 15)) * AST + (lane >> 4) * 8;                                \
    bf16x8 bfr[4], a0[4], a1[4];                                                                                             \
    _Pragma("unroll") for (int j = 0; j < 4; ++j) bfr[j] = *(const bf16x8*)(b + j * 16 * AST);                               \
    _Pragma("unroll") for (int i = 0; i < 4; ++i) a0[i] = *(const bf16x8*)(a + i * 16 * AST);                                \
    __builtin_amdgcn_sched_barrier(0);                                                                                       \
    _Pragma("unroll") for (int i = 0; i < 4; ++i) a1[i] = *(const bf16x8*)(a + (4 + i) * 16 * AST);                          \
    __builtin_amdgcn_sched_barrier(0);                                                                                       \
    _Pragma("unroll") for (int i = 0; i < 4; ++i) _Pragma("unroll") for (int j = 0; j < 4; ++j) acc[i][j] = mfma16(bfr[j], a0[i], acc[i][j]); \
    __builtin_amdgcn_sched_barrier(0);                                                                                       \
    _Pragma("unroll") for (int i = 0; i < 4; ++i) _Pragma("unroll") for (int j = 0; j < 4; ++j) acc[4 + i][j] = mfma16(bfr[j], a1[i], acc[4 + i][j]); \
    __builtin_amdgcn_sched_barrier(0);                                                                                       \
    if ((t) + 1 < nk) SSTORE2(sa, sb, ((t) + 1) & 1);                                                                        \
    LBAR();                                                                                                                  \
  }
  GLOAD2(s0a, s0b, 0);
  SSTORE2(s0a, s0b, 0);
  GLOAD2(s1a, s1b, 32);
  LBAR();
  int t = 0;
  for (;;) {
    STEP2(t, s0a, s0b, s1a, s1b);
    if (++t >= nk) break;
    STEP2(t, s1a, s1b, s0a, s0b);
    if (++t >= nk) break;
  }
#undef GLOAD2
#undef SSTORE2
#undef STEP2
}
DI void tile_mn8(int t, int nm, int nn, int& mi, int& ni) {
  const int nig = 8 * nn, g = t / nig, rem = t % nig, fm = g * 8;
  const int gsz = (nm - fm) < 8 ? (nm - fm) : 8;
  mi = fm + rem % gsz;
  ni = rem / gsz;
}
template <class Epi, class Epi8>
DI void gemm_phase(const bf16_t* A, int lda, int a_ks, const bf16_t* Bt, int ldb, int b_ks, int K, int nm, int nn, char* lds, int B, int G, Epi epi, Epi8 epi8, bool skipctx = false) {
  if (skipctx) nm -= 4;
  const int NT = nm * nn;
  int nfull = (NT / G) * G, R = NT - nfull;
  if (4 * R > 2 * G) { nfull = NT; R = 0; }
  for (int t = B; t < nfull + 4 * R; t += G) {
    int mi, ni;
    if (t < nfull) {
      tile_mn8(t, nm, nn, mi, ni);
      if (skipctx) mi += (mi >> 5) + 1;
      f32x4 acc[8][4];
#pragma unroll
      for (int i = 0; i < 8; ++i)
#pragma unroll
        for (int j = 0; j < 4; ++j) acc[i][j] = (f32x4){0.f, 0.f, 0.f, 0.f};
      gemm_core2(A + (size_t)mi * 256 * lda, lda, a_ks, Bt + (size_t)ni * 128 * ldb, ldb, b_ks, K, acc, lds);
      const int lane = otid() & 63, wid = otid() >> 6, wr = wid >> 1, wc = wid & 1;
#pragma unroll
      for (int i = 0; i < 8; ++i)
#pragma unroll
        for (int jp = 0; jp < 2; ++jp) epi8(mi * 256 + wr * 128 + i * 16 + (lane & 15), ni * 128 + wc * 64 + jp * 32 + (lane >> 4) * 8, acc[i][2 * jp], acc[i][2 * jp + 1]);
    } else {
      const int u = t - nfull, sub = u & 3;
      tile_mn8(nfull + (u >> 2), nm, nn, mi, ni);
      if (skipctx) mi += (mi >> 5) + 1;
      const int m0 = mi * 256 + (sub >> 1) * 128, n0 = ni * 128 + (sub & 1) * 64;
      f32x4 acc[4][2]; zero_acc<2>(acc);
      gemm_core<2>(A + (size_t)m0 * lda, lda, a_ks, Bt + (size_t)n0 * ldb, ldb, b_ks, K, acc, lds);
      gemm_emit<2>(acc, m0, n0, epi);
    }
  }
}
DI int sg_col(int gc) { const int j = gc >> 7; return (j < 12 ? 512 + 128 * j : 2560 + 128 * (j - 12)) + (gc & 127); }

constexpr int N_CVT = 1152 + 32 + 768 + 384 + 256 + 1024 + 1024 + 32;
DI void job_cvt(const Params& p, int layer, int t, char* lds) {
  const float* src; int ld, ncol0 = 0, nlim, K, ntot, nrow0 = 0; bf16_t* dst;
  char* ws = p.ws;
  if (t < 1152) { src = p.w_in + (size_t)layer * 1024 * 7696; ld = 7696; ncol0 = 0; nlim = 4608; dst = (bf16_t*)(ws + OFF_WIN); K = 1024; ntot = 7808; nrow0 = 0; }
  else if ((t -= 1152) < 32) { src = p.w_in + (size_t)layer * 1024 * 7696; ld = 7696; ncol0 = 4608; nlim = 4624; dst = (bf16_t*)(ws + OFF_WIN); K = 1024; ntot = 7808; nrow0 = 4608; }
  else if ((t -= 32) < 768) { src = p.w_in + (size_t)layer * 1024 * 7696; ld = 7696; ncol0 = 4624; nlim = 7696; dst = (bf16_t*)(ws + OFF_WIN); K = 1024; ntot = 7808; nrow0 = 4736; }
  else if ((t -= 768) < 384) { const int i = t / 128; t %= 128; src = p.wbr + ((size_t)layer * 3 + i) * 512 * 1024; ld = 1024; nlim = 1024; dst = (bf16_t*)(ws + OFF_WBR) + (size_t)i * 1024 * 512; K = 512; ntot = 1024; }
  else if ((t -= 384) < 256) { src = p.wout + (size_t)layer * 1024 * 1024; ld = 1024; nlim = 1024; dst = (bf16_t*)(ws + OFF_WO); K = 1024; ntot = 1024; }
  else if ((t -= 256) < 1024) { src = p.w1 + (size_t)layer * 1024 * 4096; ld = 4096; nlim = 4096; dst = (bf16_t*)(ws + OFF_W1); K = 1024; ntot = 4096; }
  else if ((t -= 1024) < 1024) { src = p.w2 + (size_t)layer * 4096 * 1024; ld = 1024; nlim = 1024; dst = (bf16_t*)(ws + OFF_W2); K = 4096; ntot = 1024; }
  else { t -= 1024; src = p.lgw + ((size_t)layer * 32 + t) * 4096; ld = 64; nlim = 64; dst = (bf16_t*)(ws + OFF_LG) + (size_t)t * 4096; K = 64; ntot = 0; t = 0; }
  const int nkt = K / 64, nt = t / nkt, kt = t % nkt;
  float* tl = (float*)lds;
  const int tid = otid();
  {
    const int nn = tid & 63, ncol = ncol0 + nt * 64 + nn;
#pragma unroll
    for (int i = 0; i < 16; ++i) {
      const int kk = i * 4 + (tid >> 6);
      tl[kk * 65 + nn] = (ncol < nlim) ? src[(size_t)(kt * 64 + kk) * ld + ncol] : 0.f;
    }
  }
  __syncthreads();
  {
    const int n = tid >> 2, kq = tid & 3;
    float v[16];
#pragma unroll
    for (int e = 0; e < 16; ++e) v[e] = tl[(kq * 16 + e) * 65 + n];
    u32x4 w0 = {pk2(v[0], v[1]), pk2(v[2], v[3]), pk2(v[4], v[5]), pk2(v[6], v[7])};
    u32x4 w1 = {pk2(v[8], v[9]), pk2(v[10], v[11]), pk2(v[12], v[13]), pk2(v[14], v[15])};
    const int nd = nrow0 + nt * 64 + n, kd = kt * 64 + kq * 16;
    bf16_t* d = ntot ? dst + ((size_t)(kd >> 5) * ntot + nd) * 32 + (kd & 31) : dst + (size_t)nd * K + kd;
    *(u32x4*)d = w0;
    *(u32x4*)(d + 8) = w1;
  }
  __syncthreads();
}
DI void job_mod(const Params& p, int it, char* lds) {
  const int nc = it % 96, l = it / 96, tid = otid();
  float* sc = (float*)lds;
  float* red = sc + 5 * 1024;
  for (int i = tid; i < 5 * 1024; i += 256) {
    const int v = i >> 10, k = i & 1023;
    const float cv = v < 4 ? p.c[v * 1024 + k] : p.cctx[k];
    sc[i] = cv * sigm(cv);
  }
  __syncthreads();
  const int col = tid & 63, kg = tid >> 6, n = nc * 64 + col;
  const float* w = p.ada_w + ((size_t)l * 1024 + kg * 256) * 6144 + n;
  const float* s0 = sc + kg * 256;
  float a0 = 0, a1 = 0, a2 = 0, a3 = 0, a4 = 0;
#pragma unroll 8
  for (int k = 0; k < 256; ++k) {
    const float wv = w[(size_t)k * 6144];
    a0 += s0[k] * wv; a1 += s0[1024 + k] * wv; a2 += s0[2048 + k] * wv; a3 += s0[3072 + k] * wv; a4 += s0[4096 + k] * wv;
  }
  red[(kg * 5 + 0) * 64 + col] = a0; red[(kg * 5 + 1) * 64 + col] = a1; red[(kg * 5 + 2) * 64 + col] = a2; red[(kg * 5 + 3) * 64 + col] = a3; red[(kg * 5 + 4) * 64 + col] = a4;
  __syncthreads();
  for (int i = tid; i < 320; i += 256) {
    const int v = i >> 6, cc = i & 63;
    const float r = ((red[(0 * 5 + v) * 64 + cc] + red[(1 * 5 + v) * 64 + cc]) + (red[(2 * 5 + v) * 64 + cc] + red[(3 * 5 + v) * 64 + cc])) + p.ada_b[l * 6144 + nc * 64 + cc];
    ((float*)(p.ws + OFF_MOD))[(size_t)(l * 5 + v) * 6144 + nc * 64 + cc] = r;
  }
  __syncthreads();
}
DI void job_rope(const Params& p, int it) {
  const int idx = it * 256 + otid(), t = idx >> 5, ax = (idx >> 4) & 1, f = idx & 15;
  const float inv = powf(10000.f, -(float)f / 16.f);
  const float pos = (float)(ax ? (t & 63) : (t >> 6));
  float s, c;
  sincosf(pos * inv, &s, &c);
  ((f32x2*)(p.ws + OFF_ROPE))[idx] = (f32x2){c, s};
}
DI void job_norm(const Params& p, int layer, int which, int it) {
  const int lane = otid() & 63, wid = otid() >> 6, r = it * 8 + wid;
  const float* xr0 = (which == 1) ? res_in_row(p, layer, r) : (const float*)res_out_row(p, r);
  const float* xr1 = (which == 1) ? res_in_row(p, layer, r + 4) : (const float*)res_out_row(p, r + 4);
  const float* mv = mod_vec(p, layer, r);
  const float* sh = mv + (which == 1 ? 0 : 3072);
  const float* sc = mv + (which == 1 ? 1024 : 4096);
  const float* g = (which == 1 ? p.n1g : p.n2g) + layer * 1024;
  f32x4 xa[4], xb[4];
#pragma unroll
  for (int i = 0; i < 4; ++i) { xa[i] = *(const f32x4*)(xr0 + i * 256 + lane * 4); xb[i] = *(const f32x4*)(xr1 + i * 256 + lane * 4); }
  float sa = 0.f, sb = 0.f;
#pragma unroll
  for (int i = 0; i < 4; ++i) {
    sa += xa[i][0] * xa[i][0] + xa[i][1] * xa[i][1] + xa[i][2] * xa[i][2] + xa[i][3] * xa[i][3];
    sb += xb[i][0] * xb[i][0] + xb[i][1] * xb[i][1] + xb[i][2] * xb[i][2] + xb[i][3] * xb[i][3];
  }
  sa = wsum(sa); sb = wsum(sb);
  const float ra = rsqrtf(sa * (1.f / 1024.f) + EPS), rb = rsqrtf(sb * (1.f / 1024.f) + EPS);
  bf16_t* H0 = (bf16_t*)(p.ws + OFF_H) + (size_t)r * 32;
  bf16_t* H1 = H0 + 4 * 32;
#pragma unroll
  for (int i = 0; i < 4; ++i) {
    const int c = i * 256 + lane * 4;
    const f32x4 gv = *(const f32x4*)(g + c), sv = *(const f32x4*)(sc + c), hv = *(const f32x4*)(sh + c);
    float o[4], q[4];
#pragma unroll
    for (int e = 0; e < 4; ++e) { const float m = gv[e] * (1.f + sv[e]); o[e] = xa[i][e] * ra * m + hv[e]; q[e] = xb[i][e] * rb * m + hv[e]; }
    const size_t so = (size_t)(c >> 5) * MR * 32 + (c & 31);
    *(u32x2*)(H0 + so) = (u32x2){pk2(o[0], o[1]), pk2(o[2], o[3])};
    *(u32x2*)(H1 + so) = (u32x2){pk2(q[0], q[1]), pk2(q[2], q[3])};
  }
}

DI void job_daprep1(const Params& p, int layer, int r, bool dup) {
  const int lane = otid() & 63, s = r % TT;
  const int G = lane >> 2, quarter = lane & 3;
  bf16_t* ptr = (bf16_t*)(p.ws + OFF_P) + (size_t)r * LDP + (G < 8 ? C_DAQ + G * 64 : C_DAK + (G - 8) * 64) + quarter * 16;
  const u32x4 w0 = *(const u32x4*)ptr, w1 = *(const u32x4*)(ptr + 8);
  float y[16];
#pragma unroll
  for (int e = 0; e < 4; ++e) { y[2 * e] = bflo(w0[e]); y[2 * e + 1] = bfhi(w0[e]); y[8 + 2 * e] = bflo(w1[e]); y[9 + 2 * e] = bfhi(w1[e]); }
  float ss = 0.f;
#pragma unroll
  for (int e = 0; e < 16; ++e) ss += y[e] * y[e];
  ss += shx<1>(ss);
  ss += shx<2>(ss);
  float rstd = rsqrtf(ss * (1.f / 64.f) + EPS);
  const float* g = (G < 8 ? p.daqg : p.dakg) + layer * 64 + quarter * 16;
#pragma unroll
  for (int e = 0; e < 16; ++e) y[e] = y[e] * rstd * g[e];
  if (s >= TC) {
    const f32x2* tb = (const f32x2*)(p.ws + OFF_ROPE) + ((size_t)(s - TC) * 2 + (quarter >> 1)) * 16;
#pragma unroll
    for (int e = 0; e < 16; ++e) {
      const float yp = shx<1>(y[e]);
      const f32x2 cs = tb[e];
      y[e] = (quarter & 1) ? (y[e] * cs.x + yp * cs.y) : (y[e] * cs.x - yp * cs.y);
    }
  }
  if (G < 8) {
#pragma unroll
    for (int e = 0; e < 16; ++e) y[e] *= 0.125f * 1.4426950408889634f;
  }
  if (dup) return;
  *(u32x4*)ptr = (u32x4){pk2(y[0], y[1]), pk2(y[2], y[3]), pk2(y[4], y[5]), pk2(y[6], y[7])};
  *(u32x4*)(ptr + 8) = (u32x4){pk2(y[8], y[9]), pk2(y[10], y[11]), pk2(y[12], y[13]), pk2(y[14], y[15])};
}
DI void job_daprep(const Params& p, int layer, int it, bool dup) {
  const int wid = otid() >> 6;
#pragma unroll
  for (int rr = 0; rr < 2; ++rr) job_daprep1(p, layer, it * 8 + rr * 4 + wid, dup);
}
DI void job_vt(const Params& p, int it, char* lds) {
  const int h = it & 3, c = (it >> 2) % NCH, b = it / (4 * NCH), tid = otid();
  bf16_t* tl = (bf16_t*)lds;
  const bf16_t* P = (const bf16_t*)(p.ws + OFF_P);
#pragma unroll
  for (int i = 0; i < 4; ++i) {
    const int q = tid + 256 * i, row = q >> 4, pc = q & 15;
    const u32x4 w = *(const u32x4*)(P + (size_t)(b * TT + c * 64 + row) * LDP + C_DAV + h * 128 + pc * 8);
    unsigned* d = (unsigned*)(tl + row * 130 + pc * 8);
    d[0] = w[0]; d[1] = w[1]; d[2] = w[2]; d[3] = w[3];
  }
  __syncthreads();
  {
    const int dv = tid >> 1, half = tid & 1;
    unsigned o[16];
#pragma unroll
    for (int e = 0; e < 16; ++e) o[e] = (unsigned)tl[(half * 32 + 2 * e) * 130 + dv] | ((unsigned)tl[(half * 32 + 2 * e + 1) * 130 + dv] << 16);
    bf16_t* d = (bf16_t*)(p.ws + OFF_VT) + ((size_t)(b * 4 + h) * 128 + dv) * TT + c * 64 + half * 32;
#pragma unroll
#define VTW(w) o[(((w) & 3) >> 1) * 8 + ((w) >> 2) * 2 + ((w) & 1)]
    for (int e = 0; e < 4; ++e) *(u32x4*)(d + e * 8) = (u32x4){VTW(4 * e), VTW(4 * e + 1), VTW(4 * e + 2), VTW(4 * e + 3)};
#undef VTW
  }
  __syncthreads();
}

constexpr int N_ATT = 1056;
DI void job_attn(const Params& p, int layer, int a, char* lds, bool dup) {
  const int tid = otid(), lane = tid & 63, wid = tid >> 6, l15 = lane & 15, g = lane >> 4;
  const int grp = a / 528, within = a % 528, bh = grp * 8 + (within & 7), qb = within >> 3, b = bh >> 2, h = bh & 3;
  if (layer == 1 && qb < 2) return;
  const int nt = qb < 2 ? 4 : NCH;
  bf16_t* P = (bf16_t*)(p.ws + OFF_P);
  const bf16_t* VT = (const bf16_t*)(p.ws + OFF_VT) + (size_t)(b * 4 + h) * 128 * TT;
  int ly_ = layer; asm volatile("" : "+s"(ly_));
  const float lam_init = __uint_as_float(ly_ == 0 ? 0x3e4ccccdu : 0x3eb60549u);
  const float* lv = p.dalam + layer * 256;
  const float lam = __uint_as_float(__builtin_amdgcn_readfirstlane(__float_as_uint(expf(wsum(lv[lane] * lv[64 + lane])) - expf(wsum(lv[128 + lane] * lv[192 + lane])) + lam_init)));
  const float mq = wmax(fabsf(p.daqg[layer * 64 + lane])), mk = wmax(fabsf(p.dakg[layer * 64 + lane]));
  const float negMb = __uint_as_float(__builtin_amdgcn_readfirstlane(__float_as_uint(-(8.f * mq * mk * 1.03f * 1.4426950408889634f + 0.5f))));
  const int r0 = b * TT + qb * 128 + wid * 32;
  bf16x8 qf[2][2][2];
#pragma unroll
  for (int c = 0; c < 2; ++c)
#pragma unroll
    for (int i = 0; i < 2; ++i)
#pragma unroll
      for (int ks = 0; ks < 2; ++ks) qf[c][i][ks] = *(const bf16x8*)(P + (size_t)(r0 + i * 16 + l15) * LDP + C_DAQ + h * 128 + c * 64 + ks * 32 + g * 8);
  bf16_t* Ks = (bf16_t*)lds;
  bf16_t* Vs = Ks + 2 * 64 * 144;
  u32x4 rk[4], rv[4];
  const bf16_t* kg = P + (size_t)(b * TT) * LDP + C_DAK + h * 128;
#define KLOAD(t) { _Pragma("unroll") for (int i = 0; i < 4; ++i) { const int q = tid + 256 * i; rk[i] = *(const u32x4*)(kg + (size_t)((t) * 64 + (q >> 4)) * LDP + (q & 15) * 8); } }
#define VLOAD(t) { _Pragma("unroll") for (int i = 0; i < 4; ++i) { const int q = tid + 256 * i; rv[i] = *(const u32x4*)(VT + (size_t)(q >> 3) * TT + (t) * 64 + (q & 7) * 8); } }
#define KSTORE(buf) { _Pragma("unroll") for (int i = 0; i < 4; ++i) { const int q = tid + 256 * i; *(u32x4*)(Ks + ((buf) * 64 + (q >> 4)) * 144 + (q & 15) * 8) = rk[i]; } }
#define VSTORE(buf) { _Pragma("unroll") for (int i = 0; i < 4; ++i) { const int q = tid + 256 * i; *(u32x4*)(Vs + ((buf) * 128 + (q >> 3)) * 80 + (q & 7) * 8) = rv[i]; } }
#define QK_INTO(S, Kb, half, CI)                                                                                       \
  _Pragma("unroll") for (int c = 0; c < 2; ++c) {                                                                      \
    bf16x8 kf[2][2];                                                                                                   \
    _Pragma("unroll") for (int k2 = 0; k2 < 2; ++k2) _Pragma("unroll") for (int ks = 0; ks < 2; ++ks)                  \
      kf[k2][ks] = *(const bf16x8*)((Kb) + ((half) * 32 + k2 * 16 + l15) * 144 + c * 64 + ks * 32 + g * 8);             \
    __builtin_amdgcn_sched_barrier(0);                                                                                 \
    _Pragma("unroll") for (int k2 = 0; k2 < 2; ++k2) _Pragma("unroll") for (int i = 0; i < 2; ++i) {                   \
      S[c][i][k2] = mfma16(kf[k2][0], qf[c][i][0], CI(c, i));     \
      S[c][i][k2] = mfma16(kf[k2][1], qf[c][i][1], S[c][i][k2]); }                                                     \
  }                                                                                                                    \
  __builtin_amdgcn_sched_barrier(0);
#define EXPSUM(S)                                                                                                      \
  _Pragma("unroll") for (int c = 0; c < 2; ++c) _Pragma("unroll") for (int i = 0; i < 2; ++i) {                        \
    _Pragma("unroll") for (int k2 = 0; k2 < 2; ++k2) _Pragma("unroll") for (int e = 0; e < 4; ++e) S[c][i][k2][e] = __builtin_amdgcn_exp2f(S[c][i][k2][e]); \
    lsum[c][i] += ((S[c][i][0][0] + S[c][i][0][1]) + (S[c][i][0][2] + S[c][i][0][3])) + ((S[c][i][1][0] + S[c][i][1][1]) + (S[c][i][1][2] + S[c][i][1][3])); }
#define EXP_S() _Pragma("unroll") for (int c = 0; c < 2; ++c) _Pragma("unroll") for (int i = 0; i < 2; ++i) _Pragma("unroll") for (int k2 = 0; k2 < 2; ++k2) _Pragma("unroll") for (int e = 0; e < 4; ++e) S[c][i][k2][e] = __builtin_amdgcn_exp2f(S[c][i][k2][e]);
  float lsum[2][2] = {{0.f, 0.f}, {0.f, 0.f}};
  KLOAD(0);
  KSTORE(0);
  __syncthreads();
  const f32x4 negMv = {negMb, negMb, negMb, negMb};
#define CI1(c, i) negMv
  f32x4 SA[2][2][2], SB[2][2][2];
#pragma unroll 1
  for (int t = 0; t < nt; ++t) {
    if (t + 1 < nt) KLOAD(t + 1);
    const bf16_t* Kb = Ks + (t & 1) * 64 * 144;
    QK_INTO(SA, Kb, 0, CI1)
    if (t > 0) { EXPSUM(SB) }
    __builtin_amdgcn_sched_barrier(0);
    QK_INTO(SB, Kb, 1, CI1)
    EXPSUM(SA)
    if (t + 1 < nt) KSTORE((t + 1) & 1);
    __syncthreads();
  }
  EXPSUM(SB)
  f32x4 ci2[2][2];
#pragma unroll
  for (int i = 0; i < 2; ++i) {
    float l0 = lsum[0][i], l1 = lsum[1][i];
    l0 += shx<16>(l0); l0 = add32(l0);
    l1 += shx<16>(l1); l1 = add32(l1);
    const float c0 = negMb - __log2f(l0), c1 = negMb + __log2f(fabsf(lam)) - __log2f(l1);
    ci2[0][i] = (f32x4){c0, c0, c0, c0}; ci2[1][i] = (f32x4){c1, c1, c1, c1};
  }
  const float nsl = lam < 0.f ? 1.f : -1.f;
#define CI2(c, i) ci2[c][i]
  f32x4 O[2][8];
#pragma unroll
  for (int i = 0; i < 2; ++i)
#pragma unroll
    for (int n = 0; n < 8; ++n) O[i][n] = (f32x4){0.f, 0.f, 0.f, 0.f};
  KLOAD(0); VLOAD(0);
  KSTORE(0); VSTORE(0);
  __syncthreads();
#pragma unroll 1
  for (int t = 0; t < nt; ++t) {
    if (t + 1 < nt) KLOAD(t + 1);
    const bf16_t* Kb = Ks + (t & 1) * 64 * 144;
    const bf16_t* Vb = Vs + (t & 1) * 128 * 80;
#pragma unroll
    for (int half = 0; half < 2; ++half) {
      bf16x8 pf[2], vfa[4], vfb[4];
#define VREAD(dst, n0) _Pragma("unroll") for (int n = 0; n < 4; ++n) dst[n] = *(const bf16x8*)(Vb + (((n0) + n) * 16 + l15) * 80 + half * 32 + g * 8);
      {
        f32x4 S[2][2][2];
        QK_INTO(S, Kb, half, CI2)
        VREAD(vfa, 0)
        EXP_S()
#pragma unroll
        for (int i = 0; i < 2; ++i) {
          float w[8];
#pragma unroll
          for (int k2 = 0; k2 < 2; ++k2)
#pragma unroll
            for (int e = 0; e < 4; ++e) w[k2 * 4 + e] = __builtin_fmaf(nsl, S[1][i][k2][e], S[0][i][k2][e]);
          const u32x4 ww = {pk2(w[0], w[1]), pk2(w[2], w[3]), pk2(w[4], w[5]), pk2(w[6], w[7])};
          pf[i] = __builtin_bit_cast(bf16x8, ww);
        }
      }
      __builtin_amdgcn_sched_barrier(0);
      VREAD(vfb, 4)
#pragma unroll
      for (int n = 0; n < 4; ++n)
#pragma unroll
        for (int i = 0; i < 2; ++i) O[i][n] = mfma16(pf[i], vfa[n], O[i][n]);
      __builtin_amdgcn_sched_barrier(0);
#pragma unroll
      for (int n = 0; n < 4; ++n)
#pragma unroll
        for (int i = 0; i < 2; ++i) O[i][4 + n] = mfma16(pf[i], vfb[n], O[i][4 + n]);
      __builtin_amdgcn_sched_barrier(0);
#undef VREAD
      if (half == 0 && t + 1 < nt) VLOAD(t + 1);
    }
    if (t + 1 < nt) { KSTORE((t + 1) & 1); VSTORE((t + 1) & 1); }
    __syncthreads();
  }
#undef KLOAD
#undef VLOAD
#undef KSTORE
#undef VSTORE
#undef CI1
#undef CI2
#undef QK_INTO
#undef EXPSUM
#undef EXP_S
  const int lane_e = otid() & 63, l15e = lane_e & 15, ge = lane_e >> 4;
  const float* sg = p.dasub + layer * 128;
#pragma unroll
  for (int i = 0; i < 2; ++i)
#pragma unroll
    for (int e = 0; e < 4; ++e) {
      float ss = 0.f;
#pragma unroll
      for (int n = 0; n < 8; ++n) ss += O[i][n][e] * O[i][n][e];
      ss += shx<1>(ss); ss += shx<2>(ss); ss += shx<4>(ss); ss += shx<8>(ss);
      const float rstd = rsqrtf(ss * (1.f / 128.f) + EPS) * (1.f - lam_init);
      bf16_t* op = P + (size_t)(r0 + i * 16 + ge * 4 + e) * LDP + C_DAQ + h * 128 + l15e;
#pragma unroll
      for (int n = 0; n < 8; ++n) if (!dup) op[n * 16] = f2bf(O[i][n][e] * rstd * sg[n * 16 + l15e]);
    }
}

DI float gelu_tanh(float x) { const float u = 0.7978845608028654f * (x + 0.044715f * x * x * x); return 0.5f * x * (1.f + tanhf(u)); }
template <int PASS>
DI void job_lru(const Params& p, int layer, int it, char* lds, bool dup) {
  const int tid = otid(), lane = tid & 63, wid = tid >> 6, l15 = lane & 15, g = lane >> 4;
  const int n = it & 7, c = (it >> 3) % NCH, b = it / (8 * NCH);
  float* xc32 = (float*)lds;
  bf16_t* xcb = (bf16_t*)(lds + 16384);
  f32x2* ab = (f32x2*)(lds + 16384 + 9216);
  f32x2* segtot = (f32x2*)(lds + 16384 + 9216 + 32768);
  float* carry = (float*)(lds + 16384 + 9216 + 32768 + 2048);
  bf16_t* P = (bf16_t*)(p.ws + OFF_P);
  f32x2* LC = (f32x2*)(p.ws + OFF_LC);
  const int ch = tid & 63, seg = tid >> 6;
  {
    const int segLo = c < 4 ? 0 : TC, segHi = c < 4 ? TC : TT;
    const int s0 = c * 64 + seg * 16;
    float cw[4];
#pragma unroll
    for (int k = 0; k < 4; ++k) cw[k] = p.lcw[(size_t)(layer * 4 + k) * 512 + n * 64 + ch];
    const float cb = p.lcb[layer * 512 + n * 64 + ch];
    float xw[19];
#pragma unroll
    for (int j = 0; j < 19; ++j) {
      const int s = s0 - 1 + j;
      xw[j] = (s >= segLo && s < segHi) ? bf2f(P[(size_t)(b * TT + s) * LDP + C_LX + n * 64 + ch]) : 0.f;
    }
#pragma unroll
    for (int u = 0; u < 16; ++u) {
      const float v = cw[0] * xw[u] + cw[1] * xw[u + 1] + cw[2] * xw[u + 2] + cw[3] * xw[u + 3] + cb;
      xc32[(seg * 16 + u) * 64 + ch] = v;
      xcb[(seg * 16 + u) * 72 + ch] = f2bf(v);
    }
  }
  if (PASS == 3 && tid < 128) {
    const int d = tid >> 6;
    const int pos = d == 0 ? c : (c < 4 ? 3 - c : 4 + (NCH - 1 - c));
    float hh = 0.f;
    for (int q0 = 0; q0 < pos; q0 += 16) {
      f32x2 AB[16];
#pragma unroll
      for (int j = 0; j < 16; ++j) {
        const int q = q0 + j, qq = q < pos ? q : pos - 1;
        const int cc = d == 0 ? qq : (qq < 4 ? 3 - qq : NCH - 1 - (qq - 4));
        AB[j] = LC[((((size_t)b * NCH + cc) * 8 + n) * 2 + d) * 64 + ch];
      }
#pragma unroll
      for (int j = 0; j < 16; ++j) if (q0 + j < pos) hh = AB[j].x * hh + AB[j].y;
    }
    carry[d * 64 + ch] = hh;
  }
  __syncthreads();
  float hacc[16];
#pragma unroll
  for (int u = 0; u < 16; ++u) hacc[u] = 0.f;
#pragma unroll 1
  for (int d = 0; d < 2; ++d) {
    {
      f32x4 ar[4], ai[4];
#pragma unroll
      for (int i = 0; i < 4; ++i) { ar[i] = (f32x4){0.f, 0.f, 0.f, 0.f}; ai[i] = (f32x4){0.f, 0.f, 0.f, 0.f}; }
      const bf16_t* LG = (const bf16_t*)(p.ws + OFF_LG);
      const bf16_t* wr_ = LG + ((size_t)((d * 2 + 0) * 8 + n)) * 4096 + (wid * 16 + l15) * 64 + g * 8;
      const bf16_t* wi_ = LG + ((size_t)((d * 2 + 1) * 8 + n)) * 4096 + (wid * 16 + l15) * 64 + g * 8;
#pragma unroll
      for (int ks = 0; ks < 2; ++ks) {
        const bf16x8 br = *(const bf16x8*)(wr_ + ks * 32), bi = *(const bf16x8*)(wi_ + ks * 32);
#pragma unroll
        for (int i = 0; i < 4; ++i) {
          const bf16x8 af = *(const bf16x8*)(xcb + (i * 16 + l15) * 72 + ks * 32 + g * 8);
          ar[i] = mfma16(br, af, ar[i]);
          ai[i] = mfma16(bi, af, ai[i]);
        }
      }
#pragma unroll
      for (int e = 0; e < 4; ++e) {
        const int che = wid * 16 + g * 4 + e, cg_ = n * 64 + che;
        const float br = p.lgb[(size_t)((layer * 2 + d) * 2 + 0) * 512 + cg_], bi = p.lgb[(size_t)((layer * 2 + d) * 2 + 1) * 512 + cg_];
        const float sp = softplusf(-p.llam[(size_t)(layer * 2 + d) * 512 + cg_]);
#pragma unroll
        for (int i = 0; i < 4; ++i) {
          const int tok = i * 16 + l15;
          const float r = sigm(ar[i][e] + br), ig = sigm(ai[i][e] + bi);
          const float la = -8.f * r * sp;
          const float av = __expf(la);
          const float bv = __builtin_sqrtf(fmaxf(1.f - __expf(2.f * la), 0.f)) * ig * xc32[tok * 64 + che];
          ab[tok * 64 + che] = (f32x2){av, bv};
        }
      }
    }
    __syncthreads();
    float hloc[16], cploc[16];
    {
      float hp = 0.f, cp = 1.f;
#pragma unroll
      for (int uu = 0; uu < 16; ++uu) {
        const int u = d == 0 ? uu : 15 - uu;
        const f32x2 v = ab[(seg * 16 + u) * 64 + ch];
        hp = v.x * hp + v.y;
        cp *= v.x;
        hloc[uu] = hp; cploc[uu] = cp;
      }
      segtot[seg * 64 + ch] = (f32x2){cp, hp};
    }
    __syncthreads();
    if (PASS == 1) {
      if (tid < 64) {
        float A = 1.f, Bv = 0.f;
#pragma unroll
        for (int q = 0; q < 4; ++q) {
          const f32x2 v = segtot[(d == 0 ? q : 3 - q) * 64 + ch];
          Bv = v.x * Bv + v.y; A *= v.x;
        }
        LC[((((size_t)b * NCH + c) * 8 + n) * 2 + d) * 64 + ch] = (f32x2){A, Bv};
      }
    } else {
      float hh = carry[d * 64 + ch];
      const int npre = d == 0 ? seg : 3 - seg;
      for (int q = 0; q < npre; ++q) {
        const f32x2 v = segtot[(d == 0 ? q : 3 - q) * 64 + ch];
        hh = v.x * hh + v.y;
      }
#pragma unroll
      for (int uu = 0; uu < 16; ++uu) {
        const int u = d == 0 ? uu : 15 - uu;
        const float hv = hloc[uu] + cploc[uu] * hh;
        hacc[d == 0 ? uu : 15 - uu] += hv;
        (void)u;
      }
    }
    __syncthreads();
  }
  if (PASS == 3) {
#pragma unroll
    for (int u = 0; u < 16; ++u) {
      bf16_t* yp = P + (size_t)(b * TT + c * 64 + seg * 16 + u) * LDP + C_LY + n * 64 + ch;
      if (!dup) *yp = f2bf(gelu_tanh(bf2f(*yp)) * hacc[u]);
    }
  }
}

DI void job_gconv(const Params& p, int layer, int it, bool dup) {
  const int tid = otid(), grp = it % 12, cg_ = it / 12, cp = tid & 15, rg = tid >> 4;
  const int cin = cg_ % NCH;
  const bool first = (cin == 0 || cin == 4), last = (cin == 3 || cin == NCH - 1);
  bf16_t* P = (bf16_t*)(p.ws + OFF_P);
  const bf16_t* HALO = (const bf16_t*)(p.ws + OFF_HALO);
  const int col = grp * 128 + cp * 8;
  u32x4 xr[7];
#pragma unroll
  for (int j = 0; j < 7; ++j) {
    const int q = rg * 4 - 1 + j;
    u32x4 v = {0u, 0u, 0u, 0u};
    if (q >= 0 && q < 64) v = *(const u32x4*)(P + (size_t)(cg_ * 64 + q) * LDP + C_GQKV + col);
    else if (q < 0) { if (!first) v = *(const u32x4*)(HALO + ((size_t)(cg_ - 1) * 3 + 2) * 1536 + col); }
    else { if (!last) v = *(const u32x4*)(HALO + ((size_t)(cg_ + 1) * 3 + (q - 64)) * 1536 + col); }
    xr[j] = v;
  }
  float w[4][8];
#pragma unroll
  for (int k = 0; k < 4; ++k) {
    const f32x4 a = *(const f32x4*)(p.gcw + (size_t)(layer * 4 + k) * 1536 + col), bq = *(const f32x4*)(p.gcw + (size_t)(layer * 4 + k) * 1536 + col + 4);
#pragma unroll
    for (int e = 0; e < 4; ++e) { w[k][e] = a[e]; w[k][4 + e] = bq[e]; }
  }
  __syncthreads();
#pragma unroll
  for (int jr = 0; jr < 4; ++jr) {
    float y[8];
#pragma unroll
    for (int e = 0; e < 8; ++e) y[e] = 0.f;
#pragma unroll
    for (int k = 0; k < 4; ++k)
#pragma unroll
      for (int e = 0; e < 4; ++e) { y[2 * e] += w[k][2 * e] * bflo(xr[jr + k][e]); y[2 * e + 1] += w[k][2 * e + 1] * bfhi(xr[jr + k][e]); }
    float ss = 0.f;
#pragma unroll
    for (int e = 0; e < 8; ++e) { y[e] = y[e] * sigm(y[e]); ss += y[e] * y[e]; }
    if (grp < 8) {
      ss += shx<1>(ss); ss += shx<2>(ss); ss += shx<4>(ss); ss += shx<8>(ss);
      const float sc = rsqrtf(ss + EPS) * (grp < 4 ? 0.08838834764831845f : 1.f);
#pragma unroll
      for (int e = 0; e < 8; ++e) y[e] *= sc;
    }
    if (!dup) *(u32x4*)(P + (size_t)(cg_ * 64 + rg * 4 + jr) * LDP + C_GQKV + col) = (u32x4){pk2(y[0], y[1]), pk2(y[2], y[3]), pk2(y[4], y[5]), pk2(y[6], y[7])};
  }
  __syncthreads();
}

DI void job_gprep(const Params& p, int layer, int it, char* lds) {
  const int tid = otid(), lane = tid & 63, wid = tid >> 6, l15 = lane & 15, g = lane >> 4;
  const int h = it & 3, c = (it >> 2) % NCH, b = it / (4 * NCH);
  bf16_t* kt_ = (bf16_t*)lds;
  bf16_t* qt_ = kt_ + 64 * 136;
  float* Ld = (float*)lds;
  float* KK = (float*)(lds + 34816);
  float* QK = KK + 64 * 65;
  float* gcs = QK + 64 * 65;
  float* bts = gcs + 128;
  const bf16_t* P = (const bf16_t*)(p.ws + OFF_P);
#pragma unroll
  for (int i = 0; i < 4; ++i) {
    const int q = tid + 256 * i, row = q >> 4, pc = q & 15;
    const bf16_t* rp = P + (size_t)(b * TT + c * 64 + row) * LDP + C_GQKV + h * 128 + pc * 8;
    *(u32x4*)(qt_ + row * 136 + pc * 8) = *(const u32x4*)rp;
    *(u32x4*)(kt_ + row * 136 + pc * 8) = *(const u32x4*)(rp + 512);
  }
  float* GSC = (float*)(p.ws + OFF_GSC);
  if (tid < 128) {
    const int d = wid, i = lane, tn = d ? 63 - i : i, r = b * TT + c * 64 + tn;
    const float* gba = (const float*)(p.ws + OFF_GBA) + (size_t)r * 16;
    const float gval = -expf(p.galog[(layer * 2 + d) * 4 + h]) * softplusf(gba[8 + d * 4 + h] + p.gdtb[(layer * 2 + d) * 4 + h]);
    const float beta = sigm(gba[d * 4 + h]);
    float v = gval;
#pragma unroll
    for (int o = 1; o < 64; o <<= 1) { const float t = __int_as_float(__builtin_amdgcn_ds_bpermute(((lane - o) & 63) << 2, __float_as_int(v))); if (lane >= o) v += t; }
    const float glast = __int_as_float(__builtin_amdgcn_readlane(__float_as_int(v), 63));
    gcs[d * 64 + i] = v;
    bts[d * 64 + i] = beta;
    float* gs = GSC + (size_t)(it * 2 + d) * 192;
    gs[i] = expf(v);
    gs[64 + i] = expf(glast - v);
    if (i == 0) gs[128] = expf(glast);
  }
  __syncthreads();
  {
    f32x4 akk[4], aqk[4];
#pragma unroll
    for (int j = 0; j < 4; ++j) { akk[j] = (f32x4){0.f, 0.f, 0.f, 0.f}; aqk[j] = (f32x4){0.f, 0.f, 0.f, 0.f}; }
#pragma unroll
    for (int ks = 0; ks < 4; ++ks) {
      const bf16x8 ak = *(const bf16x8*)(kt_ + (wid * 16 + l15) * 136 + ks * 32 + g * 8);
      const bf16x8 aq = *(const bf16x8*)(qt_ + (wid * 16 + l15) * 136 + ks * 32 + g * 8);
#pragma unroll
      for (int j = 0; j < 4; ++j) {
        const bf16x8 bk = *(const bf16x8*)(kt_ + (j * 16 + l15) * 136 + ks * 32 + g * 8);
        akk[j] = mfma16(ak, bk, akk[j]);
        aqk[j] = mfma16(aq, bk, aqk[j]);
      }
    }
#pragma unroll
    for (int j = 0; j < 4; ++j)
#pragma unroll
      for (int e = 0; e < 4; ++e) { KK[(wid * 16 + g * 4 + e) * 65 + j * 16 + l15] = akk[j][e]; QK[(wid * 16 + g * 4 + e) * 65 + j * 16 + l15] = aqk[j][e]; }
  }
  __syncthreads();
  bf16_t* M1 = (bf16_t*)(p.ws + OFF_H);
  bf16_t* AT = M1 + (size_t)4224 * 4096;
#pragma unroll 1
  for (int d = 0; d < 2; ++d) {
    bf16_t* atp = AT + (size_t)(it * 2 + d) * 4096;
#pragma unroll 4
    for (int idx = tid; idx < 4096; idx += 256) {
      const int i = idx >> 6, j = idx & 63, ti = d ? 63 - i : i, tj = d ? 63 - j : j;
      const float dec = (j <= i) ? expf(gcs[d * 64 + i] - gcs[d * 64 + j]) : 0.f;
      Ld[d * 4096 + idx] = (j < i) ? bts[d * 64 + i] * KK[ti * 65 + tj] * dec : 0.f;
      atp[idx] = f2bf(QK[ti * 65 + tj] * dec);
    }
  }
  __syncthreads();
  if (wid < 2) {
    const int d = wid;
    const float* L = Ld + d * 4096;
    const float bc = bts[d * 64 + lane];
    bf16_t* mp = M1 + (size_t)(it * 2 + d) * 4096 + lane;
    float x[64];
#pragma unroll
    for (int i = 0; i < 64; ++i) {
      float s = (i == lane) ? 1.f : 0.f;
#pragma unroll
      for (int j = 0; j < i; ++j) s -= L[i * 64 + j] * x[j];
      x[i] = s;
      mp[i * 64] = f2bf(s * bc);
    }
  }
  __syncthreads();
}

struct GChunk { bf16x8 kf[4], qf[4], m1f[2], atf[2]; unsigned vr[2][4]; float eg[4], egl[4]; float ge; };
DI void gdn_load(GChunk& R, const Params& p, int b, int h, int d, int dvs, int c) {
  const int tid = otid(), lane = tid & 63, wid = tid >> 6, l15 = lane & 15, g = lane >> 4;
  const bf16_t* P = (const bf16_t*)(p.ws + OFF_P);
  const bf16_t* M1 = (const bf16_t*)(p.ws + OFF_H);
  const bf16_t* AT = M1 + (size_t)4224 * 4096;
  const float* GSC = (const float*)(p.ws + OFF_GSC);
  const int item = ((b * NCH + c) * 4 + h) * 2 + d;
  const int irow = 16 * wid + l15, tn = d ? 63 - irow : irow;
  const bf16_t* rowp = P + (size_t)(b * TT + c * 64 + tn) * LDP + C_GQKV + h * 128;
#pragma unroll
  for (int ks = 0; ks < 4; ++ks) { R.qf[ks] = *(const bf16x8*)(rowp + ks * 32 + g * 8); R.kf[ks] = *(const bf16x8*)(rowp + 512 + ks * 32 + g * 8); }
#pragma unroll
  for (int ks = 0; ks < 2; ++ks) {
    R.m1f[ks] = *(const bf16x8*)(M1 + (size_t)item * 4096 + irow * 64 + ks * 32 + g * 8);
    R.atf[ks] = *(const bf16x8*)(AT + (size_t)item * 4096 + irow * 64 + ks * 32 + g * 8);
  }
#pragma unroll
  for (int e = 0; e < 4; ++e) {
    const int i = 16 * wid + g * 4 + e, t2 = d ? 63 - i : i;
    R.vr[0][e] = *(const unsigned*)(P + (size_t)(b * TT + c * 64 + t2) * LDP + C_GQKV + 1024 + h * 128 + dvs * 32 + (l15 & ~1));
    R.vr[1][e] = *(const unsigned*)(P + (size_t)(b * TT + c * 64 + t2) * LDP + C_GQKV + 1024 + h * 128 + dvs * 32 + 16 + (l15 & ~1));
    R.eg[e] = GSC[(size_t)item * 192 + i];
    R.egl[e] = GSC[(size_t)item * 192 + 64 + i];
  }
  R.ge = GSC[(size_t)item * 192 + 128];
}
DI void gdn_put_kt(const GChunk& R, bf16_t* KT) {
  const int tid = otid(), lane = tid & 63, i = 16 * (tid >> 6) + (lane & 15), g = lane >> 4;
#pragma unroll
  for (int ks = 0; ks < 4; ++ks)
#pragma unroll
    for (int e = 0; e < 8; ++e) KT[(ks * 32 + g * 8 + e) * 72 + i] = (bf16_t)R.kf[ks][e];
}
DI int gdn_chunk_at(int d, int n) { return d == 0 ? n : (n < 4 ? 3 - n : NCH - 1 - (n - 4)); }
DI void job_gscan(const Params& p, int u, char* lds) {
  const int tid = otid(), lane = tid & 63, wid = tid >> 6, l15 = lane & 15, g = lane >> 4;
  const int seq = (u & 7) + 8 * (u >> 5), dvs = (u >> 3) & 3, d = seq & 1, h = (seq >> 1) & 3, b = seq >> 3;
  bf16_t* KT = (bf16_t*)lds;
  bf16_t* ST = KT + 2 * 128 * 72;
  bf16_t* XT = ST + 32 * 136;
  bf16_t* VnT = XT + 32 * 72;
  bf16_t* VsT = VnT + 32 * 72;
  bf16_t* OUT = d == 0 ? (bf16_t*)(p.ws + OFF_P) + C_DAV : (bf16_t*)(p.ws + OFF_OB);
  const int ldo = d == 0 ? LDP : 512;
  __builtin_amdgcn_s_setprio(3);
  f32x4 S[2][2];
#pragma unroll
  for (int a = 0; a < 2; ++a)
#pragma unroll
    for (int ct = 0; ct < 2; ++ct) S[a][ct] = (f32x4){0.f, 0.f, 0.f, 0.f};
  for (int i = tid; i < 32 * 136 / 2; i += 256) ((unsigned*)ST)[i] = 0u;
  GChunk cur, nxt;
  gdn_load(cur, p, b, h, d, dvs, gdn_chunk_at(d, 0));
  gdn_put_kt(cur, KT);
  __syncthreads();
#pragma unroll 1
  for (int n = 0; n < NCH; ++n) {
    const int c = gdn_chunk_at(d, n);
    if (n + 1 < NCH) gdn_load(nxt, p, b, h, d, dvs, gdn_chunk_at(d, n + 1));
    const bf16_t* KTc = KT + (n & 1) * 128 * 72;
    f32x4 ksa[2], qsa[2];
#pragma unroll
    for (int ct = 0; ct < 2; ++ct) { ksa[ct] = (f32x4){0.f, 0.f, 0.f, 0.f}; qsa[ct] = (f32x4){0.f, 0.f, 0.f, 0.f}; }
#pragma unroll
    for (int ks = 0; ks < 4; ++ks)
#pragma unroll
      for (int ct = 0; ct < 2; ++ct) {
        const bf16x8 bS = *(const bf16x8*)(ST + (ct * 16 + l15) * 136 + ks * 32 + g * 8);
        ksa[ct] = mfma16(cur.kf[ks], bS, ksa[ct]);
        qsa[ct] = mfma16(cur.qf[ks], bS, qsa[ct]);
      }
#pragma unroll
    for (int ct = 0; ct < 2; ++ct) {
      float x[4];
#pragma unroll
      for (int e = 0; e < 4; ++e) x[e] = ((l15 & 1) ? bfhi(cur.vr[ct][e]) : bflo(cur.vr[ct][e])) - cur.eg[e] * ksa[ct][e];
      *(u32x2*)(XT + (ct * 16 + l15) * 72 + 16 * wid + g * 4) = (u32x2){pk2(x[0], x[1]), pk2(x[2], x[3])};
    }
    __syncthreads();
#pragma unroll
    for (int ct = 0; ct < 2; ++ct) {
      f32x4 vn = {0.f, 0.f, 0.f, 0.f};
#pragma unroll
      for (int ks = 0; ks < 2; ++ks) vn = mfma16(cur.m1f[ks], *(const bf16x8*)(XT + (ct * 16 + l15) * 72 + ks * 32 + g * 8), vn);
      *(u32x2*)(VnT + (ct * 16 + l15) * 72 + 16 * wid + g * 4) = (u32x2){pk2(vn[0], vn[1]), pk2(vn[2], vn[3])};
      *(u32x2*)(VsT + (ct * 16 + l15) * 72 + 16 * wid + g * 4) = (u32x2){pk2(vn[0] * cur.egl[0], vn[1] * cur.egl[1]), pk2(vn[2] * cur.egl[2], vn[3] * cur.egl[3])};
    }
    __syncthreads();
#pragma unroll
    for (int ct = 0; ct < 2; ++ct) {
      f32x4 o;
#pragma unroll
      for (int e = 0; e < 4; ++e) o[e] = cur.eg[e] * qsa[ct][e];
#pragma unroll
      for (int ks = 0; ks < 2; ++ks) o = mfma16(cur.atf[ks], *(const bf16x8*)(VnT + (ct * 16 + l15) * 72 + ks * 32 + g * 8), o);
#pragma unroll
      for (int e = 0; e < 4; ++e) {
        const int i = 16 * wid + g * 4 + e, t2 = d ? 63 - i : i;
        OUT[(size_t)(b * TT + c * 64 + t2) * ldo + h * 128 + dvs * 32 + ct * 16 + l15] = f2bf(o[e]);
      }
    }
#pragma unroll
    for (int rt2 = 0; rt2 < 2; ++rt2) {
      const int rt = 2 * wid + rt2;
#pragma unroll
      for (int ct = 0; ct < 2; ++ct)
#pragma unroll
        for (int e = 0; e < 4; ++e) S[rt2][ct][e] *= cur.ge;
#pragma unroll
      for (int ks = 0; ks < 2; ++ks) {
        const bf16x8 ka = *(const bf16x8*)(KTc + (rt * 16 + l15) * 72 + ks * 32 + g * 8);
#pragma unroll
        for (int ct = 0; ct < 2; ++ct) S[rt2][ct] = mfma16(ka, *(const bf16x8*)(VsT + (ct * 16 + l15) * 72 + ks * 32 + g * 8), S[rt2][ct]);
      }
#pragma unroll
      for (int ct = 0; ct < 2; ++ct)
        *(u32x2*)(ST + (ct * 16 + l15) * 136 + rt * 16 + g * 4) = (u32x2){pk2(S[rt2][ct][0], S[rt2][ct][1]), pk2(S[rt2][ct][2], S[rt2][ct][3])};
    }
    if (n + 1 < NCH) { gdn_put_kt(nxt, KT + ((n + 1) & 1) * 128 * 72); cur = nxt; }
    __syncthreads();
  }
  __builtin_amdgcn_s_setprio(0);
}
DI void job_gpost1(const Params& p, int layer, int r) {
  const int lane = otid() & 63;
  bf16_t* P = (bf16_t*)(p.ws + OFF_P) + (size_t)r * LDP;
  const bf16_t* OB = (const bf16_t*)(p.ws + OFF_OB) + (size_t)r * 512;
  const u32x4 of = *(const u32x4*)(P + C_DAV + lane * 8), ob = *(const u32x4*)(OB + lane * 8), z = *(const u32x4*)(P + C_GZ + lane * 8);
  float o[8], zz[8], ss = 0.f;
#pragma unroll
  for (int e = 0; e < 4; ++e) {
    o[2 * e] = bflo(of[e]) + bflo(ob[e]); o[2 * e + 1] = bfhi(of[e]) + bfhi(ob[e]);
    zz[2 * e] = bflo(z[e]); zz[2 * e + 1] = bfhi(z[e]);
  }
#pragma unroll
  for (int e = 0; e < 8; ++e) ss += o[e] * o[e];
  ss += shx<1>(ss); ss += shx<2>(ss); ss += shx<4>(ss); ss += shx<8>(ss);
  const float rstd = rsqrtf(ss * (1.f / 128.f) + EPS);
  const float* gn = p.gng + layer * 128 + (lane & 15) * 8;
  float y[8];
#pragma unroll
  for (int e = 0; e < 8; ++e) y[e] = o[e] * rstd * gn[e] * (zz[e] * sigm(zz[e]));
  *(u32x4*)(P + C_GZ + lane * 8) = (u32x4){pk2(y[0], y[1]), pk2(y[2], y[3]), pk2(y[4], y[5]), pk2(y[6], y[7])};
}

DI void job_gpost(const Params& p, int layer, int it) {
  const int wid = otid() >> 6;
#pragma unroll
  for (int rr = 0; rr < 2; ++rr) job_gpost1(p, layer, it * 8 + rr * 4 + wid);
}
#ifdef SK_JL1
#define JL1(x)
#else
#define JL1(x) x
#endif
#ifdef SK_JGC
#define JGC(x)
#else
#define JGC(x) x
#endif
#ifdef SK_JVT
#define JVT(x)
#else
#define JVT(x) x
#endif
#ifdef SK_JDP
#define JDP(x)
#else
#define JDP(x) x
#endif
#ifdef SK_JGP
#define JGP(x)
#else
#define JGP(x) x
#endif
#ifdef SK_JL3
#define JL3(x)
#else
#define JL3(x) x
#endif
#ifdef SK_JGS
#define JGS(x)
#else
#define JGS(x) x
#endif
#ifdef SK_JAT
#define JAT(x)
#else
#define JAT(x) x
#endif
#define LAS __attribute__((address_space(3)))
#define XB_TMO      128
#define XB_XCNT(j)  (256  + 64 * (j))
#define XB_XSUB(j)  (1280 + 64 * (j))
#define XB_XGEN(j)  (2304 + 64 * (j))
#define XB_TOP      3328
#define XB_TOPGEN   3392
#define XCD_BAR_WORDS 3456
#define XB_SPIN_CAP (1u << 18)

__device__ __forceinline__ unsigned xb_ld(unsigned* p)              { return __hip_atomic_load(p, __ATOMIC_RELAXED, __HIP_MEMORY_SCOPE_AGENT); }
__device__ __forceinline__ unsigned xb_add(unsigned* p, unsigned v) { return __hip_atomic_fetch_add(p, v, __ATOMIC_RELAXED, __HIP_MEMORY_SCOPE_AGENT); }
__device__ __forceinline__ unsigned xb_xcc_id() { return (unsigned)__builtin_amdgcn_s_getreg((3 << 11) | 20) & 0xFu; }
#define XB_SPIN(cond, bar) do { unsigned _sp = 0; while (cond) { __builtin_amdgcn_s_sleep(1); \
    if ((++_sp & 255u) == 0u) { if (xb_ld(&(bar)[XB_TMO])) break; if (_sp > XB_SPIN_CAP) { atomicAdd(&(bar)[XB_TMO], 1u); break; } } } } while (0)

struct XcdBarrier {
    unsigned* bar; unsigned x;
    volatile LAS unsigned* st;
};

__device__ __forceinline__ XcdBarrier xcd_barrier_post(unsigned* bar, volatile LAS unsigned* st) {
    XcdBarrier b; b.bar = bar; b.x = xb_xcc_id(); b.st = st;
    if (threadIdx.x == 0) (void)xb_add(&bar[XB_XCNT(b.x)], 1u);
    return b;
}
__device__ __forceinline__ void xcd_barrier_complete(unsigned* bar, unsigned x, unsigned& nloc, unsigned& nx) {
    const unsigned G = gridDim.x * gridDim.y * gridDim.z;
    unsigned sum, cnt, mine, sp = 0u;
    for (;;) {
        sum = 0u; cnt = 0u; mine = 0u;
#pragma unroll
        for (unsigned j = 0; j < 16; ++j) { const unsigned c = xb_ld(&bar[XB_XCNT(j)]); sum += c; cnt += (c > 0u) ? 1u : 0u; mine = (j == x) ? c : mine; }
        if (sum == G) break;
        __builtin_amdgcn_s_sleep(1);
        if ((++sp & 255u) == 0u) { if (xb_ld(&bar[XB_TMO])) break; if (sp > XB_SPIN_CAP) { atomicAdd(&bar[XB_TMO], 1u); break; } }
    }
    nloc = mine > 0u ? mine : 1u; nx = cnt > 0u ? cnt : 1u;
}

__device__ __forceinline__ void xcd_barrier(const XcdBarrier& b) {
    asm volatile("s_waitcnt vmcnt(0)" ::: "memory");
    __syncthreads();
    if (threadIdx.x == 0) {
        unsigned* bar = b.bar; unsigned bx_ = b.x;
        asm volatile("" : "+s"(bar), "+s"(bx_));
        __builtin_amdgcn_s_waitcnt(0);
        unsigned nloc = b.st[0], nx = b.st[1];
        if (nloc == 0u) { xcd_barrier_complete(bar, bx_, nloc, nx); b.st[0] = nloc; b.st[1] = nx; }
        const unsigned old = xb_add(&bar[XB_XSUB(bx_)], 1u);
        const unsigned gen = old / nloc;
        if (old + 1u == (gen + 1u) * nloc) {
            __builtin_amdgcn_fence(__ATOMIC_RELEASE, "agent");
            asm volatile("s_waitcnt vmcnt(0)" ::: "memory");
            const unsigned og = xb_add(&bar[XB_TOP], 1u);
            const unsigned tg = og / nx;
            if (og + 1u == (tg + 1u) * nx) xb_add(&bar[XB_TOPGEN], 1u);
            else XB_SPIN(xb_ld(&bar[XB_TOPGEN]) == tg, bar);
            __builtin_amdgcn_fence(__ATOMIC_ACQUIRE, "agent");
            xb_add(&bar[XB_XGEN(bx_)], 1u);
            asm volatile("s_waitcnt vmcnt(0)" ::: "memory");
        } else {
            XB_SPIN(xb_ld(&bar[XB_XGEN(bx_)]) == gen, bar);
            __builtin_amdgcn_fence(__ATOMIC_ACQUIRE, "agent");
            asm volatile("s_waitcnt vmcnt(0)" ::: "memory");
        }
    }
    __syncthreads();
}


#define PH_BEGIN(k) for (int rep_ = 0, nrep_ = 1 + (((p.probe >> (k)) & 1) | ((k) == 5 ? ((p.probe >> 12) | (p.probe >> 13)) & 1 : 0)); rep_ < nrep_; ++rep_) { const bool dup = rep_ > 0; (void)dup;
#define PH_END xcd_barrier(xb_); }
#ifndef PROBE_MASK
#define PROBE_MASK 0
#endif
__global__ void __launch_bounds__(256, 2) mega(Params p) {
  __shared__ __attribute__((aligned(16))) char lds[LDS_BYTES];
  __shared__ int s_item;
  __shared__ unsigned xb_st[2];
  if (otid() == 0) { xb_st[0] = 0u; xb_st[1] = 0u; }
  __syncthreads();
  const XcdBarrier xb_ = xcd_barrier_post((unsigned*)(p.ws + OFF_CTR) + 64, (volatile LAS unsigned*)xb_st);
  cg::grid_group grid = cg::this_grid();
  const int G = gridDim.x, B = blockIdx.x;
  bf16_t* P = (bf16_t*)(p.ws + OFF_P);
  bf16_t* H = (bf16_t*)(p.ws + OFF_H);
  for (int it = B; it < 192 + 1024 + N_CVT; it += G) {
    if (it < 192) job_mod(p, it, lds);
    else if (it < 1216) job_rope(p, it - 192);
    else job_cvt(p, 0, it - 1216, lds);
  }
  if (p.probe < 0) grid.sync();
  xcd_barrier(xb_);
#pragma unroll 1
  for (int layer = 0; layer < 2; ++layer) {
    bf16_t* MG = (bf16_t*)(p.ws + OFF_VT);
    bf16_t* HID = P;
    PH_BEGIN(1)
    {
      const int n1 = layer == 1 ? N_CVT : 0;
      for (int it = B; it < n1 + MR / 8; it += G) { if (it < n1) job_cvt(p, 1, it, lds); else job_norm(p, layer, 1, it - n1); }
    }
    PH_END
    PH_BEGIN(2)
    {
      bf16_t* HALO = (bf16_t*)(p.ws + OFF_HALO);
      float* GBA = (float*)(p.ws + OFF_GBA);
      gemm_phase(H, 32, MR * 32, (const bf16_t*)(p.ws + OFF_WIN), 32, 7808 * 32, 1024, 132, 37, lds, B, G, [&](int row, int col, f32x4 v) {
        if (col < C_GBA) {
          const u32x2 w = {pk2(v[0], v[1]), pk2(v[2], v[3])};
          *(u32x2*)(P + (size_t)row * LDP + col) = w;
          if (col >= C_GQKV && col < C_GZ) {
            const int sm = row & 63;
            if (sm <= 1 || sm == 63) *(u32x2*)(HALO + ((size_t)(row >> 6) * 3 + (sm == 63 ? 2 : sm)) * 1536 + (col - C_GQKV)) = w;
          }
        } else if (col < C_GBA + 16) {
          *(f32x4*)(GBA + (size_t)row * 16 + (col - C_GBA)) = v;
        }
      }, [&](int row, int col, f32x4 v0, f32x4 v1) {
        if (col < C_GBA) {
          const u32x4 w = (u32x4){pk2(v0[0], v0[1]), pk2(v0[2], v0[3]), pk2(v1[0], v1[1]), pk2(v1[2], v1[3])};
          *(u32x4*)(P + (size_t)row * LDP + col) = w;
          if (col >= C_GQKV && col < C_GZ) {
            const int sm = row & 63;
            if (sm <= 1 || sm == 63) *(u32x4*)(HALO + ((size_t)(row >> 6) * 3 + (sm == 63 ? 2 : sm)) * 1536 + (col - C_GQKV)) = w;
          }
        } else if (col < C_GBA + 16) {
          *(f32x4*)(GBA + (size_t)row * 16 + (col - C_GBA)) = v0;
          *(f32x4*)(GBA + (size_t)row * 16 + (col - C_GBA) + 4) = v1;
        }
      });
    }
    PH_END
    PH_BEGIN(3)
    {
      const int nA = 8 * NCH * 4, nB = nA + 6336, nC = nB + 2112, nD = nC + MR / 8;
      for (int it = B; it < nD; it += G) {
        if (it < nA) JL1(job_lru<1>(p, layer, it, lds, dup));
        else if (it < nB) JGC(job_gconv(p, layer, it - nA, dup));
        else if (it < nC) JVT(job_vt(p, it - nB, lds));
        else JDP(job_daprep(p, layer, it - nC, dup));
      }
    }
    PH_END
    PH_BEGIN(4)
    for (int it = B; it < 2112; it += G) JGP(job_gprep(p, layer, it, lds));
    PH_END
    PH_BEGIN(5)
    {
      for (;;) {
        const int x = blockIdx.x & 7;
        if (otid() == 0) s_item = (int)__hip_atomic_fetch_add((unsigned*)(p.ws + OFF_CTR) + ((layer * 2 + rep_) * 8 + x), 1u, __ATOMIC_RELAXED, __HIP_MEMORY_SCOPE_AGENT);
        __syncthreads();
        const int j = __builtin_amdgcn_readfirstlane(s_item);
        __syncthreads();
        if (j >= 16 + 132 + 528) break;
        if (j < 16) { if (!(dup && ((p.probe >> 12) & 1))) JGS(job_gscan(p, j * 8 + x, lds)); }
        else if (j < 148) {
          const int k = j - 16, grp = k / 66, qq = k % 66, qb = qq < 64 ? qq + 2 : qq - 64;
          if (!(dup && ((p.probe >> 13) & 1))) JAT(job_attn(p, layer, grp * 528 + qb * 8 + x, lds, dup));
        } else { if (!(dup && (((p.probe >> 12) | (p.probe >> 13)) & 1))) JL3(job_lru<3>(p, layer, (j - 148) * 8 + x, lds, dup)); }
      }
    }
    PH_END
    PH_BEGIN(6)
    for (int it = B; it < MR / 8 + MR / 8; it += G) { if (it < MR / 8) job_gpost(p, layer, it); else job_norm(p, layer, 1, it - MR / 8); }
    PH_END
    PH_BEGIN(7)
    gemm_phase(H, 32, MR * 32, (const bf16_t*)(p.ws + OFF_WIN) + (size_t)4736 * 32, 32, 7808 * 32, 1024, 132, 24, lds, B, G, [&](int row, int col, f32x4 v) {
      *(u32x2*)(P + (size_t)row * LDP + sg_col(col)) = (u32x2){pk2(sigm(v[0]), sigm(v[1])), pk2(sigm(v[2]), sigm(v[3]))};
    }, [&](int row, int col, f32x4 v0, f32x4 v1) {
      *(u32x4*)(P + (size_t)row * LDP + sg_col(col)) = (u32x4){pk2(sigm(v0[0]), sigm(v0[1])), pk2(sigm(v0[2]), sigm(v0[3])), pk2(sigm(v1[0]), sigm(v1[1])), pk2(sigm(v1[2]), sigm(v1[3]))};
    }, layer == 1);
    PH_END
    PH_BEGIN(14)
    {
      const bf16_t* WBR = (const bf16_t*)(p.ws + OFF_WBR);
      const int nm14 = layer == 1 ? 256 : 264;
      for (int t = B; t < nm14 * 8; t += G) {
        int mi, ni; tile_mn(t, nm14, 8, mi, ni);
        if (layer == 1) mi += 2 * (mi >> 6) + 2;
        f32x4 mg[4][4]; zero_acc<4>(mg);
#pragma unroll 1
        for (int i = 0; i < 3; ++i) {
          f32x4 ay[4][4]; zero_acc<4>(ay);
          const int coff = i == 0 ? C_DAQ : (i == 1 ? C_LY : C_GZ);
          gemm_core<4>(P + (size_t)mi * 128 * LDP + coff, LDP, 32, WBR + (size_t)i * 1024 * 512 + (size_t)(ni * 128) * 32, 32, 1024 * 32, 512, ay, lds);
          const int lane = otid() & 63, wid = otid() >> 6, wr = wid >> 1, wc = wid & 1;
#pragma unroll
          for (int a2 = 0; a2 < 4; ++a2)
#pragma unroll
            for (int b2 = 0; b2 < 4; ++b2) {
              const int row = mi * 128 + wr * 64 + a2 * 16 + (lane & 15), col = ni * 128 + wc * 64 + b2 * 16 + (lane >> 4) * 4;
              const u32x2 sg = *(const u32x2*)(P + (size_t)row * LDP + sg_col(i * 1024 + col));
              mg[a2][b2] += (f32x4){bflo(sg.x), bfhi(sg.x), bflo(sg.y), bfhi(sg.y)} * ay[a2][b2];
            }
        }
        gemm_emit<4>(mg, mi * 128, ni * 128, [&](int row, int col, f32x4 v) { *(u32x2*)(MG + ((size_t)(col >> 5) * MR + row) * 32 + (col & 31)) = (u32x2){pk2(v[0], v[1]), pk2(v[2], v[3])}; });
      }
    }
    PH_END
    PH_BEGIN(8)
    gemm_phase(MG, 32, MR * 32, (const bf16_t*)(p.ws + OFF_WO), 32, 1024 * 32, 1024, 132, 8, lds, B, G, [&](int row, int col, f32x4 v) {
      const f32x4 xin = *(const f32x4*)(res_in_row(p, layer, row) + col);
      const f32x4 g1 = *(const f32x4*)(mod_vec(p, layer, row) + 2048 + col);
      if (!dup) *(f32x4*)(res_out_row(p, row) + col) = xin + g1 * v;
    }, [&](int row, int col, f32x4 v0, f32x4 v1) {
      const float* xi = res_in_row(p, layer, row) + col;
      const float* gm = mod_vec(p, layer, row) + 2048 + col;
      float* xo = res_out_row(p, row) + col;
      const f32x4 o0 = *(const f32x4*)xi + *(const f32x4*)gm * v0, o1 = *(const f32x4*)(xi + 4) + *(const f32x4*)(gm + 4) * v1;
      if (!dup) { *(f32x4*)xo = o0; *(f32x4*)(xo + 4) = o1; }
    }, layer == 1);
    PH_END
    PH_BEGIN(9)
    for (int it = B; it < MR / 8; it += G) job_norm(p, layer, 2, it);
    PH_END
    PH_BEGIN(10)
    gemm_phase(H, 32, MR * 32, (const bf16_t*)(p.ws + OFF_W1), 32, 4096 * 32, 1024, 132, 32, lds, B, G, [&](int row, int col, f32x4 v) {
      float r[4];
#pragma unroll
      for (int e = 0; e < 4; ++e) { const float q = fmaxf(v[e], 0.f); r[e] = q * q; }
      *(u32x2*)(HID + ((size_t)(col >> 5) * MR + row) * 32 + (col & 31)) = (u32x2){pk2(r[0], r[1]), pk2(r[2], r[3])};
    }, [&](int row, int col, f32x4 v0, f32x4 v1) {
      float r[8];
#pragma unroll
      for (int e = 0; e < 4; ++e) { const float q0 = fmaxf(v0[e], 0.f), q1 = fmaxf(v1[e], 0.f); r[e] = q0 * q0; r[4 + e] = q1 * q1; }
      *(u32x4*)(HID + ((size_t)(col >> 5) * MR + row) * 32 + (col & 31)) = (u32x4){pk2(r[0], r[1]), pk2(r[2], r[3]), pk2(r[4], r[5]), pk2(r[6], r[7])};
    }, layer == 1);
    PH_END
    PH_BEGIN(11)
    gemm_phase(HID, 32, MR * 32, (const bf16_t*)(p.ws + OFF_W2), 32, 1024 * 32, 4096, 132, 8, lds, B, G, [&](int row, int col, f32x4 v) {
      float* xo = res_out_row(p, row) + col;
      const f32x4 g2 = *(const f32x4*)(mod_vec(p, layer, row) + 5120 + col);
      if (!dup) *(f32x4*)xo = *(const f32x4*)xo + g2 * v;
    }, [&](int row, int col, f32x4 v0, f32x4 v1) {
      float* xo = res_out_row(p, row) + col;
      const float* gm = mod_vec(p, layer, row) + 5120 + col;
      const f32x4 o0 = *(const f32x4*)xo + *(const f32x4*)gm * v0, o1 = *(const f32x4*)(xo + 4) + *(const f32x4*)(gm + 4) * v1;
      if (!dup) { *(f32x4*)xo = o0; *(f32x4*)(xo + 4) = o1; }
    }, layer == 1);
    PH_END
  }
}

extern "C" void kernel_launch(void* const* d_in, const int* in_sizes, int n_in, void* d_out, int out_size, void* d_ws, size_t ws_size, hipStream_t stream) {
  static int grid_blocks = 0;
  if (!grid_blocks) {
    int dev = 0, cus = 0, per_cu = 0;
    hipGetDevice(&dev);
    hipDeviceGetAttribute(&cus, hipDeviceAttributeMultiprocessorCount, dev);
    hipOccupancyMaxActiveBlocksPerMultiprocessor(&per_cu, mega, 256, 0);
    if (per_cu > 2) per_cu = 2;
    grid_blocks = cus * per_cu;
    grid_blocks -= grid_blocks % 8;
  }
  Params p{};
  const float** f = (const float**)&p;
  for (int i = 0; i < 26; ++i) f[i] = (const float*)d_in[i];
  p.out = (float*)d_out;
  p.ws = (char*)d_ws;
  p.probe = PROBE_MASK;
  if (ws_size < WS_TOTAL) { fprintf(stderr, "workspace too small: %zu < %zu\n", ws_size, (size_t)WS_TOTAL); return; }
  hipMemsetAsync((char*)d_ws + OFF_CTR, 0, 256 + 16384, stream);
  void* args[] = {&p};
  hipError_t e = hipLaunchCooperativeKernel((void*)mega, dim3(grid_blocks), dim3(256), args, 0, stream);
  if (e != hipSuccess) fprintf(stderr, "cooperative launch failed: %s (grid %d)\n", hipGetErrorString(e), grid_blocks);
}
```

```cpp
#include <hip/hip_runtime.h>
#include <hip/hip_cooperative_groups.h>
#include <cstdint>
#include <cstdio>
namespace cg = cooperative_groups;

#define DI __device__ __forceinline__
typedef unsigned short bf16_t;
typedef short bf16x8 __attribute__((ext_vector_type(8)));
typedef float f32x4 __attribute__((ext_vector_type(4)));
typedef float f32x2 __attribute__((ext_vector_type(2)));
typedef unsigned u32x4 __attribute__((ext_vector_type(4)));
typedef unsigned u32x2 __attribute__((ext_vector_type(2)));
typedef __bf16 bf16x2_t __attribute__((ext_vector_type(2)));

constexpr int DM = 1024, NB = 4, TL = 8192, TC = 256, TT = 8448, MR = NB * TT;
constexpr int LDP = 4736;
constexpr int C_DAQ = 0, C_DAK = 512, C_DAV = 1024, C_LX = 1536, C_LY = 2048, C_GQKV = 2560, C_GZ = 4096, C_GBA = 4608;
constexpr int NCH = 132;
constexpr float EPS = 1e-6f;
constexpr int LDS_BYTES = 77824;

constexpr size_t al256(size_t x) { return (x + 255) & ~(size_t)255; }
constexpr size_t OFF_WIN = 0;
constexpr size_t OFF_WBR = OFF_WIN + al256((size_t)7808 * 1024 * 2);
constexpr size_t OFF_WO = OFF_WBR + al256((size_t)3 * 1024 * 512 * 2);
constexpr size_t OFF_W1 = OFF_WO + al256((size_t)1024 * 1024 * 2);
constexpr size_t OFF_W2 = OFF_W1 + al256((size_t)4096 * 1024 * 2);
constexpr size_t OFF_LG = OFF_W2 + al256((size_t)4096 * 1024 * 2);
constexpr size_t OFF_P = OFF_LG + al256((size_t)32 * 4096 * 2);
constexpr size_t OFF_H = OFF_P + al256((size_t)MR * LDP * 2);
constexpr size_t OFF_VT = OFF_H + al256((size_t)MR * 1024 * 2);
constexpr size_t OFF_OB = OFF_VT + al256((size_t)MR * 512 * 2);
constexpr size_t OFF_HALO = OFF_OB + al256((size_t)MR * 512 * 2);
constexpr size_t OFF_GBA = OFF_HALO + al256((size_t)528 * 3 * 1536 * 2);
constexpr size_t OFF_GSC = OFF_GBA + al256((size_t)MR * 16 * 4);
constexpr size_t OFF_LC = OFF_GSC + al256((size_t)4224 * 192 * 4);
constexpr size_t OFF_CTX = OFF_LC + al256((size_t)4 * NCH * 8 * 2 * 64 * 8);
constexpr size_t OFF_MOD = OFF_CTX + al256((size_t)4 * 256 * 1024 * 4);
constexpr size_t OFF_ROPE = OFF_MOD + al256((size_t)2 * 5 * 6144 * 4);
constexpr size_t OFF_CTR = OFF_ROPE + al256((size_t)8192 * 32 * 8);
constexpr size_t WS_TOTAL = OFF_CTR + 256 + 16384;
static_assert(WS_TOTAL <= (size_t)536870912, "workspace map too large");

struct Params {
  const float *x, *c, *ctx, *cctx, *ada_w, *ada_b, *n1g, *n2g, *w_in, *daqg, *dakg, *dalam, *dasub, *lcw, *lcb, *lgw, *lgb, *llam,
      *gcw, *galog, *gdtb, *gng, *wbr, *wout, *w1, *w2;
  float* out;
  char* ws;
  int probe;
  int pad_;
};

DI unsigned pk2(float lo, float hi) { f32x2 v = {lo, hi}; bf16x2_t b = __builtin_convertvector(v, bf16x2_t); return __builtin_bit_cast(unsigned, b); }
DI bf16_t f2bf(float f) { return (bf16_t)(pk2(f, 0.f) & 0xffffu); }
DI float bf2f(bf16_t u) { return __uint_as_float(((unsigned)u) << 16); }
DI float bflo(unsigned w) { return __uint_as_float(w << 16); }
DI float bfhi(unsigned w) { return __uint_as_float(w & 0xffff0000u); }
DI int otid() { int t = __builtin_amdgcn_workitem_id_x(); asm volatile("" : "+v"(t)); return t; }
template <int M> DI float shx(float v) { return __int_as_float(__builtin_amdgcn_ds_swizzle(__float_as_int(v), (M << 10) | 0x1f)); }
DI float add32(float v) { auto r = __builtin_amdgcn_permlane32_swap(__float_as_uint(v), __float_as_uint(v), false, false); return __uint_as_float(r[0]) + __uint_as_float(r[1]); }
DI float max32(float v) { auto r = __builtin_amdgcn_permlane32_swap(__float_as_uint(v), __float_as_uint(v), false, false); return fmaxf(__uint_as_float(r[0]), __uint_as_float(r[1])); }
DI float wsum(float v) { v += shx<1>(v); v += shx<2>(v); v += shx<4>(v); v += shx<8>(v); v += shx<16>(v); return add32(v); }
DI float wmax(float v) { v = fmaxf(v, shx<1>(v)); v = fmaxf(v, shx<2>(v)); v = fmaxf(v, shx<4>(v)); v = fmaxf(v, shx<8>(v)); v = fmaxf(v, shx<16>(v)); return max32(v); }
DI float sigm(float x) { return 1.f / (1.f + __expf(-x)); }
DI float softplusf(float x) { return x > 20.f ? x : log1pf(expf(x)); }
DI f32x4 mfma16(bf16x8 a, bf16x8 b, f32x4 c) { return __builtin_amdgcn_mfma_f32_16x16x32_bf16(a, b, c, 0, 0, 0); }

DI const float* res_in_row(const Params& p, int layer, int r) {
  const int b = r / TT, s = r % TT;
  if (layer == 0) return s < TC ? p.ctx + ((size_t)b * TC + s) * DM : p.x + ((size_t)b * TL + (s - TC)) * DM;
  return s < TC ? (const float*)(p.ws + OFF_CTX) + ((size_t)b * TC + s) * DM : p.out + ((size_t)b * TL + (s - TC)) * DM;
}
DI float* res_out_row(const Params& p, int r) {
  const int b = r / TT, s = r % TT;
  return s < TC ? (float*)(p.ws + OFF_CTX) + ((size_t)b * TC + s) * DM : p.out + ((size_t)b * TL + (s - TC)) * DM;
}
DI const float* mod_vec(const Params& p, int layer, int r) {
  const int b = r / TT, s = r % TT;
  return (const float*)(p.ws + OFF_MOD) + (size_t)(layer * 5 + (s < TC ? 4 : b)) * 6144;
}

template <int WN>
DI void gemm_core(const bf16_t* __restrict__ A, int lda, int a_ks, const bf16_t* __restrict__ Bt, int ldb, int b_ks, int K, f32x4 (&acc)[4][WN], char* lds) {
  constexpr int BN = 32 * WN, AST = 72, NBP = BN * 8 / 256;
  bf16_t* As = (bf16_t*)lds;
  bf16_t* Bs = As + 2 * 128 * AST;
  const int tid = otid(), lane = tid & 63, wid = tid >> 6, wr = wid >> 1, wc = wid & 1;
  u32x4 ra[4], rb[NBP];
  const int nk = K / 64;
#define GLOAD(k0)                                                                                                            \
  {                                                                                                                          \
    _Pragma("unroll") for (int i = 0; i < 4; ++i) { const int q = tid + 256 * i; ra[i] = *(const u32x4*)(A + (size_t)(q >> 3) * lda + (size_t)(((k0) >> 5) + ((q & 7) >> 2)) * a_ks + (q & 3) * 8); } \
    _Pragma("unroll") for (int i = 0; i < NBP; ++i) { const int q = tid + 256 * i; rb[i] = *(const u32x4*)(Bt + (size_t)(q >> 3) * ldb + (size_t)(((k0) >> 5) + ((q & 7) >> 2)) * b_ks + (q & 3) * 8); } \
  }
#define SSTORE(buf)                                                                                                          \
  {                                                                                                                          \
    _Pragma("unroll") for (int i = 0; i < 4; ++i) { const int q = tid + 256 * i; *(u32x4*)(As + ((buf) * 128 + (q >> 3)) * AST + (q & 7) * 8) = ra[i]; } \
    _Pragma("unroll") for (int i = 0; i < NBP; ++i) { const int q = tid + 256 * i; *(u32x4*)(Bs + ((buf) * BN + (q >> 3)) * AST + (q & 7) * 8) = rb[i]; } \
  }
  GLOAD(0);
  SSTORE(0);
  __syncthreads();
  for (int t = 0; t < nk; ++t) {
    if (t + 1 < nk) GLOAD((t + 1) * 64);
    const bf16_t* a = As + ((t & 1) * 128 + wr * 64 + (lane & 15)) * AST + (lane >> 4) * 8;
    const bf16_t* b = Bs + ((t & 1) * BN + wc * 16 * WN + (lane & 15)) * AST + (lane >> 4) * 8;
#pragma unroll
    for (int ks = 0; ks < 2; ++ks) {
      bf16x8 af[4], bfr[WN];
#pragma unroll
      for (int i = 0; i < 4; ++i) af[i] = *(const bf16x8*)(a + i * 16 * AST + ks * 32);
#pragma unroll
      for (int j = 0; j < WN; ++j) bfr[j] = *(const bf16x8*)(b + j * 16 * AST + ks * 32);
      __builtin_amdgcn_sched_barrier(0);
#pragma unroll
      for (int i = 0; i < 4; ++i)
#pragma unroll
        for (int j = 0; j < WN; ++j) acc[i][j] = mfma16(bfr[j], af[i], acc[i][j]);
      __builtin_amdgcn_sched_barrier(0);
    }
    if (t + 1 < nk) SSTORE((t + 1) & 1);
    __syncthreads();
  }
#undef GLOAD
#undef SSTORE
}
DI void tile_mn(int t, int nm, int nn, int& mi, int& ni) {
  const int nig = 16 * nn, g = t / nig, rem = t % nig, fm = g * 16;
  const int gsz = (nm - fm) < 16 ? (nm - fm) : 16;
  mi = fm + rem % gsz;
  ni = rem / gsz;
}
template <int WN, class Epi>
DI void gemm_emit(const f32x4 (&acc)[4][WN], int m0, int n0, Epi epi) {
  const int lane = otid() & 63, wid = otid() >> 6, wr = wid >> 1, wc = wid & 1;
#pragma unroll
  for (int i = 0; i < 4; ++i)
#pragma unroll
    for (int j = 0; j < WN; ++j) epi(m0 + wr * 64 + i * 16 + (lane & 15), n0 + wc * 16 * WN + j * 16 + (lane >> 4) * 4, acc[i][j]);
}
template <int WN>
DI void zero_acc(f32x4 (&acc)[4][WN]) {
#pragma unroll
  for (int i = 0; i < 4; ++i)
#pragma unroll
    for (int j = 0; j < WN; ++j) acc[i][j] = (f32x4){0.f, 0.f, 0.f, 0.f};
}

DI void gemm_core2(const bf16_t* __restrict__ A, int lda, int a_ks, const bf16_t* __restrict__ Bt, int ldb, int b_ks, int K, f32x4 (&acc)[8][4], char* lds) {
  constexpr int AST = 48;
  bf16_t* As = (bf16_t*)lds;
  bf16_t* Bs = As + 2 * 256 * AST;
  const int tid = otid(), lane = tid & 63, wid = tid >> 6, wr = wid >> 1, wc = wid & 1;
  u32x4 s0a[4], s0b[2], s1a[4], s1b[2];
  const int nk = K / 32;
  const bf16_t* ag = A + (size_t)(tid >> 2) * lda + (tid & 3) * 8;
  const bf16_t* bg = Bt + (size_t)(tid >> 2) * ldb + (tid & 3) * 8;
  const int bc_ = tid >> 2, brow = ((bc_ >> 5) * 2 + ((bc_ >> 2) & 1)) * 16 + ((bc_ >> 3) & 3) * 4 + (bc_ & 3);
#define LBAR() { asm volatile("s_waitcnt lgkmcnt(0)" ::: "memory"); __builtin_amdgcn_s_barrier(); asm volatile("" ::: "memory"); }
#define GLOAD2(ra, rb, k0)                                                                                                   \
  {                                                                                                                          \
    _Pragma("unroll") for (int i = 0; i < 4; ++i) ra[i] = *(const u32x4*)(ag + (size_t)(64 * i) * lda + (size_t)((k0) >> 5) * a_ks);               \
    _Pragma("unroll") for (int i = 0; i < 2; ++i) rb[i] = *(const u32x4*)(bg + (size_t)(64 * i) * ldb + (size_t)((k0) >> 5) * b_ks);               \
  }
#define SSTORE2(ra, rb, buf)                                                                                                 \
  {                                                                                                                          \
    _Pragma("unroll") for (int i = 0; i < 4; ++i) *(u32x4*)(As + ((buf) * 256 + 64 * i + (tid >> 2)) * AST + (tid & 3) * 8) = ra[i]; \
    _Pragma("unroll") for (int i = 0; i < 2; ++i) *(u32x4*)(Bs + ((buf) * 128 + 64 * i + brow) * AST + (tid & 3) * 8) = rb[i]; \
  }
#define STEP2(t, la, lb, sa, sb)                                                                                             \
  {                                                                                                                          \
    if ((t) + 2 < nk) GLOAD2(la, lb, ((t) + 2) * 32);                                                                        \
    const bf16_t* a = As + (((t) & 1) * 256 + wr * 128 + (lane & 15)) * AST + (lane >> 4) * 8;                               \
    const bf16_t* b = Bs + (((t) & 1) * 128 + wc * 64 + (lane & 15)) * AST + (lane >> 4) * 8;                                \
    bf16x8 bfr[4], a0[4], a1[4];                                                                                             \
    _Pragma("unroll") for (int j = 0; j < 4; ++j) bfr[j] = *(const bf16x8*)(b + j * 16 * AST);                               \
    _Pragma("unroll") for (int i = 0; i < 4; ++i) a0[i] = *(const bf16x8*)(a + i * 16 * AST);                                \
    __builtin_amdgcn_sched_barrier(0);                                                                                       \
    _Pragma("unroll") for (int i = 0; i < 4; ++i) a1[i] = *(const bf16x8*)(a + (4 + i) * 16 * AST);                          \
    __builtin_amdgcn_sched_barrier(0);                                                                                       \
    _Pragma("unroll") for (int i = 0; i < 4; ++i) _Pragma("unroll") for (int j = 0; j < 4; ++j) acc[i][j] = mfma16(bfr[j], a0[i], acc[i][j]); \
    __builtin_amdgcn_sched_barrier(0);                                                                                       \
    _Pragma("unroll") for (int i = 0; i < 4; ++i) _Pragma("unroll") for (int j = 0; j < 4; ++j) acc[4 + i][j] = mfma16(bfr[j], a1[i], acc[4 + i][j]); \
    __builtin_amdgcn_sched_barrier(0);                                                                                       \
    if ((t) + 1 < nk) SSTORE2(sa, sb, ((t) + 1) & 1);                                                                        \
    LBAR();                                                                                                                  \
  }
  GLOAD2(s0a, s0b, 0);
  SSTORE2(s0a, s0b, 0);
  GLOAD2(s1a, s1b, 32);
  LBAR();
  int t = 0;
  for (;;) {
    STEP2(t, s0a, s0b, s1a, s1b);
    if (++t >= nk) break;
    STEP2(t, s1a, s1b, s0a, s0b);
    if (++t >= nk) break;
  }
#undef GLOAD2
#undef SSTORE2
#undef STEP2
}
DI void tile_mn8(int t, int nm, int nn, int& mi, int& ni) {
  const int nig = 8 * nn, g = t / nig, rem = t % nig, fm = g * 8;
  const int gsz = (nm - fm) < 8 ? (nm - fm) : 8;
  mi = fm + rem % gsz;
  ni = rem / gsz;
}
template <class Epi, class Epi8>
DI void gemm_phase(const bf16_t* A, int lda, int a_ks, const bf16_t* Bt, int ldb, int b_ks, int K, int nm, int nn, char* lds, int B, int G, Epi epi, Epi8 epi8, bool skipctx = false) {
  if (skipctx) nm -= 4;
  const int NT = nm * nn;
  int nfull = (NT / G) * G, R = NT - nfull;
  if (4 * R > 2 * G) { nfull = NT; R = 0; }
  for (int t = B; t < nfull + 4 * R; t += G) {
    int mi, ni;
    if (t < nfull) {
      tile_mn8(t, nm, nn, mi, ni);
      if (skipctx) mi += (mi >> 5) + 1;
      f32x4 acc[8][4];
#pragma unroll
      for (int i = 0; i < 8; ++i)
#pragma unroll
        for (int j = 0; j < 4; ++j) acc[i][j] = (f32x4){0.f, 0.f, 0.f, 0.f};
      gemm_core2(A + (size_t)mi * 256 * lda, lda, a_ks, Bt + (size_t)ni * 128 * ldb, ldb, b_ks, K, acc, lds);
      const int lane = otid() & 63, wid = otid() >> 6, wr = wid >> 1, wc = wid & 1;
#pragma unroll
      for (int i = 0; i < 8; ++i)
#pragma unroll
        for (int jp = 0; jp < 2; ++jp) epi8(mi * 256 + wr * 128 + i * 16 + (lane & 15), ni * 128 + wc * 64 + jp * 32 + (lane >> 4) * 8, acc[i][2 * jp], acc[i][2 * jp + 1]);
    } else {
      const int u = t - nfull, sub = u & 3;
      tile_mn8(nfull + (u >> 2), nm, nn, mi, ni);
      if (skipctx) mi += (mi >> 5) + 1;
      const int m0 = mi * 256 + (sub >> 1) * 128, n0 = ni * 128 + (sub & 1) * 64;
      f32x4 acc[4][2]; zero_acc<2>(acc);
      gemm_core<2>(A + (size_t)m0 * lda, lda, a_ks, Bt + (size_t)n0 * ldb, ldb, b_ks, K, acc, lds);
      gemm_emit<2>(acc, m0, n0, epi);
    }
  }
}
DI int sg_col(int gc) { const int j = gc >> 7; return (j < 12 ? 512 + 128 * j : 2560 + 128 * (j - 12)) + (gc & 127); }

constexpr int N_CVT = 1152 + 32 + 768 + 384 + 256 + 1024 + 1024 + 32;
DI void job_cvt(const Params& p, int layer, int t, char* lds) {
  const float* src; int ld, ncol0 = 0, nlim, K, ntot, nrow0 = 0; bf16_t* dst;
  char* ws = p.ws;
  if (t < 1152) { src = p.w_in + (size_t)layer * 1024 * 7696; ld = 7696; ncol0 = 0; nlim = 4608; dst = (bf16_t*)(ws + OFF_WIN); K = 1024; ntot = 7808; nrow0 = 0; }
  else if ((t -= 1152) < 32) { src = p.w_in + (size_t)layer * 1024 * 7696; ld = 7696; ncol0 = 4608; nlim = 4624; dst = (bf16_t*)(ws + OFF_WIN); K = 1024; ntot = 7808; nrow0 = 4608; }
  else if ((t -= 32) < 768) { src = p.w_in + (size_t)layer * 1024 * 7696; ld = 7696; ncol0 = 4624; nlim = 7696; dst = (bf16_t*)(ws + OFF_WIN); K = 1024; ntot = 7808; nrow0 = 4736; }
  else if ((t -= 768) < 384) { const int i = t / 128; t %= 128; src = p.wbr + ((size_t)layer * 3 + i) * 512 * 1024; ld = 1024; nlim = 1024; dst = (bf16_t*)(ws + OFF_WBR) + (size_t)i * 1024 * 512; K = 512; ntot = 1024; }
  else if ((t -= 384) < 256) { src = p.wout + (size_t)layer * 1024 * 1024; ld = 1024; nlim = 1024; dst = (bf16_t*)(ws + OFF_WO); K = 1024; ntot = 1024; }
  else if ((t -= 256) < 1024) { src = p.w1 + (size_t)layer * 1024 * 4096; ld = 4096; nlim = 4096; dst = (bf16_t*)(ws + OFF_W1); K = 1024; ntot = 4096; }
  else if ((t -= 1024) < 1024) { src = p.w2 + (size_t)layer * 4096 * 1024; ld = 1024; nlim = 1024; dst = (bf16_t*)(ws + OFF_W2); K = 4096; ntot = 1024; }
  else { t -= 1024; src = p.lgw + ((size_t)layer * 32 + t) * 4096; ld = 64; nlim = 64; dst = (bf16_t*)(ws + OFF_LG) + (size_t)t * 4096; K = 64; ntot = 0; t = 0; }
  const int nkt = K / 64, nt = t / nkt, kt = t % nkt;
  float* tl = (float*)lds;
  const int tid = otid();
  {
    const int nn = tid & 63, ncol = ncol0 + nt * 64 + nn;
#pragma unroll
    for (int i = 0; i < 16; ++i) {
      const int kk = i * 4 + (tid >> 6);
      tl[kk * 65 + nn] = (ncol < nlim) ? src[(size_t)(kt * 64 + kk) * ld + ncol] : 0.f;
    }
  }
  __syncthreads();
  {
    const int n = tid >> 2, kq = tid & 3;
    float v[16];
#pragma unroll
    for (int e = 0; e < 16; ++e) v[e] = tl[(kq * 16 + e) * 65 + n];
    u32x4 w0 = {pk2(v[0], v[1]), pk2(v[2], v[3]), pk2(v[4], v[5]), pk2(v[6], v[7])};
    u32x4 w1 = {pk2(v[8], v[9]), pk2(v[10], v[11]), pk2(v[12], v[13]), pk2(v[14], v[15])};
    const int nd = nrow0 + nt * 64 + n, kd = kt * 64 + kq * 16;
    bf16_t* d = ntot ? dst + ((size_t)(kd >> 5) * ntot + nd) * 32 + (kd & 31) : dst + (size_t)nd * K + kd;
    *(u32x4*)d = w0;
    *(u32x4*)(d + 8) = w1;
  }
  __syncthreads();
}
DI void job_mod(const Params& p, int it, char* lds) {
  const int nc = it % 96, l = it / 96, tid = otid();
  float* sc = (float*)lds;
  float* red = sc + 5 * 1024;
  for (int i = tid; i < 5 * 1024; i += 256) {
    const int v = i >> 10, k = i & 1023;
    const float cv = v < 4 ? p.c[v * 1024 + k] : p.cctx[k];
    sc[i] = cv * sigm(cv);
  }
  __syncthreads();
  const int col = tid & 63, kg = tid >> 6, n = nc * 64 + col;
  const float* w = p.ada_w + ((size_t)l * 1024 + kg * 256) * 6144 + n;
  const float* s0 = sc + kg * 256;
  float a0 = 0, a1 = 0, a2 = 0, a3 = 0, a4 = 0;
#pragma unroll 8
  for (int k = 0; k < 256; ++k) {
    const float wv = w[(size_t)k * 6144];
    a0 += s0[k] * wv; a1 += s0[1024 + k] * wv; a2 += s0[2048 + k] * wv; a3 += s0[3072 + k] * wv; a4 += s0[4096 + k] * wv;
  }
  red[(kg * 5 + 0) * 64 + col] = a0; red[(kg * 5 + 1) * 64 + col] = a1; red[(kg * 5 + 2) * 64 + col] = a2; red[(kg * 5 + 3) * 64 + col] = a3; red[(kg * 5 + 4) * 64 + col] = a4;
  __syncthreads();
  for (int i = tid; i < 320; i += 256) {
    const int v = i >> 6, cc = i & 63;
    const float r = ((red[(0 * 5 + v) * 64 + cc] + red[(1 * 5 + v) * 64 + cc]) + (red[(2 * 5 + v) * 64 + cc] + red[(3 * 5 + v) * 64 + cc])) + p.ada_b[l * 6144 + nc * 64 + cc];
    ((float*)(p.ws + OFF_MOD))[(size_t)(l * 5 + v) * 6144 + nc * 64 + cc] = r;
  }
  __syncthreads();
}
DI void job_rope(const Params& p, int it) {
  const int idx = it * 256 + otid(), t = idx >> 5, ax = (idx >> 4) & 1, f = idx & 15;
  const float inv = powf(10000.f, -(float)f / 16.f);
  const float pos = (float)(ax ? (t & 63) : (t >> 6));
  float s, c;
  sincosf(pos * inv, &s, &c);
  ((f32x2*)(p.ws + OFF_ROPE))[idx] = (f32x2){c, s};
}
DI void job_norm(const Params& p, int layer, int which, int it) {
  const int lane = otid() & 63, wid = otid() >> 6, r = it * 8 + wid;
  const float* xr0 = (which == 1) ? res_in_row(p, layer, r) : (const float*)res_out_row(p, r);
  const float* xr1 = (which == 1) ? res_in_row(p, layer, r + 4) : (const float*)res_out_row(p, r + 4);
  const float* mv = mod_vec(p, layer, r);
  const float* sh = mv + (which == 1 ? 0 : 3072);
  const float* sc = mv + (which == 1 ? 1024 : 4096);
  const float* g = (which == 1 ? p.n1g : p.n2g) + layer * 1024;
  f32x4 xa[4], xb[4];
#pragma unroll
  for (int i = 0; i < 4; ++i) { xa[i] = *(const f32x4*)(xr0 + i * 256 + lane * 4); xb[i] = *(const f32x4*)(xr1 + i * 256 + lane * 4); }
  float sa = 0.f, sb = 0.f;
#pragma unroll
  for (int i = 0; i < 4; ++i) {
    sa += xa[i][0] * xa[i][0] + xa[i][1] * xa[i][1] + xa[i][2] * xa[i][2] + xa[i][3] * xa[i][3];
    sb += xb[i][0] * xb[i][0] + xb[i][1] * xb[i][1] + xb[i][2] * xb[i][2] + xb[i][3] * xb[i][3];
  }
  sa = wsum(sa); sb = wsum(sb);
  const float ra = rsqrtf(sa * (1.f / 1024.f) + EPS), rb = rsqrtf(sb * (1.f / 1024.f) + EPS);
  bf16_t* H0 = (bf16_t*)(p.ws + OFF_H) + (size_t)r * 32;
  bf16_t* H1 = H0 + 4 * 32;
#pragma unroll
  for (int i = 0; i < 4; ++i) {
    const int c = i * 256 + lane * 4;
    const f32x4 gv = *(const f32x4*)(g + c), sv = *(const f32x4*)(sc + c), hv = *(const f32x4*)(sh + c);
    float o[4], q[4];
#pragma unroll
    for (int e = 0; e < 4; ++e) { const float m = gv[e] * (1.f + sv[e]); o[e] = xa[i][e] * ra * m + hv[e]; q[e] = xb[i][e] * rb * m + hv[e]; }
    const size_t so = (size_t)(c >> 5) * MR * 32 + (c & 31);
    *(u32x2*)(H0 + so) = (u32x2){pk2(o[0], o[1]), pk2(o[2], o[3])};
    *(u32x2*)(H1 + so) = (u32x2){pk2(q[0], q[1]), pk2(q[2], q[3])};
  }
}

DI void job_daprep1(const Params& p, int layer, int r, bool dup) {
  const int lane = otid() & 63, s = r % TT;
  const int G = lane >> 2, quarter = lane & 3;
  bf16_t* ptr = (bf16_t*)(p.ws + OFF_P) + (size_t)r * LDP + (G < 8 ? C_DAQ + G * 64 : C_DAK + (G - 8) * 64) + quarter * 16;
  const u32x4 w0 = *(const u32x4*)ptr, w1 = *(const u32x4*)(ptr + 8);
  float y[16];
#pragma unroll
  for (int e = 0; e < 4; ++e) { y[2 * e] = bflo(w0[e]); y[2 * e + 1] = bfhi(w0[e]); y[8 + 2 * e] = bflo(w1[e]); y[9 + 2 * e] = bfhi(w1[e]); }
  float ss = 0.f;
#pragma unroll
  for (int e = 0; e < 16; ++e) ss += y[e] * y[e];
  ss += shx<1>(ss);
  ss += shx<2>(ss);
  float rstd = rsqrtf(ss * (1.f / 64.f) + EPS);
  const float* g = (G < 8 ? p.daqg : p.dakg) + layer * 64 + quarter * 16;
#pragma unroll
  for (int e = 0; e < 16; ++e) y[e] = y[e] * rstd * g[e];
  if (s >= TC) {
    const f32x2* tb = (const f32x2*)(p.ws + OFF_ROPE) + ((size_t)(s - TC) * 2 + (quarter >> 1)) * 16;
#pragma unroll
    for (int e = 0; e < 16; ++e) {
      const float yp = shx<1>(y[e]);
      const f32x2 cs = tb[e];
      y[e] = (quarter & 1) ? (y[e] * cs.x + yp * cs.y) : (y[e] * cs.x - yp * cs.y);
    }
  }
  if (G < 8) {
#pragma unroll
    for (int e = 0; e < 16; ++e) y[e] *= 0.125f * 1.4426950408889634f;
  }
  if (dup) return;
  *(u32x4*)ptr = (u32x4){pk2(y[0], y[1]), pk2(y[2], y[3]), pk2(y[4], y[5]), pk2(y[6], y[7])};
  *(u32x4*)(ptr + 8) = (u32x4){pk2(y[8], y[9]), pk2(y[10], y[11]), pk2(y[12], y[13]), pk2(y[14], y[15])};
}
DI void job_daprep(const Params& p, int layer, int it, bool dup) {
  const int wid = otid() >> 6;
#pragma unroll
  for (int rr = 0; rr < 2; ++rr) job_daprep1(p, layer, it * 8 + rr * 4 + wid, dup);
}
DI void job_vt(const Params& p, int it, char* lds) {
  const int h = it & 3, c = (it >> 2) % NCH, b = it / (4 * NCH), tid = otid();
  bf16_t* tl = (bf16_t*)lds;
  const bf16_t* P = (const bf16_t*)(p.ws + OFF_P);
#pragma unroll
  for (int i = 0; i < 4; ++i) {
    const int q = tid + 256 * i, row = q >> 4, pc = q & 15;
    const u32x4 w = *(const u32x4*)(P + (size_t)(b * TT + c * 64 + row) * LDP + C_DAV + h * 128 + pc * 8);
    unsigned* d = (unsigned*)(tl + row * 130 + pc * 8);
    d[0] = w[0]; d[1] = w[1]; d[2] = w[2]; d[3] = w[3];
  }
  __syncthreads();
  {
    const int dv = tid >> 1, half = tid & 1;
    unsigned o[16];
#pragma unroll
    for (int e = 0; e < 16; ++e) o[e] = (unsigned)tl[(half * 32 + 2 * e) * 130 + dv] | ((unsigned)tl[(half * 32 + 2 * e + 1) * 130 + dv] << 16);
    bf16_t* d = (bf16_t*)(p.ws + OFF_VT) + ((size_t)(b * 4 + h) * 128 + dv) * TT + c * 64 + half * 32;
#pragma unroll
#define VTW(w) o[(((w) & 3) >> 1) * 8 + ((w) >> 2) * 2 + ((w) & 1)]
    for (int e = 0; e < 4; ++e) *(u32x4*)(d + e * 8) = (u32x4){VTW(4 * e), VTW(4 * e + 1), VTW(4 * e + 2), VTW(4 * e + 3)};
#undef VTW
  }
  __syncthreads();
}

constexpr int N_ATT = 1056;
DI void job_attn(const Params& p, int layer, int a, char* lds, bool dup) {
  const int tid = otid(), lane = tid & 63, wid = tid >> 6, l15 = lane & 15, g = lane >> 4;
  const int grp = a / 528, within = a % 528, bh = grp * 8 + (within & 7), qb = within >> 3, b = bh >> 2, h = bh & 3;
  if (layer == 1 && qb < 2) return;
  const int nt = qb < 2 ? 4 : NCH;
  bf16_t* P = (bf16_t*)(p.ws + OFF_P);
  const bf16_t* VT = (const bf16_t*)(p.ws + OFF_VT) + (size_t)(b * 4 + h) * 128 * TT;
  int ly_ = layer; asm volatile("" : "+s"(ly_));
  const float lam_init = __uint_as_float(ly_ == 0 ? 0x3e4ccccdu : 0x3eb60549u);
  const float* lv = p.dalam + layer * 256;
  const float lam = __uint_as_float(__builtin_amdgcn_readfirstlane(__float_as_uint(expf(wsum(lv[lane] * lv[64 + lane])) - expf(wsum(lv[128 + lane] * lv[192 + lane])) + lam_init)));
  const float mq = wmax(fabsf(p.daqg[layer * 64 + lane])), mk = wmax(fabsf(p.dakg[layer * 64 + lane]));
  const float negMb = __uint_as_float(__builtin_amdgcn_readfirstlane(__float_as_uint(-(8.f * mq * mk * 1.03f * 1.4426950408889634f + 0.5f))));
  const int r0 = b * TT + qb * 128 + wid * 32;
  bf16x8 qf[2][2][2];
#pragma unroll
  for (int c = 0; c < 2; ++c)
#pragma unroll
    for (int i = 0; i < 2; ++i)
#pragma unroll
      for (int ks = 0; ks < 2; ++ks) qf[c][i][ks] = *(const bf16x8*)(P + (size_t)(r0 + i * 16 + l15) * LDP + C_DAQ + h * 128 + c * 64 + ks * 32 + g * 8);
  bf16_t* Ks = (bf16_t*)lds;
  bf16_t* Vs = Ks + 2 * 64 * 144;
  u32x4 rk[4], rv[4];
  const bf16_t* kg = P + (size_t)(b * TT) * LDP + C_DAK + h * 128;
#define KLOAD(t) { _Pragma("unroll") for (int i = 0; i < 4; ++i) { const int q = tid + 256 * i; rk[i] = *(const u32x4*)(kg + (size_t)((t) * 64 + (q >> 4)) * LDP + (q & 15) * 8); } }
#define VLOAD(t) { _Pragma("unroll") for (int i = 0; i < 4; ++i) { const int q = tid + 256 * i; rv[i] = *(const u32x4*)(VT + (size_t)(q >> 3) * TT + (t) * 64 + (q & 7) * 8); } }
#define KSTORE(buf) { _Pragma("unroll") for (int i = 0; i < 4; ++i) { const int q = tid + 256 * i; *(u32x4*)(Ks + ((buf) * 64 + (q >> 4)) * 144 + (q & 15) * 8) = rk[i]; } }
#define VSTORE(buf) { _Pragma("unroll") for (int i = 0; i < 4; ++i) { const int q = tid + 256 * i; *(u32x4*)(Vs + ((buf) * 128 + (q >> 3)) * 80 + (q & 7) * 8) = rv[i]; } }
#define QK_INTO(S, Kb, half, CI)                                                                                       \
  _Pragma("unroll") for (int c = 0; c < 2; ++c) {                                                                      \
    bf16x8 kf[2][2];                                                                                                   \
    _Pragma("unroll") for (int k2 = 0; k2 < 2; ++k2) _Pragma("unroll") for (int ks = 0; ks < 2; ++ks)                  \
      kf[k2][ks] = *(const bf16x8*)((Kb) + ((half) * 32 + k2 * 16 + l15) * 144 + c * 64 + ks * 32 + g * 8);             \
    __builtin_amdgcn_sched_barrier(0);                                                                                 \
    _Pragma("unroll") for (int k2 = 0; k2 < 2; ++k2) _Pragma("unroll") for (int i = 0; i < 2; ++i) {                   \
      S[c][i][k2] = mfma16(kf[k2][0], qf[c][i][0], CI(c, i));     \
      S[c][i][k2] = mfma16(kf[k2][1], qf[c][i][1], S[c][i][k2]); }                                                     \
  }                                                                                                                    \
  __builtin_amdgcn_sched_barrier(0);
#define EXPSUM(S)                                                                                                      \
  _Pragma("unroll") for (int c = 0; c < 2; ++c) _Pragma("unroll") for (int i = 0; i < 2; ++i) {                        \
    _Pragma("unroll") for (int k2 = 0; k2 < 2; ++k2) _Pragma("unroll") for (int e = 0; e < 4; ++e) S[c][i][k2][e] = __builtin_amdgcn_exp2f(S[c][i][k2][e]); \
    lsum[c][i] += ((S[c][i][0][0] + S[c][i][0][1]) + (S[c][i][0][2] + S[c][i][0][3])) + ((S[c][i][1][0] + S[c][i][1][1]) + (S[c][i][1][2] + S[c][i][1][3])); }
#define EXP_S() _Pragma("unroll") for (int c = 0; c < 2; ++c) _Pragma("unroll") for (int i = 0; i < 2; ++i) _Pragma("unroll") for (int k2 = 0; k2 < 2; ++k2) _Pragma("unroll") for (int e = 0; e < 4; ++e) S[c][i][k2][e] = __builtin_amdgcn_exp2f(S[c][i][k2][e]);
  float lsum[2][2] = {{0.f, 0.f}, {0.f, 0.f}};
  KLOAD(0);
  KSTORE(0);
  __syncthreads();
  const f32x4 negMv = {negMb, negMb, negMb, negMb};
#define CI1(c, i) negMv
  f32x4 SA[2][2][2], SB[2][2][2];
#pragma unroll 1
  for (int t = 0; t < nt; ++t) {
    if (t + 1 < nt) KLOAD(t + 1);
    const bf16_t* Kb = Ks + (t & 1) * 64 * 144;
    QK_INTO(SA, Kb, 0, CI1)
    if (t > 0) { EXPSUM(SB) }
    __builtin_amdgcn_sched_barrier(0);
    QK_INTO(SB, Kb, 1, CI1)
    EXPSUM(SA)
    if (t + 1 < nt) KSTORE((t + 1) & 1);
    __syncthreads();
  }
  EXPSUM(SB)
  f32x4 ci2[2][2];
#pragma unroll
  for (int i = 0; i < 2; ++i) {
    float l0 = lsum[0][i], l1 = lsum[1][i];
    l0 += shx<16>(l0); l0 = add32(l0);
    l1 += shx<16>(l1); l1 = add32(l1);
    const float c0 = negMb - __log2f(l0), c1 = negMb + __log2f(fabsf(lam)) - __log2f(l1);
    ci2[0][i] = (f32x4){c0, c0, c0, c0}; ci2[1][i] = (f32x4){c1, c1, c1, c1};
  }
  const float nsl = lam < 0.f ? 1.f : -1.f;
#define CI2(c, i) ci2[c][i]
  f32x4 O[2][8];
#pragma unroll
  for (int i = 0; i < 2; ++i)
#pragma unroll
    for (int n = 0; n < 8; ++n) O[i][n] = (f32x4){0.f, 0.f, 0.f, 0.f};
  KLOAD(0); VLOAD(0);
  KSTORE(0); VSTORE(0);
  __syncthreads();
#pragma unroll 1
  for (int t = 0; t < nt; ++t) {
    if (t + 1 < nt) KLOAD(t + 1);
    const bf16_t* Kb = Ks + (t & 1) * 64 * 144;
    const bf16_t* Vb = Vs + (t & 1) * 128 * 80;
#pragma unroll
    for (int half = 0; half < 2; ++half) {
      bf16x8 pf[2], vfa[4], vfb[4];
#define VREAD(dst, n0) _Pragma("unroll") for (int n = 0; n < 4; ++n) dst[n] = *(const bf16x8*)(Vb + (((n0) + n) * 16 + l15) * 80 + half * 32 + g * 8);
      {
        f32x4 S[2][2][2];
        QK_INTO(S, Kb, half, CI2)
        VREAD(vfa, 0)
        EXP_S()
#pragma unroll
        for (int i = 0; i < 2; ++i) {
          float w[8];
#pragma unroll
          for (int k2 = 0; k2 < 2; ++k2)
#pragma unroll
            for (int e = 0; e < 4; ++e) w[k2 * 4 + e] = __builtin_fmaf(nsl, S[1][i][k2][e], S[0][i][k2][e]);
          const u32x4 ww = {pk2(w[0], w[1]), pk2(w[2], w[3]), pk2(w[4], w[5]), pk2(w[6], w[7])};
          pf[i] = __builtin_bit_cast(bf16x8, ww);
        }
      }
      __builtin_amdgcn_sched_barrier(0);
      VREAD(vfb, 4)
#pragma unroll
      for (int n = 0; n < 4; ++n)
#pragma unroll
        for (int i = 0; i < 2; ++i) O[i][n] = mfma16(pf[i], vfa[n], O[i][n]);
      __builtin_amdgcn_sched_barrier(0);
#pragma unroll
      for (int n = 0; n < 4; ++n)
#pragma unroll
        for (int i = 0; i < 2; ++i) O[i][4 + n] = mfma16(pf[i], vfb[n], O[i][4 + n]);
      __builtin_amdgcn_sched_barrier(0);
#undef VREAD
      if (half == 0 && t + 1 < nt) VLOAD(t + 1);
    }
    if (t + 1 < nt) { KSTORE((t + 1) & 1); VSTORE((t + 1) & 1); }
    __syncthreads();
  }
#undef KLOAD
#undef VLOAD
#undef KSTORE
#undef VSTORE
#undef CI1
#undef CI2
#undef QK_INTO
#undef EXPSUM
#undef EXP_S
  const int lane_e = otid() & 63, l15e = lane_e & 15, ge = lane_e >> 4;
  const float* sg = p.dasub + layer * 128;
#pragma unroll
  for (int i = 0; i < 2; ++i)
#pragma unroll
    for (int e = 0; e < 4; ++e) {
      float ss = 0.f;
#pragma unroll
      for (int n = 0; n < 8; ++n) ss += O[i][n][e] * O[i][n][e];
      ss += shx<1>(ss); ss += shx<2>(ss); ss += shx<4>(ss); ss += shx<8>(ss);
      const float rstd = rsqrtf(ss * (1.f / 128.f) + EPS) * (1.f - lam_init);
      bf16_t* op = P + (size_t)(r0 + i * 16 + ge * 4 + e) * LDP + C_DAQ + h * 128 + l15e;
#pragma unroll
      for (int n = 0; n < 8; ++n) if (!dup) op[n * 16] = f2bf(O[i][n][e] * rstd * sg[n * 16 + l15e]);
    }
}

DI float gelu_tanh(float x) { const float u = 0.7978845608028654f * (x + 0.044715f * x * x * x); return 0.5f * x * (1.f + tanhf(u)); }
template <int PASS>
DI void job_lru(const Params& p, int layer, int it, char* lds, bool dup) {
  const int tid = otid(), lane = tid & 63, wid = tid >> 6, l15 = lane & 15, g = lane >> 4;
  const int n = it & 7, c = (it >> 3) % NCH, b = it / (8 * NCH);
  float* xc32 = (float*)lds;
  bf16_t* xcb = (bf16_t*)(lds + 16384);
  f32x2* ab = (f32x2*)(lds + 16384 + 9216);
  f32x2* segtot = (f32x2*)(lds + 16384 + 9216 + 32768);
  float* carry = (float*)(lds + 16384 + 9216 + 32768 + 2048);
  bf16_t* P = (bf16_t*)(p.ws + OFF_P);
  f32x2* LC = (f32x2*)(p.ws + OFF_LC);
  const int ch = tid & 63, seg = tid >> 6;
  {
    const int segLo = c < 4 ? 0 : TC, segHi = c < 4 ? TC : TT;
    const int s0 = c * 64 + seg * 16;
    float cw[4];
#pragma unroll
    for (int k = 0; k < 4; ++k) cw[k] = p.lcw[(size_t)(layer * 4 + k) * 512 + n * 64 + ch];
    const float cb = p.lcb[layer * 512 + n * 64 + ch];
    float xw[19];
#pragma unroll
    for (int j = 0; j < 19; ++j) {
      const int s = s0 - 1 + j;
      xw[j] = (s >= segLo && s < segHi) ? bf2f(P[(size_t)(b * TT + s) * LDP + C_LX + n * 64 + ch]) : 0.f;
    }
#pragma unroll
    for (int u = 0; u < 16; ++u) {
      const float v = cw[0] * xw[u] + cw[1] * xw[u + 1] + cw[2] * xw[u + 2] + cw[3] * xw[u + 3] + cb;
      xc32[(seg * 16 + u) * 64 + ch] = v;
      xcb[(seg * 16 + u) * 72 + ch] = f2bf(v);
    }
  }
  if (PASS == 3 && tid < 128) {
    const int d = tid >> 6;
    const int pos = d == 0 ? c : (c < 4 ? 3 - c : 4 + (NCH - 1 - c));
    float hh = 0.f;
    for (int q0 = 0; q0 < pos; q0 += 16) {
      f32x2 AB[16];
#pragma unroll
      for (int j = 0; j < 16; ++j) {
        const int q = q0 + j, qq = q < pos ? q : pos - 1;
        const int cc = d == 0 ? qq : (qq < 4 ? 3 - qq : NCH - 1 - (qq - 4));
        AB[j] = LC[((((size_t)b * NCH + cc) * 8 + n) * 2 + d) * 64 + ch];
      }
#pragma unroll
      for (int j = 0; j < 16; ++j) if (q0 + j < pos) hh = AB[j].x * hh + AB[j].y;
    }
    carry[d * 64 + ch] = hh;
  }
  __syncthreads();
  float hacc[16];
#pragma unroll
  for (int u = 0; u < 16; ++u) hacc[u] = 0.f;
#pragma unroll 1
  for (int d = 0; d < 2; ++d) {
    {
      f32x4 ar[4], ai[4];
#pragma unroll
      for (int i = 0; i < 4; ++i) { ar[i] = (f32x4){0.f, 0.f, 0.f, 0.f}; ai[i] = (f32x4){0.f, 0.f, 0.f, 0.f}; }
      const bf16_t* LG = (const bf16_t*)(p.ws + OFF_LG);
      const bf16_t* wr_ = LG + ((size_t)((d * 2 + 0) * 8 + n)) * 4096 + (wid * 16 + l15) * 64 + g * 8;
      const bf16_t* wi_ = LG + ((size_t)((d * 2 + 1) * 8 + n)) * 4096 + (wid * 16 + l15) * 64 + g * 8;
#pragma unroll
      for (int ks = 0; ks < 2; ++ks) {
        const bf16x8 br = *(const bf16x8*)(wr_ + ks * 32), bi = *(const bf16x8*)(wi_ + ks * 32);
#pragma unroll
        for (int i = 0; i < 4; ++i) {
          const bf16x8 af = *(const bf16x8*)(xcb + (i * 16 + l15) * 72 + ks * 32 + g * 8);
          ar[i] = mfma16(br, af, ar[i]);
          ai[i] = mfma16(bi, af, ai[i]);
        }
      }
#pragma unroll
      for (int e = 0; e < 4; ++e) {
        const int che = wid * 16 + g * 4 + e, cg_ = n * 64 + che;
        const float br = p.lgb[(size_t)((layer * 2 + d) * 2 + 0) * 512 + cg_], bi = p.lgb[(size_t)((layer * 2 + d) * 2 + 1) * 512 + cg_];
        const float sp = softplusf(-p.llam[(size_t)(layer * 2 + d) * 512 + cg_]);
#pragma unroll
        for (int i = 0; i < 4; ++i) {
          const int tok = i * 16 + l15;
          const float r = sigm(ar[i][e] + br), ig = sigm(ai[i][e] + bi);
          const float la = -8.f * r * sp;
          const float av = __expf(la);
          const float bv = __builtin_sqrtf(fmaxf(1.f - __expf(2.f * la), 0.f)) * ig * xc32[tok * 64 + che];
          ab[tok * 64 + che] = (f32x2){av, bv};
        }
      }
    }
    __syncthreads();
    float hloc[16], cploc[16];
    {
      float hp = 0.f, cp = 1.f;
#pragma unroll
      for (int uu = 0; uu < 16; ++uu) {
        const int u = d == 0 ? uu : 15 - uu;
        const f32x2 v = ab[(seg * 16 + u) * 64 + ch];
        hp = v.x * hp + v.y;
        cp *= v.x;
        hloc[uu] = hp; cploc[uu] = cp;
      }
      segtot[seg * 64 + ch] = (f32x2){cp, hp};
    }
    __syncthreads();
    if (PASS == 1) {
      if (tid < 64) {
        float A = 1.f, Bv = 0.f;
#pragma unroll
        for (int q = 0; q < 4; ++q) {
          const f32x2 v = segtot[(d == 0 ? q : 3 - q) * 64 + ch];
          Bv = v.x * Bv + v.y; A *= v.x;
        }
        LC[((((size_t)b * NCH + c) * 8 + n) * 2 + d) * 64 + ch] = (f32x2){A, Bv};
      }
    } else {
      float hh = carry[d * 64 + ch];
      const int npre = d == 0 ? seg : 3 - seg;
      for (int q = 0; q < npre; ++q) {
        const f32x2 v = segtot[(d == 0 ? q : 3 - q) * 64 + ch];
        hh = v.x * hh + v.y;
      }
#pragma unroll
      for (int uu = 0; uu < 16; ++uu) {
        const int u = d == 0 ? uu : 15 - uu;
        const float hv = hloc[uu] + cploc[uu] * hh;
        hacc[d == 0 ? uu : 15 - uu] += hv;
        (void)u;
      }
    }
    __syncthreads();
  }
  if (PASS == 3) {
#pragma unroll
    for (int u = 0; u < 16; ++u) {
      bf16_t* yp = P + (size_t)(b * TT + c * 64 + seg * 16 + u) * LDP + C_LY + n * 64 + ch;
      if (!dup) *yp = f2bf(gelu_tanh(bf2f(*yp)) * hacc[u]);
    }
  }
}

DI void job_gconv(const Params& p, int layer, int it, bool dup) {
  const int tid = otid(), grp = it % 12, cg_ = it / 12, cp = tid & 15, rg = tid >> 4;
  const int cin = cg_ % NCH;
  const bool first = (cin == 0 || cin == 4), last = (cin == 3 || cin == NCH - 1);
  bf16_t* P = (bf16_t*)(p.ws + OFF_P);
  const bf16_t* HALO = (const bf16_t*)(p.ws + OFF_HALO);
  const int col = grp * 128 + cp * 8;
  u32x4 xr[7];
#pragma unroll
  for (int j = 0; j < 7; ++j) {
    const int q = rg * 4 - 1 + j;
    u32x4 v = {0u, 0u, 0u, 0u};
    if (q >= 0 && q < 64) v = *(const u32x4*)(P + (size_t)(cg_ * 64 + q) * LDP + C_GQKV + col);
    else if (q < 0) { if (!first) v = *(const u32x4*)(HALO + ((size_t)(cg_ - 1) * 3 + 2) * 1536 + col); }
    else { if (!last) v = *(const u32x4*)(HALO + ((size_t)(cg_ + 1) * 3 + (q - 64)) * 1536 + col); }
    xr[j] = v;
  }
  float w[4][8];
#pragma unroll
  for (int k = 0; k < 4; ++k) {
    const f32x4 a = *(const f32x4*)(p.gcw + (size_t)(layer * 4 + k) * 1536 + col), bq = *(const f32x4*)(p.gcw + (size_t)(layer * 4 + k) * 1536 + col + 4);
#pragma unroll
    for (int e = 0; e < 4; ++e) { w[k][e] = a[e]; w[k][4 + e] = bq[e]; }
  }
  __syncthreads();
#pragma unroll
  for (int jr = 0; jr < 4; ++jr) {
    float y[8];
#pragma unroll
    for (int e = 0; e < 8; ++e) y[e] = 0.f;
#pragma unroll
    for (int k = 0; k < 4; ++k)
#pragma unroll
      for (int e = 0; e < 4; ++e) { y[2 * e] += w[k][2 * e] * bflo(xr[jr + k][e]); y[2 * e + 1] += w[k][2 * e + 1] * bfhi(xr[jr + k][e]); }
    float ss = 0.f;
#pragma unroll
    for (int e = 0; e < 8; ++e) { y[e] = y[e] * sigm(y[e]); ss += y[e] * y[e]; }
    if (grp < 8) {
      ss += shx<1>(ss); ss += shx<2>(ss); ss += shx<4>(ss); ss += shx<8>(ss);
      const float sc = rsqrtf(ss + EPS) * (grp < 4 ? 0.08838834764831845f : 1.f);
#pragma unroll
      for (int e = 0; e < 8; ++e) y[e] *= sc;
    }
    if (!dup) *(u32x4*)(P + (size_t)(cg_ * 64 + rg * 4 + jr) * LDP + C_GQKV + col) = (u32x4){pk2(y[0], y[1]), pk2(y[2], y[3]), pk2(y[4], y[5]), pk2(y[6], y[7])};
  }
  __syncthreads();
}

DI void job_gprep(const Params& p, int layer, int it, char* lds) {
  const int tid = otid(), lane = tid & 63, wid = tid >> 6, l15 = lane & 15, g = lane >> 4;
  const int h = it & 3, c = (it >> 2) % NCH, b = it / (4 * NCH);
  bf16_t* kt_ = (bf16_t*)lds;
  bf16_t* qt_ = kt_ + 64 * 136;
  float* Ld = (float*)lds;
  float* KK = (float*)(lds + 34816);
  float* QK = KK + 64 * 65;
  float* gcs = QK + 64 * 65;
  float* bts = gcs + 128;
  const bf16_t* P = (const bf16_t*)(p.ws + OFF_P);
#pragma unroll
  for (int i = 0; i < 4; ++i) {
    const int q = tid + 256 * i, row = q >> 4, pc = q & 15;
    const bf16_t* rp = P + (size_t)(b * TT + c * 64 + row) * LDP + C_GQKV + h * 128 + pc * 8;
    *(u32x4*)(qt_ + row * 136 + pc * 8) = *(const u32x4*)rp;
    *(u32x4*)(kt_ + row * 136 + pc * 8) = *(const u32x4*)(rp + 512);
  }
  float* GSC = (float*)(p.ws + OFF_GSC);
  if (tid < 128) {
    const int d = wid, i = lane, tn = d ? 63 - i : i, r = b * TT + c * 64 + tn;
    const float* gba = (const float*)(p.ws + OFF_GBA) + (size_t)r * 16;
    const float gval = -expf(p.galog[(layer * 2 + d) * 4 + h]) * softplusf(gba[8 + d * 4 + h] + p.gdtb[(layer * 2 + d) * 4 + h]);
    const float beta = sigm(gba[d * 4 + h]);
    float v = gval;
#pragma unroll
    for (int o = 1; o < 64; o <<= 1) { const float t = __int_as_float(__builtin_amdgcn_ds_bpermute(((lane - o) & 63) << 2, __float_as_int(v))); if (lane >= o) v += t; }
    const float glast = __int_as_float(__builtin_amdgcn_readlane(__float_as_int(v), 63));
    gcs[d * 64 + i] = v;
    bts[d * 64 + i] = beta;
    float* gs = GSC + (size_t)(it * 2 + d) * 192;
    gs[i] = expf(v);
    gs[64 + i] = expf(glast - v);
    if (i == 0) gs[128] = expf(glast);
  }
  __syncthreads();
  {
    f32x4 akk[4], aqk[4];
#pragma unroll
    for (int j = 0; j < 4; ++j) { akk[j] = (f32x4){0.f, 0.f, 0.f, 0.f}; aqk[j] = (f32x4){0.f, 0.f, 0.f, 0.f}; }
#pragma unroll
    for (int ks = 0; ks < 4; ++ks) {
      const bf16x8 ak = *(const bf16x8*)(kt_ + (wid * 16 + l15) * 136 + ks * 32 + g * 8);
      const bf16x8 aq = *(const bf16x8*)(qt_ + (wid * 16 + l15) * 136 + ks * 32 + g * 8);
#pragma unroll
      for (int j = 0; j < 4; ++j) {
        const bf16x8 bk = *(const bf16x8*)(kt_ + (j * 16 + l15) * 136 + ks * 32 + g * 8);
        akk[j] = mfma16(ak, bk, akk[j]);
        aqk[j] = mfma16(aq, bk, aqk[j]);
      }
    }
#pragma unroll
    for (int j = 0; j < 4; ++j)
#pragma unroll
      for (int e = 0; e < 4; ++e) { KK[(wid * 16 + g * 4 + e) * 65 + j * 16 + l15] = akk[j][e]; QK[(wid * 16 + g * 4 + e) * 65 + j * 16 + l15] = aqk[j][e]; }
  }
  __syncthreads();
  bf16_t* M1 = (bf16_t*)(p.ws + OFF_H);
  bf16_t* AT = M1 + (size_t)4224 * 4096;
#pragma unroll 1
  for (int d = 0; d < 2; ++d) {
    bf16_t* atp = AT + (size_t)(it * 2 + d) * 4096;
#pragma unroll 4
    for (int idx = tid; idx < 4096; idx += 256) {
      const int i = idx >> 6, j = idx & 63, ti = d ? 63 - i : i, tj = d ? 63 - j : j;
      const float dec = (j <= i) ? expf(gcs[d * 64 + i] - gcs[d * 64 + j]) : 0.f;
      Ld[d * 4096 + idx] = (j < i) ? bts[d * 64 + i] * KK[ti * 65 + tj] * dec : 0.f;
      atp[idx] = f2bf(QK[ti * 65 + tj] * dec);
    }
  }
  __syncthreads();
  if (wid < 2) {
    const int d = wid;
    const float* L = Ld + d * 4096;
    const float bc = bts[d * 64 + lane];
    bf16_t* mp = M1 + (size_t)(it * 2 + d) * 4096 + lane;
    float x[64];
#pragma unroll
    for (int i = 0; i < 64; ++i) {
      float s = (i == lane) ? 1.f : 0.f;
#pragma unroll
      for (int j = 0; j < i; ++j) s -= L[i * 64 + j] * x[j];
      x[i] = s;
      mp[i * 64] = f2bf(s * bc);
    }
  }
  __syncthreads();
}

struct GChunk { bf16x8 kf[4], qf[4], m1f[2], atf[2]; unsigned vr[2][4]; float eg[4], egl[4]; float ge; };
DI void gdn_load(GChunk& R, const Params& p, int b, int h, int d, int dvs, int c) {
  const int tid = otid(), lane = tid & 63, wid = tid >> 6, l15 = lane & 15, g = lane >> 4;
  const bf16_t* P = (const bf16_t*)(p.ws + OFF_P);
  const bf16_t* M1 = (const bf16_t*)(p.ws + OFF_H);
  const bf16_t* AT = M1 + (size_t)4224 * 4096;
  const float* GSC = (const float*)(p.ws + OFF_GSC);
  const int item = ((b * NCH + c) * 4 + h) * 2 + d;
  const int irow = 16 * wid + l15, tn = d ? 63 - irow : irow;
  const bf16_t* rowp = P + (size_t)(b * TT + c * 64 + tn) * LDP + C_GQKV + h * 128;
#pragma unroll
  for (int ks = 0; ks < 4; ++ks) { R.qf[ks] = *(const bf16x8*)(rowp + ks * 32 + g * 8); R.kf[ks] = *(const bf16x8*)(rowp + 512 + ks * 32 + g * 8); }
#pragma unroll
  for (int ks = 0; ks < 2; ++ks) {
    R.m1f[ks] = *(const bf16x8*)(M1 + (size_t)item * 4096 + irow * 64 + ks * 32 + g * 8);
    R.atf[ks] = *(const bf16x8*)(AT + (size_t)item * 4096 + irow * 64 + ks * 32 + g * 8);
  }
#pragma unroll
  for (int e = 0; e < 4; ++e) {
    const int i = 16 * wid + g * 4 + e, t2 = d ? 63 - i : i;
    R.vr[0][e] = *(const unsigned*)(P + (size_t)(b * TT + c * 64 + t2) * LDP + C_GQKV + 1024 + h * 128 + dvs * 32 + (l15 & ~1));
    R.vr[1][e] = *(const unsigned*)(P + (size_t)(b * TT + c * 64 + t2) * LDP + C_GQKV + 1024 + h * 128 + dvs * 32 + 16 + (l15 & ~1));
    R.eg[e] = GSC[(size_t)item * 192 + i];
    R.egl[e] = GSC[(size_t)item * 192 + 64 + i];
  }
  R.ge = GSC[(size_t)item * 192 + 128];
}
DI void gdn_put_kt(const GChunk& R, bf16_t* KT) {
  const int tid = otid(), lane = tid & 63, i = 16 * (tid >> 6) + (lane & 15), g = lane >> 4;
#pragma unroll
  for (int ks = 0; ks < 4; ++ks)
#pragma unroll
    for (int e = 0; e < 8; ++e) KT[(ks * 32 + g * 8 + e) * 72 + i] = (bf16_t)R.kf[ks][e];
}
DI int gdn_chunk_at(int d, int n) { return d == 0 ? n : (n < 4 ? 3 - n : NCH - 1 - (n - 4)); }
DI void job_gscan(const Params& p, int u, char* lds) {
  const int tid = otid(), lane = tid & 63, wid = tid >> 6, l15 = lane & 15, g = lane >> 4;
  const int seq = (u & 7) + 8 * (u >> 5), dvs = (u >> 3) & 3, d = seq & 1, h = (seq >> 1) & 3, b = seq >> 3;
  bf16_t* KT = (bf16_t*)lds;
  bf16_t* ST = KT + 2 * 128 * 72;
  bf16_t* XT = ST + 32 * 136;
  bf16_t* VnT = XT + 32 * 72;
  bf16_t* VsT = VnT + 32 * 72;
  bf16_t* OUT = d == 0 ? (bf16_t*)(p.ws + OFF_P) + C_DAV : (bf16_t*)(p.ws + OFF_OB);
  const int ldo = d == 0 ? LDP : 512;
  __builtin_amdgcn_s_setprio(3);
  f32x4 S[2][2];
#pragma unroll
  for (int a = 0; a < 2; ++a)
#pragma unroll
    for (int ct = 0; ct < 2; ++ct) S[a][ct] = (f32x4){0.f, 0.f, 0.f, 0.f};
  for (int i = tid; i < 32 * 136 / 2; i += 256) ((unsigned*)ST)[i] = 0u;
  GChunk cur, nxt;
  gdn_load(cur, p, b, h, d, dvs, gdn_chunk_at(d, 0));
  gdn_put_kt(cur, KT);
  __syncthreads();
#pragma unroll 1
  for (int n = 0; n < NCH; ++n) {
    const int c = gdn_chunk_at(d, n);
    if (n + 1 < NCH) gdn_load(nxt, p, b, h, d, dvs, gdn_chunk_at(d, n + 1));
    const bf16_t* KTc = KT + (n & 1) * 128 * 72;
    f32x4 ksa[2], qsa[2];
#pragma unroll
    for (int ct = 0; ct < 2; ++ct) { ksa[ct] = (f32x4){0.f, 0.f, 0.f, 0.f}; qsa[ct] = (f32x4){0.f, 0.f, 0.f, 0.f}; }
#pragma unroll
    for (int ks = 0; ks < 4; ++ks)
#pragma unroll
      for (int ct = 0; ct < 2; ++ct) {
        const bf16x8 bS = *(const bf16x8*)(ST + (ct * 16 + l15) * 136 + ks * 32 + g * 8);
        ksa[ct] = mfma16(cur.kf[ks], bS, ksa[ct]);
        qsa[ct] = mfma16(cur.qf[ks], bS, qsa[ct]);
      }
#pragma unroll
    for (int ct = 0; ct < 2; ++ct) {
      float x[4];
#pragma unroll
      for (int e = 0; e < 4; ++e) x[e] = ((l15 & 1) ? bfhi(cur.vr[ct][e]) : bflo(cur.vr[ct][e])) - cur.eg[e] * ksa[ct][e];
      *(u32x2*)(XT + (ct * 16 + l15) * 72 + 16 * wid + g * 4) = (u32x2){pk2(x[0], x[1]), pk2(x[2], x[3])};
    }
    __syncthreads();
#pragma unroll
    for (int ct = 0; ct < 2; ++ct) {
      f32x4 vn = {0.f, 0.f, 0.f, 0.f};
#pragma unroll
      for (int ks = 0; ks < 2; ++ks) vn = mfma16(cur.m1f[ks], *(const bf16x8*)(XT + (ct * 16 + l15) * 72 + ks * 32 + g * 8), vn);
      *(u32x2*)(VnT + (ct * 16 + l15) * 72 + 16 * wid + g * 4) = (u32x2){pk2(vn[0], vn[1]), pk2(vn[2], vn[3])};
      *(u32x2*)(VsT + (ct * 16 + l15) * 72 + 16 * wid + g * 4) = (u32x2){pk2(vn[0] * cur.egl[0], vn[1] * cur.egl[1]), pk2(vn[2] * cur.egl[2], vn[3] * cur.egl[3])};
    }
    __syncthreads();
#pragma unroll
    for (int ct = 0; ct < 2; ++ct) {
      f32x4 o;
#pragma unroll
      for (int e = 0; e < 4; ++e) o[e] = cur.eg[e] * qsa[ct][e];
#pragma unroll
      for (int ks = 0; ks < 2; ++ks) o = mfma16(cur.atf[ks], *(const bf16x8*)(VnT + (ct * 16 + l15) * 72 + ks * 32 + g * 8), o);
#pragma unroll
      for (int e = 0; e < 4; ++e) {
        const int i = 16 * wid + g * 4 + e, t2 = d ? 63 - i : i;
        OUT[(size_t)(b * TT + c * 64 + t2) * ldo + h * 128 + dvs * 32 + ct * 16 + l15] = f2bf(o[e]);
      }
    }
#pragma unroll
    for (int rt2 = 0; rt2 < 2; ++rt2) {
      const int rt = 2 * wid + rt2;
#pragma unroll
      for (int ct = 0; ct < 2; ++ct)
#pragma unroll
        for (int e = 0; e < 4; ++e) S[rt2][ct][e] *= cur.ge;
#pragma unroll
      for (int ks = 0; ks < 2; ++ks) {
        const bf16x8 ka = *(const bf16x8*)(KTc + (rt * 16 + l15) * 72 + ks * 32 + g * 8);
#pragma unroll
        for (int ct = 0; ct < 2; ++ct) S[rt2][ct] = mfma16(ka, *(const bf16x8*)(VsT + (ct * 16 + l15) * 72 + ks * 32 + g * 8), S[rt2][ct]);
      }
#pragma unroll
      for (int ct = 0; ct < 2; ++ct)
        *(u32x2*)(ST + (ct * 16 + l15) * 136 + rt * 16 + g * 4) = (u32x2){pk2(S[rt2][ct][0], S[rt2][ct][1]), pk2(S[rt2][ct][2], S[rt2][ct][3])};
    }
    if (n + 1 < NCH) { gdn_put_kt(nxt, KT + ((n + 1) & 1) * 128 * 72); cur = nxt; }
    __syncthreads();
  }
  __builtin_amdgcn_s_setprio(0);
}
DI void job_gpost1(const Params& p, int layer, int r) {
  const int lane = otid() & 63;
  bf16_t* P = (bf16_t*)(p.ws + OFF_P) + (size_t)r * LDP;
  const bf16_t* OB = (const bf16_t*)(p.ws + OFF_OB) + (size_t)r * 512;
  const u32x4 of = *(const u32x4*)(P + C_DAV + lane * 8), ob = *(const u32x4*)(OB + lane * 8), z = *(const u32x4*)(P + C_GZ + lane * 8);
  float o[8], zz[8], ss = 0.f;
#pragma unroll
  for (int e = 0; e < 4; ++e) {
    o[2 * e] = bflo(of[e]) + bflo(ob[e]); o[2 * e + 1] = bfhi(of[e]) + bfhi(ob[e]);
    zz[2 * e] = bflo(z[e]); zz[2 * e + 1] = bfhi(z[e]);
  }
#pragma unroll
  for (int e = 0; e < 8; ++e) ss += o[e] * o[e];
  ss += shx<1>(ss); ss += shx<2>(ss); ss += shx<4>(ss); ss += shx<8>(ss);
  const float rstd = rsqrtf(ss * (1.f / 128.f) + EPS);
  const float* gn = p.gng + layer * 128 + (lane & 15) * 8;
  float y[8];
#pragma unroll
  for (int e = 0; e < 8; ++e) y[e] = o[e] * rstd * gn[e] * (zz[e] * sigm(zz[e]));
  *(u32x4*)(P + C_GZ + lane * 8) = (u32x4){pk2(y[0], y[1]), pk2(y[2], y[3]), pk2(y[4], y[5]), pk2(y[6], y[7])};
}

DI void job_gpost(const Params& p, int layer, int it) {
  const int wid = otid() >> 6;
#pragma unroll
  for (int rr = 0; rr < 2; ++rr) job_gpost1(p, layer, it * 8 + rr * 4 + wid);
}
#ifdef SK_JL1
#define JL1(x)
#else
#define JL1(x) x
#endif
#ifdef SK_JGC
#define JGC(x)
#else
#define JGC(x) x
#endif
#ifdef SK_JVT
#define JVT(x)
#else
#define JVT(x) x
#endif
#ifdef SK_JDP
#define JDP(x)
#else
#define JDP(x) x
#endif
#ifdef SK_JGP
#define JGP(x)
#else
#define JGP(x) x
#endif
#ifdef SK_JL3
#define JL3(x)
#else
#define JL3(x) x
#endif
#ifdef SK_JGS
#define JGS(x)
#else
#define JGS(x) x
#endif
#ifdef SK_JAT
#define JAT(x)
#else
#define JAT(x) x
#endif
#define LAS __attribute__((address_space(3)))
#define XB_TMO      128
#define XB_XCNT(j)  (256  + 64 * (j))
#define XB_XSUB(j)  (1280 + 64 * (j))
#define XB_XGEN(j)  (2304 + 64 * (j))
#define XB_TOP      3328
#define XB_TOPGEN   3392
#define XCD_BAR_WORDS 3456
#define XB_SPIN_CAP (1u << 18)

__device__ __forceinline__ unsigned xb_ld(unsigned* p)              { return __hip_atomic_load(p, __ATOMIC_RELAXED, __HIP_MEMORY_SCOPE_AGENT); }
__device__ __forceinline__ unsigned xb_add(unsigned* p, unsigned v) { return __hip_atomic_fetch_add(p, v, __ATOMIC_RELAXED, __HIP_MEMORY_SCOPE_AGENT); }
__device__ __forceinline__ unsigned xb_xcc_id() { return (unsigned)__builtin_amdgcn_s_getreg((3 << 11) | 20) & 0xFu; }
#define XB_SPIN(cond, bar) do { unsigned _sp = 0; while (cond) { __builtin_amdgcn_s_sleep(1); \
    if ((++_sp & 255u) == 0u) { if (xb_ld(&(bar)[XB_TMO])) break; if (_sp > XB_SPIN_CAP) { atomicAdd(&(bar)[XB_TMO], 1u); break; } } } } while (0)

struct XcdBarrier {
    unsigned* bar; unsigned x;
    volatile LAS unsigned* st;
};

__device__ __forceinline__ XcdBarrier xcd_barrier_post(unsigned* bar, volatile LAS unsigned* st) {
    XcdBarrier b; b.bar = bar; b.x = xb_xcc_id(); b.st = st;
    if (threadIdx.x == 0) (void)xb_add(&bar[XB_XCNT(b.x)], 1u);
    return b;
}
__device__ __forceinline__ void xcd_barrier_complete(unsigned* bar, unsigned x, unsigned& nloc, unsigned& nx) {
    const unsigned G = gridDim.x * gridDim.y * gridDim.z;
    unsigned sum, cnt, mine, sp = 0u;
    for (;;) {
        sum = 0u; cnt = 0u; mine = 0u;
#pragma unroll
        for (unsigned j = 0; j < 16; ++j) { const unsigned c = xb_ld(&bar[XB_XCNT(j)]); sum += c; cnt += (c > 0u) ? 1u : 0u; mine = (j == x) ? c : mine; }
        if (sum == G) break;
        __builtin_amdgcn_s_sleep(1);
        if ((++sp & 255u) == 0u) { if (xb_ld(&bar[XB_TMO])) break; if (sp > XB_SPIN_CAP) { atomicAdd(&bar[XB_TMO], 1u); break; } }
    }
    nloc = mine > 0u ? mine : 1u; nx = cnt > 0u ? cnt : 1u;
}

__device__ __forceinline__ void xcd_barrier(const XcdBarrier& b) {
    asm volatile("s_waitcnt vmcnt(0)" ::: "memory");
    __syncthreads();
    if (threadIdx.x == 0) {
        unsigned* bar = b.bar; unsigned bx_ = b.x;
        asm volatile("" : "+s"(bar), "+s"(bx_));
        __builtin_amdgcn_s_waitcnt(0);
        unsigned nloc = b.st[0], nx = b.st[1];
        if (nloc == 0u) { xcd_barrier_complete(bar, bx_, nloc, nx); b.st[0] = nloc; b.st[1] = nx; }
        const unsigned old = xb_add(&bar[XB_XSUB(bx_)], 1u);
        const unsigned gen = old / nloc;
        if (old + 1u == (gen + 1u) * nloc) {
            __builtin_amdgcn_fence(__ATOMIC_RELEASE, "agent");
            asm volatile("s_waitcnt vmcnt(0)" ::: "memory");
            const unsigned og = xb_add(&bar[XB_TOP], 1u);
            const unsigned tg = og / nx;
            if (og + 1u == (tg + 1u) * nx) xb_add(&bar[XB_TOPGEN], 1u);
            else XB_SPIN(xb_ld(&bar[XB_TOPGEN]) == tg, bar);
            __builtin_amdgcn_fence(__ATOMIC_ACQUIRE, "agent");
            xb_add(&bar[XB_XGEN(bx_)], 1u);
            asm volatile("s_waitcnt vmcnt(0)" ::: "memory");
        } else {
            XB_SPIN(xb_ld(&bar[XB_XGEN(bx_)]) == gen, bar);
            __builtin_amdgcn_fence(__ATOMIC_ACQUIRE, "agent");
            asm volatile("s_waitcnt vmcnt(0)" ::: "memory");
        }
    }
    __syncthreads();
}


#define PH_BEGIN(k) for (int rep_ = 0, nrep_ = 1 + (((p.probe >> (k)) & 1) | ((k) == 5 ? ((p.probe >> 12) | (p.probe >> 13)) & 1 : 0)); rep_ < nrep_; ++rep_) { const bool dup = rep_ > 0; (void)dup;
#define PH_END xcd_barrier(xb_); }
#ifndef PROBE_MASK
#define PROBE_MASK 0
#endif
__global__ void __launch_bounds__(256, 2) mega(Params p) {
  __shared__ __attribute__((aligned(16))) char lds[LDS_BYTES];
  __shared__ int s_item;
  __shared__ unsigned xb_st[2];
  if (otid() == 0) { xb_st[0] = 0u; xb_st[1] = 0u; }
  __syncthreads();
  const XcdBarrier xb_ = xcd_barrier_post((unsigned*)(p.ws + OFF_CTR) + 64, (volatile LAS unsigned*)xb_st);
  cg::grid_group grid = cg::this_grid();
  const int G = gridDim.x, B = blockIdx.x;
  bf16_t* P = (bf16_t*)(p.ws + OFF_P);
  bf16_t* H = (bf16_t*)(p.ws + OFF_H);
  for (int it = B; it < 192 + 1024 + N_CVT; it += G) {
    if (it < 192) job_mod(p, it, lds);
    else if (it < 1216) job_rope(p, it - 192);
    else job_cvt(p, 0, it - 1216, lds);
  }
  if (p.probe < 0) grid.sync();
  xcd_barrier(xb_);
#pragma unroll 1
  for (int layer = 0; layer < 2; ++layer) {
    bf16_t* MG = (bf16_t*)(p.ws + OFF_VT);
    bf16_t* HID = P;
    PH_BEGIN(1)
    {
      const int n1 = layer == 1 ? N_CVT : 0;
      for (int it = B; it < n1 + MR / 8; it += G) { if (it < n1) job_cvt(p, 1, it, lds); else job_norm(p, layer, 1, it - n1); }
    }
    PH_END
    PH_BEGIN(2)
    {
      bf16_t* HALO = (bf16_t*)(p.ws + OFF_HALO);
      float* GBA = (float*)(p.ws + OFF_GBA);
      gemm_phase(H, 32, MR * 32, (const bf16_t*)(p.ws + OFF_WIN), 32, 7808 * 32, 1024, 132, 37, lds, B, G, [&](int row, int col, f32x4 v) {
        if (col < C_GBA) {
          const u32x2 w = {pk2(v[0], v[1]), pk2(v[2], v[3])};
          *(u32x2*)(P + (size_t)row * LDP + col) = w;
          if (col >= C_GQKV && col < C_GZ) {
            const int sm = row & 63;
            if (sm <= 1 || sm == 63) *(u32x2*)(HALO + ((size_t)(row >> 6) * 3 + (sm == 63 ? 2 : sm)) * 1536 + (col - C_GQKV)) = w;
          }
        } else if (col < C_GBA + 16) {
          *(f32x4*)(GBA + (size_t)row * 16 + (col - C_GBA)) = v;
        }
      }, [&](int row, int col, f32x4 v0, f32x4 v1) {
        if (col < C_GBA) {
          const u32x4 w = (u32x4){pk2(v0[0], v0[1]), pk2(v0[2], v0[3]), pk2(v1[0], v1[1]), pk2(v1[2], v1[3])};
          __builtin_nontemporal_store(w, (u32x4*)(P + (size_t)row * LDP + col));
          if (col >= C_GQKV && col < C_GZ) {
            const int sm = row & 63;
            if (sm <= 1 || sm == 63) *(u32x4*)(HALO + ((size_t)(row >> 6) * 3 + (sm == 63 ? 2 : sm)) * 1536 + (col - C_GQKV)) = w;
          }
        } else if (col < C_GBA + 16) {
          *(f32x4*)(GBA + (size_t)row * 16 + (col - C_GBA)) = v0;
          *(f32x4*)(GBA + (size_t)row * 16 + (col - C_GBA) + 4) = v1;
        }
      });
    }
    PH_END
    PH_BEGIN(3)
    {
      const int nA = 8 * NCH * 4, nB = nA + 6336, nC = nB + 2112, nD = nC + MR / 8;
      for (int it = B; it < nD; it += G) {
        if (it < nA) JL1(job_lru<1>(p, layer, it, lds, dup));
        else if (it < nB) JGC(job_gconv(p, layer, it - nA, dup));
        else if (it < nC) JVT(job_vt(p, it - nB, lds));
        else JDP(job_daprep(p, layer, it - nC, dup));
      }
    }
    PH_END
    PH_BEGIN(4)
    for (int it = B; it < 2112; it += G) JGP(job_gprep(p, layer, it, lds));
    PH_END
    PH_BEGIN(5)
    {
      for (;;) {
        const int x = blockIdx.x & 7;
        if (otid() == 0) s_item = (int)__hip_atomic_fetch_add((unsigned*)(p.ws + OFF_CTR) + ((layer * 2 + rep_) * 8 + x), 1u, __ATOMIC_RELAXED, __HIP_MEMORY_SCOPE_AGENT);
        __syncthreads();
        const int j = __builtin_amdgcn_readfirstlane(s_item);
        __syncthreads();
        if (j >= 16 + 132 + 528) break;
        if (j < 16) { if (!(dup && ((p.probe >> 12) & 1))) JGS(job_gscan(p, j * 8 + x, lds)); }
        else if (j < 148) {
          const int k = j - 16, grp = k / 66, qq = k % 66, qb = qq < 64 ? qq + 2 : qq - 64;
          if (!(dup && ((p.probe >> 13) & 1))) JAT(job_attn(p, layer, grp * 528 + qb * 8 + x, lds, dup));
        } else { if (!(dup && (((p.probe >> 12) | (p.probe >> 13)) & 1))) JL3(job_lru<3>(p, layer, (j - 148) * 8 + x, lds, dup)); }
      }
    }
    PH_END
    PH_BEGIN(6)
    for (int it = B; it < MR / 8 + MR / 8; it += G) { if (it < MR / 8) job_gpost(p, layer, it); else job_norm(p, layer, 1, it - MR / 8); }
    PH_END
    PH_BEGIN(7)
    gemm_phase(H, 32, MR * 32, (const bf16_t*)(p.ws + OFF_WIN) + (size_t)4736 * 32, 32, 7808 * 32, 1024, 132, 24, lds, B, G, [&](int row, int col, f32x4 v) {
      *(u32x2*)(P + (size_t)row * LDP + sg_col(col)) = (u32x2){pk2(sigm(v[0]), sigm(v[1])), pk2(sigm(v[2]), sigm(v[3]))};
    }, [&](int row, int col, f32x4 v0, f32x4 v1) {
      *(u32x4*)(P + (size_t)row * LDP + sg_col(col)) = (u32x4){pk2(sigm(v0[0]), sigm(v0[1])), pk2(sigm(v0[2]), sigm(v0[3])), pk2(sigm(v1[0]), sigm(v1[1])), pk2(sigm(v1[2]), sigm(v1[3]))};
    }, layer == 1);
    PH_END
    PH_BEGIN(14)
    {
      const bf16_t* WBR = (const bf16_t*)(p.ws + OFF_WBR);
      const int nm14 = layer == 1 ? 256 : 264;
      for (int t = B; t < nm14 * 8; t += G) {
        int mi, ni; tile_mn(t, nm14, 8, mi, ni);
        if (layer == 1) mi += 2 * (mi >> 6) + 2;
        f32x4 mg[4][4]; zero_acc<4>(mg);
#pragma unroll 1
        for (int i = 0; i < 3; ++i) {
          f32x4 ay[4][4]; zero_acc<4>(ay);
          const int coff = i == 0 ? C_DAQ : (i == 1 ? C_LY : C_GZ);
          gemm_core<4>(P + (size_t)mi * 128 * LDP + coff, LDP, 32, WBR + (size_t)i * 1024 * 512 + (size_t)(ni * 128) * 32, 32, 1024 * 32, 512, ay, lds);
          const int lane = otid() & 63, wid = otid() >> 6, wr = wid >> 1, wc = wid & 1;
#pragma unroll
          for (int a2 = 0; a2 < 4; ++a2)
#pragma unroll
            for (int b2 = 0; b2 < 4; ++b2) {
              const int row = mi * 128 + wr * 64 + a2 * 16 + (lane & 15), col = ni * 128 + wc * 64 + b2 * 16 + (lane >> 4) * 4;
              const u32x2 sg = *(const u32x2*)(P + (size_t)row * LDP + sg_col(i * 1024 + col));
              mg[a2][b2] += (f32x4){bflo(sg.x), bfhi(sg.x), bflo(sg.y), bfhi(sg.y)} * ay[a2][b2];
            }
        }
        gemm_emit<4>(mg, mi * 128, ni * 128, [&](int row, int col, f32x4 v) { *(u32x2*)(MG + ((size_t)(col >> 5) * MR + row) * 32 + (col & 31)) = (u32x2){pk2(v[0], v[1]), pk2(v[2], v[3])}; });
      }
    }
    PH_END
    PH_BEGIN(8)
    gemm_phase(MG, 32, MR * 32, (const bf16_t*)(p.ws + OFF_WO), 32, 1024 * 32, 1024, 132, 8, lds, B, G, [&](int row, int col, f32x4 v) {
      const f32x4 xin = *(const f32x4*)(res_in_row(p, layer, row) + col);
      const f32x4 g1 = *(const f32x4*)(mod_vec(p, layer, row) + 2048 + col);
      if (!dup) *(f32x4*)(res_out_row(p, row) + col) = xin + g1 * v;
    }, [&](int row, int col, f32x4 v0, f32x4 v1) {
      const float* xi = res_in_row(p, layer, row) + col;
      const float* gm = mod_vec(p, layer, row) + 2048 + col;
      float* xo = res_out_row(p, row) + col;
      const f32x4 o0 = *(const f32x4*)xi + *(const f32x4*)gm * v0, o1 = *(const f32x4*)(xi + 4) + *(const f32x4*)(gm + 4) * v1;
      if (!dup) { *(f32x4*)xo = o0; *(f32x4*)(xo + 4) = o1; }
    }, layer == 1);
    PH_END
    PH_BEGIN(9)
    for (int it = B; it < MR / 8; it += G) job_norm(p, layer, 2, it);
    PH_END
    PH_BEGIN(10)
    gemm_phase(H, 32, MR * 32, (const bf16_t*)(p.ws + OFF_W1), 32, 4096 * 32, 1024, 132, 32, lds, B, G, [&](int row, int col, f32x4 v) {
      float r[4];
#pragma unroll
      for (int e = 0; e < 4; ++e) { const float q = fmaxf(v[e], 0.f); r[e] = q * q; }
      *(u32x2*)(HID + ((size_t)(col >> 5) * MR + row) * 32 + (col & 31)) = (u32x2){pk2(r[0], r[1]), pk2(r[2], r[3])};
    }, [&](int row, int col, f32x4 v0, f32x4 v1) {
      float r[8];
#pragma unroll
      for (int e = 0; e < 4; ++e) { const float q0 = fmaxf(v0[e], 0.f), q1 = fmaxf(v1[e], 0.f); r[e] = q0 * q0; r[4 + e] = q1 * q1; }
      __builtin_nontemporal_store(((u32x4){pk2(r[0], r[1]), pk2(r[2], r[3]), pk2(r[4], r[5]), pk2(r[6], r[7])}), (u32x4*)(HID + ((size_t)(col >> 5) * MR + row) * 32 + (col & 31)));
    }, layer == 1);
    PH_END
    PH_BEGIN(11)
    gemm_phase(HID, 32, MR * 32, (const bf16_t*)(p.ws + OFF_W2), 32, 1024 * 32, 4096, 132, 8, lds, B, G, [&](int row, int col, f32x4 v) {
      float* xo = res_out_row(p, row) + col;
      const f32x4 g2 = *(const f32x4*)(mod_vec(p, layer, row) + 5120 + col);
      if (!dup) *(f32x4*)xo = *(const f32x4*)xo + g2 * v;
    }, [&](int row, int col, f32x4 v0, f32x4 v1) {
      float* xo = res_out_row(p, row) + col;
      const float* gm = mod_vec(p, layer, row) + 5120 + col;
      const f32x4 o0 = *(const f32x4*)xo + *(const f32x4*)gm * v0, o1 = *(const f32x4*)(xo + 4) + *(const f32x4*)(gm + 4) * v1;
      if (!dup) { *(f32x4*)xo = o0; *(f32x4*)(xo + 4) = o1; }
    }, layer == 1);
    PH_END
  }
}

extern "C" void kernel_launch(void* const* d_in, const int* in_sizes, int n_in, void* d_out, int out_size, void* d_ws, size_t ws_size, hipStream_t stream) {
  static int grid_blocks = 0;
  if (!grid_blocks) {
    int dev = 0, cus = 0, per_cu = 0;
    hipGetDevice(&dev);
    hipDeviceGetAttribute(&cus, hipDeviceAttributeMultiprocessorCount, dev);
    hipOccupancyMaxActiveBlocksPerMultiprocessor(&per_cu, mega, 256, 0);
    if (per_cu > 2) per_cu = 2;
    grid_blocks = cus * per_cu;
    grid_blocks -= grid_blocks % 8;
  }
  Params p{};
  const float** f = (const float**)&p;
  for (int i = 0; i < 26; ++i) f[i] = (const float*)d_in[i];
  p.out = (float*)d_out;
  p.ws = (char*)d_ws;
  p.probe = PROBE_MASK;
  if (ws_size < WS_TOTAL) { fprintf(stderr, "workspace too small: %zu < %zu\n", ws_size, (size_t)WS_TOTAL); return; }
  hipMemsetAsync((char*)d_ws + OFF_CTR, 0, 256 + 16384, stream);
  void* args[] = {&p};
  hipError_t e = hipLaunchCooperativeKernel((void*)mega, dim3(grid_blocks), dim3(256), args, 0, stream);
  if (e != hipSuccess) fprintf(stderr, "cooperative launch failed: %s (grid %d)\n", hipGetErrorString(e), grid_blocks);
}
```

```cpp
#include <hip/hip_runtime.h>
#include <hip/hip_cooperative_groups.h>
#include <cstdint>
#include <cstdio>
namespace cg = cooperative_groups;

#define DI __device__ __forceinline__
typedef unsigned short bf16_t;
typedef short bf16x8 __attribute__((ext_vector_type(8)));
typedef float f32x4 __attribute__((ext_vector_type(4)));
typedef float f32x2 __attribute__((ext_vector_type(2)));
typedef unsigned u32x4 __attribute__((ext_vector_type(4)));
typedef unsigned u32x2 __attribute__((ext_vector_type(2)));
typedef __bf16 bf16x2_t __attribute__((ext_vector_type(2)));

constexpr int DM = 1024, NB = 4, TL = 8192, TC = 256, TT = 8448, MR = NB * TT;
constexpr int LDP = 4736;
constexpr int C_DAQ = 0, C_DAK = 512, C_DAV = 1024, C_LX = 1536, C_LY = 2048, C_GQKV = 2560, C_GZ = 4096, C_GBA = 4608;
constexpr int NCH = 132;
constexpr float EPS = 1e-6f;
constexpr int LDS_BYTES = 77824;

constexpr size_t al256(size_t x) { return (x + 255) & ~(size_t)255; }
constexpr size_t OFF_WIN = 0;
constexpr size_t OFF_WBR = OFF_WIN + al256((size_t)7808 * 1024 * 2);
constexpr size_t OFF_WO = OFF_WBR + al256((size_t)3 * 1024 * 512 * 2);
constexpr size_t OFF_W1 = OFF_WO + al256((size_t)1024 * 1024 * 2);
constexpr size_t OFF_W2 = OFF_W1 + al256((size_t)4096 * 1024 * 2);
constexpr size_t OFF_LG = OFF_W2 + al256((size_t)4096 * 1024 * 2);
constexpr size_t OFF_P = OFF_LG + al256((size_t)32 * 4096 * 2);
constexpr size_t OFF_H = OFF_P + al256((size_t)MR * LDP * 2);
constexpr size_t OFF_VT = OFF_H + al256((size_t)MR * 1024 * 2);
constexpr size_t OFF_OB = OFF_VT + al256((size_t)MR * 512 * 2);
constexpr size_t OFF_HALO = OFF_OB + al256((size_t)MR * 512 * 2);
constexpr size_t OFF_GBA = OFF_HALO + al256((size_t)528 * 3 * 1536 * 2);
constexpr size_t OFF_GSC = OFF_GBA + al256((size_t)MR * 16 * 4);
constexpr size_t OFF_LC = OFF_GSC + al256((size_t)4224 * 192 * 4);
constexpr size_t OFF_CTX = OFF_LC + al256((size_t)4 * NCH * 8 * 2 * 64 * 8);
constexpr size_t OFF_MOD = OFF_CTX + al256((size_t)4 * 256 * 1024 * 4);
constexpr size_t OFF_ROPE = OFF_MOD + al256((size_t)2 * 5 * 6144 * 4);
constexpr size_t OFF_CTR = OFF_ROPE + al256((size_t)8192 * 32 * 8);
constexpr size_t WS_TOTAL = OFF_CTR + 256 + 16384;
static_assert(WS_TOTAL <= (size_t)536870912, "workspace map too large");

struct Params {
  const float *x, *c, *ctx, *cctx, *ada_w, *ada_b, *n1g, *n2g, *w_in, *daqg, *dakg, *dalam, *dasub, *lcw, *lcb, *lgw, *lgb, *llam,
      *gcw, *galog, *gdtb, *gng, *wbr, *wout, *w1, *w2;
  float* out;
  char* ws;
  int probe;
  int pad_;
};

DI unsigned pk2(float lo, float hi) { f32x2 v = {lo, hi}; bf16x2_t b = __builtin_convertvector(v, bf16x2_t); return __builtin_bit_cast(unsigned, b); }
DI bf16_t f2bf(float f) { return (bf16_t)(pk2(f, 0.f) & 0xffffu); }
DI float bf2f(bf16_t u) { return __uint_as_float(((unsigned)u) << 16); }
DI float bflo(unsigned w) { return __uint_as_float(w << 16); }
DI float bfhi(unsigned w) { return __uint_as_float(w & 0xffff0000u); }
DI int otid() { int t = __builtin_amdgcn_workitem_id_x(); asm volatile("" : "+v"(t)); return t; }
template <int M> DI float shx(float v) { return __int_as_float(__builtin_amdgcn_ds_swizzle(__float_as_int(v), (M << 10) | 0x1f)); }
DI float add32(float v) { auto r = __builtin_amdgcn_permlane32_swap(__float_as_uint(v), __float_as_uint(v), false, false); return __uint_as_float(r[0]) + __uint_as_float(r[1]); }
DI float max32(float v) { auto r = __builtin_amdgcn_permlane32_swap(__float_as_uint(v), __float_as_uint(v), false, false); return fmaxf(__uint_as_float(r[0]), __uint_as_float(r[1])); }
DI float wsum(float v) { v += shx<1>(v); v += shx<2>(v); v += shx<4>(v); v += shx<8>(v); v += shx<16>(v); return add32(v); }
DI float wmax(float v) { v = fmaxf(v, shx<1>(v)); v = fmaxf(v, shx<2>(v)); v = fmaxf(v, shx<4>(v)); v = fmaxf(v, shx<8>(v)); v = fmaxf(v, shx<16>(v)); return max32(v); }
DI float sigm(float x) { return 1.f / (1.f + __expf(-x)); }
DI float softplusf(float x) { return x > 20.f ? x : log1pf(expf(x)); }
DI f32x4 mfma16(bf16x8 a, bf16x8 b, f32x4 c) { return __builtin_amdgcn_mfma_f32_16x16x32_bf16(a, b, c, 0, 0, 0); }

DI const float* res_in_row(const Params& p, int layer, int r) {
  const int b = r / TT, s = r % TT;
  if (layer == 0) return s < TC ? p.ctx + ((size_t)b * TC + s) * DM : p.x + ((size_t)b * TL + (s - TC)) * DM;
  return s < TC ? (const float*)(p.ws + OFF_CTX) + ((size_t)b * TC + s) * DM : p.out + ((size_t)b * TL + (s - TC)) * DM;
}
DI float* res_out_row(const Params& p, int r) {
  const int b = r / TT, s = r % TT;
  return s < TC ? (float*)(p.ws + OFF_CTX) + ((size_t)b * TC + s) * DM : p.out + ((size_t)b * TL + (s - TC)) * DM;
}
DI const float* mod_vec(const Params& p, int layer, int r) {
  const int b = r / TT, s = r % TT;
  return (const float*)(p.ws + OFF_MOD) + (size_t)(layer * 5 + (s < TC ? 4 : b)) * 6144;
}

template <int WN>
DI void gemm_core(const bf16_t* __restrict__ A, int lda, int a_ks, const bf16_t* __restrict__ Bt, int ldb, int b_ks, int K, f32x4 (&acc)[4][WN], char* lds) {
  constexpr int BN = 32 * WN, AST = 72, NBP = BN * 8 / 256;
  bf16_t* As = (bf16_t*)lds;
  bf16_t* Bs = As + 2 * 128 * AST;
  const int tid = otid(), lane = tid & 63, wid = tid >> 6, wr = wid >> 1, wc = wid & 1;
  u32x4 ra[4], rb[NBP];
  const int nk = K / 64;
#define GLOAD(k0)                                                                                                            \
  {                                                                                                                          \
    _Pragma("unroll") for (int i = 0; i < 4; ++i) { const int q = tid + 256 * i; ra[i] = *(const u32x4*)(A + (size_t)(q >> 3) * lda + (size_t)(((k0) >> 5) + ((q & 7) >> 2)) * a_ks + (q & 3) * 8); } \
    _Pragma("unroll") for (int i = 0; i < NBP; ++i) { const int q = tid + 256 * i; rb[i] = *(const u32x4*)(Bt + (size_t)(q >> 3) * ldb + (size_t)(((k0) >> 5) + ((q & 7) >> 2)) * b_ks + (q & 3) * 8); } \
  }
#define SSTORE(buf)                                                                                                          \
  {                                                                                                                          \
    _Pragma("unroll") for (int i = 0; i < 4; ++i) { const int q = tid + 256 * i; *(u32x4*)(As + ((buf) * 128 + (q >> 3)) * AST + (q & 7) * 8) = ra[i]; } \
    _Pragma("unroll") for (int i = 0; i < NBP; ++i) { const int q = tid + 256 * i; *(u32x4*)(Bs + ((buf) * BN + (q >> 3)) * AST + (q & 7) * 8) = rb[i]; } \
  }
  GLOAD(0);
  SSTORE(0);
  __syncthreads();
  for (int t = 0; t < nk; ++t) {
    if (t + 1 < nk) GLOAD((t + 1) * 64);
    const bf16_t* a = As + ((t & 1) * 128 + wr * 64 + (lane & 15)) * AST + (lane >> 4) * 8;
    const bf16_t* b = Bs + ((t & 1) * BN + wc * 16 * WN + (lane & 15)) * AST + (lane >> 4) * 8;
#pragma unroll
    for (int ks = 0; ks < 2; ++ks) {
      bf16x8 af[4], bfr[WN];
#pragma unroll
      for (int i = 0; i < 4; ++i) af[i] = *(const bf16x8*)(a + i * 16 * AST + ks * 32);
#pragma unroll
      for (int j = 0; j < WN; ++j) bfr[j] = *(const bf16x8*)(b + j * 16 * AST + ks * 32);
      __builtin_amdgcn_sched_barrier(0);
#pragma unroll
      for (int i = 0; i < 4; ++i)
#pragma unroll
        for (int j = 0; j < WN; ++j) acc[i][j] = mfma16(bfr[j], af[i], acc[i][j]);
      __builtin_amdgcn_sched_barrier(0);
    }
    if (t + 1 < nk) SSTORE((t + 1) & 1);
    __syncthreads();
  }
#undef GLOAD
#undef SSTORE
}
DI void tile_mn(int t, int nm, int nn, int& mi, int& ni) {
  const int nig = 16 * nn, g = t / nig, rem = t % nig, fm = g * 16;
  const int gsz = (nm - fm) < 16 ? (nm - fm) : 16;
  mi = fm + rem % gsz;
  ni = rem / gsz;
}
template <int WN, class Epi>
DI void gemm_emit(const f32x4 (&acc)[4][WN], int m0, int n0, Epi epi) {
  const int lane = otid() & 63, wid = otid() >> 6, wr = wid >> 1, wc = wid & 1;
#pragma unroll
  for (int i = 0; i < 4; ++i)
#pragma unroll
    for (int j = 0; j < WN; ++j) epi(m0 + wr * 64 + i * 16 + (lane & 15), n0 + wc * 16 * WN + j * 16 + (lane >> 4) * 4, acc[i][j]);
}
template <int WN>
DI void zero_acc(f32x4 (&acc)[4][WN]) {
#pragma unroll
  for (int i = 0; i < 4; ++i)
#pragma unroll
    for (int j = 0; j < WN; ++j) acc[i][j] = (f32x4){0.f, 0.f, 0.f, 0.f};
}

DI void gemm_core2(const bf16_t* __restrict__ A, int lda, int a_ks, const bf16_t* __restrict__ Bt, int ldb, int b_ks, int K, f32x4 (&acc)[8][4], char* lds) {
  constexpr int AST = 48;
  bf16_t* As = (bf16_t*)lds;
  bf16_t* Bs = As + 2 * 256 * AST;
  const int tid = otid(), lane = tid & 63, wid = tid >> 6, wr = wid >> 1, wc = wid & 1;
  u32x4 s0a[4], s0b[2], s1a[4], s1b[2];
  const int nk = K / 32;
  const bf16_t* ag = A + (size_t)(tid >> 2) * lda + (tid & 3) * 8;
  const bf16_t* bg = Bt + (size_t)(tid >> 2) * ldb + (tid & 3) * 8;
  const int bc_ = tid >> 2, brow = ((bc_ >> 5) * 2 + ((bc_ >> 2) & 1)) * 16 + ((bc_ >> 3) & 3) * 4 + (bc_ & 3);
#define LBAR() { asm volatile("s_waitcnt lgkmcnt(0)" ::: "memory"); __builtin_amdgcn_s_barrier(); asm volatile("" ::: "memory"); }
#define GLOAD2(ra, rb, k0)                                                                                                   \
  {                                                                                                                          \
    _Pragma("unroll") for (int i = 0; i < 4; ++i) ra[i] = *(const u32x4*)(ag + (size_t)(64 * i) * lda + (size_t)((k0) >> 5) * a_ks);               \
    _Pragma("unroll") for (int i = 0; i < 2; ++i) rb[i] = *(const u32x4*)(bg + (size_t)(64 * i) * ldb + (size_t)((k0) >> 5) * b_ks);               \
  }
#define SSTORE2(ra, rb, buf)                                                                                                 \
  {                                                                                                                          \
    _Pragma("unroll") for (int i = 0; i < 4; ++i) *(u32x4*)(As + ((buf) * 256 + 64 * i + (tid >> 2)) * AST + (tid & 3) * 8) = ra[i]; \
    _Pragma("unroll") for (int i = 0; i < 2; ++i) *(u32x4*)(Bs + ((buf) * 128 + 64 * i + brow) * AST + (tid & 3) * 8) = rb[i]; \
  }
#define STEP2(t, la, lb, sa, sb)                                                                                             \
  {                                                                                                                          \
    if ((t) + 2 < nk) GLOAD2(la, lb, ((t) + 2) * 32);                                                                        \
    const bf16_t* a = As + (((t) & 1) * 256 + wr * 128 + (lane & 15)) * AST + (lane >> 4) * 8;                               \
    const bf16_t* b = Bs + (((t) & 1) * 128 + wc * 64 + (lane & 15)) * AST + (lane >> 4) * 8;                                \
    bf16x8 bfr[4], a0[4], a1[4];                                                                                             \
    _Pragma("unroll") for (int j = 0; j < 4; ++j) bfr[j] = *(const bf16x8*)(b + j * 16 * AST);                               \
    _Pragma("unroll") for (int i = 0; i < 4; ++i) a0[i] = *(const bf16x8*)(a + i * 16 * AST);                                \
    __builtin_amdgcn_sched_barrier(0);                                                                                       \
    _Pragma("unroll") for (int i = 0; i < 4; ++i) a1[i] = *(const bf16x8*)(a + (4 + i) * 16 * AST);                          \
    __builtin_amdgcn_sched_barrier(0);                                                                                       \
    _Pragma("unroll") for (int i = 0; i < 4; ++i) _Pragma("unroll") for (int j = 0; j < 4; ++j) acc[i][j] = mfma16(bfr[j], a0[i], acc[i][j]); \
    __builtin_amdgcn_sched_barrier(0);                                                                                       \
    _Pragma("unroll") for (int i = 0; i < 4; ++i) _Pragma("unroll") for (int j = 0; j < 4; ++j) acc[4 + i][j] = mfma16(bfr[j], a1[i], acc[4 + i][j]); \
    __builtin_amdgcn_sched_barrier(0);                                                                                       \
    if ((t) + 1 < nk) SSTORE2(sa, sb, ((t) + 1) & 1);                                                                        \
    LBAR();                                                                                                                  \
  }
  GLOAD2(s0a, s0b, 0);
  SSTORE2(s0a, s0b, 0);
  GLOAD2(s1a, s1b, 32);
  LBAR();
  int t = 0;
  for (;;) {
    STEP2(t, s0a, s0b, s1a, s1b);
    if (++t >= nk) break;
    STEP2(t, s1a, s1b, s0a, s0b);
    if (++t >= nk) break;
  }
#undef GLOAD2
#undef SSTORE2
#undef STEP2
}
DI void tile_mn8(int t, int nm, int nn, int& mi, int& ni) {
  const int nig = 8 * nn, g = t / nig, rem = t % nig, fm = g * 8;
  const int gsz = (nm - fm) < 8 ? (nm - fm) : 8;
  mi = fm + rem % gsz;
  ni = rem / gsz;
}
template <class Epi, class Epi8>
DI void gemm_phase(const bf16_t* A, int lda, int a_ks, const bf16_t* Bt, int ldb, int b_ks, int K, int nm, int nn, char* lds, int B, int G, Epi epi, Epi8 epi8, bool skipctx = false) {
  if (skipctx) nm -= 4;
  const int NT = nm * nn;
  int nfull = (NT / G) * G, R = NT - nfull;
  if (4 * R > 2 * G) { nfull = NT; R = 0; }
  for (int t = B; t < nfull + 4 * R; t += G) {
    int mi, ni;
    if (t < nfull) {
      tile_mn8(t, nm, nn, mi, ni);
      if (skipctx) mi += (mi >> 5) + 1;
      f32x4 acc[8][4];
#pragma unroll
      for (int i = 0; i < 8; ++i)
#pragma unroll
        for (int j = 0; j < 4; ++j) acc[i][j] = (f32x4){0.f, 0.f, 0.f, 0.f};
      gemm_core2(A + (size_t)mi * 256 * lda, lda, a_ks, Bt + (size_t)ni * 128 * ldb, ldb, b_ks, K, acc, lds);
      const int lane = otid() & 63, wid = otid() >> 6, wr = wid >> 1, wc = wid & 1;
#pragma unroll
      for (int i = 0; i < 8; ++i)
#pragma unroll
        for (int jp = 0; jp < 2; ++jp) epi8(mi * 256 + wr * 128 + i * 16 + (lane & 15), ni * 128 + wc * 64 + jp * 32 + (lane >> 4) * 8, acc[i][2 * jp], acc[i][2 * jp + 1]);
    } else {
      const int u = t - nfull, sub = u & 3;
      tile_mn8(nfull + (u >> 2), nm, nn, mi, ni);
      if (skipctx) mi += (mi >> 5) + 1;
      const int m0 = mi * 256 + (sub >> 1) * 128, n0 = ni * 128 + (sub & 1) * 64;
      f32x4 acc[4][2]; zero_acc<2>(acc);
      gemm_core<2>(A + (size_t)m0 * lda, lda, a_ks, Bt + (size_t)n0 * ldb, ldb, b_ks, K, acc, lds);
      gemm_emit<2>(acc, m0, n0, epi);
    }
  }
}
DI int sg_col(int gc) { const int j = gc >> 7; return (j < 12 ? 512 + 128 * j : 2560 + 128 * (j - 12)) + (gc & 127); }

constexpr int N_CVT = 1152 + 32 + 768 + 384 + 256 + 1024 + 1024 + 32;
DI void job_cvt(const Params& p, int layer, int t, char* lds) {
  const float* src; int ld, ncol0 = 0, nlim, K, ntot, nrow0 = 0; bf16_t* dst;
  char* ws = p.ws;
  if (t < 1152) { src = p.w_in + (size_t)layer * 1024 * 7696; ld = 7696; ncol0 = 0; nlim = 4608; dst = (bf16_t*)(ws + OFF_WIN); K = 1024; ntot = 7808; nrow0 = 0; }
  else if ((t -= 1152) < 32) { src = p.w_in + (size_t)layer * 1024 * 7696; ld = 7696; ncol0 = 4608; nlim = 4624; dst = (bf16_t*)(ws + OFF_WIN); K = 1024; ntot = 7808; nrow0 = 4608; }
  else if ((t -= 32) < 768) { src = p.w_in + (size_t)layer * 1024 * 7696; ld = 7696; ncol0 = 4624; nlim = 7696; dst = (bf16_t*)(ws + OFF_WIN); K = 1024; ntot = 7808; nrow0 = 4736; }
  else if ((t -= 768) < 384) { const int i = t / 128; t %= 128; src = p.wbr + ((size_t)layer * 3 + i) * 512 * 1024; ld = 1024; nlim = 1024; dst = (bf16_t*)(ws + OFF_WBR) + (size_t)i * 1024 * 512; K = 512; ntot = 1024; }
  else if ((t -= 384) < 256) { src = p.wout + (size_t)layer * 1024 * 1024; ld = 1024; nlim = 1024; dst = (bf16_t*)(ws + OFF_WO); K = 1024; ntot = 1024; }
  else if ((t -= 256) < 1024) { src = p.w1 + (size_t)layer * 1024 * 4096; ld = 4096; nlim = 4096; dst = (bf16_t*)(ws + OFF_W1); K = 1024; ntot = 4096; }
  else if ((t -= 1024) < 1024) { src = p.w2 + (size_t)layer * 4096 * 1024; ld = 1024; nlim = 1024; dst = (bf16_t*)(ws + OFF_W2); K = 4096; ntot = 1024; }
  else { t -= 1024; src = p.lgw + ((size_t)layer * 32 + t) * 4096; ld = 64; nlim = 64; dst = (bf16_t*)(ws + OFF_LG) + (size_t)t * 4096; K = 64; ntot = 0; t = 0; }
  const int nkt = K / 64, nt = t / nkt, kt = t % nkt;
  float* tl = (float*)lds;
  const int tid = otid();
  {
    const int nn = tid & 63, ncol = ncol0 + nt * 64 + nn;
#pragma unroll
    for (int i = 0; i < 16; ++i) {
      const int kk = i * 4 + (tid >> 6);
      tl[kk * 65 + nn] = (ncol < nlim) ? __builtin_nontemporal_load(src + (size_t)(kt * 64 + kk) * ld + ncol) : 0.f;
    }
  }
  __syncthreads();
  {
    const int n = tid >> 2, kq = tid & 3;
    float v[16];
#pragma unroll
    for (int e = 0; e < 16; ++e) v[e] = tl[(kq * 16 + e) * 65 + n];
    u32x4 w0 = {pk2(v[0], v[1]), pk2(v[2], v[3]), pk2(v[4], v[5]), pk2(v[6], v[7])};
    u32x4 w1 = {pk2(v[8], v[9]), pk2(v[10], v[11]), pk2(v[12], v[13]), pk2(v[14], v[15])};
    const int nd = nrow0 + nt * 64 + n, kd = kt * 64 + kq * 16;
    bf16_t* d = ntot ? dst + ((size_t)(kd >> 5) * ntot + nd) * 32 + (kd & 31) : dst + (size_t)nd * K + kd;
    *(u32x4*)d = w0;
    *(u32x4*)(d + 8) = w1;
  }
  __syncthreads();
}
DI void job_mod(const Params& p, int it, char* lds) {
  const int nc = it % 96, l = it / 96, tid = otid();
  float* sc = (float*)lds;
  float* red = sc + 5 * 1024;
  for (int i = tid; i < 5 * 1024; i += 256) {
    const int v = i >> 10, k = i & 1023;
    const float cv = v < 4 ? p.c[v * 1024 + k] : p.cctx[k];
    sc[i] = cv * sigm(cv);
  }
  __syncthreads();
  const int col = tid & 63, kg = tid >> 6, n = nc * 64 + col;
  const float* w = p.ada_w + ((size_t)l * 1024 + kg * 256) * 6144 + n;
  const float* s0 = sc + kg * 256;
  float a0 = 0, a1 = 0, a2 = 0, a3 = 0, a4 = 0;
#pragma unroll 8
  for (int k = 0; k < 256; ++k) {
    const float wv = __builtin_nontemporal_load(w + (size_t)k * 6144);
    a0 += s0[k] * wv; a1 += s0[1024 + k] * wv; a2 += s0[2048 + k] * wv; a3 += s0[3072 + k] * wv; a4 += s0[4096 + k] * wv;
  }
  red[(kg * 5 + 0) * 64 + col] = a0; red[(kg * 5 + 1) * 64 + col] = a1; red[(kg * 5 + 2) * 64 + col] = a2; red[(kg * 5 + 3) * 64 + col] = a3; red[(kg * 5 + 4) * 64 + col] = a4;
  __syncthreads();
  for (int i = tid; i < 320; i += 256) {
    const int v = i >> 6, cc = i & 63;
    const float r = ((red[(0 * 5 + v) * 64 + cc] + red[(1 * 5 + v) * 64 + cc]) + (red[(2 * 5 + v) * 64 + cc] + red[(3 * 5 + v) * 64 + cc])) + p.ada_b[l * 6144 + nc * 64 + cc];
    ((float*)(p.ws + OFF_MOD))[(size_t)(l * 5 + v) * 6144 + nc * 64 + cc] = r;
  }
  __syncthreads();
}
DI void job_rope(const Params& p, int it) {
  const int idx = it * 256 + otid(), t = idx >> 5, ax = (idx >> 4) & 1, f = idx & 15;
  const float inv = powf(10000.f, -(float)f / 16.f);
  const float pos = (float)(ax ? (t & 63) : (t >> 6));
  float s, c;
  sincosf(pos * inv, &s, &c);
  ((f32x2*)(p.ws + OFF_ROPE))[idx] = (f32x2){c, s};
}
DI void job_norm(const Params& p, int layer, int which, int it) {
  const int lane = otid() & 63, wid = otid() >> 6, r = it * 8 + wid;
  const float* xr0 = (which == 1) ? res_in_row(p, layer, r) : (const float*)res_out_row(p, r);
  const float* xr1 = (which == 1) ? res_in_row(p, layer, r + 4) : (const float*)res_out_row(p, r + 4);
  const float* mv = mod_vec(p, layer, r);
  const float* sh = mv + (which == 1 ? 0 : 3072);
  const float* sc = mv + (which == 1 ? 1024 : 4096);
  const float* g = (which == 1 ? p.n1g : p.n2g) + layer * 1024;
  f32x4 xa[4], xb[4];
#pragma unroll
  for (int i = 0; i < 4; ++i) { xa[i] = __builtin_nontemporal_load((const f32x4*)(xr0 + i * 256 + lane * 4)); xb[i] = __builtin_nontemporal_load((const f32x4*)(xr1 + i * 256 + lane * 4)); }
  float sa = 0.f, sb = 0.f;
#pragma unroll
  for (int i = 0; i < 4; ++i) {
    sa += xa[i][0] * xa[i][0] + xa[i][1] * xa[i][1] + xa[i][2] * xa[i][2] + xa[i][3] * xa[i][3];
    sb += xb[i][0] * xb[i][0] + xb[i][1] * xb[i][1] + xb[i][2] * xb[i][2] + xb[i][3] * xb[i][3];
  }
  sa = wsum(sa); sb = wsum(sb);
  const float ra = rsqrtf(sa * (1.f / 1024.f) + EPS), rb = rsqrtf(sb * (1.f / 1024.f) + EPS);
  bf16_t* H0 = (bf16_t*)(p.ws + OFF_H) + (size_t)r * 32;
  bf16_t* H1 = H0 + 4 * 32;
#pragma unroll
  for (int i = 0; i < 4; ++i) {
    const int c = i * 256 + lane * 4;
    const f32x4 gv = *(const f32x4*)(g + c), sv = *(const f32x4*)(sc + c), hv = *(const f32x4*)(sh + c);
    float o[4], q[4];
#pragma unroll
    for (int e = 0; e < 4; ++e) { const float m = gv[e] * (1.f + sv[e]); o[e] = xa[i][e] * ra * m + hv[e]; q[e] = xb[i][e] * rb * m + hv[e]; }
    const size_t so = (size_t)(c >> 5) * MR * 32 + (c & 31);
    *(u32x2*)(H0 + so) = (u32x2){pk2(o[0], o[1]), pk2(o[2], o[3])};
    *(u32x2*)(H1 + so) = (u32x2){pk2(q[0], q[1]), pk2(q[2], q[3])};
  }
}

DI void job_daprep1(const Params& p, int layer, int r, bool dup) {
  const int lane = otid() & 63, s = r % TT;
  const int G = lane >> 2, quarter = lane & 3;
  bf16_t* ptr = (bf16_t*)(p.ws + OFF_P) + (size_t)r * LDP + (G < 8 ? C_DAQ + G * 64 : C_DAK + (G - 8) * 64) + quarter * 16;
  const u32x4 w0 = *(const u32x4*)ptr, w1 = *(const u32x4*)(ptr + 8);
  float y[16];
#pragma unroll
  for (int e = 0; e < 4; ++e) { y[2 * e] = bflo(w0[e]); y[2 * e + 1] = bfhi(w0[e]); y[8 + 2 * e] = bflo(w1[e]); y[9 + 2 * e] = bfhi(w1[e]); }
  float ss = 0.f;
#pragma unroll
  for (int e = 0; e < 16; ++e) ss += y[e] * y[e];
  ss += shx<1>(ss);
  ss += shx<2>(ss);
  float rstd = rsqrtf(ss * (1.f / 64.f) + EPS);
  const float* g = (G < 8 ? p.daqg : p.dakg) + layer * 64 + quarter * 16;
#pragma unroll
  for (int e = 0; e < 16; ++e) y[e] = y[e] * rstd * g[e];
  if (s >= TC) {
    const f32x2* tb = (const f32x2*)(p.ws + OFF_ROPE) + ((size_t)(s - TC) * 2 + (quarter >> 1)) * 16;
#pragma unroll
    for (int e = 0; e < 16; ++e) {
      const float yp = shx<1>(y[e]);
      const f32x2 cs = tb[e];
      y[e] = (quarter & 1) ? (y[e] * cs.x + yp * cs.y) : (y[e] * cs.x - yp * cs.y);
    }
  }
  if (G < 8) {
#pragma unroll
    for (int e = 0; e < 16; ++e) y[e] *= 0.125f * 1.4426950408889634f;
  }
  if (dup) return;
  *(u32x4*)ptr = (u32x4){pk2(y[0], y[1]), pk2(y[2], y[3]), pk2(y[4], y[5]), pk2(y[6], y[7])};
  *(u32x4*)(ptr + 8) = (u32x4){pk2(y[8], y[9]), pk2(y[10], y[11]), pk2(y[12], y[13]), pk2(y[14], y[15])};
}
DI void job_daprep(const Params& p, int layer, int it, bool dup) {
  const int wid = otid() >> 6;
#pragma unroll
  for (int rr = 0; rr < 2; ++rr) job_daprep1(p, layer, it * 8 + rr * 4 + wid, dup);
}
DI void job_vt(const Params& p, int it, char* lds) {
  const int h = it & 3, c = (it >> 2) % NCH, b = it / (4 * NCH), tid = otid();
  bf16_t* tl = (bf16_t*)lds;
  const bf16_t* P = (const bf16_t*)(p.ws + OFF_P);
#pragma unroll
  for (int i = 0; i < 4; ++i) {
    const int q = tid + 256 * i, row = q >> 4, pc = q & 15;
    const u32x4 w = *(const u32x4*)(P + (size_t)(b * TT + c * 64 + row) * LDP + C_DAV + h * 128 + pc * 8);
    unsigned* d = (unsigned*)(tl + row * 130 + pc * 8);
    d[0] = w[0]; d[1] = w[1]; d[2] = w[2]; d[3] = w[3];
  }
  __syncthreads();
  {
    const int dv = tid >> 1, half = tid & 1;
    unsigned o[16];
#pragma unroll
    for (int e = 0; e < 16; ++e) o[e] = (unsigned)tl[(half * 32 + 2 * e) * 130 + dv] | ((unsigned)tl[(half * 32 + 2 * e + 1) * 130 + dv] << 16);
    bf16_t* d = (bf16_t*)(p.ws + OFF_VT) + ((size_t)(b * 4 + h) * 128 + dv) * TT + c * 64 + half * 32;
#pragma unroll
#define VTW(w) o[(((w) & 3) >> 1) * 8 + ((w) >> 2) * 2 + ((w) & 1)]
    for (int e = 0; e < 4; ++e) *(u32x4*)(d + e * 8) = (u32x4){VTW(4 * e), VTW(4 * e + 1), VTW(4 * e + 2), VTW(4 * e + 3)};
#undef VTW
  }
  __syncthreads();
}

constexpr int N_ATT = 1056;
DI void job_attn(const Params& p, int layer, int a, char* lds, bool dup) {
  const int tid = otid(), lane = tid & 63, wid = tid >> 6, l15 = lane & 15, g = lane >> 4;
  const int grp = a / 528, within = a % 528, bh = grp * 8 + (within & 7), qb = within >> 3, b = bh >> 2, h = bh & 3;
  if (layer == 1 && qb < 2) return;
  const int nt = qb < 2 ? 4 : NCH;
  bf16_t* P = (bf16_t*)(p.ws + OFF_P);
  const bf16_t* VT = (const bf16_t*)(p.ws + OFF_VT) + (size_t)(b * 4 + h) * 128 * TT;
  int ly_ = layer; asm volatile("" : "+s"(ly_));
  const float lam_init = __uint_as_float(ly_ == 0 ? 0x3e4ccccdu : 0x3eb60549u);
  const float* lv = p.dalam + layer * 256;
  const float lam = __uint_as_float(__builtin_amdgcn_readfirstlane(__float_as_uint(expf(wsum(lv[lane] * lv[64 + lane])) - expf(wsum(lv[128 + lane] * lv[192 + lane])) + lam_init)));
  const float mq = wmax(fabsf(p.daqg[layer * 64 + lane])), mk = wmax(fabsf(p.dakg[layer * 64 + lane]));
  const float negMb = __uint_as_float(__builtin_amdgcn_readfirstlane(__float_as_uint(-(8.f * mq * mk * 1.03f * 1.4426950408889634f + 0.5f))));
  const int r0 = b * TT + qb * 128 + wid * 32;
  bf16x8 qf[2][2][2];
#pragma unroll
  for (int c = 0; c < 2; ++c)
#pragma unroll
    for (int i = 0; i < 2; ++i)
#pragma unroll
      for (int ks = 0; ks < 2; ++ks) qf[c][i][ks] = *(const bf16x8*)(P + (size_t)(r0 + i * 16 + l15) * LDP + C_DAQ + h * 128 + c * 64 + ks * 32 + g * 8);
  bf16_t* Ks = (bf16_t*)lds;
  bf16_t* Vs = Ks + 2 * 64 * 144;
  u32x4 rk[4], rv[4];
  const bf16_t* kg = P + (size_t)(b * TT) * LDP + C_DAK + h * 128;
#define KLOAD(t) { _Pragma("unroll") for (int i = 0; i < 4; ++i) { const int q = tid + 256 * i; rk[i] = *(const u32x4*)(kg + (size_t)((t) * 64 + (q >> 4)) * LDP + (q & 15) * 8); } }
#define VLOAD(t) { _Pragma("unroll") for (int i = 0; i < 4; ++i) { const int q = tid + 256 * i; rv[i] = *(const u32x4*)(VT + (size_t)(q >> 3) * TT + (t) * 64 + (q & 7) * 8); } }
#define KSTORE(buf) { _Pragma("unroll") for (int i = 0; i < 4; ++i) { const int q = tid + 256 * i; *(u32x4*)(Ks + ((buf) * 64 + (q >> 4)) * 144 + (q & 15) * 8) = rk[i]; } }
#define VSTORE(buf) { _Pragma("unroll") for (int i = 0; i < 4; ++i) { const int q = tid + 256 * i; *(u32x4*)(Vs + ((buf) * 128 + (q >> 3)) * 80 + (q & 7) * 8) = rv[i]; } }
#define QK_INTO(S, Kb, half, CI)                                                                                       \
  _Pragma("unroll") for (int c = 0; c < 2; ++c) {                                                                      \
    bf16x8 kf[2][2];                                                                                                   \
    _Pragma("unroll") for (int k2 = 0; k2 < 2; ++k2) _Pragma("unroll") for (int ks = 0; ks < 2; ++ks)                  \
      kf[k2][ks] = *(const bf16x8*)((Kb) + ((half) * 32 + k2 * 16 + l15) * 144 + c * 64 + ks * 32 + g * 8);             \
    __builtin_amdgcn_sched_barrier(0);                                                                                 \
    _Pragma("unroll") for (int k2 = 0; k2 < 2; ++k2) _Pragma("unroll") for (int i = 0; i < 2; ++i) {                   \
      S[c][i][k2] = mfma16(kf[k2][0], qf[c][i][0], CI(c, i));     \
      S[c][i][k2] = mfma16(kf[k2][1], qf[c][i][1], S[c][i][k2]); }                                                     \
  }                                                                                                                    \
  __builtin_amdgcn_sched_barrier(0);
#define EXPSUM(S)                                                                                                      \
  _Pragma("unroll") for (int c = 0; c < 2; ++c) _Pragma("unroll") for (int i = 0; i < 2; ++i) {                        \
    _Pragma("unroll") for (int k2 = 0; k2 < 2; ++k2) _Pragma("unroll") for (int e = 0; e < 4; ++e) S[c][i][k2][e] = __builtin_amdgcn_exp2f(S[c][i][k2][e]); \
    lsum[c][i] += ((S[c][i][0][0] + S[c][i][0][1]) + (S[c][i][0][2] + S[c][i][0][3])) + ((S[c][i][1][0] + S[c][i][1][1]) + (S[c][i][1][2] + S[c][i][1][3])); }
#define EXP_S() _Pragma("unroll") for (int c = 0; c < 2; ++c) _Pragma("unroll") for (int i = 0; i < 2; ++i) _Pragma("unroll") for (int k2 = 0; k2 < 2; ++k2) _Pragma("unroll") for (int e = 0; e < 4; ++e) S[c][i][k2][e] = __builtin_amdgcn_exp2f(S[c][i][k2][e]);
  float lsum[2][2] = {{0.f, 0.f}, {0.f, 0.f}};
  KLOAD(0);
  KSTORE(0);
  __syncthreads();
  const f32x4 negMv = {negMb, negMb, negMb, negMb};
#define CI1(c, i) negMv
  f32x4 SA[2][2][2], SB[2][2][2];
#pragma unroll 1
  for (int t = 0; t < nt; ++t) {
    if (t + 1 < nt) KLOAD(t + 1);
    const bf16_t* Kb = Ks + (t & 1) * 64 * 144;
    QK_INTO(SA, Kb, 0, CI1)
    if (t > 0) { EXPSUM(SB) }
    __builtin_amdgcn_sched_barrier(0);
    QK_INTO(SB, Kb, 1, CI1)
    EXPSUM(SA)
    if (t + 1 < nt) KSTORE((t + 1) & 1);
    __syncthreads();
  }
  EXPSUM(SB)
  f32x4 ci2[2][2];
#pragma unroll
  for (int i = 0; i < 2; ++i) {
    float l0 = lsum[0][i], l1 = lsum[1][i];
    l0 += shx<16>(l0); l0 = add32(l0);
    l1 += shx<16>(l1); l1 = add32(l1);
    const float c0 = negMb - __log2f(l0), c1 = negMb + __log2f(fabsf(lam)) - __log2f(l1);
    ci2[0][i] = (f32x4){c0, c0, c0, c0}; ci2[1][i] = (f32x4){c1, c1, c1, c1};
  }
  const float nsl = lam < 0.f ? 1.f : -1.f;
#define CI2(c, i) ci2[c][i]
  f32x4 O[2][8];
#pragma unroll
  for (int i = 0; i < 2; ++i)
#pragma unroll
    for (int n = 0; n < 8; ++n) O[i][n] = (f32x4){0.f, 0.f, 0.f, 0.f};
  KLOAD(0); VLOAD(0);
  KSTORE(0); VSTORE(0);
  __syncthreads();
#pragma unroll 1
  for (int t = 0; t < nt; ++t) {
    if (t + 1 < nt) KLOAD(t + 1);
    const bf16_t* Kb = Ks + (t & 1) * 64 * 144;
    const bf16_t* Vb = Vs + (t & 1) * 128 * 80;
#pragma unroll
    for (int half = 0; half < 2; ++half) {
      bf16x8 pf[2], vfa[4], vfb[4];
#define VREAD(dst, n0) _Pragma("unroll") for (int n = 0; n < 4; ++n) dst[n] = *(const bf16x8*)(Vb + (((n0) + n) * 16 + l15) * 80 + half * 32 + g * 8);
      {
        f32x4 S[2][2][2];
        QK_INTO(S, Kb, half, CI2)
        VREAD(vfa, 0)
        EXP_S()
#pragma unroll
        for (int i = 0; i < 2; ++i) {
          float w[8];
#pragma unroll
          for (int k2 = 0; k2 < 2; ++k2)
#pragma unroll
            for (int e = 0; e < 4; ++e) w[k2 * 4 + e] = __builtin_fmaf(nsl, S[1][i][k2][e], S[0][i][k2][e]);
          const u32x4 ww = {pk2(w[0], w[1]), pk2(w[2], w[3]), pk2(w[4], w[5]), pk2(w[6], w[7])};
          pf[i] = __builtin_bit_cast(bf16x8, ww);
        }
      }
      __builtin_amdgcn_sched_barrier(0);
      VREAD(vfb, 4)
#pragma unroll
      for (int n = 0; n < 4; ++n)
#pragma unroll
        for (int i = 0; i < 2; ++i) O[i][n] = mfma16(pf[i], vfa[n], O[i][n]);
      __builtin_amdgcn_sched_barrier(0);
#pragma unroll
      for (int n = 0; n < 4; ++n)
#pragma unroll
        for (int i = 0; i < 2; ++i) O[i][4 + n] = mfma16(pf[i], vfb[n], O[i][4 + n]);
      __builtin_amdgcn_sched_barrier(0);
#undef VREAD
      if (half == 0 && t + 1 < nt) VLOAD(t + 1);
    }
    if (t + 1 < nt) { KSTORE((t + 1) & 1); VSTORE((t + 1) & 1); }
    __syncthreads();
  }
#undef KLOAD
#undef VLOAD
#undef KSTORE
#undef VSTORE
#undef CI1
#undef CI2
#undef QK_INTO
#undef EXPSUM
#undef EXP_S
  const int lane_e = otid() & 63, l15e = lane_e & 15, ge = lane_e >> 4;
  const float* sg = p.dasub + layer * 128;
#pragma unroll
  for (int i = 0; i < 2; ++i)
#pragma unroll
    for (int e = 0; e < 4; ++e) {
      float ss = 0.f;
#pragma unroll
      for (int n = 0; n < 8; ++n) ss += O[i][n][e] * O[i][n][e];
      ss += shx<1>(ss); ss += shx<2>(ss); ss += shx<4>(ss); ss += shx<8>(ss);
      const float rstd = rsqrtf(ss * (1.f / 128.f) + EPS) * (1.f - lam_init);
      bf16_t* op = P + (size_t)(r0 + i * 16 + ge * 4 + e) * LDP + C_DAQ + h * 128 + l15e;
#pragma unroll
      for (int n = 0; n < 8; ++n) if (!dup) op[n * 16] = f2bf(O[i][n][e] * rstd * sg[n * 16 + l15e]);
    }
}

DI float gelu_tanh(float x) { const float u = 0.7978845608028654f * (x + 0.044715f * x * x * x); return 0.5f * x * (1.f + tanhf(u)); }
template <int PASS>
DI void job_lru(const Params& p, int layer, int it, char* lds, bool dup) {
  const int tid = otid(), lane = tid & 63, wid = tid >> 6, l15 = lane & 15, g = lane >> 4;
  const int n = it & 7, c = (it >> 3) % NCH, b = it / (8 * NCH);
  float* xc32 = (float*)lds;
  bf16_t* xcb = (bf16_t*)(lds + 16384);
  f32x2* ab = (f32x2*)(lds + 16384 + 9216);
  f32x2* segtot = (f32x2*)(lds + 16384 + 9216 + 32768);
  float* carry = (float*)(lds + 16384 + 9216 + 32768 + 2048);
  bf16_t* P = (bf16_t*)(p.ws + OFF_P);
  f32x2* LC = (f32x2*)(p.ws + OFF_LC);
  const int ch = tid & 63, seg = tid >> 6;
  {
    const int segLo = c < 4 ? 0 : TC, segHi = c < 4 ? TC : TT;
    const int s0 = c * 64 + seg * 16;
    float cw[4];
#pragma unroll
    for (int k = 0; k < 4; ++k) cw[k] = p.lcw[(size_t)(layer * 4 + k) * 512 + n * 64 + ch];
    const float cb = p.lcb[layer * 512 + n * 64 + ch];
    float xw[19];
#pragma unroll
    for (int j = 0; j < 19; ++j) {
      const int s = s0 - 1 + j;
      xw[j] = (s >= segLo && s < segHi) ? bf2f(P[(size_t)(b * TT + s) * LDP + C_LX + n * 64 + ch]) : 0.f;
    }
#pragma unroll
    for (int u = 0; u < 16; ++u) {
      const float v = cw[0] * xw[u] + cw[1] * xw[u + 1] + cw[2] * xw[u + 2] + cw[3] * xw[u + 3] + cb;
      xc32[(seg * 16 + u) * 64 + ch] = v;
      xcb[(seg * 16 + u) * 72 + ch] = f2bf(v);
    }
  }
  if (PASS == 3 && tid < 128) {
    const int d = tid >> 6;
    const int pos = d == 0 ? c : (c < 4 ? 3 - c : 4 + (NCH - 1 - c));
    float hh = 0.f;
    for (int q0 = 0; q0 < pos; q0 += 16) {
      f32x2 AB[16];
#pragma unroll
      for (int j = 0; j < 16; ++j) {
        const int q = q0 + j, qq = q < pos ? q : pos - 1;
        const int cc = d == 0 ? qq : (qq < 4 ? 3 - qq : NCH - 1 - (qq - 4));
        AB[j] = LC[((((size_t)b * NCH + cc) * 8 + n) * 2 + d) * 64 + ch];
      }
#pragma unroll
      for (int j = 0; j < 16; ++j) if (q0 + j < pos) hh = AB[j].x * hh + AB[j].y;
    }
    carry[d * 64 + ch] = hh;
  }
  __syncthreads();
  float hacc[16];
#pragma unroll
  for (int u = 0; u < 16; ++u) hacc[u] = 0.f;
#pragma unroll 1
  for (int d = 0; d < 2; ++d) {
    {
      f32x4 ar[4], ai[4];
#pragma unroll
      for (int i = 0; i < 4; ++i) { ar[i] = (f32x4){0.f, 0.f, 0.f, 0.f}; ai[i] = (f32x4){0.f, 0.f, 0.f, 0.f}; }
      const bf16_t* LG = (const bf16_t*)(p.ws + OFF_LG);
      const bf16_t* wr_ = LG + ((size_t)((d * 2 + 0) * 8 + n)) * 4096 + (wid * 16 + l15) * 64 + g * 8;
      const bf16_t* wi_ = LG + ((size_t)((d * 2 + 1) * 8 + n)) * 4096 + (wid * 16 + l15) * 64 + g * 8;
#pragma unroll
      for (int ks = 0; ks < 2; ++ks) {
        const bf16x8 br = *(const bf16x8*)(wr_ + ks * 32), bi = *(const bf16x8*)(wi_ + ks * 32);
#pragma unroll
        for (int i = 0; i < 4; ++i) {
          const bf16x8 af = *(const bf16x8*)(xcb + (i * 16 + l15) * 72 + ks * 32 + g * 8);
          ar[i] = mfma16(br, af, ar[i]);
          ai[i] = mfma16(bi, af, ai[i]);
        }
      }
#pragma unroll
      for (int e = 0; e < 4; ++e) {
        const int che = wid * 16 + g * 4 + e, cg_ = n * 64 + che;
        const float br = p.lgb[(size_t)((layer * 2 + d) * 2 + 0) * 512 + cg_], bi = p.lgb[(size_t)((layer * 2 + d) * 2 + 1) * 512 + cg_];
        const float sp = softplusf(-p.llam[(size_t)(layer * 2 + d) * 512 + cg_]);
#pragma unroll
        for (int i = 0; i < 4; ++i) {
          const int tok = i * 16 + l15;
          const float r = sigm(ar[i][e] + br), ig = sigm(ai[i][e] + bi);
          const float la = -8.f * r * sp;
          const float av = __expf(la);
          const float bv = __builtin_sqrtf(fmaxf(1.f - __expf(2.f * la), 0.f)) * ig * xc32[tok * 64 + che];
          ab[tok * 64 + che] = (f32x2){av, bv};
        }
      }
    }
    __syncthreads();
    float hloc[16], cploc[16];
    {
      float hp = 0.f, cp = 1.f;
#pragma unroll
      for (int uu = 0; uu < 16; ++uu) {
        const int u = d == 0 ? uu : 15 - uu;
        const f32x2 v = ab[(seg * 16 + u) * 64 + ch];
        hp = v.x * hp + v.y;
        cp *= v.x;
        hloc[uu] = hp; cploc[uu] = cp;
      }
      segtot[seg * 64 + ch] = (f32x2){cp, hp};
    }
    __syncthreads();
    if (PASS == 1) {
      if (tid < 64) {
        float A = 1.f, Bv = 0.f;
#pragma unroll
        for (int q = 0; q < 4; ++q) {
          const f32x2 v = segtot[(d == 0 ? q : 3 - q) * 64 + ch];
          Bv = v.x * Bv + v.y; A *= v.x;
        }
        LC[((((size_t)b * NCH + c) * 8 + n) * 2 + d) * 64 + ch] = (f32x2){A, Bv};
      }
    } else {
      float hh = carry[d * 64 + ch];
      const int npre = d == 0 ? seg : 3 - seg;
      for (int q = 0; q < npre; ++q) {
        const f32x2 v = segtot[(d == 0 ? q : 3 - q) * 64 + ch];
        hh = v.x * hh + v.y;
      }
#pragma unroll
      for (int uu = 0; uu < 16; ++uu) {
        const int u = d == 0 ? uu : 15 - uu;
        const float hv = hloc[uu] + cploc[uu] * hh;
        hacc[d == 0 ? uu : 15 - uu] += hv;
        (void)u;
      }
    }
    __syncthreads();
  }
  if (PASS == 3) {
#pragma unroll
    for (int u = 0; u < 16; ++u) {
      bf16_t* yp = P + (size_t)(b * TT + c * 64 + seg * 16 + u) * LDP + C_LY + n * 64 + ch;
      if (!dup) *yp = f2bf(gelu_tanh(bf2f(*yp)) * hacc[u]);
    }
  }
}

DI void job_gconv(const Params& p, int layer, int it, bool dup) {
  const int tid = otid(), grp = it % 12, cg_ = it / 12, cp = tid & 15, rg = tid >> 4;
  const int cin = cg_ % NCH;
  const bool first = (cin == 0 || cin == 4), last = (cin == 3 || cin == NCH - 1);
  bf16_t* P = (bf16_t*)(p.ws + OFF_P);
  const bf16_t* HALO = (const bf16_t*)(p.ws + OFF_HALO);
  const int col = grp * 128 + cp * 8;
  u32x4 xr[7];
#pragma unroll
  for (int j = 0; j < 7; ++j) {
    const int q = rg * 4 - 1 + j;
    u32x4 v = {0u, 0u, 0u, 0u};
    if (q >= 0 && q < 64) v = *(const u32x4*)(P + (size_t)(cg_ * 64 + q) * LDP + C_GQKV + col);
    else if (q < 0) { if (!first) v = *(const u32x4*)(HALO + ((size_t)(cg_ - 1) * 3 + 2) * 1536 + col); }
    else { if (!last) v = *(const u32x4*)(HALO + ((size_t)(cg_ + 1) * 3 + (q - 64)) * 1536 + col); }
    xr[j] = v;
  }
  float w[4][8];
#pragma unroll
  for (int k = 0; k < 4; ++k) {
    const f32x4 a = *(const f32x4*)(p.gcw + (size_t)(layer * 4 + k) * 1536 + col), bq = *(const f32x4*)(p.gcw + (size_t)(layer * 4 + k) * 1536 + col + 4);
#pragma unroll
    for (int e = 0; e < 4; ++e) { w[k][e] = a[e]; w[k][4 + e] = bq[e]; }
  }
  __syncthreads();
#pragma unroll
  for (int jr = 0; jr < 4; ++jr) {
    float y[8];
#pragma unroll
    for (int e = 0; e < 8; ++e) y[e] = 0.f;
#pragma unroll
    for (int k = 0; k < 4; ++k)
#pragma unroll
      for (int e = 0; e < 4; ++e) { y[2 * e] += w[k][2 * e] * bflo(xr[jr + k][e]); y[2 * e + 1] += w[k][2 * e + 1] * bfhi(xr[jr + k][e]); }
    float ss = 0.f;
#pragma unroll
    for (int e = 0; e < 8; ++e) { y[e] = y[e] * sigm(y[e]); ss += y[e] * y[e]; }
    if (grp < 8) {
      ss += shx<1>(ss); ss += shx<2>(ss); ss += shx<4>(ss); ss += shx<8>(ss);
      const float sc = rsqrtf(ss + EPS) * (grp < 4 ? 0.08838834764831845f : 1.f);
#pragma unroll
      for (int e = 0; e < 8; ++e) y[e] *= sc;
    }
    if (!dup) *(u32x4*)(P + (size_t)(cg_ * 64 + rg * 4 + jr) * LDP + C_GQKV + col) = (u32x4){pk2(y[0], y[1]), pk2(y[2], y[3]), pk2(y[4], y[5]), pk2(y[6], y[7])};
  }
  __syncthreads();
}

DI void job_gprep(const Params& p, int layer, int it, char* lds) {
  const int tid = otid(), lane = tid & 63, wid = tid >> 6, l15 = lane & 15, g = lane >> 4;
  const int h = it & 3, c = (it >> 2) % NCH, b = it / (4 * NCH);
  bf16_t* kt_ = (bf16_t*)lds;
  bf16_t* qt_ = kt_ + 64 * 136;
  float* Ld = (float*)lds;
  float* KK = (float*)(lds + 34816);
  float* QK = KK + 64 * 65;
  float* gcs = QK + 64 * 65;
  float* bts = gcs + 128;
  const bf16_t* P = (const bf16_t*)(p.ws + OFF_P);
#pragma unroll
  for (int i = 0; i < 4; ++i) {
    const int q = tid + 256 * i, row = q >> 4, pc = q & 15;
    const bf16_t* rp = P + (size_t)(b * TT + c * 64 + row) * LDP + C_GQKV + h * 128 + pc * 8;
    *(u32x4*)(qt_ + row * 136 + pc * 8) = *(const u32x4*)rp;
    *(u32x4*)(kt_ + row * 136 + pc * 8) = *(const u32x4*)(rp + 512);
  }
  float* GSC = (float*)(p.ws + OFF_GSC);
  if (tid < 128) {
    const int d = wid, i = lane, tn = d ? 63 - i : i, r = b * TT + c * 64 + tn;
    const float* gba = (const float*)(p.ws + OFF_GBA) + (size_t)r * 16;
    const float gval = -expf(p.galog[(layer * 2 + d) * 4 + h]) * softplusf(gba[8 + d * 4 + h] + p.gdtb[(layer * 2 + d) * 4 + h]);
    const float beta = sigm(gba[d * 4 + h]);
    float v = gval;
#pragma unroll
    for (int o = 1; o < 64; o <<= 1) { const float t = __int_as_float(__builtin_amdgcn_ds_bpermute(((lane - o) & 63) << 2, __float_as_int(v))); if (lane >= o) v += t; }
    const float glast = __int_as_float(__builtin_amdgcn_readlane(__float_as_int(v), 63));
    gcs[d * 64 + i] = v;
    bts[d * 64 + i] = beta;
    float* gs = GSC + (size_t)(it * 2 + d) * 192;
    gs[i] = expf(v);
    gs[64 + i] = expf(glast - v);
    if (i == 0) gs[128] = expf(glast);
  }
  __syncthreads();
  {
    f32x4 akk[4], aqk[4];
#pragma unroll
    for (int j = 0; j < 4; ++j) { akk[j] = (f32x4){0.f, 0.f, 0.f, 0.f}; aqk[j] = (f32x4){0.f, 0.f, 0.f, 0.f}; }
#pragma unroll
    for (int ks = 0; ks < 4; ++ks) {
      const bf16x8 ak = *(const bf16x8*)(kt_ + (wid * 16 + l15) * 136 + ks * 32 + g * 8);
      const bf16x8 aq = *(const bf16x8*)(qt_ + (wid * 16 + l15) * 136 + ks * 32 + g * 8);
#pragma unroll
      for (int j = 0; j < 4; ++j) {
        const bf16x8 bk = *(const bf16x8*)(kt_ + (j * 16 + l15) * 136 + ks * 32 + g * 8);
        akk[j] = mfma16(ak, bk, akk[j]);
        aqk[j] = mfma16(aq, bk, aqk[j]);
      }
    }
#pragma unroll
    for (int j = 0; j < 4; ++j)
#pragma unroll
      for (int e = 0; e < 4; ++e) { KK[(wid * 16 + g * 4 + e) * 65 + j * 16 + l15] = akk[j][e]; QK[(wid * 16 + g * 4 + e) * 65 + j * 16 + l15] = aqk[j][e]; }
  }
  __syncthreads();
  bf16_t* M1 = (bf16_t*)(p.ws + OFF_H);
  bf16_t* AT = M1 + (size_t)4224 * 4096;
#pragma unroll 1
  for (int d = 0; d < 2; ++d) {
    bf16_t* atp = AT + (size_t)(it * 2 + d) * 4096;
#pragma unroll 4
    for (int idx = tid; idx < 4096; idx += 256) {
      const int i = idx >> 6, j = idx & 63, ti = d ? 63 - i : i, tj = d ? 63 - j : j;
      const float dec = (j <= i) ? expf(gcs[d * 64 + i] - gcs[d * 64 + j]) : 0.f;
      Ld[d * 4096 + idx] = (j < i) ? bts[d * 64 + i] * KK[ti * 65 + tj] * dec : 0.f;
      atp[idx] = f2bf(QK[ti * 65 + tj] * dec);
    }
  }
  __syncthreads();
  if (wid < 2) {
    const int d = wid;
    const float* L = Ld + d * 4096;
    const float bc = bts[d * 64 + lane];
    bf16_t* mp = M1 + (size_t)(it * 2 + d) * 4096 + lane;
    float x[64];
#pragma unroll
    for (int i = 0; i < 64; ++i) {
      float s = (i == lane) ? 1.f : 0.f;
#pragma unroll
      for (int j = 0; j < i; ++j) s -= L[i * 64 + j] * x[j];
      x[i] = s;
      mp[i * 64] = f2bf(s * bc);
    }
  }
  __syncthreads();
}

struct GChunk { bf16x8 kf[4], qf[4], m1f[2], atf[2]; unsigned vr[2][4]; float eg[4], egl[4]; float ge; };
DI void gdn_load(GChunk& R, const Params& p, int b, int h, int d, int dvs, int c) {
  const int tid = otid(), lane = tid & 63, wid = tid >> 6, l15 = lane & 15, g = lane >> 4;
  const bf16_t* P = (const bf16_t*)(p.ws + OFF_P);
  const bf16_t* M1 = (const bf16_t*)(p.ws + OFF_H);
  const bf16_t* AT = M1 + (size_t)4224 * 4096;
  const float* GSC = (const float*)(p.ws + OFF_GSC);
  const int item = ((b * NCH + c) * 4 + h) * 2 + d;
  const int irow = 16 * wid + l15, tn = d ? 63 - irow : irow;
  const bf16_t* rowp = P + (size_t)(b * TT + c * 64 + tn) * LDP + C_GQKV + h * 128;
#pragma unroll
  for (int ks = 0; ks < 4; ++ks) { R.qf[ks] = *(const bf16x8*)(rowp + ks * 32 + g * 8); R.kf[ks] = *(const bf16x8*)(rowp + 512 + ks * 32 + g * 8); }
#pragma unroll
  for (int ks = 0; ks < 2; ++ks) {
    R.m1f[ks] = *(const bf16x8*)(M1 + (size_t)item * 4096 + irow * 64 + ks * 32 + g * 8);
    R.atf[ks] = *(const bf16x8*)(AT + (size_t)item * 4096 + irow * 64 + ks * 32 + g * 8);
  }
#pragma unroll
  for (int e = 0; e < 4; ++e) {
    const int i = 16 * wid + g * 4 + e, t2 = d ? 63 - i : i;
    R.vr[0][e] = *(const unsigned*)(P + (size_t)(b * TT + c * 64 + t2) * LDP + C_GQKV + 1024 + h * 128 + dvs * 32 + (l15 & ~1));
    R.vr[1][e] = *(const unsigned*)(P + (size_t)(b * TT + c * 64 + t2) * LDP + C_GQKV + 1024 + h * 128 + dvs * 32 + 16 + (l15 & ~1));
    R.eg[e] = GSC[(size_t)item * 192 + i];
    R.egl[e] = GSC[(size_t)item * 192 + 64 + i];
  }
  R.ge = GSC[(size_t)item * 192 + 128];
}
DI void gdn_put_kt(const GChunk& R, bf16_t* KT) {
  const int tid = otid(), lane = tid & 63, i = 16 * (tid >> 6) + (lane & 15), g = lane >> 4;
#pragma unroll
  for (int ks = 0; ks < 4; ++ks)
#pragma unroll
    for (int e = 0; e < 8; ++e) KT[(ks * 32 + g * 8 + e) * 72 + i] = (bf16_t)R.kf[ks][e];
}
DI int gdn_chunk_at(int d, int n) { return d == 0 ? n : (n < 4 ? 3 - n : NCH - 1 - (n - 4)); }
DI void job_gscan(const Params& p, int u, char* lds) {
  const int tid = otid(), lane = tid & 63, wid = tid >> 6, l15 = lane & 15, g = lane >> 4;
  const int seq = (u & 7) + 8 * (u >> 5), dvs = (u >> 3) & 3, d = seq & 1, h = (seq >> 1) & 3, b = seq >> 3;
  bf16_t* KT = (bf16_t*)lds;
  bf16_t* ST = KT + 2 * 128 * 72;
  bf16_t* XT = ST + 32 * 136;
  bf16_t* VnT = XT + 32 * 72;
  bf16_t* VsT = VnT + 32 * 72;
  bf16_t* OUT = d == 0 ? (bf16_t*)(p.ws + OFF_P) + C_DAV : (bf16_t*)(p.ws + OFF_OB);
  const int ldo = d == 0 ? LDP : 512;
  __builtin_amdgcn_s_setprio(3);
  f32x4 S[2][2];
#pragma unroll
  for (int a = 0; a < 2; ++a)
#pragma unroll
    for (int ct = 0; ct < 2; ++ct) S[a][ct] = (f32x4){0.f, 0.f, 0.f, 0.f};
  for (int i = tid; i < 32 * 136 / 2; i += 256) ((unsigned*)ST)[i] = 0u;
  GChunk cur, nxt;
  gdn_load(cur, p, b, h, d, dvs, gdn_chunk_at(d, 0));
  gdn_put_kt(cur, KT);
  __syncthreads();
#pragma unroll 1
  for (int n = 0; n < NCH; ++n) {
    const int c = gdn_chunk_at(d, n);
    if (n + 1 < NCH) gdn_load(nxt, p, b, h, d, dvs, gdn_chunk_at(d, n + 1));
    const bf16_t* KTc = KT + (n & 1) * 128 * 72;
    f32x4 ksa[2], qsa[2];
#pragma unroll
    for (int ct = 0; ct < 2; ++ct) { ksa[ct] = (f32x4){0.f, 0.f, 0.f, 0.f}; qsa[ct] = (f32x4){0.f, 0.f, 0.f, 0.f}; }
#pragma unroll
    for (int ks = 0; ks < 4; ++ks)
#pragma unroll
      for (int ct = 0; ct < 2; ++ct) {
        const bf16x8 bS = *(const bf16x8*)(ST + (ct * 16 + l15) * 136 + ks * 32 + g * 8);
        ksa[ct] = mfma16(cur.kf[ks], bS, ksa[ct]);
        qsa[ct] = mfma16(cur.qf[ks], bS, qsa[ct]);
      }
#pragma unroll
    for (int ct = 0; ct < 2; ++ct) {
      float x[4];
#pragma unroll
      for (int e = 0; e < 4; ++e) x[e] = ((l15 & 1) ? bfhi(cur.vr[ct][e]) : bflo(cur.vr[ct][e])) - cur.eg[e] * ksa[ct][e];
      *(u32x2*)(XT + (ct * 16 + l15) * 72 + 16 * wid + g * 4) = (u32x2){pk2(x[0], x[1]), pk2(x[2], x[3])};
    }
    __syncthreads();
#pragma unroll
    for (int ct = 0; ct < 2; ++ct) {
      f32x4 vn = {0.f, 0.f, 0.f, 0.f};
#pragma unroll
      for (int ks = 0; ks < 2; ++ks) vn = mfma16(cur.m1f[ks], *(const bf16x8*)(XT + (ct * 16 + l15) * 72 + ks * 32 + g * 8), vn);
      *(u32x2*)(VnT + (ct * 16 + l15) * 72 + 16 * wid + g * 4) = (u32x2){pk2(vn[0], vn[1]), pk2(vn[2], vn[3])};
      *(u32x2*)(VsT + (ct * 16 + l15) * 72 + 16 * wid + g * 4) = (u32x2){pk2(vn[0] * cur.egl[0], vn[1] * cur.egl[1]), pk2(vn[2] * cur.egl[2], vn[3] * cur.egl[3])};
    }
    __syncthreads();
#pragma unroll
    for (int ct = 0; ct < 2; ++ct) {
      f32x4 o;
#pragma unroll
      for (int e = 0; e < 4; ++e) o[e] = cur.eg[e] * qsa[ct][e];
#pragma unroll
      for (int ks = 0; ks < 2; ++ks) o = mfma16(cur.atf[ks], *(const bf16x8*)(VnT + (ct * 16 + l15) * 72 + ks * 32 + g * 8), o);
#pragma unroll
      for (int e = 0; e < 4; ++e) {
        const int i = 16 * wid + g * 4 + e, t2 = d ? 63 - i : i;
        OUT[(size_t)(b * TT + c * 64 + t2) * ldo + h * 128 + dvs * 32 + ct * 16 + l15] = f2bf(o[e]);
      }
    }
#pragma unroll
    for (int rt2 = 0; rt2 < 2; ++rt2) {
      const int rt = 2 * wid + rt2;
#pragma unroll
      for (int ct = 0; ct < 2; ++ct)
#pragma unroll
        for (int e = 0; e < 4; ++e) S[rt2][ct][e] *= cur.ge;
#pragma unroll
      for (int ks = 0; ks < 2; ++ks) {
        const bf16x8 ka = *(const bf16x8*)(KTc + (rt * 16 + l15) * 72 + ks * 32 + g * 8);
#pragma unroll
        for (int ct = 0; ct < 2; ++ct) S[rt2][ct] = mfma16(ka, *(const bf16x8*)(VsT + (ct * 16 + l15) * 72 + ks * 32 + g * 8), S[rt2][ct]);
      }
#pragma unroll
      for (int ct = 0; ct < 2; ++ct)
        *(u32x2*)(ST + (ct * 16 + l15) * 136 + rt * 16 + g * 4) = (u32x2){pk2(S[rt2][ct][0], S[rt2][ct][1]), pk2(S[rt2][ct][2], S[rt2][ct][3])};
    }
    if (n + 1 < NCH) { gdn_put_kt(nxt, KT + ((n + 1) & 1) * 128 * 72); cur = nxt; }
    __syncthreads();
  }
  __builtin_amdgcn_s_setprio(0);
}
DI void job_gpost1(const Params& p, int layer, int r) {
  const int lane = otid() & 63;
  bf16_t* P = (bf16_t*)(p.ws + OFF_P) + (size_t)r * LDP;
  const bf16_t* OB = (const bf16_t*)(p.ws + OFF_OB) + (size_t)r * 512;
  const u32x4 of = *(const u32x4*)(P + C_DAV + lane * 8), ob = *(const u32x4*)(OB + lane * 8), z = *(const u32x4*)(P + C_GZ + lane * 8);
  float o[8], zz[8], ss = 0.f;
#pragma unroll
  for (int e = 0; e < 4; ++e) {
    o[2 * e] = bflo(of[e]) + bflo(ob[e]); o[2 * e + 1] = bfhi(of[e]) + bfhi(ob[e]);
    zz[2 * e] = bflo(z[e]); zz[2 * e + 1] = bfhi(z[e]);
  }
#pragma unroll
  for (int e = 0; e < 8; ++e) ss += o[e] * o[e];
  ss += shx<1>(ss); ss += shx<2>(ss); ss += shx<4>(ss); ss += shx<8>(ss);
  const float rstd = rsqrtf(ss * (1.f / 128.f) + EPS);
  const float* gn = p.gng + layer * 128 + (lane & 15) * 8;
  float y[8];
#pragma unroll
  for (int e = 0; e < 8; ++e) y[e] = o[e] * rstd * gn[e] * (zz[e] * sigm(zz[e]));
  *(u32x4*)(P + C_GZ + lane * 8) = (u32x4){pk2(y[0], y[1]), pk2(y[2], y[3]), pk2(y[4], y[5]), pk2(y[6], y[7])};
}

DI void job_gpost(const Params& p, int layer, int it) {
  const int wid = otid() >> 6;
#pragma unroll
  for (int rr = 0; rr < 2; ++rr) job_gpost1(p, layer, it * 8 + rr * 4 + wid);
}
#ifdef SK_JL1
#define JL1(x)
#else
#define JL1(x) x
#endif
#ifdef SK_JGC
#define JGC(x)
#else
#define JGC(x) x
#endif
#ifdef SK_JVT
#define JVT(x)
#else
#define JVT(x) x
#endif
#ifdef SK_JDP
#define JDP(x)
#else
#define JDP(x) x
#endif
#ifdef SK_JGP
#define JGP(x)
#else
#define JGP(x) x
#endif
#ifdef SK_JL3
#define JL3(x)
#else
#define JL3(x) x
#endif
#ifdef SK_JGS
#define JGS(x)
#else
#define JGS(x) x
#endif
#ifdef SK_JAT
#define JAT(x)
#else
#define JAT(x) x
#endif
#define LAS __attribute__((address_space(3)))
#define XB_TMO      128
#define XB_XCNT(j)  (256  + 64 * (j))
#define XB_XSUB(j)  (1280 + 64 * (j))
#define XB_XGEN(j)  (2304 + 64 * (j))
#define XB_TOP      3328
#define XB_TOPGEN   3392
#define XCD_BAR_WORDS 3456
#define XB_SPIN_CAP (1u << 18)

__device__ __forceinline__ unsigned xb_ld(unsigned* p)              { return __hip_atomic_load(p, __ATOMIC_RELAXED, __HIP_MEMORY_SCOPE_AGENT); }
__device__ __forceinline__ unsigned xb_add(unsigned* p, unsigned v) { return __hip_atomic_fetch_add(p, v, __ATOMIC_RELAXED, __HIP_MEMORY_SCOPE_AGENT); }
__device__ __forceinline__ unsigned xb_xcc_id() { return (unsigned)__builtin_amdgcn_s_getreg((3 << 11) | 20) & 0xFu; }
#define XB_SPIN(cond, bar) do { unsigned _sp = 0; while (cond) { __builtin_amdgcn_s_sleep(1); \
    if ((++_sp & 255u) == 0u) { if (xb_ld(&(bar)[XB_TMO])) break; if (_sp > XB_SPIN_CAP) { atomicAdd(&(bar)[XB_TMO], 1u); break; } } } } while (0)

struct XcdBarrier {
    unsigned* bar; unsigned x;
    volatile LAS unsigned* st;
};

__device__ __forceinline__ XcdBarrier xcd_barrier_post(unsigned* bar, volatile LAS unsigned* st) {
    XcdBarrier b; b.bar = bar; b.x = xb_xcc_id(); b.st = st;
    if (threadIdx.x == 0) (void)xb_add(&bar[XB_XCNT(b.x)], 1u);
    return b;
}
__device__ __forceinline__ void xcd_barrier_complete(unsigned* bar, unsigned x, unsigned& nloc, unsigned& nx) {
    const unsigned G = gridDim.x * gridDim.y * gridDim.z;
    unsigned sum, cnt, mine, sp = 0u;
    for (;;) {
        sum = 0u; cnt = 0u; mine = 0u;
#pragma unroll
        for (unsigned j = 0; j < 16; ++j) { const unsigned c = xb_ld(&bar[XB_XCNT(j)]); sum += c; cnt += (c > 0u) ? 1u : 0u; mine = (j == x) ? c : mine; }
        if (sum == G) break;
        __builtin_amdgcn_s_sleep(1);
        if ((++sp & 255u) == 0u) { if (xb_ld(&bar[XB_TMO])) break; if (sp > XB_SPIN_CAP) { atomicAdd(&bar[XB_TMO], 1u); break; } }
    }
    nloc = mine > 0u ? mine : 1u; nx = cnt > 0u ? cnt : 1u;
}

__device__ __forceinline__ void xcd_barrier(const XcdBarrier& b) {
    asm volatile("s_waitcnt vmcnt(0)" ::: "memory");
    __syncthreads();
    if (threadIdx.x == 0) {
        unsigned* bar = b.bar; unsigned bx_ = b.x;
        asm volatile("" : "+s"(bar), "+s"(bx_));
        __builtin_amdgcn_s_waitcnt(0);
        unsigned nloc = b.st[0], nx = b.st[1];
        if (nloc == 0u) { xcd_barrier_complete(bar, bx_, nloc, nx); b.st[0] = nloc; b.st[1] = nx; }
        const unsigned old = xb_add(&bar[XB_XSUB(bx_)], 1u);
        const unsigned gen = old / nloc;
        if (old + 1u == (gen + 1u) * nloc) {
            __builtin_amdgcn_fence(__ATOMIC_RELEASE, "agent");
            asm volatile("s_waitcnt vmcnt(0)" ::: "memory");
            const unsigned og = xb_add(&bar[XB_TOP], 1u);
            const unsigned tg = og / nx;
            if (og + 1u == (tg + 1u) * nx) xb_add(&bar[XB_TOPGEN], 1u);
            else XB_SPIN(xb_ld(&bar[XB_TOPGEN]) == tg, bar);
            __builtin_amdgcn_fence(__ATOMIC_ACQUIRE, "agent");
            xb_add(&bar[XB_XGEN(bx_)], 1u);
            asm volatile("s_waitcnt vmcnt(0)" ::: "memory");
        } else {
            XB_SPIN(xb_ld(&bar[XB_XGEN(bx_)]) == gen, bar);
            __builtin_amdgcn_fence(__ATOMIC_ACQUIRE, "agent");
            asm volatile("s_waitcnt vmcnt(0)" ::: "memory");
        }
    }
    __syncthreads();
}


#define PH_BEGIN(k) for (int rep_ = 0, nrep_ = 1 + (((p.probe >> (k)) & 1) | ((k) == 5 ? ((p.probe >> 12) | (p.probe >> 13)) & 1 : 0)); rep_ < nrep_; ++rep_) { const bool dup = rep_ > 0; (void)dup;
#define PH_END xcd_barrier(xb_); }
#ifndef PROBE_MASK
#define PROBE_MASK 0
#endif
__global__ void __launch_bounds__(256, 2) mega(Params p) {
  __shared__ __attribute__((aligned(16))) char lds[LDS_BYTES];
  __shared__ int s_item;
  __shared__ unsigned xb_st[2];
  if (otid() == 0) { xb_st[0] = 0u; xb_st[1] = 0u; }
  __syncthreads();
  const XcdBarrier xb_ = xcd_barrier_post((unsigned*)(p.ws + OFF_CTR) + 64, (volatile LAS unsigned*)xb_st);
  cg::grid_group grid = cg::this_grid();
  const int G = gridDim.x, B = blockIdx.x;
  bf16_t* P = (bf16_t*)(p.ws + OFF_P);
  bf16_t* H = (bf16_t*)(p.ws + OFF_H);
  for (int it = B; it < 192 + 1024 + N_CVT; it += G) {
    if (it < 192) job_mod(p, it, lds);
    else if (it < 1216) job_rope(p, it - 192);
    else job_cvt(p, 0, it - 1216, lds);
  }
  if (p.probe < 0) grid.sync();
  xcd_barrier(xb_);
#pragma unroll 1
  for (int layer = 0; layer < 2; ++layer) {
    bf16_t* MG = (bf16_t*)(p.ws + OFF_VT);
    bf16_t* HID = P;
    PH_BEGIN(1)
    {
      const int n1 = layer == 1 ? N_CVT : 0;
      for (int it = B; it < n1 + MR / 8; it += G) { if (it < n1) job_cvt(p, 1, it, lds); else job_norm(p, layer, 1, it - n1); }
    }
    PH_END
    PH_BEGIN(2)
    {
      bf16_t* HALO = (bf16_t*)(p.ws + OFF_HALO);
      float* GBA = (float*)(p.ws + OFF_GBA);
      gemm_phase(H, 32, MR * 32, (const bf16_t*)(p.ws + OFF_WIN), 32, 7808 * 32, 1024, 132, 37, lds, B, G, [&](int row, int col, f32x4 v) {
        if (col < C_GBA) {
          const u32x2 w = {pk2(v[0], v[1]), pk2(v[2], v[3])};
          *(u32x2*)(P + (size_t)row * LDP + col) = w;
          if (col >= C_GQKV && col < C_GZ) {
            const int sm = row & 63;
            if (sm <= 1 || sm == 63) *(u32x2*)(HALO + ((size_t)(row >> 6) * 3 + (sm == 63 ? 2 : sm)) * 1536 + (col - C_GQKV)) = w;
          }
        } else if (col < C_GBA + 16) {
          *(f32x4*)(GBA + (size_t)row * 16 + (col - C_GBA)) = v;
        }
      }, [&](int row, int col, f32x4 v0, f32x4 v1) {
        if (col < C_GBA) {
          const u32x4 w = (u32x4){pk2(v0[0], v0[1]), pk2(v0[2], v0[3]), pk2(v1[0], v1[1]), pk2(v1[2], v1[3])};
          __builtin_nontemporal_store(w, (u32x4*)(P + (size_t)row * LDP + col));
          if (col >= C_GQKV && col < C_GZ) {
            const int sm = row & 63;
            if (sm <= 1 || sm == 63) *(u32x4*)(HALO + ((size_t)(row >> 6) * 3 + (sm == 63 ? 2 : sm)) * 1536 + (col - C_GQKV)) = w;
          }
        } else if (col < C_GBA + 16) {
          *(f32x4*)(GBA + (size_t)row * 16 + (col - C_GBA)) = v0;
          *(f32x4*)(GBA + (size_t)row * 16 + (col - C_GBA) + 4) = v1;
        }
      });
    }
    PH_END
    PH_BEGIN(3)
    {
      const int nA = 8 * NCH * 4, nB = nA + 6336, nC = nB + 2112, nD = nC + MR / 8;
      for (int it = B; it < nD; it += G) {
        if (it < nA) JL1(job_lru<1>(p, layer, it, lds, dup));
        else if (it < nB) JGC(job_gconv(p, layer, it - nA, dup));
        else if (it < nC) JVT(job_vt(p, it - nB, lds));
        else JDP(job_daprep(p, layer, it - nC, dup));
      }
    }
    PH_END
    PH_BEGIN(4)
    for (int it = B; it < 2112; it += G) JGP(job_gprep(p, layer, it, lds));
    PH_END
    PH_BEGIN(5)
    {
      for (;;) {
        const int x = blockIdx.x & 7;
        if (otid() == 0) s_item = (int)__hip_atomic_fetch_add((unsigned*)(p.ws + OFF_CTR) + ((layer * 2 + rep_) * 8 + x), 1u, __ATOMIC_RELAXED, __HIP_MEMORY_SCOPE_AGENT);
        __syncthreads();
        const int j = __builtin_amdgcn_readfirstlane(s_item);
        __syncthreads();
        if (j >= 16 + 132 + 528) break;
        if (j < 16) { if (!(dup && ((p.probe >> 12) & 1))) JGS(job_gscan(p, j * 8 + x, lds)); }
        else if (j < 148) {
          const int k = j - 16, grp = k / 66, qq = k % 66, qb = qq < 64 ? qq + 2 : qq - 64;
          if (!(dup && ((p.probe >> 13) & 1))) JAT(job_attn(p, layer, grp * 528 + qb * 8 + x, lds, dup));
        } else { if (!(dup && (((p.probe >> 12) | (p.probe >> 13)) & 1))) JL3(job_lru<3>(p, layer, (j - 148) * 8 + x, lds, dup)); }
      }
    }
    PH_END
    PH_BEGIN(6)
    for (int it = B; it < MR / 8 + MR / 8; it += G) { if (it < MR / 8) job_gpost(p, layer, it); else job_norm(p, layer, 1, it - MR / 8); }
    PH_END
    PH_BEGIN(7)
    gemm_phase(H, 32, MR * 32, (const bf16_t*)(p.ws + OFF_WIN) + (size_t)4736 * 32, 32, 7808 * 32, 1024, 132, 24, lds, B, G, [&](int row, int col, f32x4 v) {
      *(u32x2*)(P + (size_t)row * LDP + sg_col(col)) = (u32x2){pk2(sigm(v[0]), sigm(v[1])), pk2(sigm(v[2]), sigm(v[3]))};
    }, [&](int row, int col, f32x4 v0, f32x4 v1) {
      *(u32x4*)(P + (size_t)row * LDP + sg_col(col)) = (u32x4){pk2(sigm(v0[0]), sigm(v0[1])), pk2(sigm(v0[2]), sigm(v0[3])), pk2(sigm(v1[0]), sigm(v1[1])), pk2(sigm(v1[2]), sigm(v1[3]))};
    }, layer == 1);
    PH_END
    PH_BEGIN(14)
    {
      const bf16_t* WBR = (const bf16_t*)(p.ws + OFF_WBR);
      const int nm14 = layer == 1 ? 256 : 264;
      for (int t = B; t < nm14 * 8; t += G) {
        int mi, ni; tile_mn(t, nm14, 8, mi, ni);
        if (layer == 1) mi += 2 * (mi >> 6) + 2;
        f32x4 mg[4][4]; zero_acc<4>(mg);
#pragma unroll 1
        for (int i = 0; i < 3; ++i) {
          f32x4 ay[4][4]; zero_acc<4>(ay);
          const int coff = i == 0 ? C_DAQ : (i == 1 ? C_LY : C_GZ);
          gemm_core<4>(P + (size_t)mi * 128 * LDP + coff, LDP, 32, WBR + (size_t)i * 1024 * 512 + (size_t)(ni * 128) * 32, 32, 1024 * 32, 512, ay, lds);
          const int lane = otid() & 63, wid = otid() >> 6, wr = wid >> 1, wc = wid & 1;
#pragma unroll
          for (int a2 = 0; a2 < 4; ++a2)
#pragma unroll
            for (int b2 = 0; b2 < 4; ++b2) {
              const int row = mi * 128 + wr * 64 + a2 * 16 + (lane & 15), col = ni * 128 + wc * 64 + b2 * 16 + (lane >> 4) * 4;
              const u32x2 sg = *(const u32x2*)(P + (size_t)row * LDP + sg_col(i * 1024 + col));
              mg[a2][b2] += (f32x4){bflo(sg.x), bfhi(sg.x), bflo(sg.y), bfhi(sg.y)} * ay[a2][b2];
            }
        }
        gemm_emit<4>(mg, mi * 128, ni * 128, [&](int row, int col, f32x4 v) { *(u32x2*)(MG + ((size_t)(col >> 5) * MR + row) * 32 + (col & 31)) = (u32x2){pk2(v[0], v[1]), pk2(v[2], v[3])}; });
      }
    }
    PH_END
    PH_BEGIN(8)
    gemm_phase(MG, 32, MR * 32, (const bf16_t*)(p.ws + OFF_WO), 32, 1024 * 32, 1024, 132, 8, lds, B, G, [&](int row, int col, f32x4 v) {
      const f32x4 xin = *(const f32x4*)(res_in_row(p, layer, row) + col);
      const f32x4 g1 = *(const f32x4*)(mod_vec(p, layer, row) + 2048 + col);
      if (!dup) *(f32x4*)(res_out_row(p, row) + col) = xin + g1 * v;
    }, [&](int row, int col, f32x4 v0, f32x4 v1) {
      const float* xi = res_in_row(p, layer, row) + col;
      const float* gm = mod_vec(p, layer, row) + 2048 + col;
      float* xo = res_out_row(p, row) + col;
      const f32x4 o0 = __builtin_nontemporal_load((const f32x4*)xi) + *(const f32x4*)gm * v0, o1 = __builtin_nontemporal_load((const f32x4*)(xi + 4)) + *(const f32x4*)(gm + 4) * v1;
      if (!dup) { *(f32x4*)xo = o0; *(f32x4*)(xo + 4) = o1; }
    }, layer == 1);
    PH_END
    PH_BEGIN(9)
    for (int it = B; it < MR / 8; it += G) job_norm(p, layer, 2, it);
    PH_END
    PH_BEGIN(10)
    gemm_phase(H, 32, MR * 32, (const bf16_t*)(p.ws + OFF_W1), 32, 4096 * 32, 1024, 132, 32, lds, B, G, [&](int row, int col, f32x4 v) {
      float r[4];
#pragma unroll
      for (int e = 0; e < 4; ++e) { const float q = fmaxf(v[e], 0.f); r[e] = q * q; }
      *(u32x2*)(HID + ((size_t)(col >> 5) * MR + row) * 32 + (col & 31)) = (u32x2){pk2(r[0], r[1]), pk2(r[2], r[3])};
    }, [&](int row, int col, f32x4 v0, f32x4 v1) {
      float r[8];
#pragma unroll
      for (int e = 0; e < 4; ++e) { const float q0 = fmaxf(v0[e], 0.f), q1 = fmaxf(v1[e], 0.f); r[e] = q0 * q0; r[4 + e] = q1 * q1; }
      __builtin_nontemporal_store(((u32x4){pk2(r[0], r[1]), pk2(r[2], r[3]), pk2(r[4], r[5]), pk2(r[6], r[7])}), (u32x4*)(HID + ((size_t)(col >> 5) * MR + row) * 32 + (col & 31)));
    }, layer == 1);
    PH_END
    PH_BEGIN(11)
    gemm_phase(HID, 32, MR * 32, (const bf16_t*)(p.ws + OFF_W2), 32, 1024 * 32, 4096, 132, 8, lds, B, G, [&](int row, int col, f32x4 v) {
      float* xo = res_out_row(p, row) + col;
      const f32x4 g2 = *(const f32x4*)(mod_vec(p, layer, row) + 5120 + col);
      if (!dup) *(f32x4*)xo = *(const f32x4*)xo + g2 * v;
    }, [&](int row, int col, f32x4 v0, f32x4 v1) {
      float* xo = res_out_row(p, row) + col;
      const float* gm = mod_vec(p, layer, row) + 5120 + col;
      const f32x4 o0 = __builtin_nontemporal_load((const f32x4*)xo) + *(const f32x4*)gm * v0, o1 = __builtin_nontemporal_load((const f32x4*)(xo + 4)) + *(const f32x4*)(gm + 4) * v1;
      if (!dup) { *(f32x4*)xo = o0; *(f32x4*)(xo + 4) = o1; }
    }, layer == 1);
    PH_END
  }
}

extern "C" void kernel_launch(void* const* d_in, const int* in_sizes, int n_in, void* d_out, int out_size, void* d_ws, size_t ws_size, hipStream_t stream) {
  static int grid_blocks = 0;
  if (!grid_blocks) {
    int dev = 0, cus = 0, per_cu = 0;
    hipGetDevice(&dev);
    hipDeviceGetAttribute(&cus, hipDeviceAttributeMultiprocessorCount, dev);
    hipOccupancyMaxActiveBlocksPerMultiprocessor(&per_cu, mega, 256, 0);
    if (per_cu > 2) per_cu = 2;
    grid_blocks = cus * per_cu;
    grid_blocks -= grid_blocks % 8;
  }
  Params p{};
  const float** f = (const float**)&p;
  for (int i = 0; i < 26; ++i) f[i] = (const float*)d_in[i];
  p.out = (float*)d_out;
  p.ws = (char*)d_ws;
  p.probe = PROBE_MASK;
  if (ws_size < WS_TOTAL) { fprintf(stderr, "workspace too small: %zu < %zu\n", ws_size, (size_t)WS_TOTAL); return; }
  hipMemsetAsync((char*)d_ws + OFF_CTR, 0, 256 + 16384, stream);
  void* args[] = {&p};
  hipError_t e = hipLaunchCooperativeKernel((void*)mega, dim3(grid_blocks), dim3(256), args, 0, stream);
  if (e != hipSuccess) fprintf(stderr, "cooperative launch failed: %s (grid %d)\n", hipGetErrorString(e), grid_blocks);
}
```

```cpp
#include <hip/hip_runtime.h>
#include <hip/hip_cooperative_groups.h>
#include <cstdint>
#include <cstdio>
namespace cg = cooperative_groups;

#define DI __device__ __forceinline__
typedef unsigned short bf16_t;
typedef short bf16x8 __attribute__((ext_vector_type(8)));
typedef float f32x4 __attribute__((ext_vector_type(4)));
typedef float f32x2 __attribute__((ext_vector_type(2)));
typedef unsigned u32x4 __attribute__((ext_vector_type(4)));
typedef unsigned u32x2 __attribute__((ext_vector_type(2)));
typedef __bf16 bf16x2_t __attribute__((ext_vector_type(2)));

constexpr int DM = 1024, NB = 4, TL = 8192, TC = 256, TT = 8448, MR = NB * TT;
constexpr int LDP = 4736;
constexpr int C_DAQ = 0, C_DAK = 512, C_DAV = 1024, C_LX = 1536, C_LY = 2048, C_GQKV = 2560, C_GZ = 4096, C_GBA = 4608;
constexpr int NCH = 132;
constexpr float EPS = 1e-6f;
constexpr int LDS_BYTES = 77824;

constexpr size_t al256(size_t x) { return (x + 255) & ~(size_t)255; }
constexpr size_t OFF_WIN = 0;
constexpr size_t OFF_WBR = OFF_WIN + al256((size_t)7808 * 1024 * 2);
constexpr size_t OFF_WO = OFF_WBR + al256((size_t)3 * 1024 * 512 * 2);
constexpr size_t OFF_W1 = OFF_WO + al256((size_t)1024 * 1024 * 2);
constexpr size_t OFF_W2 = OFF_W1 + al256((size_t)4096 * 1024 * 2);
constexpr size_t OFF_LG = OFF_W2 + al256((size_t)4096 * 1024 * 2);
constexpr size_t OFF_P = OFF_LG + al256((size_t)32 * 4096 * 2);
constexpr size_t OFF_H = OFF_P + al256((size_t)MR * LDP * 2);
constexpr size_t OFF_VT = OFF_H + al256((size_t)MR * 1024 * 2);
constexpr size_t OFF_OB = OFF_VT + al256((size_t)MR * 512 * 2);
constexpr size_t OFF_HALO = OFF_OB + al256((size_t)MR * 512 * 2);
constexpr size_t OFF_GBA = OFF_HALO + al256((size_t)528 * 3 * 1536 * 2);
constexpr size_t OFF_GSC = OFF_GBA + al256((size_t)MR * 16 * 4);
constexpr size_t OFF_LC = OFF_GSC + al256((size_t)4224 * 192 * 4);
constexpr size_t OFF_CTX = OFF_LC + al256((size_t)4 * NCH * 8 * 2 * 64 * 8);
constexpr size_t OFF_MOD = OFF_CTX + al256((size_t)4 * 256 * 1024 * 4);
constexpr size_t OFF_ROPE = OFF_MOD + al256((size_t)2 * 5 * 6144 * 4);
constexpr size_t OFF_CTR = OFF_ROPE + al256((size_t)8192 * 32 * 8);
constexpr size_t WS_TOTAL = OFF_CTR + 256 + 16384;
static_assert(WS_TOTAL <= (size_t)536870912, "workspace map too large");

struct Params {
  const float *x, *c, *ctx, *cctx, *ada_w, *ada_b, *n1g, *n2g, *w_in, *daqg, *dakg, *dalam, *dasub, *lcw, *lcb, *lgw, *lgb, *llam,
      *gcw, *galog, *gdtb, *gng, *wbr, *wout, *w1, *w2;
  float* out;
  char* ws;
  int probe;
  int pad_;
};

DI unsigned pk2(float lo, float hi) { f32x2 v = {lo, hi}; bf16x2_t b = __builtin_convertvector(v, bf16x2_t); return __builtin_bit_cast(unsigned, b); }
DI bf16_t f2bf(float f) { return (bf16_t)(pk2(f, 0.f) & 0xffffu); }
DI float bf2f(bf16_t u) { return __uint_as_float(((unsigned)u) << 16); }
DI float bflo(unsigned w) { return __uint_as_float(w << 16); }
DI float bfhi(unsigned w) { return __uint_as_float(w & 0xffff0000u); }
DI int otid() { int t = __builtin_amdgcn_workitem_id_x(); asm volatile("" : "+v"(t)); return t; }
template <int M> DI float shx(float v) { return __int_as_float(__builtin_amdgcn_ds_swizzle(__float_as_int(v), (M << 10) | 0x1f)); }
DI float add32(float v) { auto r = __builtin_amdgcn_permlane32_swap(__float_as_uint(v), __float_as_uint(v), false, false); return __uint_as_float(r[0]) + __uint_as_float(r[1]); }
DI float max32(float v) { auto r = __builtin_amdgcn_permlane32_swap(__float_as_uint(v), __float_as_uint(v), false, false); return fmaxf(__uint_as_float(r[0]), __uint_as_float(r[1])); }
DI float wsum(float v) { v += shx<1>(v); v += shx<2>(v); v += shx<4>(v); v += shx<8>(v); v += shx<16>(v); return add32(v); }
DI float wmax(float v) { v = fmaxf(v, shx<1>(v)); v = fmaxf(v, shx<2>(v)); v = fmaxf(v, shx<4>(v)); v = fmaxf(v, shx<8>(v)); v = fmaxf(v, shx<16>(v)); return max32(v); }
DI float sigm(float x) { return 1.f / (1.f + __expf(-x)); }
DI float softplusf(float x) { return x > 20.f ? x : log1pf(expf(x)); }
DI f32x4 mfma16(bf16x8 a, bf16x8 b, f32x4 c) { return __builtin_amdgcn_mfma_f32_16x16x32_bf16(a, b, c, 0, 0, 0); }

DI const float* res_in_row(const Params& p, int layer, int r) {
  const int b = r / TT, s = r % TT;
  if (layer == 0) return s < TC ? p.ctx + ((size_t)b * TC + s) * DM : p.x + ((size_t)b * TL + (s - TC)) * DM;
  return s < TC ? (const float*)(p.ws + OFF_CTX) + ((size_t)b * TC + s) * DM : p.out + ((size_t)b * TL + (s - TC)) * DM;
}
DI float* res_out_row(const Params& p, int r) {
  const int b = r / TT, s = r % TT;
  return s < TC ? (float*)(p.ws + OFF_CTX) + ((size_t)b * TC + s) * DM : p.out + ((size_t)b * TL + (s - TC)) * DM;
}
DI const float* mod_vec(const Params& p, int layer, int r) {
  const int b = r / TT, s = r % TT;
  return (const float*)(p.ws + OFF_MOD) + (size_t)(layer * 5 + (s < TC ? 4 : b)) * 6144;
}

template <int WN>
DI void gemm_core(const bf16_t* __restrict__ A, int lda, int a_ks, const bf16_t* __restrict__ Bt, int ldb, int b_ks, int K, f32x4 (&acc)[4][WN], char* lds) {
  constexpr int BN = 32 * WN, AST = 72, NBP = BN * 8 / 256;
  bf16_t* As = (bf16_t*)lds;
  bf16_t* Bs = As + 2 * 128 * AST;
  const int tid = otid(), lane = tid & 63, wid = tid >> 6, wr = wid >> 1, wc = wid & 1;
  u32x4 ra[4], rb[NBP];
  const int nk = K / 64;
#define GLOAD(k0)                                                                                                            \
  {                                                                                                                          \
    _Pragma("unroll") for (int i = 0; i < 4; ++i) { const int q = tid + 256 * i; ra[i] = *(const u32x4*)(A + (size_t)(q >> 3) * lda + (size_t)(((k0) >> 5) + ((q & 7) >> 2)) * a_ks + (q & 3) * 8); } \
    _Pragma("unroll") for (int i = 0; i < NBP; ++i) { const int q = tid + 256 * i; rb[i] = *(const u32x4*)(Bt + (size_t)(q >> 3) * ldb + (size_t)(((k0) >> 5) + ((q & 7) >> 2)) * b_ks + (q & 3) * 8); } \
  }
#define SSTORE(buf)                                                                                                          \
  {                                                                                                                          \
    _Pragma("unroll") for (int i = 0; i < 4; ++i) { const int q = tid + 256 * i; *(u32x4*)(As + ((buf) * 128 + (q >> 3)) * AST + (q & 7) * 8) = ra[i]; } \
    _Pragma("unroll") for (int i = 0; i < NBP; ++i) { const int q = tid + 256 * i; *(u32x4*)(Bs + ((buf) * BN + (q >> 3)) * AST + (q & 7) * 8) = rb[i]; } \
  }
  GLOAD(0);
  SSTORE(0);
  __syncthreads();
  for (int t = 0; t < nk; ++t) {
    if (t + 1 < nk) GLOAD((t + 1) * 64);
    const bf16_t* a = As + ((t & 1) * 128 + wr * 64 + (lane & 15)) * AST + (lane >> 4) * 8;
    const bf16_t* b = Bs + ((t & 1) * BN + wc * 16 * WN + (lane & 15)) * AST + (lane >> 4) * 8;
#pragma unroll
    for (int ks = 0; ks < 2; ++ks) {
      bf16x8 af[4], bfr[WN];
#pragma unroll
      for (int i = 0; i < 4; ++i) af[i] = *(const bf16x8*)(a + i * 16 * AST + ks * 32);
#pragma unroll
      for (int j = 0; j < WN; ++j) bfr[j] = *(const bf16x8*)(b + j * 16 * AST + ks * 32);
      __builtin_amdgcn_sched_barrier(0);
#pragma unroll
      for (int i = 0; i < 4; ++i)
#pragma unroll
        for (int j = 0; j < WN; ++j) acc[i][j] = mfma16(bfr[j], af[i], acc[i][j]);
      __builtin_amdgcn_sched_barrier(0);
    }
    if (t + 1 < nk) SSTORE((t + 1) & 1);
    __syncthreads();
  }
#undef GLOAD
#undef SSTORE
}
DI void tile_mn(int t, int nm, int nn, int& mi, int& ni) {
  const int nig = 16 * nn, g = t / nig, rem = t % nig, fm = g * 16;
  const int gsz = (nm - fm) < 16 ? (nm - fm) : 16;
  mi = fm + rem % gsz;
  ni = rem / gsz;
}
template <int WN, class Epi>
DI void gemm_emit(const f32x4 (&acc)[4][WN], int m0, int n0, Epi epi) {
  const int lane = otid() & 63, wid = otid() >> 6, wr = wid >> 1, wc = wid & 1;
#pragma unroll
  for (int i = 0; i < 4; ++i)
#pragma unroll
    for (int j = 0; j < WN; ++j) epi(m0 + wr * 64 + i * 16 + (lane & 15), n0 + wc * 16 * WN + j * 16 + (lane >> 4) * 4, acc[i][j]);
}
template <int WN>
DI void zero_acc(f32x4 (&acc)[4][WN]) {
#pragma unroll
  for (int i = 0; i < 4; ++i)
#pragma unroll
    for (int j = 0; j < WN; ++j) acc[i][j] = (f32x4){0.f, 0.f, 0.f, 0.f};
}

DI void gemm_core2(const bf16_t* __restrict__ A, int lda, int a_ks, const bf16_t* __restrict__ Bt, int ldb, int b_ks, int K, f32x4 (&acc)[8][4], char* lds) {
  constexpr int AST = 48;
  bf16_t* As = (bf16_t*)lds;
  bf16_t* Bs = As + 2 * 256 * AST;
  const int tid = otid(), lane = tid & 63, wid = tid >> 6, wr = wid >> 1, wc = wid & 1;
  u32x4 s0a[4], s0b[2], s1a[4], s1b[2];
  const int nk = K / 32;
  const bf16_t* ag = A + (size_t)(tid >> 2) * lda + (tid & 3) * 8;
  const bf16_t* bg = Bt + (size_t)(tid >> 2) * ldb + (tid & 3) * 8;
  const int bc_ = tid >> 2, brow = ((bc_ >> 5) * 2 + ((bc_ >> 2) & 1)) * 16 + ((bc_ >> 3) & 3) * 4 + (bc_ & 3);
#define LBAR() { asm volatile("s_waitcnt lgkmcnt(0)" ::: "memory"); __builtin_amdgcn_s_barrier(); asm volatile("" ::: "memory"); }
#define GLOAD2(ra, rb, k0)                                                                                                   \
  {                                                                                                                          \
    _Pragma("unroll") for (int i = 0; i < 4; ++i) ra[i] = *(const u32x4*)(ag + (size_t)(64 * i) * lda + (size_t)((k0) >> 5) * a_ks);               \
    _Pragma("unroll") for (int i = 0; i < 2; ++i) rb[i] = *(const u32x4*)(bg + (size_t)(64 * i) * ldb + (size_t)((k0) >> 5) * b_ks);               \
  }
#define SSTORE2(ra, rb, buf)                                                                                                 \
  {                                                                                                                          \
    _Pragma("unroll") for (int i = 0; i < 4; ++i) *(u32x4*)(As + ((buf) * 256 + 64 * i + (tid >> 2)) * AST + (tid & 3) * 8) = ra[i]; \
    _Pragma("unroll") for (int i = 0; i < 2; ++i) *(u32x4*)(Bs + ((buf) * 128 + 64 * i + brow) * AST + (tid & 3) * 8) = rb[i]; \
  }
#define STEP2(t, la, lb, sa, sb)                                                                                             \
  {                                                                                                                          \
    if ((t) + 2 < nk) GLOAD2(la, lb, ((t) + 2) * 32);                                                                        \
    const bf16_t* a = As + (((t) & 1) * 256 + wr * 128 + (lane & 15)) * AST + (lane >> 4) * 8;                               \
    const bf16_t* b = Bs + (((t) & 1) * 128 + wc * 64 + (lane & 15)) * AST + (lane >> 4) * 8;                                \
    bf16x8 bfr[4], a0[4], a1[4];                                                                                             \
    _Pragma("unroll") for (int j = 0; j < 4; ++j) bfr[j] = *(const bf16x8*)(b + j * 16 * AST);                               \
    _Pragma("unroll") for (int i = 0; i < 4; ++i) a0[i] = *(const bf16x8*)(a + i * 16 * AST);                                \
    __builtin_amdgcn_sched_barrier(0);                                                                                       \
    _Pragma("unroll") for (int i = 0; i < 4; ++i) a1[i] = *(const bf16x8*)(a + (4 + i) * 16 * AST);                          \
    __builtin_amdgcn_sched_barrier(0);                                                                                       \
    _Pragma("unroll") for (int i = 0; i < 4; ++i) _Pragma("unroll") for (int j = 0; j < 4; ++j) acc[i][j] = mfma16(bfr[j], a0[i], acc[i][j]); \
    __builtin_amdgcn_sched_barrier(0);                                                                                       \
    _Pragma("unroll") for (int i = 0; i < 4; ++i) _Pragma("unroll") for (int j = 0; j < 4; ++j) acc[4 + i][j] = mfma16(bfr[j], a1[i], acc[4 + i][j]); \
    __builtin_amdgcn_sched_barrier(0);                                                                                       \
    if ((t) + 1 < nk) SSTORE2(sa, sb, ((t) + 1) & 1);                                                                        \
    LBAR();                                                                                                                  \
  }
  GLOAD2(s0a, s0b, 0);
  SSTORE2(s0a, s0b, 0);
  GLOAD2(s1a, s1b, 32);
  LBAR();
  int t = 0;
  for (;;) {
    STEP2(t, s0a, s0b, s1a, s1b);
    if (++t >= nk) break;
    STEP2(t, s1a, s1b, s0a, s0b);
    if (++t >= nk) break;
  }
#undef GLOAD2
#undef SSTORE2
#undef STEP2
}
DI void tile_mn8(int t, int nm, int nn, int& mi, int& ni) {
  const int nig = 8 * nn, g = t / nig, rem = t % nig, fm = g * 8;
  const int gsz = (nm - fm) < 8 ? (nm - fm) : 8;
  mi = fm + rem % gsz;
  ni = rem / gsz;
}
template <class Epi, class Epi8>
DI void gemm_phase(const bf16_t* A, int lda, int a_ks, const bf16_t* Bt, int ldb, int b_ks, int K, int nm, int nn, char* lds, int B, int G, Epi epi, Epi8 epi8, bool skipctx = false) {
  if (skipctx) nm -= 4;
  const int NT = nm * nn;
  int nfull = (NT / G) * G, R = NT - nfull;
  if (4 * R > 2 * G) { nfull = NT; R = 0; }
  for (int t = B; t < nfull + 4 * R; t += G) {
    int mi, ni;
    if (t < nfull) {
      tile_mn8(t, nm, nn, mi, ni);
      if (skipctx) mi += (mi >> 5) + 1;
      f32x4 acc[8][4];
#pragma unroll
      for (int i = 0; i < 8; ++i)
#pragma unroll
        for (int j = 0; j < 4; ++j) acc[i][j] = (f32x4){0.f, 0.f, 0.f, 0.f};
      gemm_core2(A + (size_t)mi * 256 * lda, lda, a_ks, Bt + (size_t)ni * 128 * ldb, ldb, b_ks, K, acc, lds);
      const int lane = otid() & 63, wid = otid() >> 6, wr = wid >> 1, wc = wid & 1;
#pragma unroll
      for (int i = 0; i < 8; ++i)
#pragma unroll
        for (int jp = 0; jp < 2; ++jp) epi8(mi * 256 + wr * 128 + i * 16 + (lane & 15), ni * 128 + wc * 64 + jp * 32 + (lane >> 4) * 8, acc[i][2 * jp], acc[i][2 * jp + 1]);
    } else {
      const int u = t - nfull, sub = u & 3;
      tile_mn8(nfull + (u >> 2), nm, nn, mi, ni);
      if (skipctx) mi += (mi >> 5) + 1;
      const int m0 = mi * 256 + (sub >> 1) * 128, n0 = ni * 128 + (sub & 1) * 64;
      f32x4 acc[4][2]; zero_acc<2>(acc);
      gemm_core<2>(A + (size_t)m0 * lda, lda, a_ks, Bt + (size_t)n0 * ldb, ldb, b_ks, K, acc, lds);
      gemm_emit<2>(acc, m0, n0, epi);
    }
  }
}
DI int sg_col(int gc) { const int j = gc >> 7; return (j < 12 ? 512 + 128 * j : 2560 + 128 * (j - 12)) + (gc & 127); }

constexpr int N_CVT = 1152 + 32 + 768 + 384 + 256 + 1024 + 1024 + 32;
DI void job_cvt(const Params& p, int layer, int t, char* lds) {
  const float* src; int ld, ncol0 = 0, nlim, K, ntot, nrow0 = 0; bf16_t* dst;
  char* ws = p.ws;
  if (t < 1152) { src = p.w_in + (size_t)layer * 1024 * 7696; ld = 7696; ncol0 = 0; nlim = 4608; dst = (bf16_t*)(ws + OFF_WIN); K = 1024; ntot = 7808; nrow0 = 0; }
  else if ((t -= 1152) < 32) { src = p.w_in + (size_t)layer * 1024 * 7696; ld = 7696; ncol0 = 4608; nlim = 4624; dst = (bf16_t*)(ws + OFF_WIN); K = 1024; ntot = 7808; nrow0 = 4608; }
  else if ((t -= 32) < 768) { src = p.w_in + (size_t)layer * 1024 * 7696; ld = 7696; ncol0 = 4624; nlim = 7696; dst = (bf16_t*)(ws + OFF_WIN); K = 1024; ntot = 7808; nrow0 = 4736; }
  else if ((t -= 768) < 384) { const int i = t / 128; t %= 128; src = p.wbr + ((size_t)layer * 3 + i) * 512 * 1024; ld = 1024; nlim = 1024; dst = (bf16_t*)(ws + OFF_WBR) + (size_t)i * 1024 * 512; K = 512; ntot = 1024; }
  else if ((t -= 384) < 256) { src = p.wout + (size_t)layer * 1024 * 1024; ld = 1024; nlim = 1024; dst = (bf16_t*)(ws + OFF_WO); K = 1024; ntot = 1024; }
  else if ((t -= 256) < 1024) { src = p.w1 + (size_t)layer * 1024 * 4096; ld = 4096; nlim = 4096; dst = (bf16_t*)(ws + OFF_W1); K = 1024; ntot = 4096; }
  else if ((t -= 1024) < 1024) { src = p.w2 + (size_t)layer * 4096 * 1024; ld = 1024; nlim = 1024; dst = (bf16_t*)(ws + OFF_W2); K = 4096; ntot = 1024; }
  else { t -= 1024; src = p.lgw + ((size_t)layer * 32 + t) * 4096; ld = 64; nlim = 64; dst = (bf16_t*)(ws + OFF_LG) + (size_t)t * 4096; K = 64; ntot = 0; t = 0; }
  const int nkt = K / 64, nt = t / nkt, kt = t % nkt;
  float* tl = (float*)lds;
  const int tid = otid();
  {
    const int nn = tid & 63, ncol = ncol0 + nt * 64 + nn;
#pragma unroll
    for (int i = 0; i < 16; ++i) {
      const int kk = i * 4 + (tid >> 6);
      tl[kk * 65 + nn] = (ncol < nlim) ? __builtin_nontemporal_load(src + (size_t)(kt * 64 + kk) * ld + ncol) : 0.f;
    }
  }
  __syncthreads();
  {
    const int n = tid >> 2, kq = tid & 3;
    float v[16];
#pragma unroll
    for (int e = 0; e < 16; ++e) v[e] = tl[(kq * 16 + e) * 65 + n];
    u32x4 w0 = {pk2(v[0], v[1]), pk2(v[2], v[3]), pk2(v[4], v[5]), pk2(v[6], v[7])};
    u32x4 w1 = {pk2(v[8], v[9]), pk2(v[10], v[11]), pk2(v[12], v[13]), pk2(v[14], v[15])};
    const int nd = nrow0 + nt * 64 + n, kd = kt * 64 + kq * 16;
    bf16_t* d = ntot ? dst + ((size_t)(kd >> 5) * ntot + nd) * 32 + (kd & 31) : dst + (size_t)nd * K + kd;
    *(u32x4*)d = w0;
    *(u32x4*)(d + 8) = w1;
  }
  __syncthreads();
}
DI void job_mod(const Params& p, int it, char* lds) {
  const int nc = it % 96, l = it / 96, tid = otid();
  float* sc = (float*)lds;
  float* red = sc + 5 * 1024;
  for (int i = tid; i < 5 * 1024; i += 256) {
    const int v = i >> 10, k = i & 1023;
    const float cv = v < 4 ? p.c[v * 1024 + k] : p.cctx[k];
    sc[i] = cv * sigm(cv);
  }
  __syncthreads();
  const int col = tid & 63, kg = tid >> 6, n = nc * 64 + col;
  const float* w = p.ada_w + ((size_t)l * 1024 + kg * 256) * 6144 + n;
  const float* s0 = sc + kg * 256;
  float a0 = 0, a1 = 0, a2 = 0, a3 = 0, a4 = 0;
#pragma unroll 8
  for (int k = 0; k < 256; ++k) {
    const float wv = __builtin_nontemporal_load(w + (size_t)k * 6144);
    a0 += s0[k] * wv; a1 += s0[1024 + k] * wv; a2 += s0[2048 + k] * wv; a3 += s0[3072 + k] * wv; a4 += s0[4096 + k] * wv;
  }
  red[(kg * 5 + 0) * 64 + col] = a0; red[(kg * 5 + 1) * 64 + col] = a1; red[(kg * 5 + 2) * 64 + col] = a2; red[(kg * 5 + 3) * 64 + col] = a3; red[(kg * 5 + 4) * 64 + col] = a4;
  __syncthreads();
  for (int i = tid; i < 320; i += 256) {
    const int v = i >> 6, cc = i & 63;
    const float r = ((red[(0 * 5 + v) * 64 + cc] + red[(1 * 5 + v) * 64 + cc]) + (red[(2 * 5 + v) * 64 + cc] + red[(3 * 5 + v) * 64 + cc])) + p.ada_b[l * 6144 + nc * 64 + cc];
    ((float*)(p.ws + OFF_MOD))[(size_t)(l * 5 + v) * 6144 + nc * 64 + cc] = r;
  }
  __syncthreads();
}
DI void job_rope(const Params& p, int it) {
  const int idx = it * 256 + otid(), t = idx >> 5, ax = (idx >> 4) & 1, f = idx & 15;
  const float inv = powf(10000.f, -(float)f / 16.f);
  const float pos = (float)(ax ? (t & 63) : (t >> 6));
  float s, c;
  sincosf(pos * inv, &s, &c);
  ((f32x2*)(p.ws + OFF_ROPE))[idx] = (f32x2){c, s};
}
DI void job_norm(const Params& p, int layer, int which, int it) {
  const int lane = otid() & 63, wid = otid() >> 6, r = it * 8 + wid;
  const float* xr0 = (which == 1) ? res_in_row(p, layer, r) : (const float*)res_out_row(p, r);
  const float* xr1 = (which == 1) ? res_in_row(p, layer, r + 4) : (const float*)res_out_row(p, r + 4);
  const float* mv = mod_vec(p, layer, r);
  const float* sh = mv + (which == 1 ? 0 : 3072);
  const float* sc = mv + (which == 1 ? 1024 : 4096);
  const float* g = (which == 1 ? p.n1g : p.n2g) + layer * 1024;
  f32x4 xa[4], xb[4];
#pragma unroll
  for (int i = 0; i < 2; ++i)
#pragma unroll
    for (int hf = 0; hf < 2; ++hf) {
      xa[2 * i + hf] = __builtin_nontemporal_load((const f32x4*)(xr0 + i * 512 + lane * 8 + hf * 4));
      xb[2 * i + hf] = __builtin_nontemporal_load((const f32x4*)(xr1 + i * 512 + lane * 8 + hf * 4));
    }
  float sa = 0.f, sb = 0.f;
#pragma unroll
  for (int i = 0; i < 4; ++i) {
    sa += xa[i][0] * xa[i][0] + xa[i][1] * xa[i][1] + xa[i][2] * xa[i][2] + xa[i][3] * xa[i][3];
    sb += xb[i][0] * xb[i][0] + xb[i][1] * xb[i][1] + xb[i][2] * xb[i][2] + xb[i][3] * xb[i][3];
  }
  sa = wsum(sa); sb = wsum(sb);
  const float ra = rsqrtf(sa * (1.f / 1024.f) + EPS), rb = rsqrtf(sb * (1.f / 1024.f) + EPS);
  bf16_t* H0 = (bf16_t*)(p.ws + OFF_H) + (size_t)r * 32;
  bf16_t* H1 = H0 + 4 * 32;
#pragma unroll
  for (int i = 0; i < 2; ++i) {
    const int c = i * 512 + lane * 8;
    float o[8], q[8];
#pragma unroll
    for (int hf = 0; hf < 2; ++hf) {
      const f32x4 gv = *(const f32x4*)(g + c + hf * 4), sv = *(const f32x4*)(sc + c + hf * 4), hv = *(const f32x4*)(sh + c + hf * 4);
#pragma unroll
      for (int e = 0; e < 4; ++e) { const float m = gv[e] * (1.f + sv[e]); o[hf * 4 + e] = xa[2 * i + hf][e] * ra * m + hv[e]; q[hf * 4 + e] = xb[2 * i + hf][e] * rb * m + hv[e]; }
    }
    const size_t so = (size_t)(c >> 5) * MR * 32 + (c & 31);
    *(u32x4*)(H0 + so) = (u32x4){pk2(o[0], o[1]), pk2(o[2], o[3]), pk2(o[4], o[5]), pk2(o[6], o[7])};
    *(u32x4*)(H1 + so) = (u32x4){pk2(q[0], q[1]), pk2(q[2], q[3]), pk2(q[4], q[5]), pk2(q[6], q[7])};
  }
}

DI void job_daprep1(const Params& p, int layer, int r, bool dup) {
  const int lane = otid() & 63, s = r % TT;
  const int G = lane >> 2, quarter = lane & 3;
  bf16_t* ptr = (bf16_t*)(p.ws + OFF_P) + (size_t)r * LDP + (G < 8 ? C_DAQ + G * 64 : C_DAK + (G - 8) * 64) + quarter * 16;
  const u32x4 w0 = *(const u32x4*)ptr, w1 = *(const u32x4*)(ptr + 8);
  float y[16];
#pragma unroll
  for (int e = 0; e < 4; ++e) { y[2 * e] = bflo(w0[e]); y[2 * e + 1] = bfhi(w0[e]); y[8 + 2 * e] = bflo(w1[e]); y[9 + 2 * e] = bfhi(w1[e]); }
  float ss = 0.f;
#pragma unroll
  for (int e = 0; e < 16; ++e) ss += y[e] * y[e];
  ss += shx<1>(ss);
  ss += shx<2>(ss);
  float rstd = rsqrtf(ss * (1.f / 64.f) + EPS);
  const float* g = (G < 8 ? p.daqg : p.dakg) + layer * 64 + quarter * 16;
#pragma unroll
  for (int e = 0; e < 16; ++e) y[e] = y[e] * rstd * g[e];
  if (s >= TC) {
    const f32x2* tb = (const f32x2*)(p.ws + OFF_ROPE) + ((size_t)(s - TC) * 2 + (quarter >> 1)) * 16;
#pragma unroll
    for (int e = 0; e < 16; ++e) {
      const float yp = shx<1>(y[e]);
      const f32x2 cs = tb[e];
      y[e] = (quarter & 1) ? (y[e] * cs.x + yp * cs.y) : (y[e] * cs.x - yp * cs.y);
    }
  }
  if (G < 8) {
#pragma unroll
    for (int e = 0; e < 16; ++e) y[e] *= 0.125f * 1.4426950408889634f;
  }
  if (dup) return;
  *(u32x4*)ptr = (u32x4){pk2(y[0], y[1]), pk2(y[2], y[3]), pk2(y[4], y[5]), pk2(y[6], y[7])};
  *(u32x4*)(ptr + 8) = (u32x4){pk2(y[8], y[9]), pk2(y[10], y[11]), pk2(y[12], y[13]), pk2(y[14], y[15])};
}
DI void job_daprep(const Params& p, int layer, int it, bool dup) {
  const int wid = otid() >> 6;
#pragma unroll
  for (int rr = 0; rr < 2; ++rr) job_daprep1(p, layer, it * 8 + rr * 4 + wid, dup);
}
DI void job_vt(const Params& p, int it, char* lds) {
  const int h = it & 3, c = (it >> 2) % NCH, b = it / (4 * NCH), tid = otid();
  bf16_t* tl = (bf16_t*)lds;
  const bf16_t* P = (const bf16_t*)(p.ws + OFF_P);
#pragma unroll
  for (int i = 0; i < 4; ++i) {
    const int q = tid + 256 * i, row = q >> 4, pc = q & 15;
    const u32x4 w = *(const u32x4*)(P + (size_t)(b * TT + c * 64 + row) * LDP + C_DAV + h * 128 + pc * 8);
    unsigned* d = (unsigned*)(tl + row * 130 + pc * 8);
    d[0] = w[0]; d[1] = w[1]; d[2] = w[2]; d[3] = w[3];
  }
  __syncthreads();
  {
    const int dv = tid >> 1, half = tid & 1;
    unsigned o[16];
#pragma unroll
    for (int e = 0; e < 16; ++e) o[e] = (unsigned)tl[(half * 32 + 2 * e) * 130 + dv] | ((unsigned)tl[(half * 32 + 2 * e + 1) * 130 + dv] << 16);
    bf16_t* d = (bf16_t*)(p.ws + OFF_VT) + ((size_t)(b * 4 + h) * 128 + dv) * TT + c * 64 + half * 32;
#pragma unroll
#define VTW(w) o[(((w) & 3) >> 1) * 8 + ((w) >> 2) * 2 + ((w) & 1)]
    for (int e = 0; e < 4; ++e) *(u32x4*)(d + e * 8) = (u32x4){VTW(4 * e), VTW(4 * e + 1), VTW(4 * e + 2), VTW(4 * e + 3)};
#undef VTW
  }
  __syncthreads();
}

constexpr int N_ATT = 1056;
DI void job_attn(const Params& p, int layer, int a, char* lds, bool dup) {
  const int tid = otid(), lane = tid & 63, wid = tid >> 6, l15 = lane & 15, g = lane >> 4;
  const int grp = a / 528, within = a % 528, bh = grp * 8 + (within & 7), qb = within >> 3, b = bh >> 2, h = bh & 3;
  if (layer == 1 && qb < 2) return;
  const int nt = qb < 2 ? 4 : NCH;
  bf16_t* P = (bf16_t*)(p.ws + OFF_P);
  const bf16_t* VT = (const bf16_t*)(p.ws + OFF_VT) + (size_t)(b * 4 + h) * 128 * TT;
  int ly_ = layer; asm volatile("" : "+s"(ly_));
  const float lam_init = __uint_as_float(ly_ == 0 ? 0x3e4ccccdu : 0x3eb60549u);
  const float* lv = p.dalam + layer * 256;
  const float lam = __uint_as_float(__builtin_amdgcn_readfirstlane(__float_as_uint(expf(wsum(lv[lane] * lv[64 + lane])) - expf(wsum(lv[128 + lane] * lv[192 + lane])) + lam_init)));
  const float mq = wmax(fabsf(p.daqg[layer * 64 + lane])), mk = wmax(fabsf(p.dakg[layer * 64 + lane]));
  const float negMb = __uint_as_float(__builtin_amdgcn_readfirstlane(__float_as_uint(-(8.f * mq * mk * 1.03f * 1.4426950408889634f + 0.5f))));
  const int r0 = b * TT + qb * 128 + wid * 32;
  bf16x8 qf[2][2][2];
#pragma unroll
  for (int c = 0; c < 2; ++c)
#pragma unroll
    for (int i = 0; i < 2; ++i)
#pragma unroll
      for (int ks = 0; ks < 2; ++ks) qf[c][i][ks] = *(const bf16x8*)(P + (size_t)(r0 + i * 16 + l15) * LDP + C_DAQ + h * 128 + c * 64 + ks * 32 + g * 8);
  bf16_t* Ks = (bf16_t*)lds;
  bf16_t* Vs = Ks + 2 * 64 * 144;
  u32x4 rk[4], rv[4];
  const bf16_t* kg = P + (size_t)(b * TT) * LDP + C_DAK + h * 128;
#define KLOAD(t) { _Pragma("unroll") for (int i = 0; i < 4; ++i) { const int q = tid + 256 * i; rk[i] = *(const u32x4*)(kg + (size_t)((t) * 64 + (q >> 4)) * LDP + (q & 15) * 8); } }
#define VLOAD(t) { _Pragma("unroll") for (int i = 0; i < 4; ++i) { const int q = tid + 256 * i; rv[i] = *(const u32x4*)(VT + (size_t)(q >> 3) * TT + (t) * 64 + (q & 7) * 8); } }
#define KSTORE(buf) { _Pragma("unroll") for (int i = 0; i < 4; ++i) { const int q = tid + 256 * i; *(u32x4*)(Ks + ((buf) * 64 + (q >> 4)) * 144 + (q & 15) * 8) = rk[i]; } }
#define VSTORE(buf) { _Pragma("unroll") for (int i = 0; i < 4; ++i) { const int q = tid + 256 * i; *(u32x4*)(Vs + ((buf) * 128 + (q >> 3)) * 80 + (q & 7) * 8) = rv[i]; } }
#define QK_INTO(S, Kb, half, CI)                                                                                       \
  _Pragma("unroll") for (int c = 0; c < 2; ++c) {                                                                      \
    bf16x8 kf[2][2];                                                                                                   \
    _Pragma("unroll") for (int k2 = 0; k2 < 2; ++k2) _Pragma("unroll") for (int ks = 0; ks < 2; ++ks)                  \
      kf[k2][ks] = *(const bf16x8*)((Kb) + ((half) * 32 + k2 * 16 + l15) * 144 + c * 64 + ks * 32 + g * 8);             \
    __builtin_amdgcn_sched_barrier(0);                                                                                 \
    _Pragma("unroll") for (int k2 = 0; k2 < 2; ++k2) _Pragma("unroll") for (int i = 0; i < 2; ++i) {                   \
      S[c][i][k2] = mfma16(kf[k2][0], qf[c][i][0], CI(c, i));     \
      S[c][i][k2] = mfma16(kf[k2][1], qf[c][i][1], S[c][i][k2]); }                                                     \
  }                                                                                                                    \
  __builtin_amdgcn_sched_barrier(0);
#define EXPSUM(S)                                                                                                      \
  _Pragma("unroll") for (int c = 0; c < 2; ++c) _Pragma("unroll") for (int i = 0; i < 2; ++i) {                        \
    _Pragma("unroll") for (int k2 = 0; k2 < 2; ++k2) _Pragma("unroll") for (int e = 0; e < 4; ++e) S[c][i][k2][e] = __builtin_amdgcn_exp2f(S[c][i][k2][e]); \
    lsum[c][i] += ((S[c][i][0][0] + S[c][i][0][1]) + (S[c][i][0][2] + S[c][i][0][3])) + ((S[c][i][1][0] + S[c][i][1][1]) + (S[c][i][1][2] + S[c][i][1][3])); }
#define EXP_S() _Pragma("unroll") for (int c = 0; c < 2; ++c) _Pragma("unroll") for (int i = 0; i < 2; ++i) _Pragma("unroll") for (int k2 = 0; k2 < 2; ++k2) _Pragma("unroll") for (int e = 0; e < 4; ++e) S[c][i][k2][e] = __builtin_amdgcn_exp2f(S[c][i][k2][e]);
  float lsum[2][2] = {{0.f, 0.f}, {0.f, 0.f}};
  KLOAD(0);
  KSTORE(0);
  __syncthreads();
  const f32x4 negMv = {negMb, negMb, negMb, negMb};
#define CI1(c, i) negMv
  f32x4 SA[2][2][2], SB[2][2][2];
#pragma unroll 1
  for (int t = 0; t < nt; ++t) {
    if (t + 1 < nt) KLOAD(t + 1);
    const bf16_t* Kb = Ks + (t & 1) * 64 * 144;
    QK_INTO(SA, Kb, 0, CI1)
    if (t > 0) { EXPSUM(SB) }
    __builtin_amdgcn_sched_barrier(0);
    QK_INTO(SB, Kb, 1, CI1)
    EXPSUM(SA)
    if (t + 1 < nt) KSTORE((t + 1) & 1);
    __syncthreads();
  }
  EXPSUM(SB)
  f32x4 ci2[2][2];
#pragma unroll
  for (int i = 0; i < 2; ++i) {
    float l0 = lsum[0][i], l1 = lsum[1][i];
    l0 += shx<16>(l0); l0 = add32(l0);
    l1 += shx<16>(l1); l1 = add32(l1);
    const float c0 = negMb - __log2f(l0), c1 = negMb + __log2f(fabsf(lam)) - __log2f(l1);
    ci2[0][i] = (f32x4){c0, c0, c0, c0}; ci2[1][i] = (f32x4){c1, c1, c1, c1};
  }
  const float nsl = lam < 0.f ? 1.f : -1.f;
#define CI2(c, i) ci2[c][i]
  f32x4 O[2][8];
#pragma unroll
  for (int i = 0; i < 2; ++i)
#pragma unroll
    for (int n = 0; n < 8; ++n) O[i][n] = (f32x4){0.f, 0.f, 0.f, 0.f};
  KLOAD(0); VLOAD(0);
  KSTORE(0); VSTORE(0);
  __syncthreads();
#pragma unroll 1
  for (int t = 0; t < nt; ++t) {
    if (t + 1 < nt) KLOAD(t + 1);
    const bf16_t* Kb = Ks + (t & 1) * 64 * 144;
    const bf16_t* Vb = Vs + (t & 1) * 128 * 80;
#pragma unroll
    for (int half = 0; half < 2; ++half) {
      bf16x8 pf[2], vfa[4], vfb[4];
#define VREAD(dst, n0) _Pragma("unroll") for (int n = 0; n < 4; ++n) dst[n] = *(const bf16x8*)(Vb + (((n0) + n) * 16 + l15) * 80 + half * 32 + g * 8);
      {
        f32x4 S[2][2][2];
        QK_INTO(S, Kb, half, CI2)
        VREAD(vfa, 0)
        EXP_S()
#pragma unroll
        for (int i = 0; i < 2; ++i) {
          float w[8];
#pragma unroll
          for (int k2 = 0; k2 < 2; ++k2)
#pragma unroll
            for (int e = 0; e < 4; ++e) w[k2 * 4 + e] = __builtin_fmaf(nsl, S[1][i][k2][e], S[0][i][k2][e]);
          const u32x4 ww = {pk2(w[0], w[1]), pk2(w[2], w[3]), pk2(w[4], w[5]), pk2(w[6], w[7])};
          pf[i] = __builtin_bit_cast(bf16x8, ww);
        }
      }
      __builtin_amdgcn_sched_barrier(0);
      VREAD(vfb, 4)
#pragma unroll
      for (int n = 0; n < 4; ++n)
#pragma unroll
        for (int i = 0; i < 2; ++i) O[i][n] = mfma16(pf[i], vfa[n], O[i][n]);
      __builtin_amdgcn_sched_barrier(0);
#pragma unroll
      for (int n = 0; n < 4; ++n)
#pragma unroll
        for (int i = 0; i < 2; ++i) O[i][4 + n] = mfma16(pf[i], vfb[n], O[i][4 + n]);
      __builtin_amdgcn_sched_barrier(0);
#undef VREAD
      if (half == 0 && t + 1 < nt) VLOAD(t + 1);
    }
    if (t + 1 < nt) { KSTORE((t + 1) & 1); VSTORE((t + 1) & 1); }
    __syncthreads();
  }
#undef KLOAD
#undef VLOAD
#undef KSTORE
#undef VSTORE
#undef CI1
#undef CI2
#undef QK_INTO
#undef EXPSUM
#undef EXP_S
  const int lane_e = otid() & 63, l15e = lane_e & 15, ge = lane_e >> 4;
  const float* sg = p.dasub + layer * 128;
#pragma unroll
  for (int i = 0; i < 2; ++i)
#pragma unroll
    for (int e = 0; e < 4; ++e) {
      float ss = 0.f;
#pragma unroll
      for (int n = 0; n < 8; ++n) ss += O[i][n][e] * O[i][n][e];
      ss += shx<1>(ss); ss += shx<2>(ss); ss += shx<4>(ss); ss += shx<8>(ss);
      const float rstd = rsqrtf(ss * (1.f / 128.f) + EPS) * (1.f - lam_init);
      bf16_t* op = P + (size_t)(r0 + i * 16 + ge * 4 + e) * LDP + C_DAQ + h * 128 + l15e;
#pragma unroll
      for (int n = 0; n < 8; ++n) if (!dup) op[n * 16] = f2bf(O[i][n][e] * rstd * sg[n * 16 + l15e]);
    }
}

DI float gelu_tanh(float x) { const float u = 0.7978845608028654f * (x + 0.044715f * x * x * x); return 0.5f * x * (1.f + tanhf(u)); }
template <int PASS>
DI void job_lru(const Params& p, int layer, int it, char* lds, bool dup) {
  const int tid = otid(), lane = tid & 63, wid = tid >> 6, l15 = lane & 15, g = lane >> 4;
  const int n = it & 7, c = (it >> 3) % NCH, b = it / (8 * NCH);
  float* xc32 = (float*)lds;
  bf16_t* xcb = (bf16_t*)(lds + 16384);
  f32x2* ab = (f32x2*)(lds + 16384 + 9216);
  f32x2* segtot = (f32x2*)(lds + 16384 + 9216 + 32768);
  float* carry = (float*)(lds + 16384 + 9216 + 32768 + 2048);
  bf16_t* P = (bf16_t*)(p.ws + OFF_P);
  f32x2* LC = (f32x2*)(p.ws + OFF_LC);
  const int ch = tid & 63, seg = tid >> 6;
  {
    const int segLo = c < 4 ? 0 : TC, segHi = c < 4 ? TC : TT;
    const int s0 = c * 64 + seg * 16;
    float cw[4];
#pragma unroll
    for (int k = 0; k < 4; ++k) cw[k] = p.lcw[(size_t)(layer * 4 + k) * 512 + n * 64 + ch];
    const float cb = p.lcb[layer * 512 + n * 64 + ch];
    float xw[19];
#pragma unroll
    for (int j = 0; j < 19; ++j) {
      const int s = s0 - 1 + j;
      xw[j] = (s >= segLo && s < segHi) ? bf2f(P[(size_t)(b * TT + s) * LDP + C_LX + n * 64 + ch]) : 0.f;
    }
#pragma unroll
    for (int u = 0; u < 16; ++u) {
      const float v = cw[0] * xw[u] + cw[1] * xw[u + 1] + cw[2] * xw[u + 2] + cw[3] * xw[u + 3] + cb;
      xc32[(seg * 16 + u) * 64 + ch] = v;
      xcb[(seg * 16 + u) * 72 + ch] = f2bf(v);
    }
  }
  if (PASS == 3 && tid < 128) {
    const int d = tid >> 6;
    const int pos = d == 0 ? c : (c < 4 ? 3 - c : 4 + (NCH - 1 - c));
    float hh = 0.f;
    for (int q0 = 0; q0 < pos; q0 += 16) {
      f32x2 AB[16];
#pragma unroll
      for (int j = 0; j < 16; ++j) {
        const int q = q0 + j, qq = q < pos ? q : pos - 1;
        const int cc = d == 0 ? qq : (qq < 4 ? 3 - qq : NCH - 1 - (qq - 4));
        AB[j] = LC[((((size_t)b * NCH + cc) * 8 + n) * 2 + d) * 64 + ch];
      }
#pragma unroll
      for (int j = 0; j < 16; ++j) if (q0 + j < pos) hh = AB[j].x * hh + AB[j].y;
    }
    carry[d * 64 + ch] = hh;
  }
  __syncthreads();
  float hacc[16];
#pragma unroll
  for (int u = 0; u < 16; ++u) hacc[u] = 0.f;
#pragma unroll 1
  for (int d = 0; d < 2; ++d) {
    {
      f32x4 ar[4], ai[4];
#pragma unroll
      for (int i = 0; i < 4; ++i) { ar[i] = (f32x4){0.f, 0.f, 0.f, 0.f}; ai[i] = (f32x4){0.f, 0.f, 0.f, 0.f}; }
      const bf16_t* LG = (const bf16_t*)(p.ws + OFF_LG);
      const bf16_t* wr_ = LG + ((size_t)((d * 2 + 0) * 8 + n)) * 4096 + (wid * 16 + l15) * 64 + g * 8;
      const bf16_t* wi_ = LG + ((size_t)((d * 2 + 1) * 8 + n)) * 4096 + (wid * 16 + l15) * 64 + g * 8;
#pragma unroll
      for (int ks = 0; ks < 2; ++ks) {
        const bf16x8 br = *(const bf16x8*)(wr_ + ks * 32), bi = *(const bf16x8*)(wi_ + ks * 32);
#pragma unroll
        for (int i = 0; i < 4; ++i) {
          const bf16x8 af = *(const bf16x8*)(xcb + (i * 16 + l15) * 72 + ks * 32 + g * 8);
          ar[i] = mfma16(br, af, ar[i]);
          ai[i] = mfma16(bi, af, ai[i]);
        }
      }
#pragma unroll
      for (int e = 0; e < 4; ++e) {
        const int che = wid * 16 + g * 4 + e, cg_ = n * 64 + che;
        const float br = p.lgb[(size_t)((layer * 2 + d) * 2 + 0) * 512 + cg_], bi = p.lgb[(size_t)((layer * 2 + d) * 2 + 1) * 512 + cg_];
        const float sp = softplusf(-p.llam[(size_t)(layer * 2 + d) * 512 + cg_]);
#pragma unroll
        for (int i = 0; i < 4; ++i) {
          const int tok = i * 16 + l15;
          const float r = sigm(ar[i][e] + br), ig = sigm(ai[i][e] + bi);
          const float la = -8.f * r * sp;
          const float av = __expf(la);
          const float bv = __builtin_sqrtf(fmaxf(1.f - __expf(2.f * la), 0.f)) * ig * xc32[tok * 64 + che];
          ab[tok * 64 + che] = (f32x2){av, bv};
        }
      }
    }
    __syncthreads();
    float hloc[16], cploc[16];
    {
      float hp = 0.f, cp = 1.f;
#pragma unroll
      for (int uu = 0; uu < 16; ++uu) {
        const int u = d == 0 ? uu : 15 - uu;
        const f32x2 v = ab[(seg * 16 + u) * 64 + ch];
        hp = v.x * hp + v.y;
        cp *= v.x;
        hloc[uu] = hp; cploc[uu] = cp;
      }
      segtot[seg * 64 + ch] = (f32x2){cp, hp};
    }
    __syncthreads();
    if (PASS == 1) {
      if (tid < 64) {
        float A = 1.f, Bv = 0.f;
#pragma unroll
        for (int q = 0; q < 4; ++q) {
          const f32x2 v = segtot[(d == 0 ? q : 3 - q) * 64 + ch];
          Bv = v.x * Bv + v.y; A *= v.x;
        }
        LC[((((size_t)b * NCH + c) * 8 + n) * 2 + d) * 64 + ch] = (f32x2){A, Bv};
      }
    } else {
      float hh = carry[d * 64 + ch];
      const int npre = d == 0 ? seg : 3 - seg;
      for (int q = 0; q < npre; ++q) {
        const f32x2 v = segtot[(d == 0 ? q : 3 - q) * 64 + ch];
        hh = v.x * hh + v.y;
      }
#pragma unroll
      for (int uu = 0; uu < 16; ++uu) {
        const int u = d == 0 ? uu : 15 - uu;
        const float hv = hloc[uu] + cploc[uu] * hh;
        hacc[d == 0 ? uu : 15 - uu] += hv;
        (void)u;
      }
    }
    __syncthreads();
  }
  if (PASS == 3) {
#pragma unroll
    for (int u = 0; u < 16; ++u) {
      bf16_t* yp = P + (size_t)(b * TT + c * 64 + seg * 16 + u) * LDP + C_LY + n * 64 + ch;
      if (!dup) *yp = f2bf(gelu_tanh(bf2f(*yp)) * hacc[u]);
    }
  }
}

DI void job_gconv(const Params& p, int layer, int it, bool dup) {
  const int tid = otid(), grp = it % 12, cg_ = it / 12, cp = tid & 15, rg = tid >> 4;
  const int cin = cg_ % NCH;
  const bool first = (cin == 0 || cin == 4), last = (cin == 3 || cin == NCH - 1);
  bf16_t* P = (bf16_t*)(p.ws + OFF_P);
  const bf16_t* HALO = (const bf16_t*)(p.ws + OFF_HALO);
  const int col = grp * 128 + cp * 8;
  u32x4 xr[7];
#pragma unroll
  for (int j = 0; j < 7; ++j) {
    const int q = rg * 4 - 1 + j;
    u32x4 v = {0u, 0u, 0u, 0u};
    if (q >= 0 && q < 64) v = *(const u32x4*)(P + (size_t)(cg_ * 64 + q) * LDP + C_GQKV + col);
    else if (q < 0) { if (!first) v = *(const u32x4*)(HALO + ((size_t)(cg_ - 1) * 3 + 2) * 1536 + col); }
    else { if (!last) v = *(const u32x4*)(HALO + ((size_t)(cg_ + 1) * 3 + (q - 64)) * 1536 + col); }
    xr[j] = v;
  }
  float w[4][8];
#pragma unroll
  for (int k = 0; k < 4; ++k) {
    const f32x4 a = *(const f32x4*)(p.gcw + (size_t)(layer * 4 + k) * 1536 + col), bq = *(const f32x4*)(p.gcw + (size_t)(layer * 4 + k) * 1536 + col + 4);
#pragma unroll
    for (int e = 0; e < 4; ++e) { w[k][e] = a[e]; w[k][4 + e] = bq[e]; }
  }
  __syncthreads();
#pragma unroll
  for (int jr = 0; jr < 4; ++jr) {
    float y[8];
#pragma unroll
    for (int e = 0; e < 8; ++e) y[e] = 0.f;
#pragma unroll
    for (int k = 0; k < 4; ++k)
#pragma unroll
      for (int e = 0; e < 4; ++e) { y[2 * e] += w[k][2 * e] * bflo(xr[jr + k][e]); y[2 * e + 1] += w[k][2 * e + 1] * bfhi(xr[jr + k][e]); }
    float ss = 0.f;
#pragma unroll
    for (int e = 0; e < 8; ++e) { y[e] = y[e] * sigm(y[e]); ss += y[e] * y[e]; }
    if (grp < 8) {
      ss += shx<1>(ss); ss += shx<2>(ss); ss += shx<4>(ss); ss += shx<8>(ss);
      const float sc = rsqrtf(ss + EPS) * (grp < 4 ? 0.08838834764831845f : 1.f);
#pragma unroll
      for (int e = 0; e < 8; ++e) y[e] *= sc;
    }
    if (!dup) *(u32x4*)(P + (size_t)(cg_ * 64 + rg * 4 + jr) * LDP + C_GQKV + col) = (u32x4){pk2(y[0], y[1]), pk2(y[2], y[3]), pk2(y[4], y[5]), pk2(y[6], y[7])};
  }
  __syncthreads();
}

DI void job_gprep(const Params& p, int layer, int it, char* lds) {
  const int tid = otid(), lane = tid & 63, wid = tid >> 6, l15 = lane & 15, g = lane >> 4;
  const int h = it & 3, c = (it >> 2) % NCH, b = it / (4 * NCH);
  bf16_t* kt_ = (bf16_t*)lds;
  bf16_t* qt_ = kt_ + 64 * 136;
  float* Ld = (float*)lds;
  float* KK = (float*)(lds + 34816);
  float* QK = KK + 64 * 65;
  float* gcs = QK + 64 * 65;
  float* bts = gcs + 128;
  const bf16_t* P = (const bf16_t*)(p.ws + OFF_P);
#pragma unroll
  for (int i = 0; i < 4; ++i) {
    const int q = tid + 256 * i, row = q >> 4, pc = q & 15;
    const bf16_t* rp = P + (size_t)(b * TT + c * 64 + row) * LDP + C_GQKV + h * 128 + pc * 8;
    *(u32x4*)(qt_ + row * 136 + pc * 8) = *(const u32x4*)rp;
    *(u32x4*)(kt_ + row * 136 + pc * 8) = *(const u32x4*)(rp + 512);
  }
  float* GSC = (float*)(p.ws + OFF_GSC);
  if (tid < 128) {
    const int d = wid, i = lane, tn = d ? 63 - i : i, r = b * TT + c * 64 + tn;
    const float* gba = (const float*)(p.ws + OFF_GBA) + (size_t)r * 16;
    const float gval = -expf(p.galog[(layer * 2 + d) * 4 + h]) * softplusf(gba[8 + d * 4 + h] + p.gdtb[(layer * 2 + d) * 4 + h]);
    const float beta = sigm(gba[d * 4 + h]);
    float v = gval;
#pragma unroll
    for (int o = 1; o < 64; o <<= 1) { const float t = __int_as_float(__builtin_amdgcn_ds_bpermute(((lane - o) & 63) << 2, __float_as_int(v))); if (lane >= o) v += t; }
    const float glast = __int_as_float(__builtin_amdgcn_readlane(__float_as_int(v), 63));
    gcs[d * 64 + i] = v;
    bts[d * 64 + i] = beta;
    float* gs = GSC + (size_t)(it * 2 + d) * 192;
    gs[i] = expf(v);
    gs[64 + i] = expf(glast - v);
    if (i == 0) gs[128] = expf(glast);
  }
  __syncthreads();
  {
    f32x4 akk[4], aqk[4];
#pragma unroll
    for (int j = 0; j < 4; ++j) { akk[j] = (f32x4){0.f, 0.f, 0.f, 0.f}; aqk[j] = (f32x4){0.f, 0.f, 0.f, 0.f}; }
#pragma unroll
    for (int ks = 0; ks < 4; ++ks) {
      const bf16x8 ak = *(const bf16x8*)(kt_ + (wid * 16 + l15) * 136 + ks * 32 + g * 8);
      const bf16x8 aq = *(const bf16x8*)(qt_ + (wid * 16 + l15) * 136 + ks * 32 + g * 8);
#pragma unroll
      for (int j = 0; j < 4; ++j) {
        const bf16x8 bk = *(const bf16x8*)(kt_ + (j * 16 + l15) * 136 + ks * 32 + g * 8);
        akk[j] = mfma16(ak, bk, akk[j]);
        aqk[j] = mfma16(aq, bk, aqk[j]);
      }
    }
#pragma unroll
    for (int j = 0; j < 4; ++j)
#pragma unroll
      for (int e = 0; e < 4; ++e) { KK[(wid * 16 + g * 4 + e) * 65 + j * 16 + l15] = akk[j][e]; QK[(wid * 16 + g * 4 + e) * 65 + j * 16 + l15] = aqk[j][e]; }
  }
  __syncthreads();
  bf16_t* M1 = (bf16_t*)(p.ws + OFF_H);
  bf16_t* AT = M1 + (size_t)4224 * 4096;
#pragma unroll 1
  for (int d = 0; d < 2; ++d) {
    bf16_t* atp = AT + (size_t)(it * 2 + d) * 4096;
#pragma unroll 4
    for (int idx = tid; idx < 4096; idx += 256) {
      const int i = idx >> 6, j = idx & 63, ti = d ? 63 - i : i, tj = d ? 63 - j : j;
      const float dec = (j <= i) ? expf(gcs[d * 64 + i] - gcs[d * 64 + j]) : 0.f;
      Ld[d * 4096 + idx] = (j < i) ? bts[d * 64 + i] * KK[ti * 65 + tj] * dec : 0.f;
      atp[idx] = f2bf(QK[ti * 65 + tj] * dec);
    }
  }
  __syncthreads();
  if (wid < 2) {
    const int d = wid;
    const float* L = Ld + d * 4096;
    const float bc = bts[d * 64 + lane];
    bf16_t* mp = M1 + (size_t)(it * 2 + d) * 4096 + lane;
    float x[64];
#pragma unroll
    for (int i = 0; i < 64; ++i) {
      float s = (i == lane) ? 1.f : 0.f;
#pragma unroll
      for (int j = 0; j < i; ++j) s -= L[i * 64 + j] * x[j];
      x[i] = s;
      mp[i * 64] = f2bf(s * bc);
    }
  }
  __syncthreads();
}

struct GChunk { bf16x8 kf[4], qf[4], m1f[2], atf[2]; unsigned vr[2][4]; float eg[4], egl[4]; float ge; };
DI void gdn_load(GChunk& R, const Params& p, int b, int h, int d, int dvs, int c) {
  const int tid = otid(), lane = tid & 63, wid = tid >> 6, l15 = lane & 15, g = lane >> 4;
  const bf16_t* P = (const bf16_t*)(p.ws + OFF_P);
  const bf16_t* M1 = (const bf16_t*)(p.ws + OFF_H);
  const bf16_t* AT = M1 + (size_t)4224 * 4096;
  const float* GSC = (const float*)(p.ws + OFF_GSC);
  const int item = ((b * NCH + c) * 4 + h) * 2 + d;
  const int irow = 16 * wid + l15, tn = d ? 63 - irow : irow;
  const bf16_t* rowp = P + (size_t)(b * TT + c * 64 + tn) * LDP + C_GQKV + h * 128;
#pragma unroll
  for (int ks = 0; ks < 4; ++ks) { R.qf[ks] = *(const bf16x8*)(rowp + ks * 32 + g * 8); R.kf[ks] = *(const bf16x8*)(rowp + 512 + ks * 32 + g * 8); }
#pragma unroll
  for (int ks = 0; ks < 2; ++ks) {
    R.m1f[ks] = *(const bf16x8*)(M1 + (size_t)item * 4096 + irow * 64 + ks * 32 + g * 8);
    R.atf[ks] = *(const bf16x8*)(AT + (size_t)item * 4096 + irow * 64 + ks * 32 + g * 8);
  }
#pragma unroll
  for (int e = 0; e < 4; ++e) {
    const int i = 16 * wid + g * 4 + e, t2 = d ? 63 - i : i;
    R.vr[0][e] = *(const unsigned*)(P + (size_t)(b * TT + c * 64 + t2) * LDP + C_GQKV + 1024 + h * 128 + dvs * 32 + (l15 & ~1));
    R.vr[1][e] = *(const unsigned*)(P + (size_t)(b * TT + c * 64 + t2) * LDP + C_GQKV + 1024 + h * 128 + dvs * 32 + 16 + (l15 & ~1));
    R.eg[e] = GSC[(size_t)item * 192 + i];
    R.egl[e] = GSC[(size_t)item * 192 + 64 + i];
  }
  R.ge = GSC[(size_t)item * 192 + 128];
}
DI void gdn_put_kt(const GChunk& R, bf16_t* KT) {
  const int tid = otid(), lane = tid & 63, i = 16 * (tid >> 6) + (lane & 15), g = lane >> 4;
#pragma unroll
  for (int ks = 0; ks < 4; ++ks)
#pragma unroll
    for (int e = 0; e < 8; ++e) KT[(ks * 32 + g * 8 + e) * 72 + i] = (bf16_t)R.kf[ks][e];
}
DI int gdn_chunk_at(int d, int n) { return d == 0 ? n : (n < 4 ? 3 - n : NCH - 1 - (n - 4)); }
DI void job_gscan(const Params& p, int u, char* lds) {
  const int tid = otid(), lane = tid & 63, wid = tid >> 6, l15 = lane & 15, g = lane >> 4;
  const int seq = (u & 7) + 8 * (u >> 5), dvs = (u >> 3) & 3, d = seq & 1, h = (seq >> 1) & 3, b = seq >> 3;
  bf16_t* KT = (bf16_t*)lds;
  bf16_t* ST = KT + 2 * 128 * 72;
  bf16_t* XT = ST + 32 * 136;
  bf16_t* VnT = XT + 32 * 72;
  bf16_t* VsT = VnT + 32 * 72;
  bf16_t* OUT = d == 0 ? (bf16_t*)(p.ws + OFF_P) + C_DAV : (bf16_t*)(p.ws + OFF_OB);
  const int ldo = d == 0 ? LDP : 512;
  __builtin_amdgcn_s_setprio(3);
  f32x4 S[2][2];
#pragma unroll
  for (int a = 0; a < 2; ++a)
#pragma unroll
    for (int ct = 0; ct < 2; ++ct) S[a][ct] = (f32x4){0.f, 0.f, 0.f, 0.f};
  for (int i = tid; i < 32 * 136 / 2; i += 256) ((unsigned*)ST)[i] = 0u;
  GChunk cur, nxt;
  gdn_load(cur, p, b, h, d, dvs, gdn_chunk_at(d, 0));
  gdn_put_kt(cur, KT);
  __syncthreads();
#pragma unroll 1
  for (int n = 0; n < NCH; ++n) {
    const int c = gdn_chunk_at(d, n);
    if (n + 1 < NCH) gdn_load(nxt, p, b, h, d, dvs, gdn_chunk_at(d, n + 1));
    const bf16_t* KTc = KT + (n & 1) * 128 * 72;
    f32x4 ksa[2], qsa[2];
#pragma unroll
    for (int ct = 0; ct < 2; ++ct) { ksa[ct] = (f32x4){0.f, 0.f, 0.f, 0.f}; qsa[ct] = (f32x4){0.f, 0.f, 0.f, 0.f}; }
#pragma unroll
    for (int ks = 0; ks < 4; ++ks)
#pragma unroll
      for (int ct = 0; ct < 2; ++ct) {
        const bf16x8 bS = *(const bf16x8*)(ST + (ct * 16 + l15) * 136 + ks * 32 + g * 8);
        ksa[ct] = mfma16(cur.kf[ks], bS, ksa[ct]);
        qsa[ct] = mfma16(cur.qf[ks], bS, qsa[ct]);
      }
#pragma unroll
    for (int ct = 0; ct < 2; ++ct) {
      float x[4];
#pragma unroll
      for (int e = 0; e < 4; ++e) x[e] = ((l15 & 1) ? bfhi(cur.vr[ct][e]) : bflo(cur.vr[ct][e])) - cur.eg[e] * ksa[ct][e];
      *(u32x2*)(XT + (ct * 16 + l15) * 72 + 16 * wid + g * 4) = (u32x2){pk2(x[0], x[1]), pk2(x[2], x[3])};
    }
    __syncthreads();
#pragma unroll
    for (int ct = 0; ct < 2; ++ct) {
      f32x4 vn = {0.f, 0.f, 0.f, 0.f};
#pragma unroll
      for (int ks = 0; ks < 2; ++ks) vn = mfma16(cur.m1f[ks], *(const bf16x8*)(XT + (ct * 16 + l15) * 72 + ks * 32 + g * 8), vn);
      *(u32x2*)(VnT + (ct * 16 + l15) * 72 + 16 * wid + g * 4) = (u32x2){pk2(vn[0], vn[1]), pk2(vn[2], vn[3])};
      *(u32x2*)(VsT + (ct * 16 + l15) * 72 + 16 * wid + g * 4) = (u32x2){pk2(vn[0] * cur.egl[0], vn[1] * cur.egl[1]), pk2(vn[2] * cur.egl[2], vn[3] * cur.egl[3])};
    }
    __syncthreads();
#pragma unroll
    for (int ct = 0; ct < 2; ++ct) {
      f32x4 o;
#pragma unroll
      for (int e = 0; e < 4; ++e) o[e] = cur.eg[e] * qsa[ct][e];
#pragma unroll
      for (int ks = 0; ks < 2; ++ks) o = mfma16(cur.atf[ks], *(const bf16x8*)(VnT + (ct * 16 + l15) * 72 + ks * 32 + g * 8), o);
#pragma unroll
      for (int e = 0; e < 4; ++e) {
        const int i = 16 * wid + g * 4 + e, t2 = d ? 63 - i : i;
        OUT[(size_t)(b * TT + c * 64 + t2) * ldo + h * 128 + dvs * 32 + ct * 16 + l15] = f2bf(o[e]);
      }
    }
#pragma unroll
    for (int rt2 = 0; rt2 < 2; ++rt2) {
      const int rt = 2 * wid + rt2;
#pragma unroll
      for (int ct = 0; ct < 2; ++ct)
#pragma unroll
        for (int e = 0; e < 4; ++e) S[rt2][ct][e] *= cur.ge;
#pragma unroll
      for (int ks = 0; ks < 2; ++ks) {
        const bf16x8 ka = *(const bf16x8*)(KTc + (rt * 16 + l15) * 72 + ks * 32 + g * 8);
#pragma unroll
        for (int ct = 0; ct < 2; ++ct) S[rt2][ct] = mfma16(ka, *(const bf16x8*)(VsT + (ct * 16 + l15) * 72 + ks * 32 + g * 8), S[rt2][ct]);
      }
#pragma unroll
      for (int ct = 0; ct < 2; ++ct)
        *(u32x2*)(ST + (ct * 16 + l15) * 136 + rt * 16 + g * 4) = (u32x2){pk2(S[rt2][ct][0], S[rt2][ct][1]), pk2(S[rt2][ct][2], S[rt2][ct][3])};
    }
    if (n + 1 < NCH) { gdn_put_kt(nxt, KT + ((n + 1) & 1) * 128 * 72); cur = nxt; }
    __syncthreads();
  }
  __builtin_amdgcn_s_setprio(0);
}
DI void job_gpost1(const Params& p, int layer, int r) {
  const int lane = otid() & 63;
  bf16_t* P = (bf16_t*)(p.ws + OFF_P) + (size_t)r * LDP;
  const bf16_t* OB = (const bf16_t*)(p.ws + OFF_OB) + (size_t)r * 512;
  const u32x4 of = *(const u32x4*)(P + C_DAV + lane * 8), ob = *(const u32x4*)(OB + lane * 8), z = *(const u32x4*)(P + C_GZ + lane * 8);
  float o[8], zz[8], ss = 0.f;
#pragma unroll
  for (int e = 0; e < 4; ++e) {
    o[2 * e] = bflo(of[e]) + bflo(ob[e]); o[2 * e + 1] = bfhi(of[e]) + bfhi(ob[e]);
    zz[2 * e] = bflo(z[e]); zz[2 * e + 1] = bfhi(z[e]);
  }
#pragma unroll
  for (int e = 0; e < 8; ++e) ss += o[e] * o[e];
  ss += shx<1>(ss); ss += shx<2>(ss); ss += shx<4>(ss); ss += shx<8>(ss);
  const float rstd = rsqrtf(ss * (1.f / 128.f) + EPS);
  const float* gn = p.gng + layer * 128 + (lane & 15) * 8;
  float y[8];
#pragma unroll
  for (int e = 0; e < 8; ++e) y[e] = o[e] * rstd * gn[e] * (zz[e] * sigm(zz[e]));
  *(u32x4*)(P + C_GZ + lane * 8) = (u32x4){pk2(y[0], y[1]), pk2(y[2], y[3]), pk2(y[4], y[5]), pk2(y[6], y[7])};
}

DI void job_gpost(const Params& p, int layer, int it) {
  const int wid = otid() >> 6;
#pragma unroll
  for (int rr = 0; rr < 2; ++rr) job_gpost1(p, layer, it * 8 + rr * 4 + wid);
}
#ifdef SK_JL1
#define JL1(x)
#else
#define JL1(x) x
#endif
#ifdef SK_JGC
#define JGC(x)
#else
#define JGC(x) x
#endif
#ifdef SK_JVT
#define JVT(x)
#else
#define JVT(x) x
#endif
#ifdef SK_JDP
#define JDP(x)
#else
#define JDP(x) x
#endif
#ifdef SK_JGP
#define JGP(x)
#else
#define JGP(x) x
#endif
#ifdef SK_JL3
#define JL3(x)
#else
#define JL3(x) x
#endif
#ifdef SK_JGS
#define JGS(x)
#else
#define JGS(x) x
#endif
#ifdef SK_JAT
#define JAT(x)
#else
#define JAT(x) x
#endif
#define LAS __attribute__((address_space(3)))
#define XB_TMO      128
#define XB_XCNT(j)  (256  + 64 * (j))
#define XB_XSUB(j)  (1280 + 64 * (j))
#define XB_XGEN(j)  (2304 + 64 * (j))
#define XB_TOP      3328
#define XB_TOPGEN   3392
#define XCD_BAR_WORDS 3456
#define XB_SPIN_CAP (1u << 18)

__device__ __forceinline__ unsigned xb_ld(unsigned* p)              { return __hip_atomic_load(p, __ATOMIC_RELAXED, __HIP_MEMORY_SCOPE_AGENT); }
__device__ __forceinline__ unsigned xb_add(unsigned* p, unsigned v) { return __hip_atomic_fetch_add(p, v, __ATOMIC_RELAXED, __HIP_MEMORY_SCOPE_AGENT); }
__device__ __forceinline__ unsigned xb_xcc_id() { return (unsigned)__builtin_amdgcn_s_getreg((3 << 11) | 20) & 0xFu; }
#define XB_SPIN(cond, bar) do { unsigned _sp = 0; while (cond) { __builtin_amdgcn_s_sleep(1); \
    if ((++_sp & 255u) == 0u) { if (xb_ld(&(bar)[XB_TMO])) break; if (_sp > XB_SPIN_CAP) { atomicAdd(&(bar)[XB_TMO], 1u); break; } } } } while (0)

struct XcdBarrier {
    unsigned* bar; unsigned x;
    volatile LAS unsigned* st;
};

__device__ __forceinline__ XcdBarrier xcd_barrier_post(unsigned* bar, volatile LAS unsigned* st) {
    XcdBarrier b; b.bar = bar; b.x = xb_xcc_id(); b.st = st;
    if (threadIdx.x == 0) (void)xb_add(&bar[XB_XCNT(b.x)], 1u);
    return b;
}
__device__ __forceinline__ void xcd_barrier_complete(unsigned* bar, unsigned x, unsigned& nloc, unsigned& nx) {
    const unsigned G = gridDim.x * gridDim.y * gridDim.z;
    unsigned sum, cnt, mine, sp = 0u;
    for (;;) {
        sum = 0u; cnt = 0u; mine = 0u;
#pragma unroll
        for (unsigned j = 0; j < 16; ++j) { const unsigned c = xb_ld(&bar[XB_XCNT(j)]); sum += c; cnt += (c > 0u) ? 1u : 0u; mine = (j == x) ? c : mine; }
        if (sum == G) break;
        __builtin_amdgcn_s_sleep(1);
        if ((++sp & 255u) == 0u) { if (xb_ld(&bar[XB_TMO])) break; if (sp > XB_SPIN_CAP) { atomicAdd(&bar[XB_TMO], 1u); break; } }
    }
    nloc = mine > 0u ? mine : 1u; nx = cnt > 0u ? cnt : 1u;
}

__device__ __forceinline__ void xcd_barrier(const XcdBarrier& b) {
    asm volatile("s_waitcnt vmcnt(0)" ::: "memory");
    __syncthreads();
    if (threadIdx.x == 0) {
        unsigned* bar = b.bar; unsigned bx_ = b.x;
        asm volatile("" : "+s"(bar), "+s"(bx_));
        __builtin_amdgcn_s_waitcnt(0);
        unsigned nloc = b.st[0], nx = b.st[1];
        if (nloc == 0u) { xcd_barrier_complete(bar, bx_, nloc, nx); b.st[0] = nloc; b.st[1] = nx; }
        const unsigned old = xb_add(&bar[XB_XSUB(bx_)], 1u);
        const unsigned gen = old / nloc;
        if (old + 1u == (gen + 1u) * nloc) {
            __builtin_amdgcn_fence(__ATOMIC_RELEASE, "agent");
            asm volatile("s_waitcnt vmcnt(0)" ::: "memory");
            const unsigned og = xb_add(&bar[XB_TOP], 1u);
            const unsigned tg = og / nx;
            if (og + 1u == (tg + 1u) * nx) xb_add(&bar[XB_TOPGEN], 1u);
            else XB_SPIN(xb_ld(&bar[XB_TOPGEN]) == tg, bar);
            __builtin_amdgcn_fence(__ATOMIC_ACQUIRE, "agent");
            xb_add(&bar[XB_XGEN(bx_)], 1u);
            asm volatile("s_waitcnt vmcnt(0)" ::: "memory");
        } else {
            XB_SPIN(xb_ld(&bar[XB_XGEN(bx_)]) == gen, bar);
            __builtin_amdgcn_fence(__ATOMIC_ACQUIRE, "agent");
            asm volatile("s_waitcnt vmcnt(0)" ::: "memory");
        }
    }
    __syncthreads();
}


#define PH_BEGIN(k) for (int rep_ = 0, nrep_ = 1 + (((p.probe >> (k)) & 1) | ((k) == 5 ? ((p.probe >> 12) | (p.probe >> 13)) & 1 : 0)); rep_ < nrep_; ++rep_) { const bool dup = rep_ > 0; (void)dup;
#define PH_END xcd_barrier(xb_); }
#ifndef PROBE_MASK
#define PROBE_MASK 0
#endif
__global__ void __launch_bounds__(256, 2) mega(Params p) {
  __shared__ __attribute__((aligned(16))) char lds[LDS_BYTES];
  __shared__ int s_item;
  __shared__ unsigned xb_st[2];
  if (otid() == 0) { xb_st[0] = 0u; xb_st[1] = 0u; }
  __syncthreads();
  const XcdBarrier xb_ = xcd_barrier_post((unsigned*)(p.ws + OFF_CTR) + 64, (volatile LAS unsigned*)xb_st);
  cg::grid_group grid = cg::this_grid();
  const int G = gridDim.x, B = blockIdx.x;
  bf16_t* P = (bf16_t*)(p.ws + OFF_P);
  bf16_t* H = (bf16_t*)(p.ws + OFF_H);
  for (int it = B; it < 192 + 1024 + N_CVT; it += G) {
    if (it < 192) job_mod(p, it, lds);
    else if (it < 1216) job_rope(p, it - 192);
    else job_cvt(p, 0, it - 1216, lds);
  }
  if (p.probe < 0) grid.sync();
  xcd_barrier(xb_);
#pragma unroll 1
  for (int layer = 0; layer < 2; ++layer) {
    bf16_t* MG = (bf16_t*)(p.ws + OFF_VT);
    bf16_t* HID = P;
    PH_BEGIN(1)
    {
      const int n1 = layer == 1 ? N_CVT : 0;
      for (int it = B; it < n1 + MR / 8; it += G) { if (it < n1) job_cvt(p, 1, it, lds); else job_norm(p, layer, 1, it - n1); }
    }
    PH_END
    PH_BEGIN(2)
    {
      bf16_t* HALO = (bf16_t*)(p.ws + OFF_HALO);
      float* GBA = (float*)(p.ws + OFF_GBA);
      gemm_phase(H, 32, MR * 32, (const bf16_t*)(p.ws + OFF_WIN), 32, 7808 * 32, 1024, 132, 37, lds, B, G, [&](int row, int col, f32x4 v) {
        if (col < C_GBA) {
          const u32x2 w = {pk2(v[0], v[1]), pk2(v[2], v[3])};
          *(u32x2*)(P + (size_t)row * LDP + col) = w;
          if (col >= C_GQKV && col < C_GZ) {
            const int sm = row & 63;
            if (sm <= 1 || sm == 63) *(u32x2*)(HALO + ((size_t)(row >> 6) * 3 + (sm == 63 ? 2 : sm)) * 1536 + (col - C_GQKV)) = w;
          }
        } else if (col < C_GBA + 16) {
          *(f32x4*)(GBA + (size_t)row * 16 + (col - C_GBA)) = v;
        }
      }, [&](int row, int col, f32x4 v0, f32x4 v1) {
        if (col < C_GBA) {
          const u32x4 w = (u32x4){pk2(v0[0], v0[1]), pk2(v0[2], v0[3]), pk2(v1[0], v1[1]), pk2(v1[2], v1[3])};
          __builtin_nontemporal_store(w, (u32x4*)(P + (size_t)row * LDP + col));
          if (col >= C_GQKV && col < C_GZ) {
            const int sm = row & 63;
            if (sm <= 1 || sm == 63) *(u32x4*)(HALO + ((size_t)(row >> 6) * 3 + (sm == 63 ? 2 : sm)) * 1536 + (col - C_GQKV)) = w;
          }
        } else if (col < C_GBA + 16) {
          *(f32x4*)(GBA + (size_t)row * 16 + (col - C_GBA)) = v0;
          *(f32x4*)(GBA + (size_t)row * 16 + (col - C_GBA) + 4) = v1;
        }
      });
    }
    PH_END
    PH_BEGIN(3)
    {
      const int nA = 8 * NCH * 4, nB = nA + 6336, nC = nB + 2112, nD = nC + MR / 8;
      for (int it = B; it < nD; it += G) {
        if (it < nA) JL1(job_lru<1>(p, layer, it, lds, dup));
        else if (it < nB) JGC(job_gconv(p, layer, it - nA, dup));
        else if (it < nC) JVT(job_vt(p, it - nB, lds));
        else JDP(job_daprep(p, layer, it - nC, dup));
      }
    }
    PH_END
    PH_BEGIN(4)
    for (int it = B; it < 2112; it += G) JGP(job_gprep(p, layer, it, lds));
    PH_END
    PH_BEGIN(5)
    {
      for (;;) {
        const int x = blockIdx.x & 7;
        if (otid() == 0) s_item = (int)__hip_atomic_fetch_add((unsigned*)(p.ws + OFF_CTR) + ((layer * 2 + rep_) * 8 + x), 1u, __ATOMIC_RELAXED, __HIP_MEMORY_SCOPE_AGENT);
        __syncthreads();
        const int j = __builtin_amdgcn_readfirstlane(s_item);
        __syncthreads();
        if (j >= 16 + 132 + 528) break;
        if (j < 16) { if (!(dup && ((p.probe >> 12) & 1))) JGS(job_gscan(p, j * 8 + x, lds)); }
        else if (j < 148) {
          const int k = j - 16, grp = k / 66, qq = k % 66, qb = qq < 64 ? qq + 2 : qq - 64;
          if (!(dup && ((p.probe >> 13) & 1))) JAT(job_attn(p, layer, grp * 528 + qb * 8 + x, lds, dup));
        } else { if (!(dup && (((p.probe >> 12) | (p.probe >> 13)) & 1))) JL3(job_lru<3>(p, layer, (j - 148) * 8 + x, lds, dup)); }
      }
    }
    PH_END
    PH_BEGIN(6)
    for (int it = B; it < MR / 8 + MR / 8; it += G) { if (it < MR / 8) job_gpost(p, layer, it); else job_norm(p, layer, 1, it - MR / 8); }
    PH_END
    PH_BEGIN(7)
    gemm_phase(H, 32, MR * 32, (const bf16_t*)(p.ws + OFF_WIN) + (size_t)4736 * 32, 32, 7808 * 32, 1024, 132, 24, lds, B, G, [&](int row, int col, f32x4 v) {
      *(u32x2*)(P + (size_t)row * LDP + sg_col(col)) = (u32x2){pk2(sigm(v[0]), sigm(v[1])), pk2(sigm(v[2]), sigm(v[3]))};
    }, [&](int row, int col, f32x4 v0, f32x4 v1) {
      *(u32x4*)(P + (size_t)row * LDP + sg_col(col)) = (u32x4){pk2(sigm(v0[0]), sigm(v0[1])), pk2(sigm(v0[2]), sigm(v0[3])), pk2(sigm(v1[0]), sigm(v1[1])), pk2(sigm(v1[2]), sigm(v1[3]))};
    }, layer == 1);
    PH_END
    PH_BEGIN(14)
    {
      const bf16_t* WBR = (const bf16_t*)(p.ws + OFF_WBR);
      const int nm14 = layer == 1 ? 256 : 264;
      for (int t = B; t < nm14 * 8; t += G) {
        int mi, ni; tile_mn(t, nm14, 8, mi, ni);
        if (layer == 1) mi += 2 * (mi >> 6) + 2;
        f32x4 mg[4][4]; zero_acc<4>(mg);
#pragma unroll 1
        for (int i = 0; i < 3; ++i) {
          f32x4 ay[4][4]; zero_acc<4>(ay);
          const int coff = i == 0 ? C_DAQ : (i == 1 ? C_LY : C_GZ);
          gemm_core<4>(P + (size_t)mi * 128 * LDP + coff, LDP, 32, WBR + (size_t)i * 1024 * 512 + (size_t)(ni * 128) * 32, 32, 1024 * 32, 512, ay, lds);
          const int lane = otid() & 63, wid = otid() >> 6, wr = wid >> 1, wc = wid & 1;
#pragma unroll
          for (int a2 = 0; a2 < 4; ++a2)
#pragma unroll
            for (int b2 = 0; b2 < 4; ++b2) {
              const int row = mi * 128 + wr * 64 + a2 * 16 + (lane & 15), col = ni * 128 + wc * 64 + b2 * 16 + (lane >> 4) * 4;
              const u32x2 sg = *(const u32x2*)(P + (size_t)row * LDP + sg_col(i * 1024 + col));
              mg[a2][b2] += (f32x4){bflo(sg.x), bfhi(sg.x), bflo(sg.y), bfhi(sg.y)} * ay[a2][b2];
            }
        }
        gemm_emit<4>(mg, mi * 128, ni * 128, [&](int row, int col, f32x4 v) { *(u32x2*)(MG + ((size_t)(col >> 5) * MR + row) * 32 + (col & 31)) = (u32x2){pk2(v[0], v[1]), pk2(v[2], v[3])}; });
      }
    }
    PH_END
    PH_BEGIN(8)
    gemm_phase(MG, 32, MR * 32, (const bf16_t*)(p.ws + OFF_WO), 32, 1024 * 32, 1024, 132, 8, lds, B, G, [&](int row, int col, f32x4 v) {
      const f32x4 xin = *(const f32x4*)(res_in_row(p, layer, row) + col);
      const f32x4 g1 = *(const f32x4*)(mod_vec(p, layer, row) + 2048 + col);
      if (!dup) *(f32x4*)(res_out_row(p, row) + col) = xin + g1 * v;
    }, [&](int row, int col, f32x4 v0, f32x4 v1) {
      const float* xi = res_in_row(p, layer, row) + col;
      const float* gm = mod_vec(p, layer, row) + 2048 + col;
      float* xo = res_out_row(p, row) + col;
      const f32x4 o0 = __builtin_nontemporal_load((const f32x4*)xi) + *(const f32x4*)gm * v0, o1 = __builtin_nontemporal_load((const f32x4*)(xi + 4)) + *(const f32x4*)(gm + 4) * v1;
      if (!dup) { *(f32x4*)xo = o0; *(f32x4*)(xo + 4) = o1; }
    }, layer == 1);
    PH_END
    PH_BEGIN(9)
    for (int it = B; it < MR / 8; it += G) job_norm(p, layer, 2, it);
    PH_END
    PH_BEGIN(10)
    gemm_phase(H, 32, MR * 32, (const bf16_t*)(p.ws + OFF_W1), 32, 4096 * 32, 1024, 132, 32, lds, B, G, [&](int row, int col, f32x4 v) {
      float r[4];
#pragma unroll
      for (int e = 0; e < 4; ++e) { const float q = fmaxf(v[e], 0.f); r[e] = q * q; }
      *(u32x2*)(HID + ((size_t)(col >> 5) * MR + row) * 32 + (col & 31)) = (u32x2){pk2(r[0], r[1]), pk2(r[2], r[3])};
    }, [&](int row, int col, f32x4 v0, f32x4 v1) {
      float r[8];
#pragma unroll
      for (int e = 0; e < 4; ++e) { const float q0 = fmaxf(v0[e], 0.f), q1 = fmaxf(v1[e], 0.f); r[e] = q0 * q0; r[4 + e] = q1 * q1; }
      __builtin_nontemporal_store(((u32x4){pk2(r[0], r[1]), pk2(r[2], r[3]), pk2(r[4], r[5]), pk2(r[6], r[7])}), (u32x4*)(HID + ((size_t)(col >> 5) * MR + row) * 32 + (col & 31)));
    }, layer == 1);
    PH_END
    PH_BEGIN(11)
    gemm_phase(HID, 32, MR * 32, (const bf16_t*)(p.ws + OFF_W2), 32, 1024 * 32, 4096, 132, 8, lds, B, G, [&](int row, int col, f32x4 v) {
      float* xo = res_out_row(p, row) + col;
      const f32x4 g2 = *(const f32x4*)(mod_vec(p, layer, row) + 5120 + col);
      if (!dup) *(f32x4*)xo = *(const f32x4*)xo + g2 * v;
    }, [&](int row, int col, f32x4 v0, f32x4 v1) {
      float* xo = res_out_row(p, row) + col;
      const float* gm = mod_vec(p, layer, row) + 5120 + col;
      const f32x4 o0 = __builtin_nontemporal_load((const f32x4*)xo) + *(const f32x4*)gm * v0, o1 = __builtin_nontemporal_load((const f32x4*)(xo + 4)) + *(const f32x4*)(gm + 4) * v1;
      if (!dup) { *(f32x4*)xo = o0; *(f32x4*)(xo + 4) = o1; }
    }, layer == 1);
    PH_END
  }
}

extern "C" void kernel_launch(void* const* d_in, const int* in_sizes, int n_in, void* d_out, int out_size, void* d_ws, size_t ws_size, hipStream_t stream) {
  static int grid_blocks = 0;
  if (!grid_blocks) {
    int dev = 0, cus = 0, per_cu = 0;
    hipGetDevice(&dev);
    hipDeviceGetAttribute(&cus, hipDeviceAttributeMultiprocessorCount, dev);
    hipOccupancyMaxActiveBlocksPerMultiprocessor(&per_cu, mega, 256, 0);
    if (per_cu > 2) per_cu = 2;
    grid_blocks = cus * per_cu;
    grid_blocks -= grid_blocks % 8;
  }
  Params p{};
  const float** f = (const float**)&p;
  for (int i = 0; i < 26; ++i) f[i] = (const float*)d_in[i];
  p.out = (float*)d_out;
  p.ws = (char*)d_ws;
  p.probe = PROBE_MASK;
  if (ws_size < WS_TOTAL) { fprintf(stderr, "workspace too small: %zu < %zu\n", ws_size, (size_t)WS_TOTAL); return; }
  hipMemsetAsync((char*)d_ws + OFF_CTR, 0, 256 + 16384, stream);
  void* args[] = {&p};
  hipError_t e = hipLaunchCooperativeKernel((void*)mega, dim3(grid_blocks), dim3(256), args, 0, stream);
  if (e != hipSuccess) fprintf(stderr, "cooperative launch failed: %s (grid %d)\n", hipGetErrorString(e), grid_blocks);
}
```

```cpp
#include <hip/hip_runtime.h>
#include <hip/hip_cooperative_groups.h>
#include <cstdint>
#include <cstdio>
namespace cg = cooperative_groups;

#define DI __device__ __forceinline__
typedef unsigned short bf16_t;
typedef short bf16x8 __attribute__((ext_vector_type(8)));
typedef float f32x4 __attribute__((ext_vector_type(4)));
typedef float f32x2 __attribute__((ext_vector_type(2)));
typedef unsigned u32x4 __attribute__((ext_vector_type(4)));
typedef unsigned u32x2 __attribute__((ext_vector_type(2)));
typedef __bf16 bf16x2_t __attribute__((ext_vector_type(2)));

constexpr int DM = 1024, NB = 4, TL = 8192, TC = 256, TT = 8448, MR = NB * TT;
constexpr int LDP = 4736;
constexpr int C_DAQ = 0, C_DAK = 512, C_DAV = 1024, C_LX = 1536, C_LY = 2048, C_GQKV = 2560, C_GZ = 4096, C_GBA = 4608;
constexpr int NCH = 132;
constexpr float EPS = 1e-6f;
constexpr int LDS_BYTES = 77824;

constexpr size_t al256(size_t x) { return (x + 255) & ~(size_t)255; }
constexpr size_t OFF_WIN = 0;
constexpr size_t OFF_WBR = OFF_WIN + al256((size_t)7808 * 1024 * 2);
constexpr size_t OFF_WO = OFF_WBR + al256((size_t)3 * 1024 * 512 * 2);
constexpr size_t OFF_W1 = OFF_WO + al256((size_t)1024 * 1024 * 2);
constexpr size_t OFF_W2 = OFF_W1 + al256((size_t)4096 * 1024 * 2);
constexpr size_t OFF_LG = OFF_W2 + al256((size_t)4096 * 1024 * 2);
constexpr size_t OFF_P = OFF_LG + al256((size_t)32 * 4096 * 2);
constexpr size_t OFF_H = OFF_P + al256((size_t)MR * LDP * 2);
constexpr size_t OFF_VT = OFF_H + al256((size_t)MR * 1024 * 2);
constexpr size_t OFF_OB = OFF_VT + al256((size_t)MR * 512 * 2);
constexpr size_t OFF_HALO = OFF_OB + al256((size_t)MR * 512 * 2);
constexpr size_t OFF_GBA = OFF_HALO + al256((size_t)528 * 3 * 1536 * 2);
constexpr size_t OFF_GSC = OFF_GBA + al256((size_t)MR * 16 * 4);
constexpr size_t OFF_LC = OFF_GSC + al256((size_t)4224 * 192 * 4);
constexpr size_t OFF_CTX = OFF_LC + al256((size_t)4 * NCH * 8 * 2 * 64 * 8);
constexpr size_t OFF_MOD = OFF_CTX + al256((size_t)4 * 256 * 1024 * 4);
constexpr size_t OFF_ROPE = OFF_MOD + al256((size_t)2 * 5 * 6144 * 4);
constexpr size_t OFF_CTR = OFF_ROPE + al256((size_t)8192 * 32 * 8);
constexpr size_t WS_TOTAL = OFF_CTR + 256 + 16384;
static_assert(WS_TOTAL <= (size_t)536870912, "workspace map too large");

struct Params {
  const float *x, *c, *ctx, *cctx, *ada_w, *ada_b, *n1g, *n2g, *w_in, *daqg, *dakg, *dalam, *dasub, *lcw, *lcb, *lgw, *lgb, *llam,
      *gcw, *galog, *gdtb, *gng, *wbr, *wout, *w1, *w2;
  float* out;
  char* ws;
  int probe;
  int pad_;
};

DI unsigned pk2(float lo, float hi) { f32x2 v = {lo, hi}; bf16x2_t b = __builtin_convertvector(v, bf16x2_t); return __builtin_bit_cast(unsigned, b); }
DI bf16_t f2bf(float f) { return (bf16_t)(pk2(f, 0.f) & 0xffffu); }
DI float bf2f(bf16_t u) { return __uint_as_float(((unsigned)u) << 16); }
DI float bflo(unsigned w) { return __uint_as_float(w << 16); }
DI float bfhi(unsigned w) { return __uint_as_float(w & 0xffff0000u); }
DI int otid() { int t = __builtin_amdgcn_workitem_id_x(); asm volatile("" : "+v"(t)); return t; }
template <int M> DI float shx(float v) { return __int_as_float(__builtin_amdgcn_ds_swizzle(__float_as_int(v), (M << 10) | 0x1f)); }
DI float add32(float v) { auto r = __builtin_amdgcn_permlane32_swap(__float_as_uint(v), __float_as_uint(v), false, false); return __uint_as_float(r[0]) + __uint_as_float(r[1]); }
DI float max32(float v) { auto r = __builtin_amdgcn_permlane32_swap(__float_as_uint(v), __float_as_uint(v), false, false); return fmaxf(__uint_as_float(r[0]), __uint_as_float(r[1])); }
DI float wsum(float v) { v += shx<1>(v); v += shx<2>(v); v += shx<4>(v); v += shx<8>(v); v += shx<16>(v); return add32(v); }
DI float wmax(float v) { v = fmaxf(v, shx<1>(v)); v = fmaxf(v, shx<2>(v)); v = fmaxf(v, shx<4>(v)); v = fmaxf(v, shx<8>(v)); v = fmaxf(v, shx<16>(v)); return max32(v); }
DI float sigm(float x) { return 1.f / (1.f + __expf(-x)); }
DI float softplusf(float x) { return x > 20.f ? x : log1pf(expf(x)); }
DI f32x4 mfma16(bf16x8 a, bf16x8 b, f32x4 c) { return __builtin_amdgcn_mfma_f32_16x16x32_bf16(a, b, c, 0, 0, 0); }

DI const float* res_in_row(const Params& p, int layer, int r) {
  const int b = r / TT, s = r % TT;
  if (layer == 0) return s < TC ? p.ctx + ((size_t)b * TC + s) * DM : p.x + ((size_t)b * TL + (s - TC)) * DM;
  return s < TC ? (const float*)(p.ws + OFF_CTX) + ((size_t)b * TC + s) * DM : p.out + ((size_t)b * TL + (s - TC)) * DM;
}
DI float* res_out_row(const Params& p, int r) {
  const int b = r / TT, s = r % TT;
  return s < TC ? (float*)(p.ws + OFF_CTX) + ((size_t)b * TC + s) * DM : p.out + ((size_t)b * TL + (s - TC)) * DM;
}
DI const float* mod_vec(const Params& p, int layer, int r) {
  const int b = r / TT, s = r % TT;
  return (const float*)(p.ws + OFF_MOD) + (size_t)(layer * 5 + (s < TC ? 4 : b)) * 6144;
}

template <int WN>
DI void gemm_core(const bf16_t* __restrict__ A, int lda, int a_ks, const bf16_t* __restrict__ Bt, int ldb, int b_ks, int K, f32x4 (&acc)[4][WN], char* lds) {
  constexpr int BN = 32 * WN, AST = 72, NBP = BN * 8 / 256;
  bf16_t* As = (bf16_t*)lds;
  bf16_t* Bs = As + 2 * 128 * AST;
  const int tid = otid(), lane = tid & 63, wid = tid >> 6, wr = wid >> 1, wc = wid & 1;
  u32x4 ra[4], rb[NBP];
  const int nk = K / 64;
#define GLOAD(k0)                                                                                                            \
  {                                                                                                                          \
    _Pragma("unroll") for (int i = 0; i < 4; ++i) { const int q = tid + 256 * i; ra[i] = *(const u32x4*)(A + (size_t)(q >> 3) * lda + (size_t)(((k0) >> 5) + ((q & 7) >> 2)) * a_ks + (q & 3) * 8); } \
    _Pragma("unroll") for (int i = 0; i < NBP; ++i) { const int q = tid + 256 * i; rb[i] = *(const u32x4*)(Bt + (size_t)(q >> 3) * ldb + (size_t)(((k0) >> 5) + ((q & 7) >> 2)) * b_ks + (q & 3) * 8); } \
  }
#define SSTORE(buf)                                                                                                          \
  {                                                                                                                          \
    _Pragma("unroll") for (int i = 0; i < 4; ++i) { const int q = tid + 256 * i; *(u32x4*)(As + ((buf) * 128 + (q >> 3)) * AST + (q & 7) * 8) = ra[i]; } \
    _Pragma("unroll") for (int i = 0; i < NBP; ++i) { const int q = tid + 256 * i; *(u32x4*)(Bs + ((buf) * BN + (q >> 3)) * AST + (q & 7) * 8) = rb[i]; } \
  }
  GLOAD(0);
  SSTORE(0);
  __syncthreads();
  for (int t = 0; t < nk; ++t) {
    if (t + 1 < nk) GLOAD((t + 1) * 64);
    const bf16_t* a = As + ((t & 1) * 128 + wr * 64 + (lane & 15)) * AST + (lane >> 4) * 8;
    const bf16_t* b = Bs + ((t & 1) * BN + wc * 16 * WN + (lane & 15)) * AST + (lane >> 4) * 8;
#pragma unroll
    for (int ks = 0; ks < 2; ++ks) {
      bf16x8 af[4], bfr[WN];
#pragma unroll
      for (int i = 0; i < 4; ++i) af[i] = *(const bf16x8*)(a + i * 16 * AST + ks * 32);
#pragma unroll
      for (int j = 0; j < WN; ++j) bfr[j] = *(const bf16x8*)(b + j * 16 * AST + ks * 32);
      __builtin_amdgcn_sched_barrier(0);
#pragma unroll
      for (int i = 0; i < 4; ++i)
#pragma unroll
        for (int j = 0; j < WN; ++j) acc[i][j] = mfma16(bfr[j], af[i], acc[i][j]);
      __builtin_amdgcn_sched_barrier(0);
    }
    if (t + 1 < nk) SSTORE((t + 1) & 1);
    __syncthreads();
  }
#undef GLOAD
#undef SSTORE
}
DI void tile_mn(int t, int nm, int nn, int& mi, int& ni) {
  const int nig = 16 * nn, g = t / nig, rem = t % nig, fm = g * 16;
  const int gsz = (nm - fm) < 16 ? (nm - fm) : 16;
  mi = fm + rem % gsz;
  ni = rem / gsz;
}
template <int WN, class Epi>
DI void gemm_emit(const f32x4 (&acc)[4][WN], int m0, int n0, Epi epi) {
  const int lane = otid() & 63, wid = otid() >> 6, wr = wid >> 1, wc = wid & 1;
#pragma unroll
  for (int i = 0; i < 4; ++i)
#pragma unroll
    for (int j = 0; j < WN; ++j) epi(m0 + wr * 64 + i * 16 + (lane & 15), n0 + wc * 16 * WN + j * 16 + (lane >> 4) * 4, acc[i][j]);
}
template <int WN>
DI void zero_acc(f32x4 (&acc)[4][WN]) {
#pragma unroll
  for (int i = 0; i < 4; ++i)
#pragma unroll
    for (int j = 0; j < WN; ++j) acc[i][j] = (f32x4){0.f, 0.f, 0.f, 0.f};
}

DI void gemm_core2(const bf16_t* __restrict__ A, int lda, int a_ks, const bf16_t* __restrict__ Bt, int ldb, int b_ks, int K, f32x4 (&acc)[8][4], char* lds) {
  constexpr int AST = 48;
  bf16_t* As = (bf16_t*)lds;
  bf16_t* Bs = As + 2 * 256 * AST;
  const int tid = otid(), lane = tid & 63, wid = tid >> 6, wr = wid >> 1, wc = wid & 1;
  u32x4 s0a[4], s0b[2], s1a[4], s1b[2];
  const int nk = K / 32;
  const bf16_t* ag = A + (size_t)(tid >> 2) * lda + (tid & 3) * 8;
  const bf16_t* bg = Bt + (size_t)(tid >> 2) * ldb + (tid & 3) * 8;
  const int bc_ = tid >> 2, brow = ((bc_ >> 5) * 2 + ((bc_ >> 2) & 1)) * 16 + ((bc_ >> 3) & 3) * 4 + (bc_ & 3);
#define LBAR() { asm volatile("s_waitcnt lgkmcnt(0)" ::: "memory"); __builtin_amdgcn_s_barrier(); asm volatile("" ::: "memory"); }
#define GLOAD2(ra, rb, k0)                                                                                                   \
  {                                                                                                                          \
    _Pragma("unroll") for (int i = 0; i < 4; ++i) ra[i] = *(const u32x4*)(ag + (size_t)(64 * i) * lda + (size_t)((k0) >> 5) * a_ks);               \
    _Pragma("unroll") for (int i = 0; i < 2; ++i) rb[i] = *(const u32x4*)(bg + (size_t)(64 * i) * ldb + (size_t)((k0) >> 5) * b_ks);               \
  }
#define SSTORE2(ra, rb, buf)                                                                                                 \
  {                                                                                                                          \
    _Pragma("unroll") for (int i = 0; i < 4; ++i) *(u32x4*)(As + ((buf) * 256 + 64 * i + (tid >> 2)) * AST + (tid & 3) * 8) = ra[i]; \
    _Pragma("unroll") for (int i = 0; i < 2; ++i) *(u32x4*)(Bs + ((buf) * 128 + 64 * i + brow) * AST + (tid & 3) * 8) = rb[i]; \
  }
#define STEP2(t, la, lb, sa, sb)                                                                                             \
  {                                                                                                                          \
    if ((t) + 2 < nk) GLOAD2(la, lb, ((t) + 2) * 32);                                                                        \
    const bf16_t* a = As + (((t) & 1) * 256 + wr * 128 + (lane & 15)) * AST + (lane >> 4) * 8;                               \
    const bf16_t* b = Bs + (((t) & 1) * 128 + wc * 64 + (lane & 15)) * AST + (lane >> 4) * 8;                                \
    bf16x8 bfr[4], a0[4], a1[4];                                                                                             \
    _Pragma("unroll") for (int j = 0; j < 4; ++j) bfr[j] = *(const bf16x8*)(b + j * 16 * AST);                               \
    _Pragma("unroll") for (int i = 0; i < 4; ++i) a0[i] = *(const bf16x8*)(a + i * 16 * AST);                                \
    __builtin_amdgcn_sched_barrier(0);                                                                                       \
    _Pragma("unroll") for (int i = 0; i < 4; ++i) a1[i] = *(const bf16x8*)(a + (4 + i) * 16 * AST);                          \
    __builtin_amdgcn_sched_barrier(0);                                                                                       \
    _Pragma("unroll") for (int i = 0; i < 4; ++i) _Pragma("unroll") for (int j = 0; j < 4; ++j) acc[i][j] = mfma16(bfr[j], a0[i], acc[i][j]); \
    __builtin_amdgcn_sched_barrier(0);                                                                                       \
    _Pragma("unroll") for (int i = 0; i < 4; ++i) _Pragma("unroll") for (int j = 0; j < 4; ++j) acc[4 + i][j] = mfma16(bfr[j], a1[i], acc[4 + i][j]); \
    __builtin_amdgcn_sched_barrier(0);                                                                                       \
    if ((t) + 1 < nk) SSTORE2(sa, sb, ((t) + 1) & 1);                                                                        \
    LBAR();                                                                                                                  \
  }
  GLOAD2(s0a, s0b, 0);
  SSTORE2(s0a, s0b, 0);
  GLOAD2(s1a, s1b, 32);
  LBAR();
  int t = 0;
  for (;;) {
    STEP2(t, s0a, s0b, s1a, s1b);
    if (++t >= nk) break;
    STEP2(t, s1a, s1b, s0a, s0b);
    if (++t >= nk) break;
  }
#undef GLOAD2
#undef SSTORE2
#undef STEP2
}
DI void tile_mn8(int t, int nm, int nn, int& mi, int& ni) {
  const int nig = 8 * nn, g = t / nig, rem = t % nig, fm = g * 8;
  const int gsz = (nm - fm) < 8 ? (nm - fm) : 8;
  mi = fm + rem % gsz;
  ni = rem / gsz;
}
template <class Epi, class Epi8>
DI void gemm_phase(const bf16_t* A, int lda, int a_ks, const bf16_t* Bt, int ldb, int b_ks, int K, int nm, int nn, char* lds, int B, int G, Epi epi, Epi8 epi8, bool skipctx = false) {
  if (skipctx) nm -= 4;
  const int NT = nm * nn;
  int nfull = (NT / G) * G, R = NT - nfull;
  if (4 * R > 2 * G) { nfull = NT; R = 0; }
  for (int t = B; t < nfull + 4 * R; t += G) {
    int mi, ni;
    if (t < nfull) {
      tile_mn8(t, nm, nn, mi, ni);
      if (skipctx) mi += (mi >> 5) + 1;
      f32x4 acc[8][4];
#pragma unroll
      for (int i = 0; i < 8; ++i)
#pragma unroll
        for (int j = 0; j < 4; ++j) acc[i][j] = (f32x4){0.f, 0.f, 0.f, 0.f};
      gemm_core2(A + (size_t)mi * 256 * lda, lda, a_ks, Bt + (size_t)ni * 128 * ldb, ldb, b_ks, K, acc, lds);
      const int lane = otid() & 63, wid = otid() >> 6, wr = wid >> 1, wc = wid & 1;
#pragma unroll
      for (int i = 0; i < 8; ++i)
#pragma unroll
        for (int jp = 0; jp < 2; ++jp) epi8(mi * 256 + wr * 128 + i * 16 + (lane & 15), ni * 128 + wc * 64 + jp * 32 + (lane >> 4) * 8, acc[i][2 * jp], acc[i][2 * jp + 1]);
    } else {
      const int u = t - nfull, sub = u & 3;
      tile_mn8(nfull + (u >> 2), nm, nn, mi, ni);
      if (skipctx) mi += (mi >> 5) + 1;
      const int m0 = mi * 256 + (sub >> 1) * 128, n0 = ni * 128 + (sub & 1) * 64;
      f32x4 acc[4][2]; zero_acc<2>(acc);
      gemm_core<2>(A + (size_t)m0 * lda, lda, a_ks, Bt + (size_t)n0 * ldb, ldb, b_ks, K, acc, lds);
      gemm_emit<2>(acc, m0, n0, epi);
    }
  }
}
DI int sg_col(int gc) { const int j = gc >> 7; return (j < 12 ? 512 + 128 * j : 2560 + 128 * (j - 12)) + (gc & 127); }

constexpr int N_CVT = 1152 + 32 + 768 + 384 + 256 + 1024 + 1024 + 32;
DI void job_cvt(const Params& p, int layer, int t, char* lds) {
  const float* src; int ld, ncol0 = 0, nlim, K, ntot, nrow0 = 0; bf16_t* dst;
  char* ws = p.ws;
  if (t < 1152) { src = p.w_in + (size_t)layer * 1024 * 7696; ld = 7696; ncol0 = 0; nlim = 4608; dst = (bf16_t*)(ws + OFF_WIN); K = 1024; ntot = 7808; nrow0 = 0; }
  else if ((t -= 1152) < 32) { src = p.w_in + (size_t)layer * 1024 * 7696; ld = 7696; ncol0 = 4608; nlim = 4624; dst = (bf16_t*)(ws + OFF_WIN); K = 1024; ntot = 7808; nrow0 = 4608; }
  else if ((t -= 32) < 768) { src = p.w_in + (size_t)layer * 1024 * 7696; ld = 7696; ncol0 = 4624; nlim = 7696; dst = (bf16_t*)(ws + OFF_WIN); K = 1024; ntot = 7808; nrow0 = 4736; }
  else if ((t -= 768) < 384) { const int i = t / 128; t %= 128; src = p.wbr + ((size_t)layer * 3 + i) * 512 * 1024; ld = 1024; nlim = 1024; dst = (bf16_t*)(ws + OFF_WBR) + (size_t)i * 1024 * 512; K = 512; ntot = 1024; }
  else if ((t -= 384) < 256) { src = p.wout + (size_t)layer * 1024 * 1024; ld = 1024; nlim = 1024; dst = (bf16_t*)(ws + OFF_WO); K = 1024; ntot = 1024; }
  else if ((t -= 256) < 1024) { src = p.w1 + (size_t)layer * 1024 * 4096; ld = 4096; nlim = 4096; dst = (bf16_t*)(ws + OFF_W1); K = 1024; ntot = 4096; }
  else if ((t -= 1024) < 1024) { src = p.w2 + (size_t)layer * 4096 * 1024; ld = 1024; nlim = 1024; dst = (bf16_t*)(ws + OFF_W2); K = 4096; ntot = 1024; }
  else { t -= 1024; src = p.lgw + ((size_t)layer * 32 + t) * 4096; ld = 64; nlim = 64; dst = (bf16_t*)(ws + OFF_LG) + (size_t)t * 4096; K = 64; ntot = 0; t = 0; }
  const int nkt = K / 64, nt = t / nkt, kt = t % nkt;
  float* tl = (float*)lds;
  const int tid = otid();
  {
    const int c4 = (tid & 15) * 4, ncol = ncol0 + nt * 64 + c4;
#pragma unroll
    for (int i = 0; i < 4; ++i) {
      const int kk = i * 16 + (tid >> 4);
      f32x4 v = {0.f, 0.f, 0.f, 0.f};
      if (ncol + 3 < nlim) v = __builtin_nontemporal_load((const f32x4*)(src + (size_t)(kt * 64 + kk) * ld + ncol));
      tl[kk * 65 + c4] = v[0]; tl[kk * 65 + c4 + 1] = v[1]; tl[kk * 65 + c4 + 2] = v[2]; tl[kk * 65 + c4 + 3] = v[3];
    }
  }
  __syncthreads();
  {
    const int n = tid >> 2, kq = tid & 3;
    float v[16];
#pragma unroll
    for (int e = 0; e < 16; ++e) v[e] = tl[(kq * 16 + e) * 65 + n];
    u32x4 w0 = {pk2(v[0], v[1]), pk2(v[2], v[3]), pk2(v[4], v[5]), pk2(v[6], v[7])};
    u32x4 w1 = {pk2(v[8], v[9]), pk2(v[10], v[11]), pk2(v[12], v[13]), pk2(v[14], v[15])};
    const int nd = nrow0 + nt * 64 + n, kd = kt * 64 + kq * 16;
    bf16_t* d = ntot ? dst + ((size_t)(kd >> 5) * ntot + nd) * 32 + (kd & 31) : dst + (size_t)nd * K + kd;
    *(u32x4*)d = w0;
    *(u32x4*)(d + 8) = w1;
  }
  __syncthreads();
}
DI void job_mod(const Params& p, int it, char* lds) {
  const int nc = it % 96, l = it / 96, tid = otid();
  float* sc = (float*)lds;
  float* red = sc + 5 * 1024;
  for (int i = tid; i < 5 * 1024; i += 256) {
    const int v = i >> 10, k = i & 1023;
    const float cv = v < 4 ? p.c[v * 1024 + k] : p.cctx[k];
    sc[i] = cv * sigm(cv);
  }
  __syncthreads();
  const int col = tid & 63, kg = tid >> 6, n = nc * 64 + col;
  const float* w = p.ada_w + ((size_t)l * 1024 + kg * 256) * 6144 + n;
  const float* s0 = sc + kg * 256;
  float a0 = 0, a1 = 0, a2 = 0, a3 = 0, a4 = 0;
#pragma unroll 8
  for (int k = 0; k < 256; ++k) {
    const float wv = __builtin_nontemporal_load(w + (size_t)k * 6144);
    a0 += s0[k] * wv; a1 += s0[1024 + k] * wv; a2 += s0[2048 + k] * wv; a3 += s0[3072 + k] * wv; a4 += s0[4096 + k] * wv;
  }
  red[(kg * 5 + 0) * 64 + col] = a0; red[(kg * 5 + 1) * 64 + col] = a1; red[(kg * 5 + 2) * 64 + col] = a2; red[(kg * 5 + 3) * 64 + col] = a3; red[(kg * 5 + 4) * 64 + col] = a4;
  __syncthreads();
  for (int i = tid; i < 320; i += 256) {
    const int v = i >> 6, cc = i & 63;
    const float r = ((red[(0 * 5 + v) * 64 + cc] + red[(1 * 5 + v) * 64 + cc]) + (red[(2 * 5 + v) * 64 + cc] + red[(3 * 5 + v) * 64 + cc])) + p.ada_b[l * 6144 + nc * 64 + cc];
    ((float*)(p.ws + OFF_MOD))[(size_t)(l * 5 + v) * 6144 + nc * 64 + cc] = r;
  }
  __syncthreads();
}
DI void job_rope(const Params& p, int it) {
  const int idx = it * 256 + otid(), t = idx >> 5, ax = (idx >> 4) & 1, f = idx & 15;
  const float inv = powf(10000.f, -(float)f / 16.f);
  const float pos = (float)(ax ? (t & 63) : (t >> 6));
  float s, c;
  sincosf(pos * inv, &s, &c);
  ((f32x2*)(p.ws + OFF_ROPE))[idx] = (f32x2){c, s};
}
DI void job_norm(const Params& p, int layer, int which, int it) {
  const int lane = otid() & 63, wid = otid() >> 6, r = it * 8 + wid;
  const float* xr0 = (which == 1) ? res_in_row(p, layer, r) : (const float*)res_out_row(p, r);
  const float* xr1 = (which == 1) ? res_in_row(p, layer, r + 4) : (const float*)res_out_row(p, r + 4);
  const float* mv = mod_vec(p, layer, r);
  const float* sh = mv + (which == 1 ? 0 : 3072);
  const float* sc = mv + (which == 1 ? 1024 : 4096);
  const float* g = (which == 1 ? p.n1g : p.n2g) + layer * 1024;
  f32x4 xa[4], xb[4];
#pragma unroll
  for (int i = 0; i < 2; ++i)
#pragma unroll
    for (int hf = 0; hf < 2; ++hf) {
      xa[2 * i + hf] = __builtin_nontemporal_load((const f32x4*)(xr0 + i * 512 + lane * 8 + hf * 4));
      xb[2 * i + hf] = __builtin_nontemporal_load((const f32x4*)(xr1 + i * 512 + lane * 8 + hf * 4));
    }
  float sa = 0.f, sb = 0.f;
#pragma unroll
  for (int i = 0; i < 4; ++i) {
    sa += xa[i][0] * xa[i][0] + xa[i][1] * xa[i][1] + xa[i][2] * xa[i][2] + xa[i][3] * xa[i][3];
    sb += xb[i][0] * xb[i][0] + xb[i][1] * xb[i][1] + xb[i][2] * xb[i][2] + xb[i][3] * xb[i][3];
  }
  sa = wsum(sa); sb = wsum(sb);
  const float ra = rsqrtf(sa * (1.f / 1024.f) + EPS), rb = rsqrtf(sb * (1.f / 1024.f) + EPS);
  bf16_t* H0 = (bf16_t*)(p.ws + OFF_H) + (size_t)r * 32;
  bf16_t* H1 = H0 + 4 * 32;
#pragma unroll
  for (int i = 0; i < 2; ++i) {
    const int c = i * 512 + lane * 8;
    float o[8], q[8];
#pragma unroll
    for (int hf = 0; hf < 2; ++hf) {
      const f32x4 gv = *(const f32x4*)(g + c + hf * 4), sv = *(const f32x4*)(sc + c + hf * 4), hv = *(const f32x4*)(sh + c + hf * 4);
#pragma unroll
      for (int e = 0; e < 4; ++e) { const float m = gv[e] * (1.f + sv[e]); o[hf * 4 + e] = xa[2 * i + hf][e] * ra * m + hv[e]; q[hf * 4 + e] = xb[2 * i + hf][e] * rb * m + hv[e]; }
    }
    const size_t so = (size_t)(c >> 5) * MR * 32 + (c & 31);
    *(u32x4*)(H0 + so) = (u32x4){pk2(o[0], o[1]), pk2(o[2], o[3]), pk2(o[4], o[5]), pk2(o[6], o[7])};
    *(u32x4*)(H1 + so) = (u32x4){pk2(q[0], q[1]), pk2(q[2], q[3]), pk2(q[4], q[5]), pk2(q[6], q[7])};
  }
}

DI void job_daprep1(const Params& p, int layer, int r, bool dup) {
  const int lane = otid() & 63, s = r % TT;
  const int G = lane >> 2, quarter = lane & 3;
  bf16_t* ptr = (bf16_t*)(p.ws + OFF_P) + (size_t)r * LDP + (G < 8 ? C_DAQ + G * 64 : C_DAK + (G - 8) * 64) + quarter * 16;
  const u32x4 w0 = *(const u32x4*)ptr, w1 = *(const u32x4*)(ptr + 8);
  float y[16];
#pragma unroll
  for (int e = 0; e < 4; ++e) { y[2 * e] = bflo(w0[e]); y[2 * e + 1] = bfhi(w0[e]); y[8 + 2 * e] = bflo(w1[e]); y[9 + 2 * e] = bfhi(w1[e]); }
  float ss = 0.f;
#pragma unroll
  for (int e = 0; e < 16; ++e) ss += y[e] * y[e];
  ss += shx<1>(ss);
  ss += shx<2>(ss);
  float rstd = rsqrtf(ss * (1.f / 64.f) + EPS);
  const float* g = (G < 8 ? p.daqg : p.dakg) + layer * 64 + quarter * 16;
#pragma unroll
  for (int e = 0; e < 16; ++e) y[e] = y[e] * rstd * g[e];
  if (s >= TC) {
    const f32x2* tb = (const f32x2*)(p.ws + OFF_ROPE) + ((size_t)(s - TC) * 2 + (quarter >> 1)) * 16;
#pragma unroll
    for (int e = 0; e < 16; ++e) {
      const float yp = shx<1>(y[e]);
      const f32x2 cs = tb[e];
      y[e] = (quarter & 1) ? (y[e] * cs.x + yp * cs.y) : (y[e] * cs.x - yp * cs.y);
    }
  }
  if (G < 8) {
#pragma unroll
    for (int e = 0; e < 16; ++e) y[e] *= 0.125f * 1.4426950408889634f;
  }
  if (dup) return;
  *(u32x4*)ptr = (u32x4){pk2(y[0], y[1]), pk2(y[2], y[3]), pk2(y[4], y[5]), pk2(y[6], y[7])};
  *(u32x4*)(ptr + 8) = (u32x4){pk2(y[8], y[9]), pk2(y[10], y[11]), pk2(y[12], y[13]), pk2(y[14], y[15])};
}
DI void job_daprep(const Params& p, int layer, int it, bool dup) {
  const int wid = otid() >> 6;
#pragma unroll
  for (int rr = 0; rr < 2; ++rr) job_daprep1(p, layer, it * 8 + rr * 4 + wid, dup);
}
DI void job_vt(const Params& p, int it, char* lds) {
  const int h = it & 3, c = (it >> 2) % NCH, b = it / (4 * NCH), tid = otid();
  bf16_t* tl = (bf16_t*)lds;
  const bf16_t* P = (const bf16_t*)(p.ws + OFF_P);
#pragma unroll
  for (int i = 0; i < 4; ++i) {
    const int q = tid + 256 * i, row = q >> 4, pc = q & 15;
    const u32x4 w = *(const u32x4*)(P + (size_t)(b * TT + c * 64 + row) * LDP + C_DAV + h * 128 + pc * 8);
    unsigned* d = (unsigned*)(tl + row * 130 + pc * 8);
    d[0] = w[0]; d[1] = w[1]; d[2] = w[2]; d[3] = w[3];
  }
  __syncthreads();
  {
    const int dv = tid >> 1, half = tid & 1;
    unsigned o[16];
#pragma unroll
    for (int e = 0; e < 16; ++e) o[e] = (unsigned)tl[(half * 32 + 2 * e) * 130 + dv] | ((unsigned)tl[(half * 32 + 2 * e + 1) * 130 + dv] << 16);
    bf16_t* d = (bf16_t*)(p.ws + OFF_VT) + ((size_t)(b * 4 + h) * 128 + dv) * TT + c * 64 + half * 32;
#pragma unroll
#define VTW(w) o[(((w) & 3) >> 1) * 8 + ((w) >> 2) * 2 + ((w) & 1)]
    for (int e = 0; e < 4; ++e) *(u32x4*)(d + e * 8) = (u32x4){VTW(4 * e), VTW(4 * e + 1), VTW(4 * e + 2), VTW(4 * e + 3)};
#undef VTW
  }
  __syncthreads();
}

constexpr int N_ATT = 1056;
DI void job_attn(const Params& p, int layer, int a, char* lds, bool dup) {
  const int tid = otid(), lane = tid & 63, wid = tid >> 6, l15 = lane & 15, g = lane >> 4;
  const int grp = a / 528, within = a % 528, bh = grp * 8 + (within & 7), qb = within >> 3, b = bh >> 2, h = bh & 3;
  if (layer == 1 && qb < 2) return;
  const int nt = qb < 2 ? 4 : NCH;
  bf16_t* P = (bf16_t*)(p.ws + OFF_P);
  const bf16_t* VT = (const bf16_t*)(p.ws + OFF_VT) + (size_t)(b * 4 + h) * 128 * TT;
  int ly_ = layer; asm volatile("" : "+s"(ly_));
  const float lam_init = __uint_as_float(ly_ == 0 ? 0x3e4ccccdu : 0x3eb60549u);
  const float* lv = p.dalam + layer * 256;
  const float lam = __uint_as_float(__builtin_amdgcn_readfirstlane(__float_as_uint(expf(wsum(lv[lane] * lv[64 + lane])) - expf(wsum(lv[128 + lane] * lv[192 + lane])) + lam_init)));
  const float mq = wmax(fabsf(p.daqg[layer * 64 + lane])), mk = wmax(fabsf(p.dakg[layer * 64 + lane]));
  const float negMb = __uint_as_float(__builtin_amdgcn_readfirstlane(__float_as_uint(-(8.f * mq * mk * 1.03f * 1.4426950408889634f + 0.5f))));
  const int r0 = b * TT + qb * 128 + wid * 32;
  bf16x8 qf[2][2][2];
#pragma unroll
  for (int c = 0; c < 2; ++c)
#pragma unroll
    for (int i = 0; i < 2; ++i)
#pragma unroll
      for (int ks = 0; ks < 2; ++ks) qf[c][i][ks] = *(const bf16x8*)(P + (size_t)(r0 + i * 16 + l15) * LDP + C_DAQ + h * 128 + c * 64 + ks * 32 + g * 8);
  bf16_t* Ks = (bf16_t*)lds;
  bf16_t* Vs = Ks + 2 * 64 * 144;
  u32x4 rk[4], rv[4];
  const bf16_t* kg = P + (size_t)(b * TT) * LDP + C_DAK + h * 128;
#define KLOAD(t) { _Pragma("unroll") for (int i = 0; i < 4; ++i) { const int q = tid + 256 * i; rk[i] = *(const u32x4*)(kg + (size_t)((t) * 64 + (q >> 4)) * LDP + (q & 15) * 8); } }
#define VLOAD(t) { _Pragma("unroll") for (int i = 0; i < 4; ++i) { const int q = tid + 256 * i; rv[i] = *(const u32x4*)(VT + (size_t)(q >> 3) * TT + (t) * 64 + (q & 7) * 8); } }
#define KSTORE(buf) { _Pragma("unroll") for (int i = 0; i < 4; ++i) { const int q = tid + 256 * i; *(u32x4*)(Ks + ((buf) * 64 + (q >> 4)) * 144 + (q & 15) * 8) = rk[i]; } }
#define VSTORE(buf) { _Pragma("unroll") for (int i = 0; i < 4; ++i) { const int q = tid + 256 * i; *(u32x4*)(Vs + ((buf) * 128 + (q >> 3)) * 80 + (q & 7) * 8) = rv[i]; } }
#define QK_INTO(S, Kb, half, CI)                                                                                       \
  _Pragma("unroll") for (int c = 0; c < 2; ++c) {                                                                      \
    bf16x8 kf[2][2];                                                                                                   \
    _Pragma("unroll") for (int k2 = 0; k2 < 2; ++k2) _Pragma("unroll") for (int ks = 0; ks < 2; ++ks)                  \
      kf[k2][ks] = *(const bf16x8*)((Kb) + ((half) * 32 + k2 * 16 + l15) * 144 + c * 64 + ks * 32 + g * 8);             \
    __builtin_amdgcn_sched_barrier(0);                                                                                 \
    _Pragma("unroll") for (int k2 = 0; k2 < 2; ++k2) _Pragma("unroll") for (int i = 0; i < 2; ++i) {                   \
      S[c][i][k2] = mfma16(kf[k2][0], qf[c][i][0], CI(c, i));     \
      S[c][i][k2] = mfma16(kf[k2][1], qf[c][i][1], S[c][i][k2]); }                                                     \
  }                                                                                                                    \
  __builtin_amdgcn_sched_barrier(0);
#define EXPSUM(S)                                                                                                      \
  _Pragma("unroll") for (int c = 0; c < 2; ++c) _Pragma("unroll") for (int i = 0; i < 2; ++i) {                        \
    _Pragma("unroll") for (int k2 = 0; k2 < 2; ++k2) _Pragma("unroll") for (int e = 0; e < 4; ++e) S[c][i][k2][e] = __builtin_amdgcn_exp2f(S[c][i][k2][e]); \
    lsum[c][i] += ((S[c][i][0][0] + S[c][i][0][1]) + (S[c][i][0][2] + S[c][i][0][3])) + ((S[c][i][1][0] + S[c][i][1][1]) + (S[c][i][1][2] + S[c][i][1][3])); }
#define EXP_S() _Pragma("unroll") for (int c = 0; c < 2; ++c) _Pragma("unroll") for (int i = 0; i < 2; ++i) _Pragma("unroll") for (int k2 = 0; k2 < 2; ++k2) _Pragma("unroll") for (int e = 0; e < 4; ++e) S[c][i][k2][e] = __builtin_amdgcn_exp2f(S[c][i][k2][e]);
  float lsum[2][2] = {{0.f, 0.f}, {0.f, 0.f}};
  KLOAD(0);
  KSTORE(0);
  __syncthreads();
  const f32x4 negMv = {negMb, negMb, negMb, negMb};
#define CI1(c, i) negMv
  f32x4 SA[2][2][2], SB[2][2][2];
#pragma unroll 1
  for (int t = 0; t < nt; ++t) {
    if (t + 1 < nt) KLOAD(t + 1);
    const bf16_t* Kb = Ks + (t & 1) * 64 * 144;
    QK_INTO(SA, Kb, 0, CI1)
    if (t > 0) { EXPSUM(SB) }
    __builtin_amdgcn_sched_barrier(0);
    QK_INTO(SB, Kb, 1, CI1)
    EXPSUM(SA)
    if (t + 1 < nt) KSTORE((t + 1) & 1);
    __syncthreads();
  }
  EXPSUM(SB)
  f32x4 ci2[2][2];
#pragma unroll
  for (int i = 0; i < 2; ++i) {
    float l0 = lsum[0][i], l1 = lsum[1][i];
    l0 += shx<16>(l0); l0 = add32(l0);
    l1 += shx<16>(l1); l1 = add32(l1);
    const float c0 = negMb - __log2f(l0), c1 = negMb + __log2f(fabsf(lam)) - __log2f(l1);
    ci2[0][i] = (f32x4){c0, c0, c0, c0}; ci2[1][i] = (f32x4){c1, c1, c1, c1};
  }
  const float nsl = lam < 0.f ? 1.f : -1.f;
#define CI2(c, i) ci2[c][i]
  f32x4 O[2][8];
#pragma unroll
  for (int i = 0; i < 2; ++i)
#pragma unroll
    for (int n = 0; n < 8; ++n) O[i][n] = (f32x4){0.f, 0.f, 0.f, 0.f};
  KLOAD(0); VLOAD(0);
  KSTORE(0); VSTORE(0);
  __syncthreads();
#pragma unroll 1
  for (int t = 0; t < nt; ++t) {
    if (t + 1 < nt) KLOAD(t + 1);
    const bf16_t* Kb = Ks + (t & 1) * 64 * 144;
    const bf16_t* Vb = Vs + (t & 1) * 128 * 80;
#pragma unroll
    for (int half = 0; half < 2; ++half) {
      bf16x8 pf[2], vfa[4], vfb[4];
#define VREAD(dst, n0) _Pragma("unroll") for (int n = 0; n < 4; ++n) dst[n] = *(const bf16x8*)(Vb + (((n0) + n) * 16 + l15) * 80 + half * 32 + g * 8);
      {
        f32x4 S[2][2][2];
        QK_INTO(S, Kb, half, CI2)
        VREAD(vfa, 0)
        EXP_S()
#pragma unroll
        for (int i = 0; i < 2; ++i) {
          float w[8];
#pragma unroll
          for (int k2 = 0; k2 < 2; ++k2)
#pragma unroll
            for (int e = 0; e < 4; ++e) w[k2 * 4 + e] = __builtin_fmaf(nsl, S[1][i][k2][e], S[0][i][k2][e]);
          const u32x4 ww = {pk2(w[0], w[1]), pk2(w[2], w[3]), pk2(w[4], w[5]), pk2(w[6], w[7])};
          pf[i] = __builtin_bit_cast(bf16x8, ww);
        }
      }
      __builtin_amdgcn_sched_barrier(0);
      VREAD(vfb, 4)
#pragma unroll
      for (int n = 0; n < 4; ++n)
#pragma unroll
        for (int i = 0; i < 2; ++i) O[i][n] = mfma16(pf[i], vfa[n], O[i][n]);
      __builtin_amdgcn_sched_barrier(0);
#pragma unroll
      for (int n = 0; n < 4; ++n)
#pragma unroll
        for (int i = 0; i < 2; ++i) O[i][4 + n] = mfma16(pf[i], vfb[n], O[i][4 + n]);
      __builtin_amdgcn_sched_barrier(0);
#undef VREAD
      if (half == 0 && t + 1 < nt) VLOAD(t + 1);
    }
    if (t + 1 < nt) { KSTORE((t + 1) & 1); VSTORE((t + 1) & 1); }
    __syncthreads();
  }
#undef KLOAD
#undef VLOAD
#undef KSTORE
#undef VSTORE
#undef CI1
#undef CI2
#undef QK_INTO
#undef EXPSUM
#undef EXP_S
  const int lane_e = otid() & 63, l15e = lane_e & 15, ge = lane_e >> 4;
  const float* sg = p.dasub + layer * 128;
#pragma unroll
  for (int i = 0; i < 2; ++i)
#pragma unroll
    for (int e = 0; e < 4; ++e) {
      float ss = 0.f;
#pragma unroll
      for (int n = 0; n < 8; ++n) ss += O[i][n][e] * O[i][n][e];
      ss += shx<1>(ss); ss += shx<2>(ss); ss += shx<4>(ss); ss += shx<8>(ss);
      const float rstd = rsqrtf(ss * (1.f / 128.f) + EPS) * (1.f - lam_init);
      bf16_t* op = P + (size_t)(r0 + i * 16 + ge * 4 + e) * LDP + C_DAQ + h * 128 + l15e;
#pragma unroll
      for (int n = 0; n < 8; ++n) if (!dup) op[n * 16] = f2bf(O[i][n][e] * rstd * sg[n * 16 + l15e]);
    }
}

DI float gelu_tanh(float x) { const float u = 0.7978845608028654f * (x + 0.044715f * x * x * x); return 0.5f * x * (1.f + tanhf(u)); }
template <int PASS>
DI void job_lru(const Params& p, int layer, int it, char* lds, bool dup) {
  const int tid = otid(), lane = tid & 63, wid = tid >> 6, l15 = lane & 15, g = lane >> 4;
  const int n = it & 7, c = (it >> 3) % NCH, b = it / (8 * NCH);
  float* xc32 = (float*)lds;
  bf16_t* xcb = (bf16_t*)(lds + 16384);
  f32x2* ab = (f32x2*)(lds + 16384 + 9216);
  f32x2* segtot = (f32x2*)(lds + 16384 + 9216 + 32768);
  float* carry = (float*)(lds + 16384 + 9216 + 32768 + 2048);
  bf16_t* P = (bf16_t*)(p.ws + OFF_P);
  f32x2* LC = (f32x2*)(p.ws + OFF_LC);
  const int ch = tid & 63, seg = tid >> 6;
  {
    const int segLo = c < 4 ? 0 : TC, segHi = c < 4 ? TC : TT;
    const int s0 = c * 64 + seg * 16;
    float cw[4];
#pragma unroll
    for (int k = 0; k < 4; ++k) cw[k] = p.lcw[(size_t)(layer * 4 + k) * 512 + n * 64 + ch];
    const float cb = p.lcb[layer * 512 + n * 64 + ch];
    float xw[19];
#pragma unroll
    for (int j = 0; j < 19; ++j) {
      const int s = s0 - 1 + j;
      xw[j] = (s >= segLo && s < segHi) ? bf2f(P[(size_t)(b * TT + s) * LDP + C_LX + n * 64 + ch]) : 0.f;
    }
#pragma unroll
    for (int u = 0; u < 16; ++u) {
      const float v = cw[0] * xw[u] + cw[1] * xw[u + 1] + cw[2] * xw[u + 2] + cw[3] * xw[u + 3] + cb;
      xc32[(seg * 16 + u) * 64 + ch] = v;
      xcb[(seg * 16 + u) * 72 + ch] = f2bf(v);
    }
  }
  if (PASS == 3 && tid < 128) {
    const int d = tid >> 6;
    const int pos = d == 0 ? c : (c < 4 ? 3 - c : 4 + (NCH - 1 - c));
    float hh = 0.f;
    for (int q0 = 0; q0 < pos; q0 += 16) {
      f32x2 AB[16];
#pragma unroll
      for (int j = 0; j < 16; ++j) {
        const int q = q0 + j, qq = q < pos ? q : pos - 1;
        const int cc = d == 0 ? qq : (qq < 4 ? 3 - qq : NCH - 1 - (qq - 4));
        AB[j] = LC[((((size_t)b * NCH + cc) * 8 + n) * 2 + d) * 64 + ch];
      }
#pragma unroll
      for (int j = 0; j < 16; ++j) if (q0 + j < pos) hh = AB[j].x * hh + AB[j].y;
    }
    carry[d * 64 + ch] = hh;
  }
  __syncthreads();
  float hacc[16];
#pragma unroll
  for (int u = 0; u < 16; ++u) hacc[u] = 0.f;
#pragma unroll 1
  for (int d = 0; d < 2; ++d) {
    {
      f32x4 ar[4], ai[4];
#pragma unroll
      for (int i = 0; i < 4; ++i) { ar[i] = (f32x4){0.f, 0.f, 0.f, 0.f}; ai[i] = (f32x4){0.f, 0.f, 0.f, 0.f}; }
      const bf16_t* LG = (const bf16_t*)(p.ws + OFF_LG);
      const bf16_t* wr_ = LG + ((size_t)((d * 2 + 0) * 8 + n)) * 4096 + (wid * 16 + l15) * 64 + g * 8;
      const bf16_t* wi_ = LG + ((size_t)((d * 2 + 1) * 8 + n)) * 4096 + (wid * 16 + l15) * 64 + g * 8;
#pragma unroll
      for (int ks = 0; ks < 2; ++ks) {
        const bf16x8 br = *(const bf16x8*)(wr_ + ks * 32), bi = *(const bf16x8*)(wi_ + ks * 32);
#pragma unroll
        for (int i = 0; i < 4; ++i) {
          const bf16x8 af = *(const bf16x8*)(xcb + (i * 16 + l15) * 72 + ks * 32 + g * 8);
          ar[i] = mfma16(br, af, ar[i]);
          ai[i] = mfma16(bi, af, ai[i]);
        }
      }
#pragma unroll
      for (int e = 0; e < 4; ++e) {
        const int che = wid * 16 + g * 4 + e, cg_ = n * 64 + che;
        const float br = p.lgb[(size_t)((layer * 2 + d) * 2 + 0) * 512 + cg_], bi = p.lgb[(size_t)((layer * 2 + d) * 2 + 1) * 512 + cg_];
        const float sp = softplusf(-p.llam[(size_t)(layer * 2 + d) * 512 + cg_]);
#pragma unroll
        for (int i = 0; i < 4; ++i) {
          const int tok = i * 16 + l15;
          const float r = sigm(ar[i][e] + br), ig = sigm(ai[i][e] + bi);
          const float la = -8.f * r * sp;
          const float av = __expf(la);
          const float bv = __builtin_sqrtf(fmaxf(1.f - __expf(2.f * la), 0.f)) * ig * xc32[tok * 64 + che];
          ab[tok * 64 + che] = (f32x2){av, bv};
        }
      }
    }
    __syncthreads();
    float hloc[16], cploc[16];
    {
      float hp = 0.f, cp = 1.f;
#pragma unroll
      for (int uu = 0; uu < 16; ++uu) {
        const int u = d == 0 ? uu : 15 - uu;
        const f32x2 v = ab[(seg * 16 + u) * 64 + ch];
        hp = v.x * hp + v.y;
        cp *= v.x;
        hloc[uu] = hp; cploc[uu] = cp;
      }
      segtot[seg * 64 + ch] = (f32x2){cp, hp};
    }
    __syncthreads();
    if (PASS == 1) {
      if (tid < 64) {
        float A = 1.f, Bv = 0.f;
#pragma unroll
        for (int q = 0; q < 4; ++q) {
          const f32x2 v = segtot[(d == 0 ? q : 3 - q) * 64 + ch];
          Bv = v.x * Bv + v.y; A *= v.x;
        }
        LC[((((size_t)b * NCH + c) * 8 + n) * 2 + d) * 64 + ch] = (f32x2){A, Bv};
      }
    } else {
      float hh = carry[d * 64 + ch];
      const int npre = d == 0 ? seg : 3 - seg;
      for (int q = 0; q < npre; ++q) {
        const f32x2 v = segtot[(d == 0 ? q : 3 - q) * 64 + ch];
        hh = v.x * hh + v.y;
      }
#pragma unroll
      for (int uu = 0; uu < 16; ++uu) {
        const int u = d == 0 ? uu : 15 - uu;
        const float hv = hloc[uu] + cploc[uu] * hh;
        hacc[d == 0 ? uu : 15 - uu] += hv;
        (void)u;
      }
    }
    __syncthreads();
  }
  if (PASS == 3) {
#pragma unroll
    for (int u = 0; u < 16; ++u) {
      bf16_t* yp = P + (size_t)(b * TT + c * 64 + seg * 16 + u) * LDP + C_LY + n * 64 + ch;
      if (!dup) *yp = f2bf(gelu_tanh(bf2f(*yp)) * hacc[u]);
    }
  }
}

DI void job_gconv(const Params& p, int layer, int it, bool dup) {
  const int tid = otid(), grp = it % 12, cg_ = it / 12, cp = tid & 15, rg = tid >> 4;
  const int cin = cg_ % NCH;
  const bool first = (cin == 0 || cin == 4), last = (cin == 3 || cin == NCH - 1);
  bf16_t* P = (bf16_t*)(p.ws + OFF_P);
  const bf16_t* HALO = (const bf16_t*)(p.ws + OFF_HALO);
  const int col = grp * 128 + cp * 8;
  u32x4 xr[7];
#pragma unroll
  for (int j = 0; j < 7; ++j) {
    const int q = rg * 4 - 1 + j;
    u32x4 v = {0u, 0u, 0u, 0u};
    if (q >= 0 && q < 64) v = *(const u32x4*)(P + (size_t)(cg_ * 64 + q) * LDP + C_GQKV + col);
    else if (q < 0) { if (!first) v = *(const u32x4*)(HALO + ((size_t)(cg_ - 1) * 3 + 2) * 1536 + col); }
    else { if (!last) v = *(const u32x4*)(HALO + ((size_t)(cg_ + 1) * 3 + (q - 64)) * 1536 + col); }
    xr[j] = v;
  }
  float w[4][8];
#pragma unroll
  for (int k = 0; k < 4; ++k) {
    const f32x4 a = *(const f32x4*)(p.gcw + (size_t)(layer * 4 + k) * 1536 + col), bq = *(const f32x4*)(p.gcw + (size_t)(layer * 4 + k) * 1536 + col + 4);
#pragma unroll
    for (int e = 0; e < 4; ++e) { w[k][e] = a[e]; w[k][4 + e] = bq[e]; }
  }
  __syncthreads();
#pragma unroll
  for (int jr = 0; jr < 4; ++jr) {
    float y[8];
#pragma unroll
    for (int e = 0; e < 8; ++e) y[e] = 0.f;
#pragma unroll
    for (int k = 0; k < 4; ++k)
#pragma unroll
      for (int e = 0; e < 4; ++e) { y[2 * e] += w[k][2 * e] * bflo(xr[jr + k][e]); y[2 * e + 1] += w[k][2 * e + 1] * bfhi(xr[jr + k][e]); }
    float ss = 0.f;
#pragma unroll
    for (int e = 0; e < 8; ++e) { y[e] = y[e] * sigm(y[e]); ss += y[e] * y[e]; }
    if (grp < 8) {
      ss += shx<1>(ss); ss += shx<2>(ss); ss += shx<4>(ss); ss += shx<8>(ss);
      const float sc = rsqrtf(ss + EPS) * (grp < 4 ? 0.08838834764831845f : 1.f);
#pragma unroll
      for (int e = 0; e < 8; ++e) y[e] *= sc;
    }
    if (!dup) *(u32x4*)(P + (size_t)(cg_ * 64 + rg * 4 + jr) * LDP + C_GQKV + col) = (u32x4){pk2(y[0], y[1]), pk2(y[2], y[3]), pk2(y[4], y[5]), pk2(y[6], y[7])};
  }
  __syncthreads();
}

DI void job_gprep(const Params& p, int layer, int it, char* lds) {
  const int tid = otid(), lane = tid & 63, wid = tid >> 6, l15 = lane & 15, g = lane >> 4;
  const int h = it & 3, c = (it >> 2) % NCH, b = it / (4 * NCH);
  bf16_t* kt_ = (bf16_t*)lds;
  bf16_t* qt_ = kt_ + 64 * 136;
  float* Ld = (float*)lds;
  float* KK = (float*)(lds + 34816);
  float* QK = KK + 64 * 65;
  float* gcs = QK + 64 * 65;
  float* bts = gcs + 128;
  const bf16_t* P = (const bf16_t*)(p.ws + OFF_P);
#pragma unroll
  for (int i = 0; i < 4; ++i) {
    const int q = tid + 256 * i, row = q >> 4, pc = q & 15;
    const bf16_t* rp = P + (size_t)(b * TT + c * 64 + row) * LDP + C_GQKV + h * 128 + pc * 8;
    *(u32x4*)(qt_ + row * 136 + pc * 8) = *(const u32x4*)rp;
    *(u32x4*)(kt_ + row * 136 + pc * 8) = *(const u32x4*)(rp + 512);
  }
  float* GSC = (float*)(p.ws + OFF_GSC);
  if (tid < 128) {
    const int d = wid, i = lane, tn = d ? 63 - i : i, r = b * TT + c * 64 + tn;
    const float* gba = (const float*)(p.ws + OFF_GBA) + (size_t)r * 16;
    const float gval = -expf(p.galog[(layer * 2 + d) * 4 + h]) * softplusf(gba[8 + d * 4 + h] + p.gdtb[(layer * 2 + d) * 4 + h]);
    const float beta = sigm(gba[d * 4 + h]);
    float v = gval;
#pragma unroll
    for (int o = 1; o < 64; o <<= 1) { const float t = __int_as_float(__builtin_amdgcn_ds_bpermute(((lane - o) & 63) << 2, __float_as_int(v))); if (lane >= o) v += t; }
    const float glast = __int_as_float(__builtin_amdgcn_readlane(__float_as_int(v), 63));
    gcs[d * 64 + i] = v;
    bts[d * 64 + i] = beta;
    float* gs = GSC + (size_t)(it * 2 + d) * 192;
    gs[i] = expf(v);
    gs[64 + i] = expf(glast - v);
    if (i == 0) gs[128] = expf(glast);
  }
  __syncthreads();
  {
    f32x4 akk[4], aqk[4];
#pragma unroll
    for (int j = 0; j < 4; ++j) { akk[j] = (f32x4){0.f, 0.f, 0.f, 0.f}; aqk[j] = (f32x4){0.f, 0.f, 0.f, 0.f}; }
#pragma unroll
    for (int ks = 0; ks < 4; ++ks) {
      const bf16x8 ak = *(const bf16x8*)(kt_ + (wid * 16 + l15) * 136 + ks * 32 + g * 8);
      const bf16x8 aq = *(const bf16x8*)(qt_ + (wid * 16 + l15) * 136 + ks * 32 + g * 8);
#pragma unroll
      for (int j = 0; j < 4; ++j) {
        const bf16x8 bk = *(const bf16x8*)(kt_ + (j * 16 + l15) * 136 + ks * 32 + g * 8);
        akk[j] = mfma16(ak, bk, akk[j]);
        aqk[j] = mfma16(aq, bk, aqk[j]);
      }
    }
#pragma unroll
    for (int j = 0; j < 4; ++j)
#pragma unroll
      for (int e = 0; e < 4; ++e) { KK[(wid * 16 + g * 4 + e) * 65 + j * 16 + l15] = akk[j][e]; QK[(wid * 16 + g * 4 + e) * 65 + j * 16 + l15] = aqk[j][e]; }
  }
  __syncthreads();
  bf16_t* M1 = (bf16_t*)(p.ws + OFF_H);
  bf16_t* AT = M1 + (size_t)4224 * 4096;
#pragma unroll 1
  for (int d = 0; d < 2; ++d) {
    bf16_t* atp = AT + (size_t)(it * 2 + d) * 4096;
#pragma unroll 4
    for (int idx = tid; idx < 4096; idx += 256) {
      const int i = idx >> 6, j = idx & 63, ti = d ? 63 - i : i, tj = d ? 63 - j : j;
      const float dec = (j <= i) ? expf(gcs[d * 64 + i] - gcs[d * 64 + j]) : 0.f;
      Ld[d * 4096 + idx] = (j < i) ? bts[d * 64 + i] * KK[ti * 65 + tj] * dec : 0.f;
      atp[idx] = f2bf(QK[ti * 65 + tj] * dec);
    }
  }
  __syncthreads();
  if (wid < 2) {
    const int d = wid;
    const float* L = Ld + d * 4096;
    const float bc = bts[d * 64 + lane];
    bf16_t* mp = M1 + (size_t)(it * 2 + d) * 4096 + lane;
    float x[64];
#pragma unroll
    for (int i = 0; i < 64; ++i) {
      float s = (i == lane) ? 1.f : 0.f;
#pragma unroll
      for (int j = 0; j < i; ++j) s -= L[i * 64 + j] * x[j];
      x[i] = s;
      mp[i * 64] = f2bf(s * bc);
    }
  }
  __syncthreads();
}

struct GChunk { bf16x8 kf[4], qf[4], m1f[2], atf[2]; unsigned vr[2][4]; float eg[4], egl[4]; float ge; };
DI void gdn_load(GChunk& R, const Params& p, int b, int h, int d, int dvs, int c) {
  const int tid = otid(), lane = tid & 63, wid = tid >> 6, l15 = lane & 15, g = lane >> 4;
  const bf16_t* P = (const bf16_t*)(p.ws + OFF_P);
  const bf16_t* M1 = (const bf16_t*)(p.ws + OFF_H);
  const bf16_t* AT = M1 + (size_t)4224 * 4096;
  const float* GSC = (const float*)(p.ws + OFF_GSC);
  const int item = ((b * NCH + c) * 4 + h) * 2 + d;
  const int irow = 16 * wid + l15, tn = d ? 63 - irow : irow;
  const bf16_t* rowp = P + (size_t)(b * TT + c * 64 + tn) * LDP + C_GQKV + h * 128;
#pragma unroll
  for (int ks = 0; ks < 4; ++ks) { R.qf[ks] = *(const bf16x8*)(rowp + ks * 32 + g * 8); R.kf[ks] = *(const bf16x8*)(rowp + 512 + ks * 32 + g * 8); }
#pragma unroll
  for (int ks = 0; ks < 2; ++ks) {
    R.m1f[ks] = *(const bf16x8*)(M1 + (size_t)item * 4096 + irow * 64 + ks * 32 + g * 8);
    R.atf[ks] = *(const bf16x8*)(AT + (size_t)item * 4096 + irow * 64 + ks * 32 + g * 8);
  }
#pragma unroll
  for (int e = 0; e < 4; ++e) {
    const int i = 16 * wid + g * 4 + e, t2 = d ? 63 - i : i;
    R.vr[0][e] = *(const unsigned*)(P + (size_t)(b * TT + c * 64 + t2) * LDP + C_GQKV + 1024 + h * 128 + dvs * 32 + (l15 & ~1));
    R.vr[1][e] = *(const unsigned*)(P + (size_t)(b * TT + c * 64 + t2) * LDP + C_GQKV + 1024 + h * 128 + dvs * 32 + 16 + (l15 & ~1));
    R.eg[e] = GSC[(size_t)item * 192 + i];
    R.egl[e] = GSC[(size_t)item * 192 + 64 + i];
  }
  R.ge = GSC[(size_t)item * 192 + 128];
}
DI void gdn_put_kt(const GChunk& R, bf16_t* KT) {
  const int tid = otid(), lane = tid & 63, i = 16 * (tid >> 6) + (lane & 15), g = lane >> 4;
#pragma unroll
  for (int ks = 0; ks < 4; ++ks)
#pragma unroll
    for (int e = 0; e < 8; ++e) KT[(ks * 32 + g * 8 + e) * 72 + i] = (bf16_t)R.kf[ks][e];
}
DI int gdn_chunk_at(int d, int n) { return d == 0 ? n : (n < 4 ? 3 - n : NCH - 1 - (n - 4)); }
DI void job_gscan(const Params& p, int u, char* lds) {
  const int tid = otid(), lane = tid & 63, wid = tid >> 6, l15 = lane & 15, g = lane >> 4;
  const int seq = (u & 7) + 8 * (u >> 5), dvs = (u >> 3) & 3, d = seq & 1, h = (seq >> 1) & 3, b = seq >> 3;
  bf16_t* KT = (bf16_t*)lds;
  bf16_t* ST = KT + 2 * 128 * 72;
  bf16_t* XT = ST + 32 * 136;
  bf16_t* VnT = XT + 32 * 72;
  bf16_t* VsT = VnT + 32 * 72;
  bf16_t* OUT = d == 0 ? (bf16_t*)(p.ws + OFF_P) + C_DAV : (bf16_t*)(p.ws + OFF_OB);
  const int ldo = d == 0 ? LDP : 512;
  __builtin_amdgcn_s_setprio(3);
  f32x4 S[2][2];
#pragma unroll
  for (int a = 0; a < 2; ++a)
#pragma unroll
    for (int ct = 0; ct < 2; ++ct) S[a][ct] = (f32x4){0.f, 0.f, 0.f, 0.f};
  for (int i = tid; i < 32 * 136 / 2; i += 256) ((unsigned*)ST)[i] = 0u;
  GChunk cur, nxt;
  gdn_load(cur, p, b, h, d, dvs, gdn_chunk_at(d, 0));
  gdn_put_kt(cur, KT);
  __syncthreads();
#pragma unroll 1
  for (int n = 0; n < NCH; ++n) {
    const int c = gdn_chunk_at(d, n);
    if (n + 1 < NCH) gdn_load(nxt, p, b, h, d, dvs, gdn_chunk_at(d, n + 1));
    const bf16_t* KTc = KT + (n & 1) * 128 * 72;
    f32x4 ksa[2], qsa[2];
#pragma unroll
    for (int ct = 0; ct < 2; ++ct) { ksa[ct] = (f32x4){0.f, 0.f, 0.f, 0.f}; qsa[ct] = (f32x4){0.f, 0.f, 0.f, 0.f}; }
#pragma unroll
    for (int ks = 0; ks < 4; ++ks)
#pragma unroll
      for (int ct = 0; ct < 2; ++ct) {
        const bf16x8 bS = *(const bf16x8*)(ST + (ct * 16 + l15) * 136 + ks * 32 + g * 8);
        ksa[ct] = mfma16(cur.kf[ks], bS, ksa[ct]);
        qsa[ct] = mfma16(cur.qf[ks], bS, qsa[ct]);
      }
#pragma unroll
    for (int ct = 0; ct < 2; ++ct) {
      float x[4];
#pragma unroll
      for (int e = 0; e < 4; ++e) x[e] = ((l15 & 1) ? bfhi(cur.vr[ct][e]) : bflo(cur.vr[ct][e])) - cur.eg[e] * ksa[ct][e];
      *(u32x2*)(XT + (ct * 16 + l15) * 72 + 16 * wid + g * 4) = (u32x2){pk2(x[0], x[1]), pk2(x[2], x[3])};
    }
    __syncthreads();
#pragma unroll
    for (int ct = 0; ct < 2; ++ct) {
      f32x4 vn = {0.f, 0.f, 0.f, 0.f};
#pragma unroll
      for (int ks = 0; ks < 2; ++ks) vn = mfma16(cur.m1f[ks], *(const bf16x8*)(XT + (ct * 16 + l15) * 72 + ks * 32 + g * 8), vn);
      *(u32x2*)(VnT + (ct * 16 + l15) * 72 + 16 * wid + g * 4) = (u32x2){pk2(vn[0], vn[1]), pk2(vn[2], vn[3])};
      *(u32x2*)(VsT + (ct * 16 + l15) * 72 + 16 * wid + g * 4) = (u32x2){pk2(vn[0] * cur.egl[0], vn[1] * cur.egl[1]), pk2(vn[2] * cur.egl[2], vn[3] * cur.egl[3])};
    }
    __syncthreads();
#pragma unroll
    for (int ct = 0; ct < 2; ++ct) {
      f32x4 o;
#pragma unroll
      for (int e = 0; e < 4; ++e) o[e] = cur.eg[e] * qsa[ct][e];
#pragma unroll
      for (int ks = 0; ks < 2; ++ks) o = mfma16(cur.atf[ks], *(const bf16x8*)(VnT + (ct * 16 + l15) * 72 + ks * 32 + g * 8), o);
#pragma unroll
      for (int e = 0; e < 4; ++e) {
        const int i = 16 * wid + g * 4 + e, t2 = d ? 63 - i : i;
        OUT[(size_t)(b * TT + c * 64 + t2) * ldo + h * 128 + dvs * 32 + ct * 16 + l15] = f2bf(o[e]);
      }
    }
#pragma unroll
    for (int rt2 = 0; rt2 < 2; ++rt2) {
      const int rt = 2 * wid + rt2;
#pragma unroll
      for (int ct = 0; ct < 2; ++ct)
#pragma unroll
        for (int e = 0; e < 4; ++e) S[rt2][ct][e] *= cur.ge;
#pragma unroll
      for (int ks = 0; ks < 2; ++ks) {
        const bf16x8 ka = *(const bf16x8*)(KTc + (rt * 16 + l15) * 72 + ks * 32 + g * 8);
#pragma unroll
        for (int ct = 0; ct < 2; ++ct) S[rt2][ct] = mfma16(ka, *(const bf16x8*)(VsT + (ct * 16 + l15) * 72 + ks * 32 + g * 8), S[rt2][ct]);
      }
#pragma unroll
      for (int ct = 0; ct < 2; ++ct)
        *(u32x2*)(ST + (ct * 16 + l15) * 136 + rt * 16 + g * 4) = (u32x2){pk2(S[rt2][ct][0], S[rt2][ct][1]), pk2(S[rt2][ct][2], S[rt2][ct][3])};
    }
    if (n + 1 < NCH) { gdn_put_kt(nxt, KT + ((n + 1) & 1) * 128 * 72); cur = nxt; }
    __syncthreads();
  }
  __builtin_amdgcn_s_setprio(0);
}
DI void job_gpost1(const Params& p, int layer, int r) {
  const int lane = otid() & 63;
  bf16_t* P = (bf16_t*)(p.ws + OFF_P) + (size_t)r * LDP;
  const bf16_t* OB = (const bf16_t*)(p.ws + OFF_OB) + (size_t)r * 512;
  const u32x4 of = *(const u32x4*)(P + C_DAV + lane * 8), ob = *(const u32x4*)(OB + lane * 8), z = *(const u32x4*)(P + C_GZ + lane * 8);
  float o[8], zz[8], ss = 0.f;
#pragma unroll
  for (int e = 0; e < 4; ++e) {
    o[2 * e] = bflo(of[e]) + bflo(ob[e]); o[2 * e + 1] = bfhi(of[e]) + bfhi(ob[e]);
    zz[2 * e] = bflo(z[e]); zz[2 * e + 1] = bfhi(z[e]);
  }
#pragma unroll
  for (int e = 0; e < 8; ++e) ss += o[e] * o[e];
  ss += shx<1>(ss); ss += shx<2>(ss); ss += shx<4>(ss); ss += shx<8>(ss);
  const float rstd = rsqrtf(ss * (1.f / 128.f) + EPS);
  const float* gn = p.gng + layer * 128 + (lane & 15) * 8;
  float y[8];
#pragma unroll
  for (int e = 0; e < 8; ++e) y[e] = o[e] * rstd * gn[e] * (zz[e] * sigm(zz[e]));
  *(u32x4*)(P + C_GZ + lane * 8) = (u32x4){pk2(y[0], y[1]), pk2(y[2], y[3]), pk2(y[4], y[5]), pk2(y[6], y[7])};
}

DI void job_gpost(const Params& p, int layer, int it) {
  const int wid = otid() >> 6;
#pragma unroll
  for (int rr = 0; rr < 2; ++rr) job_gpost1(p, layer, it * 8 + rr * 4 + wid);
}
#ifdef SK_JL1
#define JL1(x)
#else
#define JL1(x) x
#endif
#ifdef SK_JGC
#define JGC(x)
#else
#define JGC(x) x
#endif
#ifdef SK_JVT
#define JVT(x)
#else
#define JVT(x) x
#endif
#ifdef SK_JDP
#define JDP(x)
#else
#define JDP(x) x
#endif
#ifdef SK_JGP
#define JGP(x)
#else
#define JGP(x) x
#endif
#ifdef SK_JL3
#define JL3(x)
#else
#define JL3(x) x
#endif
#ifdef SK_JGS
#define JGS(x)
#else
#define JGS(x) x
#endif
#ifdef SK_JAT
#define JAT(x)
#else
#define JAT(x) x
#endif
#define LAS __attribute__((address_space(3)))
#define XB_TMO      128
#define XB_XCNT(j)  (256  + 64 * (j))
#define XB_XSUB(j)  (1280 + 64 * (j))
#define XB_XGEN(j)  (2304 + 64 * (j))
#define XB_TOP      3328
#define XB_TOPGEN   3392
#define XCD_BAR_WORDS 3456
#define XB_SPIN_CAP (1u << 18)

__device__ __forceinline__ unsigned xb_ld(unsigned* p)              { return __hip_atomic_load(p, __ATOMIC_RELAXED, __HIP_MEMORY_SCOPE_AGENT); }
__device__ __forceinline__ unsigned xb_add(unsigned* p, unsigned v) { return __hip_atomic_fetch_add(p, v, __ATOMIC_RELAXED, __HIP_MEMORY_SCOPE_AGENT); }
__device__ __forceinline__ unsigned xb_xcc_id() { return (unsigned)__builtin_amdgcn_s_getreg((3 << 11) | 20) & 0xFu; }
#define XB_SPIN(cond, bar) do { unsigned _sp = 0; while (cond) { __builtin_amdgcn_s_sleep(1); \
    if ((++_sp & 255u) == 0u) { if (xb_ld(&(bar)[XB_TMO])) break; if (_sp > XB_SPIN_CAP) { atomicAdd(&(bar)[XB_TMO], 1u); break; } } } } while (0)

struct XcdBarrier {
    unsigned* bar; unsigned x;
    volatile LAS unsigned* st;
};

__device__ __forceinline__ XcdBarrier xcd_barrier_post(unsigned* bar, volatile LAS unsigned* st) {
    XcdBarrier b; b.bar = bar; b.x = xb_xcc_id(); b.st = st;
    if (threadIdx.x == 0) (void)xb_add(&bar[XB_XCNT(b.x)], 1u);
    return b;
}
__device__ __forceinline__ void xcd_barrier_complete(unsigned* bar, unsigned x, unsigned& nloc, unsigned& nx) {
    const unsigned G = gridDim.x * gridDim.y * gridDim.z;
    unsigned sum, cnt, mine, sp = 0u;
    for (;;) {
        sum = 0u; cnt = 0u; mine = 0u;
#pragma unroll
        for (unsigned j = 0; j < 16; ++j) { const unsigned c = xb_ld(&bar[XB_XCNT(j)]); sum += c; cnt += (c > 0u) ? 1u : 0u; mine = (j == x) ? c : mine; }
        if (sum == G) break;
        __builtin_amdgcn_s_sleep(1);
        if ((++sp & 255u) == 0u) { if (xb_ld(&bar[XB_TMO])) break; if (sp > XB_SPIN_CAP) { atomicAdd(&bar[XB_TMO], 1u); break; } }
    }
    nloc = mine > 0u ? mine : 1u; nx = cnt > 0u ? cnt : 1u;
}

__device__ __forceinline__ void xcd_barrier(const XcdBarrier& b) {
    asm volatile("s_waitcnt vmcnt(0)" ::: "memory");
    __syncthreads();
    if (threadIdx.x == 0) {
        unsigned* bar = b.bar; unsigned bx_ = b.x;
        asm volatile("" : "+s"(bar), "+s"(bx_));
        __builtin_amdgcn_s_waitcnt(0);
        unsigned nloc = b.st[0], nx = b.st[1];
        if (nloc == 0u) { xcd_barrier_complete(bar, bx_, nloc, nx); b.st[0] = nloc; b.st[1] = nx; }
        const unsigned old = xb_add(&bar[XB_XSUB(bx_)], 1u);
        const unsigned gen = old / nloc;
        if (old + 1u == (gen + 1u) * nloc) {
            __builtin_amdgcn_fence(__ATOMIC_RELEASE, "agent");
            asm volatile("s_waitcnt vmcnt(0)" ::: "memory");
            const unsigned og = xb_add(&bar[XB_TOP], 1u);
            const unsigned tg = og / nx;
            if (og + 1u == (tg + 1u) * nx) xb_add(&bar[XB_TOPGEN], 1u);
            else XB_SPIN(xb_ld(&bar[XB_TOPGEN]) == tg, bar);
            __builtin_amdgcn_fence(__ATOMIC_ACQUIRE, "agent");
            xb_add(&bar[XB_XGEN(bx_)], 1u);
            asm volatile("s_waitcnt vmcnt(0)" ::: "memory");
        } else {
            XB_SPIN(xb_ld(&bar[XB_XGEN(bx_)]) == gen, bar);
            __builtin_amdgcn_fence(__ATOMIC_ACQUIRE, "agent");
            asm volatile("s_waitcnt vmcnt(0)" ::: "memory");
        }
    }
    __syncthreads();
}


#define PH_BEGIN(k) for (int rep_ = 0, nrep_ = 1 + (((p.probe >> (k)) & 1) | ((k) == 5 ? ((p.probe >> 12) | (p.probe >> 13)) & 1 : 0)); rep_ < nrep_; ++rep_) { const bool dup = rep_ > 0; (void)dup;
#define PH_END xcd_barrier(xb_); }
#ifndef PROBE_MASK
#define PROBE_MASK 0
#endif
__global__ void __launch_bounds__(256, 2) mega(Params p) {
  __shared__ __attribute__((aligned(16))) char lds[LDS_BYTES];
  __shared__ int s_item;
  __shared__ unsigned xb_st[2];
  if (otid() == 0) { xb_st[0] = 0u; xb_st[1] = 0u; }
  __syncthreads();
  const XcdBarrier xb_ = xcd_barrier_post((unsigned*)(p.ws + OFF_CTR) + 64, (volatile LAS unsigned*)xb_st);
  cg::grid_group grid = cg::this_grid();
  const int G = gridDim.x, B = blockIdx.x;
  bf16_t* P = (bf16_t*)(p.ws + OFF_P);
  bf16_t* H = (bf16_t*)(p.ws + OFF_H);
  for (int it = B; it < 192 + 1024 + N_CVT; it += G) {
    if (it < 192) job_mod(p, it, lds);
    else if (it < 1216) job_rope(p, it - 192);
    else job_cvt(p, 0, it - 1216, lds);
  }
  if (p.probe < 0) grid.sync();
  xcd_barrier(xb_);
#pragma unroll 1
  for (int layer = 0; layer < 2; ++layer) {
    bf16_t* MG = (bf16_t*)(p.ws + OFF_VT);
    bf16_t* HID = P;
    PH_BEGIN(1)
    {
      const int n1 = layer == 1 ? N_CVT : 0;
      for (int it = B; it < n1 + MR / 8; it += G) { if (it < n1) job_cvt(p, 1, it, lds); else job_norm(p, layer, 1, it - n1); }
    }
    PH_END
    PH_BEGIN(2)
    {
      bf16_t* HALO = (bf16_t*)(p.ws + OFF_HALO);
      float* GBA = (float*)(p.ws + OFF_GBA);
      gemm_phase(H, 32, MR * 32, (const bf16_t*)(p.ws + OFF_WIN), 32, 7808 * 32, 1024, 132, 37, lds, B, G, [&](int row, int col, f32x4 v) {
        if (col < C_GBA) {
          const u32x2 w = {pk2(v[0], v[1]), pk2(v[2], v[3])};
          *(u32x2*)(P + (size_t)row * LDP + col) = w;
          if (col >= C_GQKV && col < C_GZ) {
            const int sm = row & 63;
            if (sm <= 1 || sm == 63) *(u32x2*)(HALO + ((size_t)(row >> 6) * 3 + (sm == 63 ? 2 : sm)) * 1536 + (col - C_GQKV)) = w;
          }
        } else if (col < C_GBA + 16) {
          *(f32x4*)(GBA + (size_t)row * 16 + (col - C_GBA)) = v;
        }
      }, [&](int row, int col, f32x4 v0, f32x4 v1) {
        if (col < C_GBA) {
          const u32x4 w = (u32x4){pk2(v0[0], v0[1]), pk2(v0[2], v0[3]), pk2(v1[0], v1[1]), pk2(v1[2], v1[3])};
          __builtin_nontemporal_store(w, (u32x4*)(P + (size_t)row * LDP + col));
          if (col >= C_GQKV && col < C_GZ) {
            const int sm = row & 63;
            if (sm <= 1 || sm == 63) *(u32x4*)(HALO + ((size_t)(row >> 6) * 3 + (sm == 63 ? 2 : sm)) * 1536 + (col - C_GQKV)) = w;
          }
        } else if (col < C_GBA + 16) {
          *(f32x4*)(GBA + (size_t)row * 16 + (col - C_GBA)) = v0;
          *(f32x4*)(GBA + (size_t)row * 16 + (col - C_GBA) + 4) = v1;
        }
      });
    }
    PH_END
    PH_BEGIN(3)
    {
      const int nA = 8 * NCH * 4, nB = nA + 6336, nC = nB + 2112, nD = nC + MR / 8;
      for (int it = B; it < nD; it += G) {
        if (it < nA) JL1(job_lru<1>(p, layer, it, lds, dup));
        else if (it < nB) JGC(job_gconv(p, layer, it - nA, dup));
        else if (it < nC) JVT(job_vt(p, it - nB, lds));
        else JDP(job_daprep(p, layer, it - nC, dup));
      }
    }
    PH_END
    PH_BEGIN(4)
    for (int it = B; it < 2112; it += G) JGP(job_gprep(p, layer, it, lds));
    PH_END
    PH_BEGIN(5)
    {
      for (;;) {
        const int x = blockIdx.x & 7;
        if (otid() == 0) s_item = (int)__hip_atomic_fetch_add((unsigned*)(p.ws + OFF_CTR) + ((layer * 2 + rep_) * 8 + x), 1u, __ATOMIC_RELAXED, __HIP_MEMORY_SCOPE_AGENT);
        __syncthreads();
        const int j = __builtin_amdgcn_readfirstlane(s_item);
        __syncthreads();
        if (j >= 16 + 132 + 528) break;
        if (j < 16) { if (!(dup && ((p.probe >> 12) & 1))) JGS(job_gscan(p, j * 8 + x, lds)); }
        else if (j < 148) {
          const int k = j - 16, grp = k / 66, qq = k % 66, qb = qq < 64 ? qq + 2 : qq - 64;
          if (!(dup && ((p.probe >> 13) & 1))) JAT(job_attn(p, layer, grp * 528 + qb * 8 + x, lds, dup));
        } else { if (!(dup && (((p.probe >> 12) | (p.probe >> 13)) & 1))) JL3(job_lru<3>(p, layer, (j - 148) * 8 + x, lds, dup)); }
      }
    }
    PH_END
    PH_BEGIN(6)
    for (int it = B; it < MR / 8 + MR / 8; it += G) { if (it < MR / 8) job_gpost(p, layer, it); else job_norm(p, layer, 1, it - MR / 8); }
    PH_END
    PH_BEGIN(7)
    gemm_phase(H, 32, MR * 32, (const bf16_t*)(p.ws + OFF_WIN) + (size_t)4736 * 32, 32, 7808 * 32, 1024, 132, 24, lds, B, G, [&](int row, int col, f32x4 v) {
      *(u32x2*)(P + (size_t)row * LDP + sg_col(col)) = (u32x2){pk2(sigm(v[0]), sigm(v[1])), pk2(sigm(v[2]), sigm(v[3]))};
    }, [&](int row, int col, f32x4 v0, f32x4 v1) {
      *(u32x4*)(P + (size_t)row * LDP + sg_col(col)) = (u32x4){pk2(sigm(v0[0]), sigm(v0[1])), pk2(sigm(v0[2]), sigm(v0[3])), pk2(sigm(v1[0]), sigm(v1[1])), pk2(sigm(v1[2]), sigm(v1[3]))};
    }, layer == 1);
    PH_END
    PH_BEGIN(14)
    {
      const bf16_t* WBR = (const bf16_t*)(p.ws + OFF_WBR);
      const int nm14 = layer == 1 ? 256 : 264;
      for (int t = B; t < nm14 * 8; t += G) {
        int mi, ni; tile_mn(t, nm14, 8, mi, ni);
        if (layer == 1) mi += 2 * (mi >> 6) + 2;
        f32x4 mg[4][4]; zero_acc<4>(mg);
#pragma unroll 1
        for (int i = 0; i < 3; ++i) {
          f32x4 ay[4][4]; zero_acc<4>(ay);
          const int coff = i == 0 ? C_DAQ : (i == 1 ? C_LY : C_GZ);
          gemm_core<4>(P + (size_t)mi * 128 * LDP + coff, LDP, 32, WBR + (size_t)i * 1024 * 512 + (size_t)(ni * 128) * 32, 32, 1024 * 32, 512, ay, lds);
          const int lane = otid() & 63, wid = otid() >> 6, wr = wid >> 1, wc = wid & 1;
#pragma unroll
          for (int a2 = 0; a2 < 4; ++a2)
#pragma unroll
            for (int b2 = 0; b2 < 4; ++b2) {
              const int row = mi * 128 + wr * 64 + a2 * 16 + (lane & 15), col = ni * 128 + wc * 64 + b2 * 16 + (lane >> 4) * 4;
              const u32x2 sg = *(const u32x2*)(P + (size_t)row * LDP + sg_col(i * 1024 + col));
              mg[a2][b2] += (f32x4){bflo(sg.x), bfhi(sg.x), bflo(sg.y), bfhi(sg.y)} * ay[a2][b2];
            }
        }
        gemm_emit<4>(mg, mi * 128, ni * 128, [&](int row, int col, f32x4 v) { *(u32x2*)(MG + ((size_t)(col >> 5) * MR + row) * 32 + (col & 31)) = (u32x2){pk2(v[0], v[1]), pk2(v[2], v[3])}; });
      }
    }
    PH_END
    PH_BEGIN(8)
    gemm_phase(MG, 32, MR * 32, (const bf16_t*)(p.ws + OFF_WO), 32, 1024 * 32, 1024, 132, 8, lds, B, G, [&](int row, int col, f32x4 v) {
      const f32x4 xin = *(const f32x4*)(res_in_row(p, layer, row) + col);
      const f32x4 g1 = *(const f32x4*)(mod_vec(p, layer, row) + 2048 + col);
      if (!dup) *(f32x4*)(res_out_row(p, row) + col) = xin + g1 * v;
    }, [&](int row, int col, f32x4 v0, f32x4 v1) {
      const float* xi = res_in_row(p, layer, row) + col;
      const float* gm = mod_vec(p, layer, row) + 2048 + col;
      float* xo = res_out_row(p, row) + col;
      const f32x4 o0 = __builtin_nontemporal_load((const f32x4*)xi) + *(const f32x4*)gm * v0, o1 = __builtin_nontemporal_load((const f32x4*)(xi + 4)) + *(const f32x4*)(gm + 4) * v1;
      if (!dup) { *(f32x4*)xo = o0; *(f32x4*)(xo + 4) = o1; }
    }, layer == 1);
    PH_END
    PH_BEGIN(9)
    for (int it = B; it < MR / 8; it += G) job_norm(p, layer, 2, it);
    PH_END
    PH_BEGIN(10)
    gemm_phase(H, 32, MR * 32, (const bf16_t*)(p.ws + OFF_W1), 32, 4096 * 32, 1024, 132, 32, lds, B, G, [&](int row, int col, f32x4 v) {
      float r[4];
#pragma unroll
      for (int e = 0; e < 4; ++e) { const float q = fmaxf(v[e], 0.f); r[e] = q * q; }
      *(u32x2*)(HID + ((size_t)(col >> 5) * MR + row) * 32 + (col & 31)) = (u32x2){pk2(r[0], r[1]), pk2(r[2], r[3])};
    }, [&](int row, int col, f32x4 v0, f32x4 v1) {
      float r[8];
#pragma unroll
      for (int e = 0; e < 4; ++e) { const float q0 = fmaxf(v0[e], 0.f), q1 = fmaxf(v1[e], 0.f); r[e] = q0 * q0; r[4 + e] = q1 * q1; }
      __builtin_nontemporal_store(((u32x4){pk2(r[0], r[1]), pk2(r[2], r[3]), pk2(r[4], r[5]), pk2(r[6], r[7])}), (u32x4*)(HID + ((size_t)(col >> 5) * MR + row) * 32 + (col & 31)));
    }, layer == 1);
    PH_END
    PH_BEGIN(11)
    gemm_phase(HID, 32, MR * 32, (const bf16_t*)(p.ws + OFF_W2), 32, 1024 * 32, 4096, 132, 8, lds, B, G, [&](int row, int col, f32x4 v) {
      float* xo = res_out_row(p, row) + col;
      const f32x4 g2 = *(const f32x4*)(mod_vec(p, layer, row) + 5120 + col);
      if (!dup) *(f32x4*)xo = *(const f32x4*)xo + g2 * v;
    }, [&](int row, int col, f32x4 v0, f32x4 v1) {
      float* xo = res_out_row(p, row) + col;
      const float* gm = mod_vec(p, layer, row) + 5120 + col;
      const f32x4 o0 = __builtin_nontemporal_load((const f32x4*)xo) + *(const f32x4*)gm * v0, o1 = __builtin_nontemporal_load((const f32x4*)(xo + 4)) + *(const f32x4*)(gm + 4) * v1;
      if (!dup) { *(f32x4*)xo = o0; *(f32x4*)(xo + 4) = o1; }
    }, layer == 1);
    PH_END
  }
}

extern "C" void kernel_launch(void* const* d_in, const int* in_sizes, int n_in, void* d_out, int out_size, void* d_ws, size_t ws_size, hipStream_t stream) {
  static int grid_blocks = 0;
  if (!grid_blocks) {
    int dev = 0, cus = 0, per_cu = 0;
    hipGetDevice(&dev);
    hipDeviceGetAttribute(&cus, hipDeviceAttributeMultiprocessorCount, dev);
    hipOccupancyMaxActiveBlocksPerMultiprocessor(&per_cu, mega, 256, 0);
    if (per_cu > 2) per_cu = 2;
    grid_blocks = cus * per_cu;
    grid_blocks -= grid_blocks % 8;
  }
  Params p{};
  const float** f = (const float**)&p;
  for (int i = 0; i < 26; ++i) f[i] = (const float*)d_in[i];
  p.out = (float*)d_out;
  p.ws = (char*)d_ws;
  p.probe = PROBE_MASK;
  if (ws_size < WS_TOTAL) { fprintf(stderr, "workspace too small: %zu < %zu\n", ws_size, (size_t)WS_TOTAL); return; }
  hipMemsetAsync((char*)d_ws + OFF_CTR, 0, 256 + 16384, stream);
  void* args[] = {&p};
  hipError_t e = hipLaunchCooperativeKernel((void*)mega, dim3(grid_blocks), dim3(256), args, 0, stream);
  if (e != hipSuccess) fprintf(stderr, "cooperative launch failed: %s (grid %d)\n", hipGetErrorString(e), grid_blocks);
}
```

```cpp
#include <hip/hip_runtime.h>
#include <hip/hip_cooperative_groups.h>
#include <cstdint>
#include <cstdio>
namespace cg = cooperative_groups;

#define DI __device__ __forceinline__
typedef unsigned short bf16_t;
typedef short bf16x8 __attribute__((ext_vector_type(8)));
typedef float f32x4 __attribute__((ext_vector_type(4)));
typedef float f32x2 __attribute__((ext_vector_type(2)));
typedef unsigned u32x4 __attribute__((ext_vector_type(4)));
typedef unsigned u32x2 __attribute__((ext_vector_type(2)));
typedef __bf16 bf16x2_t __attribute__((ext_vector_type(2)));

constexpr int DM = 1024, NB = 4, TL = 8192, TC = 256, TT = 8448, MR = NB * TT;
constexpr int LDP = 4736;
constexpr int C_DAQ = 0, C_DAK = 512, C_DAV = 1024, C_LX = 1536, C_LY = 2048, C_GQKV = 2560, C_GZ = 4096, C_GBA = 4608;
constexpr int NCH = 132;
constexpr float EPS = 1e-6f;
constexpr int LDS_BYTES = 77824;

constexpr size_t al256(size_t x) { return (x + 255) & ~(size_t)255; }
constexpr size_t OFF_WIN = 0;
constexpr size_t OFF_WBR = OFF_WIN + al256((size_t)7808 * 1024 * 2);
constexpr size_t OFF_WO = OFF_WBR + al256((size_t)3 * 1024 * 512 * 2);
constexpr size_t OFF_W1 = OFF_WO + al256((size_t)1024 * 1024 * 2);
constexpr size_t OFF_W2 = OFF_W1 + al256((size_t)4096 * 1024 * 2);
constexpr size_t OFF_LG = OFF_W2 + al256((size_t)4096 * 1024 * 2);
constexpr size_t OFF_P = OFF_LG + al256((size_t)32 * 4096 * 2);
constexpr size_t OFF_H = OFF_P + al256((size_t)MR * LDP * 2);
constexpr size_t OFF_VT = OFF_H + al256((size_t)MR * 1024 * 2);
constexpr size_t OFF_OB = OFF_VT + al256((size_t)MR * 512 * 2);
constexpr size_t OFF_HALO = OFF_OB + al256((size_t)MR * 512 * 2);
constexpr size_t OFF_GBA = OFF_HALO + al256((size_t)528 * 3 * 1536 * 2);
constexpr size_t OFF_GSC = OFF_GBA + al256((size_t)MR * 16 * 4);
constexpr size_t OFF_LC = OFF_GSC + al256((size_t)4224 * 192 * 4);
constexpr size_t OFF_CTX = OFF_LC + al256((size_t)4 * NCH * 8 * 2 * 64 * 8);
constexpr size_t OFF_MOD = OFF_CTX + al256((size_t)4 * 256 * 1024 * 4);
constexpr size_t OFF_ROPE = OFF_MOD + al256((size_t)2 * 5 * 6144 * 4);
constexpr size_t OFF_CTR = OFF_ROPE + al256((size_t)8192 * 32 * 8);
constexpr size_t WS_TOTAL = OFF_CTR + 256 + 16384;
static_assert(WS_TOTAL <= (size_t)536870912, "workspace map too large");

struct Params {
  const float *x, *c, *ctx, *cctx, *ada_w, *ada_b, *n1g, *n2g, *w_in, *daqg, *dakg, *dalam, *dasub, *lcw, *lcb, *lgw, *lgb, *llam,
      *gcw, *galog, *gdtb, *gng, *wbr, *wout, *w1, *w2;
  float* out;
  char* ws;
  int probe;
  int pad_;
};

DI unsigned pk2(float lo, float hi) { f32x2 v = {lo, hi}; bf16x2_t b = __builtin_convertvector(v, bf16x2_t); return __builtin_bit_cast(unsigned, b); }
DI bf16_t f2bf(float f) { return (bf16_t)(pk2(f, 0.f) & 0xffffu); }
DI float bf2f(bf16_t u) { return __uint_as_float(((unsigned)u) << 16); }
DI float bflo(unsigned w) { return __uint_as_float(w << 16); }
DI float bfhi(unsigned w) { return __uint_as_float(w & 0xffff0000u); }
DI int otid() { int t = __builtin_amdgcn_workitem_id_x(); asm volatile("" : "+v"(t)); return t; }
template <int M> DI float shx(float v) { return __int_as_float(__builtin_amdgcn_ds_swizzle(__float_as_int(v), (M << 10) | 0x1f)); }
DI float add32(float v) { auto r = __builtin_amdgcn_permlane32_swap(__float_as_uint(v), __float_as_uint(v), false, false); return __uint_as_float(r[0]) + __uint_as_float(r[1]); }
DI float max32(float v) { auto r = __builtin_amdgcn_permlane32_swap(__float_as_uint(v), __float_as_uint(v), false, false); return fmaxf(__uint_as_float(r[0]), __uint_as_float(r[1])); }
DI float wsum(float v) { v += shx<1>(v); v += shx<2>(v); v += shx<4>(v); v += shx<8>(v); v += shx<16>(v); return add32(v); }
DI float wmax(float v) { v = fmaxf(v, shx<1>(v)); v = fmaxf(v, shx<2>(v)); v = fmaxf(v, shx<4>(v)); v = fmaxf(v, shx<8>(v)); v = fmaxf(v, shx<16>(v)); return max32(v); }
DI float sigm(float x) { return 1.f / (1.f + __expf(-x)); }
DI float softplusf(float x) { return x > 20.f ? x : log1pf(expf(x)); }
DI f32x4 mfma16(bf16x8 a, bf16x8 b, f32x4 c) { return __builtin_amdgcn_mfma_f32_16x16x32_bf16(a, b, c, 0, 0, 0); }

DI const float* res_in_row(const Params& p, int layer, int r) {
  const int b = r / TT, s = r % TT;
  if (layer == 0) return s < TC ? p.ctx + ((size_t)b * TC + s) * DM : p.x + ((size_t)b * TL + (s - TC)) * DM;
  return s < TC ? (const float*)(p.ws + OFF_CTX) + ((size_t)b * TC + s) * DM : p.out + ((size_t)b * TL + (s - TC)) * DM;
}
DI float* res_out_row(const Params& p, int r) {
  const int b = r / TT, s = r % TT;
  return s < TC ? (float*)(p.ws + OFF_CTX) + ((size_t)b * TC + s) * DM : p.out + ((size_t)b * TL + (s - TC)) * DM;
}
DI const float* mod_vec(const Params& p, int layer, int r) {
  const int b = r / TT, s = r % TT;
  return (const float*)(p.ws + OFF_MOD) + (size_t)(layer * 5 + (s < TC ? 4 : b)) * 6144;
}

template <int WN>
DI void gemm_core(const bf16_t* __restrict__ A, int lda, int a_ks, const bf16_t* __restrict__ Bt, int ldb, int b_ks, int K, f32x4 (&acc)[4][WN], char* lds) {
  constexpr int BN = 32 * WN, AST = 72, NBP = BN * 8 / 256;
  bf16_t* As = (bf16_t*)lds;
  bf16_t* Bs = As + 2 * 128 * AST;
  const int tid = otid(), lane = tid & 63, wid = tid >> 6, wr = wid >> 1, wc = wid & 1;
  u32x4 ra[4], rb[NBP];
  const int nk = K / 64;
#define GLOAD(k0)                                                                                                            \
  {                                                                                                                          \
    _Pragma("unroll") for (int i = 0; i < 4; ++i) { const int q = tid + 256 * i; ra[i] = *(const u32x4*)(A + (size_t)(q >> 3) * lda + (size_t)(((k0) >> 5) + ((q & 7) >> 2)) * a_ks + (q & 3) * 8); } \
    _Pragma("unroll") for (int i = 0; i < NBP; ++i) { const int q = tid + 256 * i; rb[i] = *(const u32x4*)(Bt + (size_t)(q >> 3) * ldb + (size_t)(((k0) >> 5) + ((q & 7) >> 2)) * b_ks + (q & 3) * 8); } \
  }
#define SSTORE(buf)                                                                                                          \
  {                                                                                                                          \
    _Pragma("unroll") for (int i = 0; i < 4; ++i) { const int q = tid + 256 * i; *(u32x4*)(As + ((buf) * 128 + (q >> 3)) * AST + (q & 7) * 8) = ra[i]; } \
    _Pragma("unroll") for (int i = 0; i < NBP; ++i) { const int q = tid + 256 * i; *(u32x4*)(Bs + ((buf) * BN + (q >> 3)) * AST + (q & 7) * 8) = rb[i]; } \
  }
  GLOAD(0);
  SSTORE(0);
  __syncthreads();
  for (int t = 0; t < nk; ++t) {
    if (t + 1 < nk) GLOAD((t + 1) * 64);
    const bf16_t* a = As + ((t & 1) * 128 + wr * 64 + (lane & 15)) * AST + (lane >> 4) * 8;
    const bf16_t* b = Bs + ((t & 1) * BN + wc * 16 * WN + (lane & 15)) * AST + (lane >> 4) * 8;
#pragma unroll
    for (int ks = 0; ks < 2; ++ks) {
      bf16x8 af[4], bfr[WN];
#pragma unroll
      for (int i = 0; i < 4; ++i) af[i] = *(const bf16x8*)(a + i * 16 * AST + ks * 32);
#pragma unroll
      for (int j = 0; j < WN; ++j) bfr[j] = *(const bf16x8*)(b + j * 16 * AST + ks * 32);
      __builtin_amdgcn_sched_barrier(0);
#pragma unroll
      for (int i = 0; i < 4; ++i)
#pragma unroll
        for (int j = 0; j < WN; ++j) acc[i][j] = mfma16(bfr[j], af[i], acc[i][j]);
      __builtin_amdgcn_sched_barrier(0);
    }
    if (t + 1 < nk) SSTORE((t + 1) & 1);
    __syncthreads();
  }
#undef GLOAD
#undef SSTORE
}
DI void tile_mn(int t, int nm, int nn, int& mi, int& ni) {
  const int nig = 16 * nn, g = t / nig, rem = t % nig, fm = g * 16;
  const int gsz = (nm - fm) < 16 ? (nm - fm) : 16;
  mi = fm + rem % gsz;
  ni = rem / gsz;
}
template <int WN, class Epi>
DI void gemm_emit(const f32x4 (&acc)[4][WN], int m0, int n0, Epi epi) {
  const int lane = otid() & 63, wid = otid() >> 6, wr = wid >> 1, wc = wid & 1;
#pragma unroll
  for (int i = 0; i < 4; ++i)
#pragma unroll
    for (int j = 0; j < WN; ++j) epi(m0 + wr * 64 + i * 16 + (lane & 15), n0 + wc * 16 * WN + j * 16 + (lane >> 4) * 4, acc[i][j]);
}
template <int WN>
DI void zero_acc(f32x4 (&acc)[4][WN]) {
#pragma unroll
  for (int i = 0; i < 4; ++i)
#pragma unroll
    for (int j = 0; j < WN; ++j) acc[i][j] = (f32x4){0.f, 0.f, 0.f, 0.f};
}

DI void gemm_core2(const bf16_t* __restrict__ A, int lda, int a_ks, const bf16_t* __restrict__ Bt, int ldb, int b_ks, int K, f32x4 (&acc)[8][4], char* lds) {
  constexpr int AST = 48;
  bf16_t* As = (bf16_t*)lds;
  bf16_t* Bs = As + 2 * 256 * AST;
  const int tid = otid(), lane = tid & 63, wid = tid >> 6, wr = wid >> 1, wc = wid & 1;
  u32x4 s0a[4], s0b[2], s1a[4], s1b[2];
  const int nk = K / 32;
  const bf16_t* ag = A + (size_t)(tid >> 2) * lda + (tid & 3) * 8;
  const bf16_t* bg = Bt + (size_t)(tid >> 2) * ldb + (tid & 3) * 8;
  const int bc_ = tid >> 2, brow = ((bc_ >> 5) * 2 + ((bc_ >> 2) & 1)) * 16 + ((bc_ >> 3) & 3) * 4 + (bc_ & 3);
#define LBAR() { asm volatile("s_waitcnt lgkmcnt(0)" ::: "memory"); __builtin_amdgcn_s_barrier(); asm volatile("" ::: "memory"); }
#define GLOAD2(ra, rb, k0)                                                                                                   \
  {                                                                                                                          \
    _Pragma("unroll") for (int i = 0; i < 4; ++i) ra[i] = *(const u32x4*)(ag + (size_t)(64 * i) * lda + (size_t)((k0) >> 5) * a_ks);               \
    _Pragma("unroll") for (int i = 0; i < 2; ++i) rb[i] = *(const u32x4*)(bg + (size_t)(64 * i) * ldb + (size_t)((k0) >> 5) * b_ks);               \
  }
#define SSTORE2(ra, rb, buf)                                                                                                 \
  {                                                                                                                          \
    _Pragma("unroll") for (int i = 0; i < 4; ++i) *(u32x4*)(As + ((buf) * 256 + 64 * i + (tid >> 2)) * AST + (tid & 3) * 8) = ra[i]; \
    _Pragma("unroll") for (int i = 0; i < 2; ++i) *(u32x4*)(Bs + ((buf) * 128 + 64 * i + brow) * AST + (tid & 3) * 8) = rb[i]; \
  }
#define STEP2(t, la, lb, sa, sb)                                                                                             \
  {                                                                                                                          \
    if ((t) + 2 < nk) GLOAD2(la, lb, ((t) + 2) * 32);                                                                        \
    const bf16_t* a = As + (((t) & 1) * 256 + wr * 128 + (lane & 15)) * AST + (lane >> 4) * 8;                               \
    const bf16_t* b = Bs + (((t) & 1) * 128 + wc * 64 + (lane & 15)) * AST + (lane >> 4) * 8;                                \
    bf16x8 bfr[4], a0[4], a1[4];                                                                                             \
    _Pragma("unroll") for (int j = 0; j < 4; ++j) bfr[j] = *(const bf16x8*)(b + j * 16 * AST);                               \
    _Pragma("unroll") for (int i = 0; i < 4; ++i) a0[i] = *(const bf16x8*)(a + i * 16 * AST);                                \
    __builtin_amdgcn_sched_barrier(0);                                                                                       \
    _Pragma("unroll") for (int i = 0; i < 4; ++i) a1[i] = *(const bf16x8*)(a + (4 + i) * 16 * AST);                          \
    __builtin_amdgcn_sched_barrier(0);                                                                                       \
    _Pragma("unroll") for (int i = 0; i < 4; ++i) _Pragma("unroll") for (int j = 0; j < 4; ++j) acc[i][j] = mfma16(bfr[j], a0[i], acc[i][j]); \
    __builtin_amdgcn_sched_barrier(0);                                                                                       \
    _Pragma("unroll") for (int i = 0; i < 4; ++i) _Pragma("unroll") for (int j = 0; j < 4; ++j) acc[4 + i][j] = mfma16(bfr[j], a1[i], acc[4 + i][j]); \
    __builtin_amdgcn_sched_barrier(0);                                                                                       \
    if ((t) + 1 < nk) SSTORE2(sa, sb, ((t) + 1) & 1);                                                                        \
    LBAR();                                                                                                                  \
  }
  GLOAD2(s0a, s0b, 0);
  SSTORE2(s0a, s0b, 0);
  GLOAD2(s1a, s1b, 32);
  LBAR();
  int t = 0;
  for (;;) {
    STEP2(t, s0a, s0b, s1a, s1b);
    if (++t >= nk) break;
    STEP2(t, s1a, s1b, s0a, s0b);
    if (++t >= nk) break;
  }
#undef GLOAD2
#undef SSTORE2
#undef STEP2
}
DI void tile_mn8(int t, int nm, int nn, int& mi, int& ni) {
  const int nig = 8 * nn, g = t / nig, rem = t % nig, fm = g * 8;
  const int gsz = (nm - fm) < 8 ? (nm - fm) : 8;
  mi = fm + rem % gsz;
  ni = rem / gsz;
}
template <class Epi, class Epi8>
DI void gemm_phase(const bf16_t* A, int lda, int a_ks, const bf16_t* Bt, int ldb, int b_ks, int K, int nm, int nn, char* lds, int B, int G, Epi epi, Epi8 epi8, bool skipctx = false) {
  if (skipctx) nm -= 4;
  const int NT = nm * nn;
  int nfull = (NT / G) * G, R = NT - nfull;
  if (4 * R > 2 * G) { nfull = NT; R = 0; }
  for (int t = B; t < nfull + 4 * R; t += G) {
    int mi, ni;
    if (t < nfull) {
      tile_mn8(t, nm, nn, mi, ni);
      if (skipctx) mi += (mi >> 5) + 1;
      f32x4 acc[8][4];
#pragma unroll
      for (int i = 0; i < 8; ++i)
#pragma unroll
        for (int j = 0; j < 4; ++j) acc[i][j] = (f32x4){0.f, 0.f, 0.f, 0.f};
      gemm_core2(A + (size_t)mi * 256 * lda, lda, a_ks, Bt + (size_t)ni * 128 * ldb, ldb, b_ks, K, acc, lds);
      const int lane = otid() & 63, wid = otid() >> 6, wr = wid >> 1, wc = wid & 1;
#pragma unroll
      for (int i = 0; i < 8; ++i)
#pragma unroll
        for (int jp = 0; jp < 2; ++jp) epi8(mi * 256 + wr * 128 + i * 16 + (lane & 15), ni * 128 + wc * 64 + jp * 32 + (lane >> 4) * 8, acc[i][2 * jp], acc[i][2 * jp + 1]);
    } else {
      const int u = t - nfull, sub = u & 3;
      tile_mn8(nfull + (u >> 2), nm, nn, mi, ni);
      if (skipctx) mi += (mi >> 5) + 1;
      const int m0 = mi * 256 + (sub >> 1) * 128, n0 = ni * 128 + (sub & 1) * 64;
      f32x4 acc[4][2]; zero_acc<2>(acc);
      gemm_core<2>(A + (size_t)m0 * lda, lda, a_ks, Bt + (size_t)n0 * ldb, ldb, b_ks, K, acc, lds);
      gemm_emit<2>(acc, m0, n0, epi);
    }
  }
}
DI int sg_col(int gc) { const int j = gc >> 7; return (j < 12 ? 512 + 128 * j : 2560 + 128 * (j - 12)) + (gc & 127); }

constexpr int N_CVT = 1152 + 32 + 768 + 384 + 256 + 1024 + 1024 + 32;
DI void job_cvt(const Params& p, int layer, int t, char* lds) {
  const float* src; int ld, ncol0 = 0, nlim, K, ntot, nrow0 = 0; bf16_t* dst;
  char* ws = p.ws;
  if (t < 1152) { src = p.w_in + (size_t)layer * 1024 * 7696; ld = 7696; ncol0 = 0; nlim = 4608; dst = (bf16_t*)(ws + OFF_WIN); K = 1024; ntot = 7808; nrow0 = 0; }
  else if ((t -= 1152) < 32) { src = p.w_in + (size_t)layer * 1024 * 7696; ld = 7696; ncol0 = 4608; nlim = 4624; dst = (bf16_t*)(ws + OFF_WIN); K = 1024; ntot = 7808; nrow0 = 4608; }
  else if ((t -= 32) < 768) { src = p.w_in + (size_t)layer * 1024 * 7696; ld = 7696; ncol0 = 4624; nlim = 7696; dst = (bf16_t*)(ws + OFF_WIN); K = 1024; ntot = 7808; nrow0 = 4736; }
  else if ((t -= 768) < 384) { const int i = t / 128; t %= 128; src = p.wbr + ((size_t)layer * 3 + i) * 512 * 1024; ld = 1024; nlim = 1024; dst = (bf16_t*)(ws + OFF_WBR) + (size_t)i * 1024 * 512; K = 512; ntot = 1024; }
  else if ((t -= 384) < 256) { src = p.wout + (size_t)layer * 1024 * 1024; ld = 1024; nlim = 1024; dst = (bf16_t*)(ws + OFF_WO); K = 1024; ntot = 1024; }
  else if ((t -= 256) < 1024) { src = p.w1 + (size_t)layer * 1024 * 4096; ld = 4096; nlim = 4096; dst = (bf16_t*)(ws + OFF_W1); K = 1024; ntot = 4096; }
  else if ((t -= 1024) < 1024) { src = p.w2 + (size_t)layer * 4096 * 1024; ld = 1024; nlim = 1024; dst = (bf16_t*)(ws + OFF_W2); K = 4096; ntot = 1024; }
  else { t -= 1024; src = p.lgw + ((size_t)layer * 32 + t) * 4096; ld = 64; nlim = 64; dst = (bf16_t*)(ws + OFF_LG) + (size_t)t * 4096; K = 64; ntot = 0; t = 0; }
  const int nkt = K / 64, nt = t / nkt, kt = t % nkt;
  float* tl = (float*)lds;
  const int tid = otid();
  {
    const int c4 = (tid & 15) * 4, ncol = ncol0 + nt * 64 + c4;
#pragma unroll
    for (int i = 0; i < 4; ++i) {
      const int kk = i * 16 + (tid >> 4);
      f32x4 v = {0.f, 0.f, 0.f, 0.f};
      if (ncol + 3 < nlim) v = __builtin_nontemporal_load((const f32x4*)(src + (size_t)(kt * 64 + kk) * ld + ncol));
      tl[kk * 65 + c4] = v[0]; tl[kk * 65 + c4 + 1] = v[1]; tl[kk * 65 + c4 + 2] = v[2]; tl[kk * 65 + c4 + 3] = v[3];
    }
  }
  __syncthreads();
  {
    const int n = tid >> 2, kq = tid & 3;
    float v[16];
#pragma unroll
    for (int e = 0; e < 16; ++e) v[e] = tl[(kq * 16 + e) * 65 + n];
    u32x4 w0 = {pk2(v[0], v[1]), pk2(v[2], v[3]), pk2(v[4], v[5]), pk2(v[6], v[7])};
    u32x4 w1 = {pk2(v[8], v[9]), pk2(v[10], v[11]), pk2(v[12], v[13]), pk2(v[14], v[15])};
    const int nd = nrow0 + nt * 64 + n, kd = kt * 64 + kq * 16;
    bf16_t* d = ntot ? dst + ((size_t)(kd >> 5) * ntot + nd) * 32 + (kd & 31) : dst + (size_t)nd * K + kd;
    *(u32x4*)d = w0;
    *(u32x4*)(d + 8) = w1;
  }
  __syncthreads();
}
DI void job_mod(const Params& p, int it, char* lds) {
  const int nc = it % 96, l = it / 96, tid = otid();
  float* sc = (float*)lds;
  float* red = sc + 5 * 1024;
  for (int i = tid; i < 5 * 1024; i += 256) {
    const int v = i >> 10, k = i & 1023;
    const float cv = v < 4 ? p.c[v * 1024 + k] : p.cctx[k];
    sc[i] = cv * sigm(cv);
  }
  __syncthreads();
  const int cq = tid & 15, kg = tid >> 4, n = nc * 64 + cq * 4;
  const float* w = p.ada_w + ((size_t)l * 1024 + kg * 64) * 6144 + n;
  const float* s0 = sc + kg * 64;
  f32x4 a[5];
#pragma unroll
  for (int v = 0; v < 5; ++v) a[v] = (f32x4){0.f, 0.f, 0.f, 0.f};
#pragma unroll 8
  for (int k = 0; k < 64; ++k) {
    const f32x4 wv = __builtin_nontemporal_load((const f32x4*)(w + (size_t)k * 6144));
#pragma unroll
    for (int v = 0; v < 5; ++v) a[v] += wv * s0[v * 1024 + k];
  }
#pragma unroll
  for (int v = 0; v < 5; ++v)
#pragma unroll
    for (int e = 0; e < 4; ++e) red[(kg * 5 + v) * 64 + cq * 4 + e] = a[v][e];
  __syncthreads();
  for (int i = tid; i < 320; i += 256) {
    const int v = i >> 6, cc = i & 63;
    float r = p.ada_b[l * 6144 + nc * 64 + cc];
#pragma unroll
    for (int q = 0; q < 16; ++q) r += red[(q * 5 + v) * 64 + cc];
    ((float*)(p.ws + OFF_MOD))[(size_t)(l * 5 + v) * 6144 + nc * 64 + cc] = r;
  }
  __syncthreads();
}
DI void job_rope(const Params& p, int it) {
  const int idx = it * 256 + otid(), t = idx >> 5, ax = (idx >> 4) & 1, f = idx & 15;
  const float inv = powf(10000.f, -(float)f / 16.f);
  const float pos = (float)(ax ? (t & 63) : (t >> 6));
  float s, c;
  sincosf(pos * inv, &s, &c);
  ((f32x2*)(p.ws + OFF_ROPE))[idx] = (f32x2){c, s};
}
DI void job_norm(const Params& p, int layer, int which, int it) {
  const int lane = otid() & 63, wid = otid() >> 6, r = it * 8 + wid;
  const float* xr0 = (which == 1) ? res_in_row(p, layer, r) : (const float*)res_out_row(p, r);
  const float* xr1 = (which == 1) ? res_in_row(p, layer, r + 4) : (const float*)res_out_row(p, r + 4);
  const float* mv = mod_vec(p, layer, r);
  const float* sh = mv + (which == 1 ? 0 : 3072);
  const float* sc = mv + (which == 1 ? 1024 : 4096);
  const float* g = (which == 1 ? p.n1g : p.n2g) + layer * 1024;
  f32x4 xa[4], xb[4];
#pragma unroll
  for (int i = 0; i < 2; ++i)
#pragma unroll
    for (int hf = 0; hf < 2; ++hf) {
      xa[2 * i + hf] = __builtin_nontemporal_load((const f32x4*)(xr0 + i * 512 + lane * 8 + hf * 4));
      xb[2 * i + hf] = __builtin_nontemporal_load((const f32x4*)(xr1 + i * 512 + lane * 8 + hf * 4));
    }
  float sa = 0.f, sb = 0.f;
#pragma unroll
  for (int i = 0; i < 4; ++i) {
    sa += xa[i][0] * xa[i][0] + xa[i][1] * xa[i][1] + xa[i][2] * xa[i][2] + xa[i][3] * xa[i][3];
    sb += xb[i][0] * xb[i][0] + xb[i][1] * xb[i][1] + xb[i][2] * xb[i][2] + xb[i][3] * xb[i][3];
  }
  sa = wsum(sa); sb = wsum(sb);
  const float ra = rsqrtf(sa * (1.f / 1024.f) + EPS), rb = rsqrtf(sb * (1.f / 1024.f) + EPS);
  bf16_t* H0 = (bf16_t*)(p.ws + OFF_H) + (size_t)r * 32;
  bf16_t* H1 = H0 + 4 * 32;
#pragma unroll
  for (int i = 0; i < 2; ++i) {
    const int c = i * 512 + lane * 8;
    float o[8], q[8];
#pragma unroll
    for (int hf = 0; hf < 2; ++hf) {
      const f32x4 gv = *(const f32x4*)(g + c + hf * 4), sv = *(const f32x4*)(sc + c + hf * 4), hv = *(const f32x4*)(sh + c + hf * 4);
#pragma unroll
      for (int e = 0; e < 4; ++e) { const float m = gv[e] * (1.f + sv[e]); o[hf * 4 + e] = xa[2 * i + hf][e] * ra * m + hv[e]; q[hf * 4 + e] = xb[2 * i + hf][e] * rb * m + hv[e]; }
    }
    const size_t so = (size_t)(c >> 5) * MR * 32 + (c & 31);
    *(u32x4*)(H0 + so) = (u32x4){pk2(o[0], o[1]), pk2(o[2], o[3]), pk2(o[4], o[5]), pk2(o[6], o[7])};
    *(u32x4*)(H1 + so) = (u32x4){pk2(q[0], q[1]), pk2(q[2], q[3]), pk2(q[4], q[5]), pk2(q[6], q[7])};
  }
}

DI void job_daprep1(const Params& p, int layer, int r, bool dup) {
  const int lane = otid() & 63, s = r % TT;
  const int G = lane >> 2, quarter = lane & 3;
  bf16_t* ptr = (bf16_t*)(p.ws + OFF_P) + (size_t)r * LDP + (G < 8 ? C_DAQ + G * 64 : C_DAK + (G - 8) * 64) + quarter * 16;
  const u32x4 w0 = *(const u32x4*)ptr, w1 = *(const u32x4*)(ptr + 8);
  float y[16];
#pragma unroll
  for (int e = 0; e < 4; ++e) { y[2 * e] = bflo(w0[e]); y[2 * e + 1] = bfhi(w0[e]); y[8 + 2 * e] = bflo(w1[e]); y[9 + 2 * e] = bfhi(w1[e]); }
  float ss = 0.f;
#pragma unroll
  for (int e = 0; e < 16; ++e) ss += y[e] * y[e];
  ss += shx<1>(ss);
  ss += shx<2>(ss);
  float rstd = rsqrtf(ss * (1.f / 64.f) + EPS);
  const float* g = (G < 8 ? p.daqg : p.dakg) + layer * 64 + quarter * 16;
#pragma unroll
  for (int e = 0; e < 16; ++e) y[e] = y[e] * rstd * g[e];
  if (s >= TC) {
    const f32x2* tb = (const f32x2*)(p.ws + OFF_ROPE) + ((size_t)(s - TC) * 2 + (quarter >> 1)) * 16;
#pragma unroll
    for (int e = 0; e < 16; ++e) {
      const float yp = shx<1>(y[e]);
      const f32x2 cs = tb[e];
      y[e] = (quarter & 1) ? (y[e] * cs.x + yp * cs.y) : (y[e] * cs.x - yp * cs.y);
    }
  }
  if (G < 8) {
#pragma unroll
    for (int e = 0; e < 16; ++e) y[e] *= 0.125f * 1.4426950408889634f;
  }
  if (dup) return;
  *(u32x4*)ptr = (u32x4){pk2(y[0], y[1]), pk2(y[2], y[3]), pk2(y[4], y[5]), pk2(y[6], y[7])};
  *(u32x4*)(ptr + 8) = (u32x4){pk2(y[8], y[9]), pk2(y[10], y[11]), pk2(y[12], y[13]), pk2(y[14], y[15])};
}
DI void job_daprep(const Params& p, int layer, int it, bool dup) {
  const int wid = otid() >> 6;
#pragma unroll
  for (int rr = 0; rr < 2; ++rr) job_daprep1(p, layer, it * 8 + rr * 4 + wid, dup);
}
DI void job_vt(const Params& p, int it, char* lds) {
  const int h = it & 3, c = (it >> 2) % NCH, b = it / (4 * NCH), tid = otid();
  bf16_t* tl = (bf16_t*)lds;
  const bf16_t* P = (const bf16_t*)(p.ws + OFF_P);
#pragma unroll
  for (int i = 0; i < 4; ++i) {
    const int q = tid + 256 * i, row = q >> 4, pc = q & 15;
    const u32x4 w = *(const u32x4*)(P + (size_t)(b * TT + c * 64 + row) * LDP + C_DAV + h * 128 + pc * 8);
    unsigned* d = (unsigned*)(tl + row * 130 + pc * 8);
    d[0] = w[0]; d[1] = w[1]; d[2] = w[2]; d[3] = w[3];
  }
  __syncthreads();
  {
    const int dv = tid >> 1, half = tid & 1;
    unsigned o[16];
#pragma unroll
    for (int e = 0; e < 16; ++e) o[e] = (unsigned)tl[(half * 32 + 2 * e) * 130 + dv] | ((unsigned)tl[(half * 32 + 2 * e + 1) * 130 + dv] << 16);
    bf16_t* d = (bf16_t*)(p.ws + OFF_VT) + ((size_t)(b * 4 + h) * 128 + dv) * TT + c * 64 + half * 32;
#pragma unroll
#define VTW(w) o[(((w) & 3) >> 1) * 8 + ((w) >> 2) * 2 + ((w) & 1)]
    for (int e = 0; e < 4; ++e) *(u32x4*)(d + e * 8) = (u32x4){VTW(4 * e), VTW(4 * e + 1), VTW(4 * e + 2), VTW(4 * e + 3)};
#undef VTW
  }
  __syncthreads();
}

constexpr int N_ATT = 1056;
DI void job_attn(const Params& p, int layer, int a, char* lds, bool dup) {
  const int tid = otid(), lane = tid & 63, wid = tid >> 6, l15 = lane & 15, g = lane >> 4;
  const int grp = a / 528, within = a % 528, bh = grp * 8 + (within & 7), qb = within >> 3, b = bh >> 2, h = bh & 3;
  if (layer == 1 && qb < 2) return;
  const int nt = qb < 2 ? 4 : NCH;
  bf16_t* P = (bf16_t*)(p.ws + OFF_P);
  const bf16_t* VT = (const bf16_t*)(p.ws + OFF_VT) + (size_t)(b * 4 + h) * 128 * TT;
  int ly_ = layer; asm volatile("" : "+s"(ly_));
  const float lam_init = __uint_as_float(ly_ == 0 ? 0x3e4ccccdu : 0x3eb60549u);
  const float* lv = p.dalam + layer * 256;
  const float lam = __uint_as_float(__builtin_amdgcn_readfirstlane(__float_as_uint(expf(wsum(lv[lane] * lv[64 + lane])) - expf(wsum(lv[128 + lane] * lv[192 + lane])) + lam_init)));
  const float mq = wmax(fabsf(p.daqg[layer * 64 + lane])), mk = wmax(fabsf(p.dakg[layer * 64 + lane]));
  const float negMb = __uint_as_float(__builtin_amdgcn_readfirstlane(__float_as_uint(-(8.f * mq * mk * 1.03f * 1.4426950408889634f + 0.5f))));
  const int r0 = b * TT + qb * 128 + wid * 32;
  bf16x8 qf[2][2][2];
#pragma unroll
  for (int c = 0; c < 2; ++c)
#pragma unroll
    for (int i = 0; i < 2; ++i)
#pragma unroll
      for (int ks = 0; ks < 2; ++ks) qf[c][i][ks] = *(const bf16x8*)(P + (size_t)(r0 + i * 16 + l15) * LDP + C_DAQ + h * 128 + c * 64 + ks * 32 + g * 8);
  bf16_t* Ks = (bf16_t*)lds;
  bf16_t* Vs = Ks + 2 * 64 * 144;
  u32x4 rk[4], rv[4];
  const bf16_t* kg = P + (size_t)(b * TT) * LDP + C_DAK + h * 128;
#define KLOAD(t) { _Pragma("unroll") for (int i = 0; i < 4; ++i) { const int q = tid + 256 * i; rk[i] = *(const u32x4*)(kg + (size_t)((t) * 64 + (q >> 4)) * LDP + (q & 15) * 8); } }
#define VLOAD(t) { _Pragma("unroll") for (int i = 0; i < 4; ++i) { const int q = tid + 256 * i; rv[i] = *(const u32x4*)(VT + (size_t)(q >> 3) * TT + (t) * 64 + (q & 7) * 8); } }
#define KSTORE(buf) { _Pragma("unroll") for (int i = 0; i < 4; ++i) { const int q = tid + 256 * i; *(u32x4*)(Ks + ((buf) * 64 + (q >> 4)) * 144 + (q & 15) * 8) = rk[i]; } }
#define VSTORE(buf) { _Pragma("unroll") for (int i = 0; i < 4; ++i) { const int q = tid + 256 * i; *(u32x4*)(Vs + ((buf) * 128 + (q >> 3)) * 80 + (q & 7) * 8) = rv[i]; } }
#define QK_INTO(S, Kb, half, CI)                                                                                       \
  _Pragma("unroll") for (int c = 0; c < 2; ++c) {                                                                      \
    bf16x8 kf[2][2];                                                                                                   \
    _Pragma("unroll") for (int k2 = 0; k2 < 2; ++k2) _Pragma("unroll") for (int ks = 0; ks < 2; ++ks)                  \
      kf[k2][ks] = *(const bf16x8*)((Kb) + ((half) * 32 + k2 * 16 + l15) * 144 + c * 64 + ks * 32 + g * 8);             \
    __builtin_amdgcn_sched_barrier(0);                                                                                 \
    _Pragma("unroll") for (int k2 = 0; k2 < 2; ++k2) _Pragma("unroll") for (int i = 0; i < 2; ++i) {                   \
      S[c][i][k2] = mfma16(kf[k2][0], qf[c][i][0], CI(c, i));     \
      S[c][i][k2] = mfma16(kf[k2][1], qf[c][i][1], S[c][i][k2]); }                                                     \
  }                                                                                                                    \
  __builtin_amdgcn_sched_barrier(0);
#define EXPSUM(S)                                                                                                      \
  _Pragma("unroll") for (int c = 0; c < 2; ++c) _Pragma("unroll") for (int i = 0; i < 2; ++i) {                        \
    _Pragma("unroll") for (int k2 = 0; k2 < 2; ++k2) _Pragma("unroll") for (int e = 0; e < 4; ++e) S[c][i][k2][e] = __builtin_amdgcn_exp2f(S[c][i][k2][e]); \
    lsum[c][i] += ((S[c][i][0][0] + S[c][i][0][1]) + (S[c][i][0][2] + S[c][i][0][3])) + ((S[c][i][1][0] + S[c][i][1][1]) + (S[c][i][1][2] + S[c][i][1][3])); }
#define EXP_S() _Pragma("unroll") for (int c = 0; c < 2; ++c) _Pragma("unroll") for (int i = 0; i < 2; ++i) _Pragma("unroll") for (int k2 = 0; k2 < 2; ++k2) _Pragma("unroll") for (int e = 0; e < 4; ++e) S[c][i][k2][e] = __builtin_amdgcn_exp2f(S[c][i][k2][e]);
  float lsum[2][2] = {{0.f, 0.f}, {0.f, 0.f}};
  KLOAD(0);
  KSTORE(0);
  __syncthreads();
  const f32x4 negMv = {negMb, negMb, negMb, negMb};
#define CI1(c, i) negMv
  f32x4 SA[2][2][2], SB[2][2][2];
#pragma unroll 1
  for (int t = 0; t < nt; ++t) {
    if (t + 1 < nt) KLOAD(t + 1);
    const bf16_t* Kb = Ks + (t & 1) * 64 * 144;
    QK_INTO(SA, Kb, 0, CI1)
    if (t > 0) { EXPSUM(SB) }
    __builtin_amdgcn_sched_barrier(0);
    QK_INTO(SB, Kb, 1, CI1)
    EXPSUM(SA)
    if (t + 1 < nt) KSTORE((t + 1) & 1);
    __syncthreads();
  }
  EXPSUM(SB)
  f32x4 ci2[2][2];
#pragma unroll
  for (int i = 0; i < 2; ++i) {
    float l0 = lsum[0][i], l1 = lsum[1][i];
    l0 += shx<16>(l0); l0 = add32(l0);
    l1 += shx<16>(l1); l1 = add32(l1);
    const float c0 = negMb - __log2f(l0), c1 = negMb + __log2f(fabsf(lam)) - __log2f(l1);
    ci2[0][i] = (f32x4){c0, c0, c0, c0}; ci2[1][i] = (f32x4){c1, c1, c1, c1};
  }
  const float nsl = lam < 0.f ? 1.f : -1.f;
#define CI2(c, i) ci2[c][i]
  f32x4 O[2][8];
#pragma unroll
  for (int i = 0; i < 2; ++i)
#pragma unroll
    for (int n = 0; n < 8; ++n) O[i][n] = (f32x4){0.f, 0.f, 0.f, 0.f};
  KLOAD(0); VLOAD(0);
  KSTORE(0); VSTORE(0);
  __syncthreads();
#pragma unroll 1
  for (int t = 0; t < nt; ++t) {
    if (t + 1 < nt) KLOAD(t + 1);
    const bf16_t* Kb = Ks + (t & 1) * 64 * 144;
    const bf16_t* Vb = Vs + (t & 1) * 128 * 80;
#pragma unroll
    for (int half = 0; half < 2; ++half) {
      bf16x8 pf[2], vfa[4], vfb[4];
#define VREAD(dst, n0) _Pragma("unroll") for (int n = 0; n < 4; ++n) dst[n] = *(const bf16x8*)(Vb + (((n0) + n) * 16 + l15) * 80 + half * 32 + g * 8);
      {
        f32x4 S[2][2][2];
        QK_INTO(S, Kb, half, CI2)
        VREAD(vfa, 0)
        EXP_S()
#pragma unroll
        for (int i = 0; i < 2; ++i) {
          float w[8];
#pragma unroll
          for (int k2 = 0; k2 < 2; ++k2)
#pragma unroll
            for (int e = 0; e < 4; ++e) w[k2 * 4 + e] = __builtin_fmaf(nsl, S[1][i][k2][e], S[0][i][k2][e]);
          const u32x4 ww = {pk2(w[0], w[1]), pk2(w[2], w[3]), pk2(w[4], w[5]), pk2(w[6], w[7])};
          pf[i] = __builtin_bit_cast(bf16x8, ww);
        }
      }
      __builtin_amdgcn_sched_barrier(0);
      VREAD(vfb, 4)
#pragma unroll
      for (int n = 0; n < 4; ++n)
#pragma unroll
        for (int i = 0; i < 2; ++i) O[i][n] = mfma16(pf[i], vfa[n], O[i][n]);
      __builtin_amdgcn_sched_barrier(0);
#pragma unroll
      for (int n = 0; n < 4; ++n)
#pragma unroll
        for (int i = 0; i < 2; ++i) O[i][4 + n] = mfma16(pf[i], vfb[n], O[i][4 + n]);
      __builtin_amdgcn_sched_barrier(0);
#undef VREAD
      if (half == 0 && t + 1 < nt) VLOAD(t + 1);
    }
    if (t + 1 < nt) { KSTORE((t + 1) & 1); VSTORE((t + 1) & 1); }
    __syncthreads();
  }
#undef KLOAD
#undef VLOAD
#undef KSTORE
#undef VSTORE
#undef CI1
#undef CI2
#undef QK_INTO
#undef EXPSUM
#undef EXP_S
  const int lane_e = otid() & 63, l15e = lane_e & 15, ge = lane_e >> 4;
  const float* sg = p.dasub + layer * 128;
#pragma unroll
  for (int i = 0; i < 2; ++i)
#pragma unroll
    for (int e = 0; e < 4; ++e) {
      float ss = 0.f;
#pragma unroll
      for (int n = 0; n < 8; ++n) ss += O[i][n][e] * O[i][n][e];
      ss += shx<1>(ss); ss += shx<2>(ss); ss += shx<4>(ss); ss += shx<8>(ss);
      const float rstd = rsqrtf(ss * (1.f / 128.f) + EPS) * (1.f - lam_init);
      bf16_t* op = P + (size_t)(r0 + i * 16 + ge * 4 + e) * LDP + C_DAQ + h * 128 + l15e;
#pragma unroll
      for (int n = 0; n < 8; ++n) if (!dup) op[n * 16] = f2bf(O[i][n][e] * rstd * sg[n * 16 + l15e]);
    }
}

DI float gelu_tanh(float x) { const float u = 0.7978845608028654f * (x + 0.044715f * x * x * x); return 0.5f * x * (1.f + tanhf(u)); }
template <int PASS>
DI void job_lru(const Params& p, int layer, int it, char* lds, bool dup) {
  const int tid = otid(), lane = tid & 63, wid = tid >> 6, l15 = lane & 15, g = lane >> 4;
  const int n = it & 7, c = (it >> 3) % NCH, b = it / (8 * NCH);
  float* xc32 = (float*)lds;
  bf16_t* xcb = (bf16_t*)(lds + 16384);
  f32x2* ab = (f32x2*)(lds + 16384 + 9216);
  f32x2* segtot = (f32x2*)(lds + 16384 + 9216 + 32768);
  float* carry = (float*)(lds + 16384 + 9216 + 32768 + 2048);
  bf16_t* P = (bf16_t*)(p.ws + OFF_P);
  f32x2* LC = (f32x2*)(p.ws + OFF_LC);
  const int ch = tid & 63, seg = tid >> 6;
  {
    const int segLo = c < 4 ? 0 : TC, segHi = c < 4 ? TC : TT;
    const int s0 = c * 64 + seg * 16;
    float cw[4];
#pragma unroll
    for (int k = 0; k < 4; ++k) cw[k] = p.lcw[(size_t)(layer * 4 + k) * 512 + n * 64 + ch];
    const float cb = p.lcb[layer * 512 + n * 64 + ch];
    float xw[19];
#pragma unroll
    for (int j = 0; j < 19; ++j) {
      const int s = s0 - 1 + j;
      xw[j] = (s >= segLo && s < segHi) ? bf2f(P[(size_t)(b * TT + s) * LDP + C_LX + n * 64 + ch]) : 0.f;
    }
#pragma unroll
    for (int u = 0; u < 16; ++u) {
      const float v = cw[0] * xw[u] + cw[1] * xw[u + 1] + cw[2] * xw[u + 2] + cw[3] * xw[u + 3] + cb;
      xc32[(seg * 16 + u) * 64 + ch] = v;
      xcb[(seg * 16 + u) * 72 + ch] = f2bf(v);
    }
  }
  if (PASS == 3 && tid < 128) {
    const int d = tid >> 6;
    const int pos = d == 0 ? c : (c < 4 ? 3 - c : 4 + (NCH - 1 - c));
    float hh = 0.f;
    for (int q0 = 0; q0 < pos; q0 += 16) {
      f32x2 AB[16];
#pragma unroll
      for (int j = 0; j < 16; ++j) {
        const int q = q0 + j, qq = q < pos ? q : pos - 1;
        const int cc = d == 0 ? qq : (qq < 4 ? 3 - qq : NCH - 1 - (qq - 4));
        AB[j] = LC[((((size_t)b * NCH + cc) * 8 + n) * 2 + d) * 64 + ch];
      }
#pragma unroll
      for (int j = 0; j < 16; ++j) if (q0 + j < pos) hh = AB[j].x * hh + AB[j].y;
    }
    carry[d * 64 + ch] = hh;
  }
  __syncthreads();
  float hacc[16];
#pragma unroll
  for (int u = 0; u < 16; ++u) hacc[u] = 0.f;
#pragma unroll 1
  for (int d = 0; d < 2; ++d) {
    {
      f32x4 ar[4], ai[4];
#pragma unroll
      for (int i = 0; i < 4; ++i) { ar[i] = (f32x4){0.f, 0.f, 0.f, 0.f}; ai[i] = (f32x4){0.f, 0.f, 0.f, 0.f}; }
      const bf16_t* LG = (const bf16_t*)(p.ws + OFF_LG);
      const bf16_t* wr_ = LG + ((size_t)((d * 2 + 0) * 8 + n)) * 4096 + (wid * 16 + l15) * 64 + g * 8;
      const bf16_t* wi_ = LG + ((size_t)((d * 2 + 1) * 8 + n)) * 4096 + (wid * 16 + l15) * 64 + g * 8;
#pragma unroll
      for (int ks = 0; ks < 2; ++ks) {
        const bf16x8 br = *(const bf16x8*)(wr_ + ks * 32), bi = *(const bf16x8*)(wi_ + ks * 32);
#pragma unroll
        for (int i = 0; i < 4; ++i) {
          const bf16x8 af = *(const bf16x8*)(xcb + (i * 16 + l15) * 72 + ks * 32 + g * 8);
          ar[i] = mfma16(br, af, ar[i]);
          ai[i] = mfma16(bi, af, ai[i]);
        }
      }
#pragma unroll
      for (int e = 0; e < 4; ++e) {
        const int che = wid * 16 + g * 4 + e, cg_ = n * 64 + che;
        const float br = p.lgb[(size_t)((layer * 2 + d) * 2 + 0) * 512 + cg_], bi = p.lgb[(size_t)((layer * 2 + d) * 2 + 1) * 512 + cg_];
        const float sp = softplusf(-p.llam[(size_t)(layer * 2 + d) * 512 + cg_]);
#pragma unroll
        for (int i = 0; i < 4; ++i) {
          const int tok = i * 16 + l15;
          const float r = sigm(ar[i][e] + br), ig = sigm(ai[i][e] + bi);
          const float la = -8.f * r * sp;
          const float av = __expf(la);
          const float bv = __builtin_sqrtf(fmaxf(1.f - __expf(2.f * la), 0.f)) * ig * xc32[tok * 64 + che];
          ab[tok * 64 + che] = (f32x2){av, bv};
        }
      }
    }
    __syncthreads();
    float hloc[16], cploc[16];
    {
      float hp = 0.f, cp = 1.f;
#pragma unroll
      for (int uu = 0; uu < 16; ++uu) {
        const int u = d == 0 ? uu : 15 - uu;
        const f32x2 v = ab[(seg * 16 + u) * 64 + ch];
        hp = v.x * hp + v.y;
        cp *= v.x;
        hloc[uu] = hp; cploc[uu] = cp;
      }
      segtot[seg * 64 + ch] = (f32x2){cp, hp};
    }
    __syncthreads();
    if (PASS == 1) {
      if (tid < 64) {
        float A = 1.f, Bv = 0.f;
#pragma unroll
        for (int q = 0; q < 4; ++q) {
          const f32x2 v = segtot[(d == 0 ? q : 3 - q) * 64 + ch];
          Bv = v.x * Bv + v.y; A *= v.x;
        }
        LC[((((size_t)b * NCH + c) * 8 + n) * 2 + d) * 64 + ch] = (f32x2){A, Bv};
      }
    } else {
      float hh = carry[d * 64 + ch];
      const int npre = d == 0 ? seg : 3 - seg;
      for (int q = 0; q < npre; ++q) {
        const f32x2 v = segtot[(d == 0 ? q : 3 - q) * 64 + ch];
        hh = v.x * hh + v.y;
      }
#pragma unroll
      for (int uu = 0; uu < 16; ++uu) {
        const int u = d == 0 ? uu : 15 - uu;
        const float hv = hloc[uu] + cploc[uu] * hh;
        hacc[d == 0 ? uu : 15 - uu] += hv;
        (void)u;
      }
    }
    __syncthreads();
  }
  if (PASS == 3) {
#pragma unroll
    for (int u = 0; u < 16; ++u) {
      bf16_t* yp = P + (size_t)(b * TT + c * 64 + seg * 16 + u) * LDP + C_LY + n * 64 + ch;
      if (!dup) *yp = f2bf(gelu_tanh(bf2f(*yp)) * hacc[u]);
    }
  }
}

DI void job_gconv(const Params& p, int layer, int it, bool dup) {
  const int tid = otid(), grp = it % 12, cg_ = it / 12, cp = tid & 15, rg = tid >> 4;
  const int cin = cg_ % NCH;
  const bool first = (cin == 0 || cin == 4), last = (cin == 3 || cin == NCH - 1);
  bf16_t* P = (bf16_t*)(p.ws + OFF_P);
  const bf16_t* HALO = (const bf16_t*)(p.ws + OFF_HALO);
  const int col = grp * 128 + cp * 8;
  u32x4 xr[7];
#pragma unroll
  for (int j = 0; j < 7; ++j) {
    const int q = rg * 4 - 1 + j;
    u32x4 v = {0u, 0u, 0u, 0u};
    if (q >= 0 && q < 64) v = *(const u32x4*)(P + (size_t)(cg_ * 64 + q) * LDP + C_GQKV + col);
    else if (q < 0) { if (!first) v = *(const u32x4*)(HALO + ((size_t)(cg_ - 1) * 3 + 2) * 1536 + col); }
    else { if (!last) v = *(const u32x4*)(HALO + ((size_t)(cg_ + 1) * 3 + (q - 64)) * 1536 + col); }
    xr[j] = v;
  }
  float w[4][8];
#pragma unroll
  for (int k = 0; k < 4; ++k) {
    const f32x4 a = *(const f32x4*)(p.gcw + (size_t)(layer * 4 + k) * 1536 + col), bq = *(const f32x4*)(p.gcw + (size_t)(layer * 4 + k) * 1536 + col + 4);
#pragma unroll
    for (int e = 0; e < 4; ++e) { w[k][e] = a[e]; w[k][4 + e] = bq[e]; }
  }
  __syncthreads();
#pragma unroll
  for (int jr = 0; jr < 4; ++jr) {
    float y[8];
#pragma unroll
    for (int e = 0; e < 8; ++e) y[e] = 0.f;
#pragma unroll
    for (int k = 0; k < 4; ++k)
#pragma unroll
      for (int e = 0; e < 4; ++e) { y[2 * e] += w[k][2 * e] * bflo(xr[jr + k][e]); y[2 * e + 1] += w[k][2 * e + 1] * bfhi(xr[jr + k][e]); }
    float ss = 0.f;
#pragma unroll
    for (int e = 0; e < 8; ++e) { y[e] = y[e] * sigm(y[e]); ss += y[e] * y[e]; }
    if (grp < 8) {
      ss += shx<1>(ss); ss += shx<2>(ss); ss += shx<4>(ss); ss += shx<8>(ss);
      const float sc = rsqrtf(ss + EPS) * (grp < 4 ? 0.08838834764831845f : 1.f);
#pragma unroll
      for (int e = 0; e < 8; ++e) y[e] *= sc;
    }
    if (!dup) *(u32x4*)(P + (size_t)(cg_ * 64 + rg * 4 + jr) * LDP + C_GQKV + col) = (u32x4){pk2(y[0], y[1]), pk2(y[2], y[3]), pk2(y[4], y[5]), pk2(y[6], y[7])};
  }
  __syncthreads();
}

DI void job_gprep(const Params& p, int layer, int it, char* lds) {
  const int tid = otid(), lane = tid & 63, wid = tid >> 6, l15 = lane & 15, g = lane >> 4;
  const int h = it & 3, c = (it >> 2) % NCH, b = it / (4 * NCH);
  bf16_t* kt_ = (bf16_t*)lds;
  bf16_t* qt_ = kt_ + 64 * 136;
  float* Ld = (float*)lds;
  float* KK = (float*)(lds + 34816);
  float* QK = KK + 64 * 65;
  float* gcs = QK + 64 * 65;
  float* bts = gcs + 128;
  const bf16_t* P = (const bf16_t*)(p.ws + OFF_P);
#pragma unroll
  for (int i = 0; i < 4; ++i) {
    const int q = tid + 256 * i, row = q >> 4, pc = q & 15;
    const bf16_t* rp = P + (size_t)(b * TT + c * 64 + row) * LDP + C_GQKV + h * 128 + pc * 8;
    *(u32x4*)(qt_ + row * 136 + pc * 8) = *(const u32x4*)rp;
    *(u32x4*)(kt_ + row * 136 + pc * 8) = *(const u32x4*)(rp + 512);
  }
  float* GSC = (float*)(p.ws + OFF_GSC);
  if (tid < 128) {
    const int d = wid, i = lane, tn = d ? 63 - i : i, r = b * TT + c * 64 + tn;
    const float* gba = (const float*)(p.ws + OFF_GBA) + (size_t)r * 16;
    const float gval = -expf(p.galog[(layer * 2 + d) * 4 + h]) * softplusf(gba[8 + d * 4 + h] + p.gdtb[(layer * 2 + d) * 4 + h]);
    const float beta = sigm(gba[d * 4 + h]);
    float v = gval;
#pragma unroll
    for (int o = 1; o < 64; o <<= 1) { const float t = __int_as_float(__builtin_amdgcn_ds_bpermute(((lane - o) & 63) << 2, __float_as_int(v))); if (lane >= o) v += t; }
    const float glast = __int_as_float(__builtin_amdgcn_readlane(__float_as_int(v), 63));
    gcs[d * 64 + i] = v;
    bts[d * 64 + i] = beta;
    float* gs = GSC + (size_t)(it * 2 + d) * 192;
    gs[i] = expf(v);
    gs[64 + i] = expf(glast - v);
    if (i == 0) gs[128] = expf(glast);
  }
  __syncthreads();
  {
    f32x4 akk[4], aqk[4];
#pragma unroll
    for (int j = 0; j < 4; ++j) { akk[j] = (f32x4){0.f, 0.f, 0.f, 0.f}; aqk[j] = (f32x4){0.f, 0.f, 0.f, 0.f}; }
#pragma unroll
    for (int ks = 0; ks < 4; ++ks) {
      const bf16x8 ak = *(const bf16x8*)(kt_ + (wid * 16 + l15) * 136 + ks * 32 + g * 8);
      const bf16x8 aq = *(const bf16x8*)(qt_ + (wid * 16 + l15) * 136 + ks * 32 + g * 8);
#pragma unroll
      for (int j = 0; j < 4; ++j) {
        const bf16x8 bk = *(const bf16x8*)(kt_ + (j * 16 + l15) * 136 + ks * 32 + g * 8);
        akk[j] = mfma16(ak, bk, akk[j]);
        aqk[j] = mfma16(aq, bk, aqk[j]);
      }
    }
#pragma unroll
    for (int j = 0; j < 4; ++j)
#pragma unroll
      for (int e = 0; e < 4; ++e) { KK[(wid * 16 + g * 4 + e) * 65 + j * 16 + l15] = akk[j][e]; QK[(wid * 16 + g * 4 + e) * 65 + j * 16 + l15] = aqk[j][e]; }
  }
  __syncthreads();
  bf16_t* M1 = (bf16_t*)(p.ws + OFF_H);
  bf16_t* AT = M1 + (size_t)4224 * 4096;
#pragma unroll 1
  for (int d = 0; d < 2; ++d) {
    bf16_t* atp = AT + (size_t)(it * 2 + d) * 4096;
#pragma unroll 4
    for (int idx = tid; idx < 4096; idx += 256) {
      const int i = idx >> 6, j = idx & 63, ti = d ? 63 - i : i, tj = d ? 63 - j : j;
      const float dec = (j <= i) ? expf(gcs[d * 64 + i] - gcs[d * 64 + j]) : 0.f;
      Ld[d * 4096 + idx] = (j < i) ? bts[d * 64 + i] * KK[ti * 65 + tj] * dec : 0.f;
      atp[idx] = f2bf(QK[ti * 65 + tj] * dec);
    }
  }
  __syncthreads();
  if (wid < 2) {
    const int d = wid;
    const float* L = Ld + d * 4096;
    const float bc = bts[d * 64 + lane];
    bf16_t* mp = M1 + (size_t)(it * 2 + d) * 4096 + lane;
    float x[64];
#pragma unroll
    for (int i = 0; i < 64; ++i) {
      float s = (i == lane) ? 1.f : 0.f;
#pragma unroll
      for (int j = 0; j < i; ++j) s -= L[i * 64 + j] * x[j];
      x[i] = s;
      mp[i * 64] = f2bf(s * bc);
    }
  }
  __syncthreads();
}

struct GChunk { bf16x8 kf[4], qf[4], m1f[2], atf[2]; unsigned vr[2][4]; float eg[4], egl[4]; float ge; };
DI void gdn_load(GChunk& R, const Params& p, int b, int h, int d, int dvs, int c) {
  const int tid = otid(), lane = tid & 63, wid = tid >> 6, l15 = lane & 15, g = lane >> 4;
  const bf16_t* P = (const bf16_t*)(p.ws + OFF_P);
  const bf16_t* M1 = (const bf16_t*)(p.ws + OFF_H);
  const bf16_t* AT = M1 + (size_t)4224 * 4096;
  const float* GSC = (const float*)(p.ws + OFF_GSC);
  const int item = ((b * NCH + c) * 4 + h) * 2 + d;
  const int irow = 16 * wid + l15, tn = d ? 63 - irow : irow;
  const bf16_t* rowp = P + (size_t)(b * TT + c * 64 + tn) * LDP + C_GQKV + h * 128;
#pragma unroll
  for (int ks = 0; ks < 4; ++ks) { R.qf[ks] = *(const bf16x8*)(rowp + ks * 32 + g * 8); R.kf[ks] = *(const bf16x8*)(rowp + 512 + ks * 32 + g * 8); }
#pragma unroll
  for (int ks = 0; ks < 2; ++ks) {
    R.m1f[ks] = *(const bf16x8*)(M1 + (size_t)item * 4096 + irow * 64 + ks * 32 + g * 8);
    R.atf[ks] = *(const bf16x8*)(AT + (size_t)item * 4096 + irow * 64 + ks * 32 + g * 8);
  }
#pragma unroll
  for (int e = 0; e < 4; ++e) {
    const int i = 16 * wid + g * 4 + e, t2 = d ? 63 - i : i;
    R.vr[0][e] = *(const unsigned*)(P + (size_t)(b * TT + c * 64 + t2) * LDP + C_GQKV + 1024 + h * 128 + dvs * 32 + (l15 & ~1));
    R.vr[1][e] = *(const unsigned*)(P + (size_t)(b * TT + c * 64 + t2) * LDP + C_GQKV + 1024 + h * 128 + dvs * 32 + 16 + (l15 & ~1));
    R.eg[e] = GSC[(size_t)item * 192 + i];
    R.egl[e] = GSC[(size_t)item * 192 + 64 + i];
  }
  R.ge = GSC[(size_t)item * 192 + 128];
}
DI void gdn_put_kt(const GChunk& R, bf16_t* KT) {
  const int tid = otid(), lane = tid & 63, i = 16 * (tid >> 6) + (lane & 15), g = lane >> 4;
#pragma unroll
  for (int ks = 0; ks < 4; ++ks)
#pragma unroll
    for (int e = 0; e < 8; ++e) KT[(ks * 32 + g * 8 + e) * 72 + i] = (bf16_t)R.kf[ks][e];
}
DI int gdn_chunk_at(int d, int n) { return d == 0 ? n : (n < 4 ? 3 - n : NCH - 1 - (n - 4)); }
DI void job_gscan(const Params& p, int u, char* lds) {
  const int tid = otid(), lane = tid & 63, wid = tid >> 6, l15 = lane & 15, g = lane >> 4;
  const int seq = (u & 7) + 8 * (u >> 5), dvs = (u >> 3) & 3, d = seq & 1, h = (seq >> 1) & 3, b = seq >> 3;
  bf16_t* KT = (bf16_t*)lds;
  bf16_t* ST = KT + 2 * 128 * 72;
  bf16_t* XT = ST + 32 * 136;
  bf16_t* VnT = XT + 32 * 72;
  bf16_t* VsT = VnT + 32 * 72;
  bf16_t* OUT = d == 0 ? (bf16_t*)(p.ws + OFF_P) + C_DAV : (bf16_t*)(p.ws + OFF_OB);
  const int ldo = d == 0 ? LDP : 512;
  __builtin_amdgcn_s_setprio(3);
  f32x4 S[2][2];
#pragma unroll
  for (int a = 0; a < 2; ++a)
#pragma unroll
    for (int ct = 0; ct < 2; ++ct) S[a][ct] = (f32x4){0.f, 0.f, 0.f, 0.f};
  for (int i = tid; i < 32 * 136 / 2; i += 256) ((unsigned*)ST)[i] = 0u;
  GChunk cur, nxt;
  gdn_load(cur, p, b, h, d, dvs, gdn_chunk_at(d, 0));
  gdn_put_kt(cur, KT);
  __syncthreads();
#pragma unroll 1
  for (int n = 0; n < NCH; ++n) {
    const int c = gdn_chunk_at(d, n);
    if (n + 1 < NCH) gdn_load(nxt, p, b, h, d, dvs, gdn_chunk_at(d, n + 1));
    const bf16_t* KTc = KT + (n & 1) * 128 * 72;
    f32x4 ksa[2], qsa[2];
#pragma unroll
    for (int ct = 0; ct < 2; ++ct) { ksa[ct] = (f32x4){0.f, 0.f, 0.f, 0.f}; qsa[ct] = (f32x4){0.f, 0.f, 0.f, 0.f}; }
#pragma unroll
    for (int ks = 0; ks < 4; ++ks)
#pragma unroll
      for (int ct = 0; ct < 2; ++ct) {
        const bf16x8 bS = *(const bf16x8*)(ST + (ct * 16 + l15) * 136 + ks * 32 + g * 8);
        ksa[ct] = mfma16(cur.kf[ks], bS, ksa[ct]);
        qsa[ct] = mfma16(cur.qf[ks], bS, qsa[ct]);
      }
#pragma unroll
    for (int ct = 0; ct < 2; ++ct) {
      float x[4];
#pragma unroll
      for (int e = 0; e < 4; ++e) x[e] = ((l15 & 1) ? bfhi(cur.vr[ct][e]) : bflo(cur.vr[ct][e])) - cur.eg[e] * ksa[ct][e];
      *(u32x2*)(XT + (ct * 16 + l15) * 72 + 16 * wid + g * 4) = (u32x2){pk2(x[0], x[1]), pk2(x[2], x[3])};
    }
    __syncthreads();
#pragma unroll
    for (int ct = 0; ct < 2; ++ct) {
      f32x4 vn = {0.f, 0.f, 0.f, 0.f};
#pragma unroll
      for (int ks = 0; ks < 2; ++ks) vn = mfma16(cur.m1f[ks], *(const bf16x8*)(XT + (ct * 16 + l15) * 72 + ks * 32 + g * 8), vn);
      *(u32x2*)(VnT + (ct * 16 + l15) * 72 + 16 * wid + g * 4) = (u32x2){pk2(vn[0], vn[1]), pk2(vn[2], vn[3])};
      *(u32x2*)(VsT + (ct * 16 + l15) * 72 + 16 * wid + g * 4) = (u32x2){pk2(vn[0] * cur.egl[0], vn[1] * cur.egl[1]), pk2(vn[2] * cur.egl[2], vn[3] * cur.egl[3])};
    }
    __syncthreads();
#pragma unroll
    for (int ct = 0; ct < 2; ++ct) {
      f32x4 o;
#pragma unroll
      for (int e = 0; e < 4; ++e) o[e] = cur.eg[e] * qsa[ct][e];
#pragma unroll
      for (int ks = 0; ks < 2; ++ks) o = mfma16(cur.atf[ks], *(const bf16x8*)(VnT + (ct * 16 + l15) * 72 + ks * 32 + g * 8), o);
#pragma unroll
      for (int e = 0; e < 4; ++e) {
        const int i = 16 * wid + g * 4 + e, t2 = d ? 63 - i : i;
        OUT[(size_t)(b * TT + c * 64 + t2) * ldo + h * 128 + dvs * 32 + ct * 16 + l15] = f2bf(o[e]);
      }
    }
#pragma unroll
    for (int rt2 = 0; rt2 < 2; ++rt2) {
      const int rt = 2 * wid + rt2;
#pragma unroll
      for (int ct = 0; ct < 2; ++ct)
#pragma unroll
        for (int e = 0; e < 4; ++e) S[rt2][ct][e] *= cur.ge;
#pragma unroll
      for (int ks = 0; ks < 2; ++ks) {
        const bf16x8 ka = *(const bf16x8*)(KTc + (rt * 16 + l15) * 72 + ks * 32 + g * 8);
#pragma unroll
        for (int ct = 0; ct < 2; ++ct) S[rt2][ct] = mfma16(ka, *(const bf16x8*)(VsT + (ct * 16 + l15) * 72 + ks * 32 + g * 8), S[rt2][ct]);
      }
#pragma unroll
      for (int ct = 0; ct < 2; ++ct)
        *(u32x2*)(ST + (ct * 16 + l15) * 136 + rt * 16 + g * 4) = (u32x2){pk2(S[rt2][ct][0], S[rt2][ct][1]), pk2(S[rt2][ct][2], S[rt2][ct][3])};
    }
    if (n + 1 < NCH) { gdn_put_kt(nxt, KT + ((n + 1) & 1) * 128 * 72); cur = nxt; }
    __syncthreads();
  }
  __builtin_amdgcn_s_setprio(0);
}
DI void job_gpost1(const Params& p, int layer, int r) {
  const int lane = otid() & 63;
  bf16_t* P = (bf16_t*)(p.ws + OFF_P) + (size_t)r * LDP;
  const bf16_t* OB = (const bf16_t*)(p.ws + OFF_OB) + (size_t)r * 512;
  const u32x4 of = *(const u32x4*)(P + C_DAV + lane * 8), ob = *(const u32x4*)(OB + lane * 8), z = *(const u32x4*)(P + C_GZ + lane * 8);
  float o[8], zz[8], ss = 0.f;
#pragma unroll
  for (int e = 0; e < 4; ++e) {
    o[2 * e] = bflo(of[e]) + bflo(ob[e]); o[2 * e + 1] = bfhi(of[e]) + bfhi(ob[e]);
    zz[2 * e] = bflo(z[e]); zz[2 * e + 1] = bfhi(z[e]);
  }
#pragma unroll
  for (int e = 0; e < 8; ++e) ss += o[e] * o[e];
  ss += shx<1>(ss); ss += shx<2>(ss); ss += shx<4>(ss); ss += shx<8>(ss);
  const float rstd = rsqrtf(ss * (1.f / 128.f) + EPS);
  const float* gn = p.gng + layer * 128 + (lane & 15) * 8;
  float y[8];
#pragma unroll
  for (int e = 0; e < 8; ++e) y[e] = o[e] * rstd * gn[e] * (zz[e] * sigm(zz[e]));
  *(u32x4*)(P + C_GZ + lane * 8) = (u32x4){pk2(y[0], y[1]), pk2(y[2], y[3]), pk2(y[4], y[5]), pk2(y[6], y[7])};
}

DI void job_gpost(const Params& p, int layer, int it) {
  const int wid = otid() >> 6;
#pragma unroll
  for (int rr = 0; rr < 2; ++rr) job_gpost1(p, layer, it * 8 + rr * 4 + wid);
}
#ifdef SK_JL1
#define JL1(x)
#else
#define JL1(x) x
#endif
#ifdef SK_JGC
#define JGC(x)
#else
#define JGC(x) x
#endif
#ifdef SK_JVT
#define JVT(x)
#else
#define JVT(x) x
#endif
#ifdef SK_JDP
#define JDP(x)
#else
#define JDP(x) x
#endif
#ifdef SK_JGP
#define JGP(x)
#else
#define JGP(x) x
#endif
#ifdef SK_JL3
#define JL3(x)
#else
#define JL3(x) x
#endif
#ifdef SK_JGS
#define JGS(x)
#else
#define JGS(x) x
#endif
#ifdef SK_JAT
#define JAT(x)
#else
#define JAT(x) x
#endif
#define LAS __attribute__((address_space(3)))
#define XB_TMO      128
#define XB_XCNT(j)  (256  + 64 * (j))
#define XB_XSUB(j)  (1280 + 64 * (j))
#define XB_XGEN(j)  (2304 + 64 * (j))
#define XB_TOP      3328
#define XB_TOPGEN   3392
#define XCD_BAR_WORDS 3456
#define XB_SPIN_CAP (1u << 18)

__device__ __forceinline__ unsigned xb_ld(unsigned* p)              { return __hip_atomic_load(p, __ATOMIC_RELAXED, __HIP_MEMORY_SCOPE_AGENT); }
__device__ __forceinline__ unsigned xb_add(unsigned* p, unsigned v) { return __hip_atomic_fetch_add(p, v, __ATOMIC_RELAXED, __HIP_MEMORY_SCOPE_AGENT); }
__device__ __forceinline__ unsigned xb_xcc_id() { return (unsigned)__builtin_amdgcn_s_getreg((3 << 11) | 20) & 0xFu; }
#define XB_SPIN(cond, bar) do { unsigned _sp = 0; while (cond) { __builtin_amdgcn_s_sleep(1); \
    if ((++_sp & 255u) == 0u) { if (xb_ld(&(bar)[XB_TMO])) break; if (_sp > XB_SPIN_CAP) { atomicAdd(&(bar)[XB_TMO], 1u); break; } } } } while (0)

struct XcdBarrier {
    unsigned* bar; unsigned x;
    volatile LAS unsigned* st;
};

__device__ __forceinline__ XcdBarrier xcd_barrier_post(unsigned* bar, volatile LAS unsigned* st) {
    XcdBarrier b; b.bar = bar; b.x = xb_xcc_id(); b.st = st;
    if (threadIdx.x == 0) (void)xb_add(&bar[XB_XCNT(b.x)], 1u);
    return b;
}
__device__ __forceinline__ void xcd_barrier_complete(unsigned* bar, unsigned x, unsigned& nloc, unsigned& nx) {
    const unsigned G = gridDim.x * gridDim.y * gridDim.z;
    unsigned sum, cnt, mine, sp = 0u;
    for (;;) {
        sum = 0u; cnt = 0u; mine = 0u;
#pragma unroll
        for (unsigned j = 0; j < 16; ++j) { const unsigned c = xb_ld(&bar[XB_XCNT(j)]); sum += c; cnt += (c > 0u) ? 1u : 0u; mine = (j == x) ? c : mine; }
        if (sum == G) break;
        __builtin_amdgcn_s_sleep(1);
        if ((++sp & 255u) == 0u) { if (xb_ld(&bar[XB_TMO])) break; if (sp > XB_SPIN_CAP) { atomicAdd(&bar[XB_TMO], 1u); break; } }
    }
    nloc = mine > 0u ? mine : 1u; nx = cnt > 0u ? cnt : 1u;
}

__device__ __forceinline__ void xcd_barrier(const XcdBarrier& b) {
    asm volatile("s_waitcnt vmcnt(0)" ::: "memory");
    __syncthreads();
    if (threadIdx.x == 0) {
        unsigned* bar = b.bar; unsigned bx_ = b.x;
        asm volatile("" : "+s"(bar), "+s"(bx_));
        __builtin_amdgcn_s_waitcnt(0);
        unsigned nloc = b.st[0], nx = b.st[1];
        if (nloc == 0u) { xcd_barrier_complete(bar, bx_, nloc, nx); b.st[0] = nloc; b.st[1] = nx; }
        const unsigned old = xb_add(&bar[XB_XSUB(bx_)], 1u);
        const unsigned gen = old / nloc;
        if (old + 1u == (gen + 1u) * nloc) {
            __builtin_amdgcn_fence(__ATOMIC_RELEASE, "agent");
            asm volatile("s_waitcnt vmcnt(0)" ::: "memory");
            const unsigned og = xb_add(&bar[XB_TOP], 1u);
            const unsigned tg = og / nx;
            if (og + 1u == (tg + 1u) * nx) xb_add(&bar[XB_TOPGEN], 1u);
            else XB_SPIN(xb_ld(&bar[XB_TOPGEN]) == tg, bar);
            __builtin_amdgcn_fence(__ATOMIC_ACQUIRE, "agent");
            xb_add(&bar[XB_XGEN(bx_)], 1u);
            asm volatile("s_waitcnt vmcnt(0)" ::: "memory");
        } else {
            XB_SPIN(xb_ld(&bar[XB_XGEN(bx_)]) == gen, bar);
            __builtin_amdgcn_fence(__ATOMIC_ACQUIRE, "agent");
            asm volatile("s_waitcnt vmcnt(0)" ::: "memory");
        }
    }
    __syncthreads();
}


#define PH_BEGIN(k) for (int rep_ = 0, nrep_ = 1 + (((p.probe >> (k)) & 1) | ((k) == 5 ? ((p.probe >> 12) | (p.probe >> 13)) & 1 : 0)); rep_ < nrep_; ++rep_) { const bool dup = rep_ > 0; (void)dup;
#define PH_END xcd_barrier(xb_); }
#ifndef PROBE_MASK
#define PROBE_MASK 0
#endif
__global__ void __launch_bounds__(256, 2) mega(Params p) {
  __shared__ __attribute__((aligned(16))) char lds[LDS_BYTES];
  __shared__ int s_item;
  __shared__ unsigned xb_st[2];
  if (otid() == 0) { xb_st[0] = 0u; xb_st[1] = 0u; }
  __syncthreads();
  const XcdBarrier xb_ = xcd_barrier_post((unsigned*)(p.ws + OFF_CTR) + 64, (volatile LAS unsigned*)xb_st);
  cg::grid_group grid = cg::this_grid();
  const int G = gridDim.x, B = blockIdx.x;
  bf16_t* P = (bf16_t*)(p.ws + OFF_P);
  bf16_t* H = (bf16_t*)(p.ws + OFF_H);
  for (int it = B; it < 192 + 1024 + N_CVT; it += G) {
    if (it < 192) job_mod(p, it, lds);
    else if (it < 1216) job_rope(p, it - 192);
    else job_cvt(p, 0, it - 1216, lds);
  }
  if (p.probe < 0) grid.sync();
  xcd_barrier(xb_);
#pragma unroll 1
  for (int layer = 0; layer < 2; ++layer) {
    bf16_t* MG = (bf16_t*)(p.ws + OFF_VT);
    bf16_t* HID = P;
    PH_BEGIN(1)
    {
      const int n1 = layer == 1 ? N_CVT : 0;
      for (int it = B; it < n1 + MR / 8; it += G) { if (it < n1) job_cvt(p, 1, it, lds); else job_norm(p, layer, 1, it - n1); }
    }
    PH_END
    PH_BEGIN(2)
    {
      bf16_t* HALO = (bf16_t*)(p.ws + OFF_HALO);
      float* GBA = (float*)(p.ws + OFF_GBA);
      gemm_phase(H, 32, MR * 32, (const bf16_t*)(p.ws + OFF_WIN), 32, 7808 * 32, 1024, 132, 37, lds, B, G, [&](int row, int col, f32x4 v) {
        if (col < C_GBA) {
          const u32x2 w = {pk2(v[0], v[1]), pk2(v[2], v[3])};
          *(u32x2*)(P + (size_t)row * LDP + col) = w;
          if (col >= C_GQKV && col < C_GZ) {
            const int sm = row & 63;
            if (sm <= 1 || sm == 63) *(u32x2*)(HALO + ((size_t)(row >> 6) * 3 + (sm == 63 ? 2 : sm)) * 1536 + (col - C_GQKV)) = w;
          }
        } else if (col < C_GBA + 16) {
          *(f32x4*)(GBA + (size_t)row * 16 + (col - C_GBA)) = v;
        }
      }, [&](int row, int col, f32x4 v0, f32x4 v1) {
        if (col < C_GBA) {
          const u32x4 w = (u32x4){pk2(v0[0], v0[1]), pk2(v0[2], v0[3]), pk2(v1[0], v1[1]), pk2(v1[2], v1[3])};
          __builtin_nontemporal_store(w, (u32x4*)(P + (size_t)row * LDP + col));
          if (col >= C_GQKV && col < C_GZ) {
            const int sm = row & 63;
            if (sm <= 1 || sm == 63) *(u32x4*)(HALO + ((size_t)(row >> 6) * 3 + (sm == 63 ? 2 : sm)) * 1536 + (col - C_GQKV)) = w;
          }
        } else if (col < C_GBA + 16) {
          *(f32x4*)(GBA + (size_t)row * 16 + (col - C_GBA)) = v0;
          *(f32x4*)(GBA + (size_t)row * 16 + (col - C_GBA) + 4) = v1;
        }
      });
    }
    PH_END
    PH_BEGIN(3)
    {
      const int nA = 8 * NCH * 4, nB = nA + 6336, nC = nB + 2112, nD = nC + MR / 8;
      for (int it = B; it < nD; it += G) {
        if (it < nA) JL1(job_lru<1>(p, layer, it, lds, dup));
        else if (it < nB) JGC(job_gconv(p, layer, it - nA, dup));
        else if (it < nC) JVT(job_vt(p, it - nB, lds));
        else JDP(job_daprep(p, layer, it - nC, dup));
      }
    }
    PH_END
    PH_BEGIN(4)
    for (int it = B; it < 2112; it += G) JGP(job_gprep(p, layer, it, lds));
    PH_END
    PH_BEGIN(5)
    {
      for (;;) {
        const int x = blockIdx.x & 7;
        if (otid() == 0) s_item = (int)__hip_atomic_fetch_add((unsigned*)(p.ws + OFF_CTR) + ((layer * 2 + rep_) * 8 + x), 1u, __ATOMIC_RELAXED, __HIP_MEMORY_SCOPE_AGENT);
        __syncthreads();
        const int j = __builtin_amdgcn_readfirstlane(s_item);
        __syncthreads();
        if (j >= 16 + 132 + 528) break;
        if (j < 16) { if (!(dup && ((p.probe >> 12) & 1))) JGS(job_gscan(p, j * 8 + x, lds)); }
        else if (j < 148) {
          const int k = j - 16, grp = k / 66, qq = k % 66, qb = qq < 64 ? qq + 2 : qq - 64;
          if (!(dup && ((p.probe >> 13) & 1))) JAT(job_attn(p, layer, grp * 528 + qb * 8 + x, lds, dup));
        } else { if (!(dup && (((p.probe >> 12) | (p.probe >> 13)) & 1))) JL3(job_lru<3>(p, layer, (j - 148) * 8 + x, lds, dup)); }
      }
    }
    PH_END
    PH_BEGIN(6)
    for (int it = B; it < MR / 8 + MR / 8; it += G) { if (it < MR / 8) job_gpost(p, layer, it); else job_norm(p, layer, 1, it - MR / 8); }
    PH_END
    PH_BEGIN(7)
    gemm_phase(H, 32, MR * 32, (const bf16_t*)(p.ws + OFF_WIN) + (size_t)4736 * 32, 32, 7808 * 32, 1024, 132, 24, lds, B, G, [&](int row, int col, f32x4 v) {
      *(u32x2*)(P + (size_t)row * LDP + sg_col(col)) = (u32x2){pk2(sigm(v[0]), sigm(v[1])), pk2(sigm(v[2]), sigm(v[3]))};
    }, [&](int row, int col, f32x4 v0, f32x4 v1) {
      *(u32x4*)(P + (size_t)row * LDP + sg_col(col)) = (u32x4){pk2(sigm(v0[0]), sigm(v0[1])), pk2(sigm(v0[2]), sigm(v0[3])), pk2(sigm(v1[0]), sigm(v1[1])), pk2(sigm(v1[2]), sigm(v1[3]))};
    }, layer == 1);
    PH_END
    PH_BEGIN(14)
    {
      const bf16_t* WBR = (const bf16_t*)(p.ws + OFF_WBR);
      const int nm14 = layer == 1 ? 256 : 264;
      for (int t = B; t < nm14 * 8; t += G) {
        int mi, ni; tile_mn(t, nm14, 8, mi, ni);
        if (layer == 1) mi += 2 * (mi >> 6) + 2;
        f32x4 mg[4][4]; zero_acc<4>(mg);
#pragma unroll 1
        for (int i = 0; i < 3; ++i) {
          f32x4 ay[4][4]; zero_acc<4>(ay);
          const int coff = i == 0 ? C_DAQ : (i == 1 ? C_LY : C_GZ);
          gemm_core<4>(P + (size_t)mi * 128 * LDP + coff, LDP, 32, WBR + (size_t)i * 1024 * 512 + (size_t)(ni * 128) * 32, 32, 1024 * 32, 512, ay, lds);
          const int lane = otid() & 63, wid = otid() >> 6, wr = wid >> 1, wc = wid & 1;
#pragma unroll
          for (int a2 = 0; a2 < 4; ++a2)
#pragma unroll
            for (int b2 = 0; b2 < 4; ++b2) {
              const int row = mi * 128 + wr * 64 + a2 * 16 + (lane & 15), col = ni * 128 + wc * 64 + b2 * 16 + (lane >> 4) * 4;
              const u32x2 sg = *(const u32x2*)(P + (size_t)row * LDP + sg_col(i * 1024 + col));
              mg[a2][b2] += (f32x4){bflo(sg.x), bfhi(sg.x), bflo(sg.y), bfhi(sg.y)} * ay[a2][b2];
            }
        }
        gemm_emit<4>(mg, mi * 128, ni * 128, [&](int row, int col, f32x4 v) { *(u32x2*)(MG + ((size_t)(col >> 5) * MR + row) * 32 + (col & 31)) = (u32x2){pk2(v[0], v[1]), pk2(v[2], v[3])}; });
      }
    }
    PH_END
    PH_BEGIN(8)
    gemm_phase(MG, 32, MR * 32, (const bf16_t*)(p.ws + OFF_WO), 32, 1024 * 32, 1024, 132, 8, lds, B, G, [&](int row, int col, f32x4 v) {
      const f32x4 xin = *(const f32x4*)(res_in_row(p, layer, row) + col);
      const f32x4 g1 = *(const f32x4*)(mod_vec(p, layer, row) + 2048 + col);
      if (!dup) *(f32x4*)(res_out_row(p, row) + col) = xin + g1 * v;
    }, [&](int row, int col, f32x4 v0, f32x4 v1) {
      const float* xi = res_in_row(p, layer, row) + col;
      const float* gm = mod_vec(p, layer, row) + 2048 + col;
      float* xo = res_out_row(p, row) + col;
      const f32x4 o0 = __builtin_nontemporal_load((const f32x4*)xi) + *(const f32x4*)gm * v0, o1 = __builtin_nontemporal_load((const f32x4*)(xi + 4)) + *(const f32x4*)(gm + 4) * v1;
      if (!dup) { *(f32x4*)xo = o0; *(f32x4*)(xo + 4) = o1; }
    }, layer == 1);
    PH_END
    PH_BEGIN(9)
    for (int it = B; it < MR / 8; it += G) job_norm(p, layer, 2, it);
    PH_END
    PH_BEGIN(10)
    gemm_phase(H, 32, MR * 32, (const bf16_t*)(p.ws + OFF_W1), 32, 4096 * 32, 1024, 132, 32, lds, B, G, [&](int row, int col, f32x4 v) {
      float r[4];
#pragma unroll
      for (int e = 0; e < 4; ++e) { const float q = fmaxf(v[e], 0.f); r[e] = q * q; }
      *(u32x2*)(HID + ((size_t)(col >> 5) * MR + row) * 32 + (col & 31)) = (u32x2){pk2(r[0], r[1]), pk2(r[2], r[3])};
    }, [&](int row, int col, f32x4 v0, f32x4 v1) {
      float r[8];
#pragma unroll
      for (int e = 0; e < 4; ++e) { const float q0 = fmaxf(v0[e], 0.f), q1 = fmaxf(v1[e], 0.f); r[e] = q0 * q0; r[4 + e] = q1 * q1; }
      __builtin_nontemporal_store(((u32x4){pk2(r[0], r[1]), pk2(r[2], r[3]), pk2(r[4], r[5]), pk2(r[6], r[7])}), (u32x4*)(HID + ((size_t)(col >> 5) * MR + row) * 32 + (col & 31)));
    }, layer == 1);
    PH_END
    PH_BEGIN(11)
    gemm_phase(HID, 32, MR * 32, (const bf16_t*)(p.ws + OFF_W2), 32, 1024 * 32, 4096, 132, 8, lds, B, G, [&](int row, int col, f32x4 v) {
      float* xo = res_out_row(p, row) + col;
      const f32x4 g2 = *(const f32x4*)(mod_vec(p, layer, row) + 5120 + col);
      if (!dup) *(f32x4*)xo = *(const f32x4*)xo + g2 * v;
    }, [&](int row, int col, f32x4 v0, f32x4 v1) {
      float* xo = res_out_row(p, row) + col;
      const float* gm = mod_vec(p, layer, row) + 5120 + col;
      const f32x4 o0 = __builtin_nontemporal_load((const f32x4*)xo) + *(const f32x4*)gm * v0, o1 = __builtin_nontemporal_load((const f32x4*)(xo + 4)) + *(const f32x4*)(gm + 4) * v1;
      if (!dup) { *(f32x4*)xo = o0; *(f32x4*)(xo + 4) = o1; }
    }, layer == 1);
    PH_END
  }
}

extern "C" void kernel_launch(void* const* d_in, const int* in_sizes, int n_in, void* d_out, int out_size, void* d_ws, size_t ws_size, hipStream_t stream) {
  static int grid_blocks = 0;
  if (!grid_blocks) {
    int dev = 0, cus = 0, per_cu = 0;
    hipGetDevice(&dev);
    hipDeviceGetAttribute(&cus, hipDeviceAttributeMultiprocessorCount, dev);
    hipOccupancyMaxActiveBlocksPerMultiprocessor(&per_cu, mega, 256, 0);
    if (per_cu > 2) per_cu = 2;
    grid_blocks = cus * per_cu;
    grid_blocks -= grid_blocks % 8;
  }
  Params p{};
  const float** f = (const float**)&p;
  for (int i = 0; i < 26; ++i) f[i] = (const float*)d_in[i];
  p.out = (float*)d_out;
  p.ws = (char*)d_ws;
  p.probe = PROBE_MASK;
  if (ws_size < WS_TOTAL) { fprintf(stderr, "workspace too small: %zu < %zu\n", ws_size, (size_t)WS_TOTAL); return; }
  hipMemsetAsync((char*)d_ws + OFF_CTR, 0, 256 + 16384, stream);
  void* args[] = {&p};
  hipError_t e = hipLaunchCooperativeKernel((void*)mega, dim3(grid_blocks), dim3(256), args, 0, stream);
  if (e != hipSuccess) fprintf(stderr, "cooperative launch failed: %s (grid %d)\n", hipGetErrorString(e), grid_blocks);
}
```

```cpp
#include <hip/hip_runtime.h>
#include <hip/hip_cooperative_groups.h>
#include <cstdint>
#include <cstdio>
namespace cg = cooperative_groups;

#define DI __device__ __forceinline__
typedef unsigned short bf16_t;
typedef short bf16x8 __attribute__((ext_vector_type(8)));
typedef float f32x4 __attribute__((ext_vector_type(4)));
typedef float f32x2 __attribute__((ext_vector_type(2)));
typedef unsigned u32x4 __attribute__((ext_vector_type(4)));
typedef unsigned u32x2 __attribute__((ext_vector_type(2)));
typedef __bf16 bf16x2_t __attribute__((ext_vector_type(2)));

constexpr int DM = 1024, NB = 4, TL = 8192, TC = 256, TT = 8448, MR = NB * TT;
constexpr int LDP = 4736;
constexpr int C_DAQ = 0, C_DAK = 512, C_DAV = 1024, C_LX = 1536, C_LY = 2048, C_GQKV = 2560, C_GZ = 4096, C_GBA = 4608;
constexpr int NCH = 132;
constexpr float EPS = 1e-6f;
constexpr int LDS_BYTES = 77824;

constexpr size_t al256(size_t x) { return (x + 255) & ~(size_t)255; }
constexpr size_t OFF_WIN = 0;
constexpr size_t OFF_WBR = OFF_WIN + al256((size_t)7808 * 1024 * 2);
constexpr size_t OFF_WO = OFF_WBR + al256((size_t)3 * 1024 * 512 * 2);
constexpr size_t OFF_W1 = OFF_WO + al256((size_t)1024 * 1024 * 2);
constexpr size_t OFF_W2 = OFF_W1 + al256((size_t)4096 * 1024 * 2);
constexpr size_t OFF_LG = OFF_W2 + al256((size_t)4096 * 1024 * 2);
constexpr size_t OFF_P = OFF_LG + al256((size_t)32 * 4096 * 2);
constexpr size_t OFF_H = OFF_P + al256((size_t)MR * LDP * 2);
constexpr size_t OFF_VT = OFF_H + al256((size_t)MR * 1024 * 2);
constexpr size_t OFF_OB = OFF_VT + al256((size_t)MR * 512 * 2);
constexpr size_t OFF_HALO = OFF_OB + al256((size_t)MR * 512 * 2);
constexpr size_t OFF_GBA = OFF_HALO + al256((size_t)528 * 3 * 1536 * 2);
constexpr size_t OFF_GSC = OFF_GBA + al256((size_t)MR * 16 * 4);
constexpr size_t OFF_LC = OFF_GSC + al256((size_t)4224 * 192 * 4);
constexpr size_t OFF_CTX = OFF_LC + al256((size_t)4 * NCH * 8 * 2 * 64 * 8);
constexpr size_t OFF_MOD = OFF_CTX + al256((size_t)4 * 256 * 1024 * 4);
constexpr size_t OFF_ROPE = OFF_MOD + al256((size_t)2 * 5 * 6144 * 4);
constexpr size_t OFF_CTR = OFF_ROPE + al256((size_t)8192 * 32 * 8);
constexpr size_t WS_TOTAL = OFF_CTR + 256 + 16384;
static_assert(WS_TOTAL <= (size_t)536870912, "workspace map too large");

struct Params {
  const float *x, *c, *ctx, *cctx, *ada_w, *ada_b, *n1g, *n2g, *w_in, *daqg, *dakg, *dalam, *dasub, *lcw, *lcb, *lgw, *lgb, *llam,
      *gcw, *galog, *gdtb, *gng, *wbr, *wout, *w1, *w2;
  float* out;
  char* ws;
  int probe;
  int pad_;
};

DI unsigned pk2(float lo, float hi) { f32x2 v = {lo, hi}; bf16x2_t b = __builtin_convertvector(v, bf16x2_t); return __builtin_bit_cast(unsigned, b); }
DI bf16_t f2bf(float f) { return (bf16_t)(pk2(f, 0.f) & 0xffffu); }
DI float bf2f(bf16_t u) { return __uint_as_float(((unsigned)u) << 16); }
DI float bflo(unsigned w) { return __uint_as_float(w << 16); }
DI float bfhi(unsigned w) { return __uint_as_float(w & 0xffff0000u); }
DI int otid() { int t = __builtin_amdgcn_workitem_id_x(); asm volatile("" : "+v"(t)); return t; }
template <int M> DI float shx(float v) { return __int_as_float(__builtin_amdgcn_ds_swizzle(__float_as_int(v), (M << 10) | 0x1f)); }
DI float add32(float v) { auto r = __builtin_amdgcn_permlane32_swap(__float_as_uint(v), __float_as_uint(v), false, false); return __uint_as_float(r[0]) + __uint_as_float(r[1]); }
DI float max32(float v) { auto r = __builtin_amdgcn_permlane32_swap(__float_as_uint(v), __float_as_uint(v), false, false); return fmaxf(__uint_as_float(r[0]), __uint_as_float(r[1])); }
DI float wsum(float v) { v += shx<1>(v); v += shx<2>(v); v += shx<4>(v); v += shx<8>(v); v += shx<16>(v); return add32(v); }
DI float wmax(float v) { v = fmaxf(v, shx<1>(v)); v = fmaxf(v, shx<2>(v)); v = fmaxf(v, shx<4>(v)); v = fmaxf(v, shx<8>(v)); v = fmaxf(v, shx<16>(v)); return max32(v); }
DI float sigm(float x) { return 1.f / (1.f + __expf(-x)); }
DI float softplusf(float x) { return x > 20.f ? x : log1pf(expf(x)); }
DI f32x4 mfma16(bf16x8 a, bf16x8 b, f32x4 c) { return __builtin_amdgcn_mfma_f32_16x16x32_bf16(a, b, c, 0, 0, 0); }

DI const float* res_in_row(const Params& p, int layer, int r) {
  const int b = r / TT, s = r % TT;
  if (layer == 0) return s < TC ? p.ctx + ((size_t)b * TC + s) * DM : p.x + ((size_t)b * TL + (s - TC)) * DM;
  return s < TC ? (const float*)(p.ws + OFF_CTX) + ((size_t)b * TC + s) * DM : p.out + ((size_t)b * TL + (s - TC)) * DM;
}
DI float* res_out_row(const Params& p, int r) {
  const int b = r / TT, s = r % TT;
  return s < TC ? (float*)(p.ws + OFF_CTX) + ((size_t)b * TC + s) * DM : p.out + ((size_t)b * TL + (s - TC)) * DM;
}
DI const float* mod_vec(const Params& p, int layer, int r) {
  const int b = r / TT, s = r % TT;
  return (const float*)(p.ws + OFF_MOD) + (size_t)(layer * 5 + (s < TC ? 4 : b)) * 6144;
}

template <int WN>
DI void gemm_core(const bf16_t* __restrict__ A, int lda, int a_ks, const bf16_t* __restrict__ Bt, int ldb, int b_ks, int K, f32x4 (&acc)[4][WN], char* lds) {
  constexpr int BN = 32 * WN, AST = 72, NBP = BN * 8 / 256;
  bf16_t* As = (bf16_t*)lds;
  bf16_t* Bs = As + 2 * 128 * AST;
  const int tid = otid(), lane = tid & 63, wid = tid >> 6, wr = wid >> 1, wc = wid & 1;
  u32x4 ra[4], rb[NBP];
  const int nk = K / 64;
#define GLOAD(k0)                                                                                                            \
  {                                                                                                                          \
    _Pragma("unroll") for (int i = 0; i < 4; ++i) { const int q = tid + 256 * i; ra[i] = *(const u32x4*)(A + (size_t)(q >> 3) * lda + (size_t)(((k0) >> 5) + ((q & 7) >> 2)) * a_ks + (q & 3) * 8); } \
    _Pragma("unroll") for (int i = 0; i < NBP; ++i) { const int q = tid + 256 * i; rb[i] = *(const u32x4*)(Bt + (size_t)(q >> 3) * ldb + (size_t)(((k0) >> 5) + ((q & 7) >> 2)) * b_ks + (q & 3) * 8); } \
  }
#define SSTORE(buf)                                                                                                          \
  {                                                                                                                          \
    _Pragma("unroll") for (int i = 0; i < 4; ++i) { const int q = tid + 256 * i; *(u32x4*)(As + ((buf) * 128 + (q >> 3)) * AST + (q & 7) * 8) = ra[i]; } \
    _Pragma("unroll") for (int i = 0; i < NBP; ++i) { const int q = tid + 256 * i; *(u32x4*)(Bs + ((buf) * BN + (q >> 3)) * AST + (q & 7) * 8) = rb[i]; } \
  }
  GLOAD(0);
  SSTORE(0);
  __syncthreads();
  for (int t = 0; t < nk; ++t) {
    if (t + 1 < nk) GLOAD((t + 1) * 64);
    const bf16_t* a = As + ((t & 1) * 128 + wr * 64 + (lane & 15)) * AST + (lane >> 4) * 8;
    const bf16_t* b = Bs + ((t & 1) * BN + wc * 16 * WN + (lane & 15)) * AST + (lane >> 4) * 8;
#pragma unroll
    for (int ks = 0; ks < 2; ++ks) {
      bf16x8 af[4], bfr[WN];
#pragma unroll
      for (int i = 0; i < 4; ++i) af[i] = *(const bf16x8*)(a + i * 16 * AST + ks * 32);
#pragma unroll
      for (int j = 0; j < WN; ++j) bfr[j] = *(const bf16x8*)(b + j * 16 * AST + ks * 32);
      __builtin_amdgcn_sched_barrier(0);
#pragma unroll
      for (int i = 0; i < 4; ++i)
#pragma unroll
        for (int j = 0; j < WN; ++j) acc[i][j] = mfma16(bfr[j], af[i], acc[i][j]);
      __builtin_amdgcn_sched_barrier(0);
    }
    if (t + 1 < nk) SSTORE((t + 1) & 1);
    __syncthreads();
  }
#undef GLOAD
#undef SSTORE
}
DI void tile_mn(int t, int nm, int nn, int& mi, int& ni) {
  const int nig = 16 * nn, g = t / nig, rem = t % nig, fm = g * 16;
  const int gsz = (nm - fm) < 16 ? (nm - fm) : 16;
  mi = fm + rem % gsz;
  ni = rem / gsz;
}
template <int WN, class Epi>
DI void gemm_emit(const f32x4 (&acc)[4][WN], int m0, int n0, Epi epi) {
  const int lane = otid() & 63, wid = otid() >> 6, wr = wid >> 1, wc = wid & 1;
#pragma unroll
  for (int i = 0; i < 4; ++i)
#pragma unroll
    for (int j = 0; j < WN; ++j) epi(m0 + wr * 64 + i * 16 + (lane & 15), n0 + wc * 16 * WN + j * 16 + (lane >> 4) * 4, acc[i][j]);
}
template <int WN>
DI void zero_acc(f32x4 (&acc)[4][WN]) {
#pragma unroll
  for (int i = 0; i < 4; ++i)
#pragma unroll
    for (int j = 0; j < WN; ++j) acc[i][j] = (f32x4){0.f, 0.f, 0.f, 0.f};
}

DI void gemm_core2(const bf16_t* __restrict__ A, int lda, int a_ks, const bf16_t* __restrict__ Bt, int ldb, int b_ks, int K, f32x4 (&acc)[8][4], char* lds) {
  constexpr int AST = 48;
  bf16_t* As = (bf16_t*)lds;
  bf16_t* Bs = As + 2 * 256 * AST;
  const int tid = otid(), lane = tid & 63, wid = tid >> 6, wr = wid >> 1, wc = wid & 1;
  u32x4 s0a[4], s0b[2], s1a[4], s1b[2];
  const int nk = K / 32;
  const bf16_t* ag = A + (size_t)(tid >> 2) * lda + (tid & 3) * 8;
  const bf16_t* bg = Bt + (size_t)(tid >> 2) * ldb + (tid & 3) * 8;
  const int bc_ = tid >> 2, brow = ((bc_ >> 5) * 2 + ((bc_ >> 2) & 1)) * 16 + ((bc_ >> 3) & 3) * 4 + (bc_ & 3);
#define LBAR() { asm volatile("s_waitcnt lgkmcnt(0)" ::: "memory"); __builtin_amdgcn_s_barrier(); asm volatile("" ::: "memory"); }
#define GLOAD2(ra, rb, k0)                                                                                                   \
  {                                                                                                                          \
    _Pragma("unroll") for (int i = 0; i < 4; ++i) ra[i] = *(const u32x4*)(ag + (size_t)(64 * i) * lda + (size_t)((k0) >> 5) * a_ks);               \
    _Pragma("unroll") for (int i = 0; i < 2; ++i) rb[i] = *(const u32x4*)(bg + (size_t)(64 * i) * ldb + (size_t)((k0) >> 5) * b_ks);               \
  }
#define SSTORE2(ra, rb, buf)                                                                                                 \
  {                                                                                                                          \
    _Pragma("unroll") for (int i = 0; i < 4; ++i) *(u32x4*)(As + ((buf) * 256 + 64 * i + (tid >> 2)) * AST + (tid & 3) * 8) = ra[i]; \
    _Pragma("unroll") for (int i = 0; i < 2; ++i) *(u32x4*)(Bs + ((buf) * 128 + 64 * i + brow) * AST + (tid & 3) * 8) = rb[i]; \
  }
#define STEP2(t, la, lb, sa, sb)                                                                                             \
  {                                                                                                                          \
    if ((t) + 2 < nk) GLOAD2(la, lb, ((t) + 2) * 32);                                                                        \
    const bf16_t* a = As + (((t) & 1) * 256 + wr * 128 + (lane & 15)) * AST + (lane >> 4) * 8;                               \
    const bf16_t* b = Bs + (((t) & 1) * 128 + wc * 64 + (lane & 15)) * AST + (lane >> 4) * 8;                                \
    bf16x8 bfr[4], a0[4], a1[4];                                                                                             \
    _Pragma("unroll") for (int j = 0; j < 4; ++j) bfr[j] = *(const bf16x8*)(b + j * 16 * AST);                               \
    _Pragma("unroll") for (int i = 0; i < 4; ++i) a0[i] = *(const bf16x8*)(a + i * 16 * AST);                                \
    __builtin_amdgcn_sched_barrier(0);                                                                                       \
    _Pragma("unroll") for (int i = 0; i < 4; ++i) a1[i] = *(const bf16x8*)(a + (4 + i) * 16 * AST);                          \
    __builtin_amdgcn_sched_barrier(0);                                                                                       \
    _Pragma("unroll") for (int i = 0; i < 4; ++i) _Pragma("unroll") for (int j = 0; j < 4; ++j) acc[i][j] = mfma16(bfr[j], a0[i], acc[i][j]); \
    __builtin_amdgcn_sched_barrier(0);                                                                                       \
    _Pragma("unroll") for (int i = 0; i < 4; ++i) _Pragma("unroll") for (int j = 0; j < 4; ++j) acc[4 + i][j] = mfma16(bfr[j], a1[i], acc[4 + i][j]); \
    __builtin_amdgcn_sched_barrier(0);                                                                                       \
    if ((t) + 1 < nk) SSTORE2(sa, sb, ((t) + 1) & 1);                                                                        \
    LBAR();                                                                                                                  \
  }
  GLOAD2(s0a, s0b, 0);
  SSTORE2(s0a, s0b, 0);
  GLOAD2(s1a, s1b, 32);
  LBAR();
  int t = 0;
  for (;;) {
    STEP2(t, s0a, s0b, s1a, s1b);
    if (++t >= nk) break;
    STEP2(t, s1a, s1b, s0a, s0b);
    if (++t >= nk) break;
  }
#undef GLOAD2
#undef SSTORE2
#undef STEP2
}
DI void tile_mn8(int t, int nm, int nn, int& mi, int& ni) {
  const int nig = 8 * nn, g = t / nig, rem = t % nig, fm = g * 8;
  const int gsz = (nm - fm) < 8 ? (nm - fm) : 8;
  mi = fm + rem % gsz;
  ni = rem / gsz;
}
template <class Epi, class Epi8>
DI void gemm_phase(const bf16_t* A, int lda, int a_ks, const bf16_t* Bt, int ldb, int b_ks, int K, int nm, int nn, char* lds, int B, int G, Epi epi, Epi8 epi8, bool skipctx = false) {
  if (skipctx) nm -= 4;
  const int NT = nm * nn;
  int nfull = (NT / G) * G, R = NT - nfull;
  if (4 * R > 2 * G) { nfull = NT; R = 0; }
  for (int t = B; t < nfull + 4 * R; t += G) {
    int mi, ni;
    if (t < nfull) {
      tile_mn8(t, nm, nn, mi, ni);
      if (skipctx) mi += (mi >> 5) + 1;
      f32x4 acc[8][4];
#pragma unroll
      for (int i = 0; i < 8; ++i)
#pragma unroll
        for (int j = 0; j < 4; ++j) acc[i][j] = (f32x4){0.f, 0.f, 0.f, 0.f};
      gemm_core2(A + (size_t)mi * 256 * lda, lda, a_ks, Bt + (size_t)ni * 128 * ldb, ldb, b_ks, K, acc, lds);
      const int lane = otid() & 63, wid = otid() >> 6, wr = wid >> 1, wc = wid & 1;
#pragma unroll
      for (int i = 0; i < 8; ++i)
#pragma unroll
        for (int jp = 0; jp < 2; ++jp) epi8(mi * 256 + wr * 128 + i * 16 + (lane & 15), ni * 128 + wc * 64 + jp * 32 + (lane >> 4) * 8, acc[i][2 * jp], acc[i][2 * jp + 1]);
    } else {
      const int u = t - nfull, sub = u & 3;
      tile_mn8(nfull + (u >> 2), nm, nn, mi, ni);
      if (skipctx) mi += (mi >> 5) + 1;
      const int m0 = mi * 256 + (sub >> 1) * 128, n0 = ni * 128 + (sub & 1) * 64;
      f32x4 acc[4][2]; zero_acc<2>(acc);
      gemm_core<2>(A + (size_t)m0 * lda, lda, a_ks, Bt + (size_t)n0 * ldb, ldb, b_ks, K, acc, lds);
      gemm_emit<2>(acc, m0, n0, epi);
    }
  }
}
DI int sg_col(int gc) { const int j = gc >> 7; return (j < 12 ? 512 + 128 * j : 2560 + 128 * (j - 12)) + (gc & 127); }

constexpr int N_CVT = 1152 + 32 + 768 + 384 + 256 + 1024 + 1024 + 32;
DI void job_cvt(const Params& p, int layer, int t, char* lds) {
  const float* src; int ld, ncol0 = 0, nlim, K, ntot, nrow0 = 0; bf16_t* dst;
  char* ws = p.ws;
  if (t < 1152) { src = p.w_in + (size_t)layer * 1024 * 7696; ld = 7696; ncol0 = 0; nlim = 4608; dst = (bf16_t*)(ws + OFF_WIN); K = 1024; ntot = 7808; nrow0 = 0; }
  else if ((t -= 1152) < 32) { src = p.w_in + (size_t)layer * 1024 * 7696; ld = 7696; ncol0 = 4608; nlim = 4624; dst = (bf16_t*)(ws + OFF_WIN); K = 1024; ntot = 7808; nrow0 = 4608; }
  else if ((t -= 32) < 768) { src = p.w_in + (size_t)layer * 1024 * 7696; ld = 7696; ncol0 = 4624; nlim = 7696; dst = (bf16_t*)(ws + OFF_WIN); K = 1024; ntot = 7808; nrow0 = 4736; }
  else if ((t -= 768) < 384) { const int i = t / 128; t %= 128; src = p.wbr + ((size_t)layer * 3 + i) * 512 * 1024; ld = 1024; nlim = 1024; dst = (bf16_t*)(ws + OFF_WBR) + (size_t)i * 1024 * 512; K = 512; ntot = 1024; }
  else if ((t -= 384) < 256) { src = p.wout + (size_t)layer * 1024 * 1024; ld = 1024; nlim = 1024; dst = (bf16_t*)(ws + OFF_WO); K = 1024; ntot = 1024; }
  else if ((t -= 256) < 1024) { src = p.w1 + (size_t)layer * 1024 * 4096; ld = 4096; nlim = 4096; dst = (bf16_t*)(ws + OFF_W1); K = 1024; ntot = 4096; }
  else if ((t -= 1024) < 1024) { src = p.w2 + (size_t)layer * 4096 * 1024; ld = 1024; nlim = 1024; dst = (bf16_t*)(ws + OFF_W2); K = 4096; ntot = 1024; }
  else { t -= 1024; src = p.lgw + ((size_t)layer * 32 + t) * 4096; ld = 64; nlim = 64; dst = (bf16_t*)(ws + OFF_LG) + (size_t)t * 4096; K = 64; ntot = 0; t = 0; }
  const int nkt = K / 64, nt = t / nkt, kt = t % nkt;
  float* tl = (float*)lds;
  const int tid = otid();
  {
    const int c4 = (tid & 15) * 4, ncol = ncol0 + nt * 64 + c4;
#pragma unroll
    for (int i = 0; i < 4; ++i) {
      const int kk = i * 16 + (tid >> 4);
      f32x4 v = {0.f, 0.f, 0.f, 0.f};
      if (ncol + 3 < nlim) v = __builtin_nontemporal_load((const f32x4*)(src + (size_t)(kt * 64 + kk) * ld + ncol));
      tl[kk * 65 + c4] = v[0]; tl[kk * 65 + c4 + 1] = v[1]; tl[kk * 65 + c4 + 2] = v[2]; tl[kk * 65 + c4 + 3] = v[3];
    }
  }
  __syncthreads();
  {
    const int n = tid >> 2, kq = tid & 3;
    float v[16];
#pragma unroll
    for (int e = 0; e < 16; ++e) v[e] = tl[(kq * 16 + e) * 65 + n];
    u32x4 w0 = {pk2(v[0], v[1]), pk2(v[2], v[3]), pk2(v[4], v[5]), pk2(v[6], v[7])};
    u32x4 w1 = {pk2(v[8], v[9]), pk2(v[10], v[11]), pk2(v[12], v[13]), pk2(v[14], v[15])};
    const int nd = nrow0 + nt * 64 + n, kd = kt * 64 + kq * 16;
    bf16_t* d = ntot ? dst + ((size_t)(kd >> 5) * ntot + nd) * 32 + (kd & 31) : dst + (size_t)nd * K + kd;
    *(u32x4*)d = w0;
    *(u32x4*)(d + 8) = w1;
  }
  __syncthreads();
}
DI void job_mod(const Params& p, int it, char* lds) {
  const int nc = it % 96, l = it / 96, tid = otid();
  float* sc = (float*)lds;
  float* red = sc + 5 * 1024;
  for (int i = tid; i < 5 * 1024; i += 256) {
    const int v = i >> 10, k = i & 1023;
    const float cv = v < 4 ? p.c[v * 1024 + k] : p.cctx[k];
    sc[i] = cv * sigm(cv);
  }
  __syncthreads();
  const int cq = tid & 15, kg = tid >> 4, n = nc * 64 + cq * 4;
  const float* w = p.ada_w + ((size_t)l * 1024 + kg * 64) * 6144 + n;
  const float* s0 = sc + kg * 64;
  f32x4 a[5];
#pragma unroll
  for (int v = 0; v < 5; ++v) a[v] = (f32x4){0.f, 0.f, 0.f, 0.f};
#pragma unroll 8
  for (int k = 0; k < 64; ++k) {
    const f32x4 wv = __builtin_nontemporal_load((const f32x4*)(w + (size_t)k * 6144));
#pragma unroll
    for (int v = 0; v < 5; ++v) a[v] += wv * s0[v * 1024 + k];
  }
#pragma unroll
  for (int v = 0; v < 5; ++v)
#pragma unroll
    for (int e = 0; e < 4; ++e) red[(kg * 5 + v) * 64 + cq * 4 + e] = a[v][e];
  __syncthreads();
  for (int i = tid; i < 320; i += 256) {
    const int v = i >> 6, cc = i & 63;
    float r = p.ada_b[l * 6144 + nc * 64 + cc];
#pragma unroll
    for (int q = 0; q < 16; ++q) r += red[(q * 5 + v) * 64 + cc];
    ((float*)(p.ws + OFF_MOD))[(size_t)(l * 5 + v) * 6144 + nc * 64 + cc] = r;
  }
  __syncthreads();
}
DI void job_rope(const Params& p, int it) {
  const int idx = it * 256 + otid(), t = idx >> 5, ax = (idx >> 4) & 1, f = idx & 15;
  const float inv = powf(10000.f, -(float)f / 16.f);
  const float pos = (float)(ax ? (t & 63) : (t >> 6));
  float s, c;
  sincosf(pos * inv, &s, &c);
  ((f32x2*)(p.ws + OFF_ROPE))[idx] = (f32x2){c, s};
}
DI void job_norm(const Params& p, int layer, int which, int it) {
  const int lane = otid() & 63, wid = otid() >> 6, r = it * 8 + wid;
  const float* xr0 = (which == 1) ? res_in_row(p, layer, r) : (const float*)res_out_row(p, r);
  const float* xr1 = (which == 1) ? res_in_row(p, layer, r + 4) : (const float*)res_out_row(p, r + 4);
  const float* mv = mod_vec(p, layer, r);
  const float* sh = mv + (which == 1 ? 0 : 3072);
  const float* sc = mv + (which == 1 ? 1024 : 4096);
  const float* g = (which == 1 ? p.n1g : p.n2g) + layer * 1024;
  f32x4 xa[4], xb[4];
#pragma unroll
  for (int i = 0; i < 2; ++i)
#pragma unroll
    for (int hf = 0; hf < 2; ++hf) {
      xa[2 * i + hf] = __builtin_nontemporal_load((const f32x4*)(xr0 + i * 512 + lane * 8 + hf * 4));
      xb[2 * i + hf] = __builtin_nontemporal_load((const f32x4*)(xr1 + i * 512 + lane * 8 + hf * 4));
    }
  float sa = 0.f, sb = 0.f;
#pragma unroll
  for (int i = 0; i < 4; ++i) {
    sa += xa[i][0] * xa[i][0] + xa[i][1] * xa[i][1] + xa[i][2] * xa[i][2] + xa[i][3] * xa[i][3];
    sb += xb[i][0] * xb[i][0] + xb[i][1] * xb[i][1] + xb[i][2] * xb[i][2] + xb[i][3] * xb[i][3];
  }
  sa = wsum(sa); sb = wsum(sb);
  const float ra = rsqrtf(sa * (1.f / 1024.f) + EPS), rb = rsqrtf(sb * (1.f / 1024.f) + EPS);
  bf16_t* H0 = (bf16_t*)(p.ws + OFF_H) + (size_t)r * 32;
  bf16_t* H1 = H0 + 4 * 32;
#pragma unroll
  for (int i = 0; i < 2; ++i) {
    const int c = i * 512 + lane * 8;
    float o[8], q[8];
#pragma unroll
    for (int hf = 0; hf < 2; ++hf) {
      const f32x4 gv = *(const f32x4*)(g + c + hf * 4), sv = *(const f32x4*)(sc + c + hf * 4), hv = *(const f32x4*)(sh + c + hf * 4);
#pragma unroll
      for (int e = 0; e < 4; ++e) { const float m = gv[e] * (1.f + sv[e]); o[hf * 4 + e] = xa[2 * i + hf][e] * ra * m + hv[e]; q[hf * 4 + e] = xb[2 * i + hf][e] * rb * m + hv[e]; }
    }
    const size_t so = (size_t)(c >> 5) * MR * 32 + (c & 31);
    *(u32x4*)(H0 + so) = (u32x4){pk2(o[0], o[1]), pk2(o[2], o[3]), pk2(o[4], o[5]), pk2(o[6], o[7])};
    *(u32x4*)(H1 + so) = (u32x4){pk2(q[0], q[1]), pk2(q[2], q[3]), pk2(q[4], q[5]), pk2(q[6], q[7])};
  }
}

DI void job_daprep1(const Params& p, int layer, int r, bool dup) {
  const int lane = otid() & 63, s = r % TT;
  const int G = lane >> 2, quarter = lane & 3;
  bf16_t* ptr = (bf16_t*)(p.ws + OFF_P) + (size_t)r * LDP + (G < 8 ? C_DAQ + G * 64 : C_DAK + (G - 8) * 64) + quarter * 16;
  const u32x4 w0 = *(const u32x4*)ptr, w1 = *(const u32x4*)(ptr + 8);
  float y[16];
#pragma unroll
  for (int e = 0; e < 4; ++e) { y[2 * e] = bflo(w0[e]); y[2 * e + 1] = bfhi(w0[e]); y[8 + 2 * e] = bflo(w1[e]); y[9 + 2 * e] = bfhi(w1[e]); }
  float ss = 0.f;
#pragma unroll
  for (int e = 0; e < 16; ++e) ss += y[e] * y[e];
  ss += shx<1>(ss);
  ss += shx<2>(ss);
  float rstd = rsqrtf(ss * (1.f / 64.f) + EPS);
  const float* g = (G < 8 ? p.daqg : p.dakg) + layer * 64 + quarter * 16;
#pragma unroll
  for (int e = 0; e < 16; ++e) y[e] = y[e] * rstd * g[e];
  if (s >= TC) {
    const f32x2* tb = (const f32x2*)(p.ws + OFF_ROPE) + ((size_t)(s - TC) * 2 + (quarter >> 1)) * 16;
#pragma unroll
    for (int e = 0; e < 16; ++e) {
      const float yp = shx<1>(y[e]);
      const f32x2 cs = tb[e];
      y[e] = (quarter & 1) ? (y[e] * cs.x + yp * cs.y) : (y[e] * cs.x - yp * cs.y);
    }
  }
  if (G < 8) {
#pragma unroll
    for (int e = 0; e < 16; ++e) y[e] *= 0.125f * 1.4426950408889634f;
  }
  if (dup) return;
  *(u32x4*)ptr = (u32x4){pk2(y[0], y[1]), pk2(y[2], y[3]), pk2(y[4], y[5]), pk2(y[6], y[7])};
  *(u32x4*)(ptr + 8) = (u32x4){pk2(y[8], y[9]), pk2(y[10], y[11]), pk2(y[12], y[13]), pk2(y[14], y[15])};
}
DI void job_daprep(const Params& p, int layer, int it, bool dup) {
  const int wid = otid() >> 6;
#pragma unroll
  for (int rr = 0; rr < 2; ++rr) job_daprep1(p, layer, it * 8 + rr * 4 + wid, dup);
}
DI void job_vt(const Params& p, int it, char* lds) {
  const int h = it & 3, c = (it >> 2) % NCH, b = it / (4 * NCH), tid = otid();
  bf16_t* tl = (bf16_t*)lds;
  const bf16_t* P = (const bf16_t*)(p.ws + OFF_P);
#pragma unroll
  for (int i = 0; i < 4; ++i) {
    const int q = tid + 256 * i, row = q >> 4, pc = q & 15;
    const u32x4 w = *(const u32x4*)(P + (size_t)(b * TT + c * 64 + row) * LDP + C_DAV + h * 128 + pc * 8);
    unsigned* d = (unsigned*)(tl + row * 130 + pc * 8);
    d[0] = w[0]; d[1] = w[1]; d[2] = w[2]; d[3] = w[3];
  }
  __syncthreads();
  {
    const int dv = tid >> 1, half = tid & 1;
    unsigned o[16];
#pragma unroll
    for (int e = 0; e < 16; ++e) o[e] = (unsigned)tl[(half * 32 + 2 * e) * 130 + dv] | ((unsigned)tl[(half * 32 + 2 * e + 1) * 130 + dv] << 16);
    bf16_t* d = (bf16_t*)(p.ws + OFF_VT) + ((size_t)(b * 4 + h) * 128 + dv) * TT + c * 64 + half * 32;
#pragma unroll
#define VTW(w) o[(((w) & 3) >> 1) * 8 + ((w) >> 2) * 2 + ((w) & 1)]
    for (int e = 0; e < 4; ++e) *(u32x4*)(d + e * 8) = (u32x4){VTW(4 * e), VTW(4 * e + 1), VTW(4 * e + 2), VTW(4 * e + 3)};
#undef VTW
  }
  __syncthreads();
}

constexpr int N_ATT = 1056;
DI void job_attn(const Params& p, int layer, int a, char* lds, bool dup) {
  const int tid = otid(), lane = tid & 63, wid = tid >> 6, l15 = lane & 15, g = lane >> 4;
  const int grp = a / 528, within = a % 528, bh = grp * 8 + (within & 7), qb = within >> 3, b = bh >> 2, h = bh & 3;
  if (layer == 1 && qb < 2) return;
  const int nt = qb < 2 ? 4 : NCH;
  bf16_t* P = (bf16_t*)(p.ws + OFF_P);
  const bf16_t* VT = (const bf16_t*)(p.ws + OFF_VT) + (size_t)(b * 4 + h) * 128 * TT;
  int ly_ = layer; asm volatile("" : "+s"(ly_));
  const float lam_init = __uint_as_float(ly_ == 0 ? 0x3e4ccccdu : 0x3eb60549u);
  const float* lv = p.dalam + layer * 256;
  const float lam = __uint_as_float(__builtin_amdgcn_readfirstlane(__float_as_uint(expf(wsum(lv[lane] * lv[64 + lane])) - expf(wsum(lv[128 + lane] * lv[192 + lane])) + lam_init)));
  const float mq = wmax(fabsf(p.daqg[layer * 64 + lane])), mk = wmax(fabsf(p.dakg[layer * 64 + lane]));
  const float negMb = __uint_as_float(__builtin_amdgcn_readfirstlane(__float_as_uint(-(8.f * mq * mk * 1.03f * 1.4426950408889634f + 0.5f))));
  const int r0 = b * TT + qb * 128 + wid * 32;
  bf16x8 qf[2][2][2];
#pragma unroll
  for (int c = 0; c < 2; ++c)
#pragma unroll
    for (int i = 0; i < 2; ++i)
#pragma unroll
      for (int ks = 0; ks < 2; ++ks) qf[c][i][ks] = *(const bf16x8*)(P + (size_t)(r0 + i * 16 + l15) * LDP + C_DAQ + h * 128 + c * 64 + ks * 32 + g * 8);
  bf16_t* Ks = (bf16_t*)lds;
  bf16_t* Vs = Ks + 2 * 64 * 144;
  u32x4 rk[4], rv[4];
  const bf16_t* kg = P + (size_t)(b * TT) * LDP + C_DAK + h * 128;
#define KLOAD(t) { _Pragma("unroll") for (int i = 0; i < 4; ++i) { const int q = tid + 256 * i; rk[i] = *(const u32x4*)(kg + (size_t)((t) * 64 + (q >> 4)) * LDP + (q & 15) * 8); } }
#define VLOAD(t) { _Pragma("unroll") for (int i = 0; i < 4; ++i) { const int q = tid + 256 * i; rv[i] = *(const u32x4*)(VT + (size_t)(q >> 3) * TT + (t) * 64 + (q & 7) * 8); } }
#define KSTORE(buf) { _Pragma("unroll") for (int i = 0; i < 4; ++i) { const int q = tid + 256 * i; *(u32x4*)(Ks + ((buf) * 64 + (q >> 4)) * 144 + (q & 15) * 8) = rk[i]; } }
#define VSTORE(buf) { _Pragma("unroll") for (int i = 0; i < 4; ++i) { const int q = tid + 256 * i; *(u32x4*)(Vs + ((buf) * 128 + (q >> 3)) * 80 + (q & 7) * 8) = rv[i]; } }
#define QK_INTO(S, Kb, half, CI)                                                                                       \
  _Pragma("unroll") for (int c = 0; c < 2; ++c) {                                                                      \
    bf16x8 kf[2][2];                                                                                                   \
    _Pragma("unroll") for (int k2 = 0; k2 < 2; ++k2) _Pragma("unroll") for (int ks = 0; ks < 2; ++ks)                  \
      kf[k2][ks] = *(const bf16x8*)((Kb) + ((half) * 32 + k2 * 16 + l15) * 144 + c * 64 + ks * 32 + g * 8);             \
    __builtin_amdgcn_sched_barrier(0);                                                                                 \
    _Pragma("unroll") for (int k2 = 0; k2 < 2; ++k2) _Pragma("unroll") for (int i = 0; i < 2; ++i) {                   \
      S[c][i][k2] = mfma16(kf[k2][0], qf[c][i][0], CI(c, i));     \
      S[c][i][k2] = mfma16(kf[k2][1], qf[c][i][1], S[c][i][k2]); }                                                     \
  }                                                                                                                    \
  __builtin_amdgcn_sched_barrier(0);
#define EXPSUM(S)                                                                                                      \
  _Pragma("unroll") for (int c = 0; c < 2; ++c) _Pragma("unroll") for (int i = 0; i < 2; ++i) {                        \
    _Pragma("unroll") for (int k2 = 0; k2 < 2; ++k2) _Pragma("unroll") for (int e = 0; e < 4; ++e) S[c][i][k2][e] = __builtin_amdgcn_exp2f(S[c][i][k2][e]); \
    lsum[c][i] += ((S[c][i][0][0] + S[c][i][0][1]) + (S[c][i][0][2] + S[c][i][0][3])) + ((S[c][i][1][0] + S[c][i][1][1]) + (S[c][i][1][2] + S[c][i][1][3])); }
#define EXP_S() _Pragma("unroll") for (int c = 0; c < 2; ++c) _Pragma("unroll") for (int i = 0; i < 2; ++i) _Pragma("unroll") for (int k2 = 0; k2 < 2; ++k2) _Pragma("unroll") for (int e = 0; e < 4; ++e) S[c][i][k2][e] = __builtin_amdgcn_exp2f(S[c][i][k2][e]);
  float lsum[2][2] = {{0.f, 0.f}, {0.f, 0.f}};
  KLOAD(0);
  KSTORE(0);
  __syncthreads();
  const f32x4 negMv = {negMb, negMb, negMb, negMb};
#define CI1(c, i) negMv
  f32x4 SA[2][2][2], SB[2][2][2];
#pragma unroll 1
  for (int t = 0; t < nt; ++t) {
    if (t + 1 < nt) KLOAD(t + 1);
    const bf16_t* Kb = Ks + (t & 1) * 64 * 144;
    QK_INTO(SA, Kb, 0, CI1)
    if (t > 0) { EXPSUM(SB) }
    __builtin_amdgcn_sched_barrier(0);
    QK_INTO(SB, Kb, 1, CI1)
    EXPSUM(SA)
    if (t + 1 < nt) KSTORE((t + 1) & 1);
    __syncthreads();
  }
  EXPSUM(SB)
  f32x4 ci2[2][2];
#pragma unroll
  for (int i = 0; i < 2; ++i) {
    float l0 = lsum[0][i], l1 = lsum[1][i];
    l0 += shx<16>(l0); l0 = add32(l0);
    l1 += shx<16>(l1); l1 = add32(l1);
    const float c0 = negMb - __log2f(l0), c1 = negMb + __log2f(fabsf(lam)) - __log2f(l1);
    ci2[0][i] = (f32x4){c0, c0, c0, c0}; ci2[1][i] = (f32x4){c1, c1, c1, c1};
  }
  const float nsl = lam < 0.f ? 1.f : -1.f;
#define CI2(c, i) ci2[c][i]
  f32x4 O[2][8];
#pragma unroll
  for (int i = 0; i < 2; ++i)
#pragma unroll
    for (int n = 0; n < 8; ++n) O[i][n] = (f32x4){0.f, 0.f, 0.f, 0.f};
  KLOAD(0); VLOAD(0);
  KSTORE(0); VSTORE(0);
  __syncthreads();
#pragma unroll 1
  for (int t = 0; t < nt; ++t) {
    if (t + 1 < nt) KLOAD(t + 1);
    const bf16_t* Kb = Ks + (t & 1) * 64 * 144;
    const bf16_t* Vb = Vs + (t & 1) * 128 * 80;
#pragma unroll
    for (int half = 0; half < 2; ++half) {
      bf16x8 pf[2], vfa[4], vfb[4];
#define VREAD(dst, n0) _Pragma("unroll") for (int n = 0; n < 4; ++n) dst[n] = *(const bf16x8*)(Vb + (((n0) + n) * 16 + l15) * 80 + half * 32 + g * 8);
      {
        f32x4 S[2][2][2];
        QK_INTO(S, Kb, half, CI2)
        VREAD(vfa, 0)
        EXP_S()
#pragma unroll
        for (int i = 0; i < 2; ++i) {
          float w[8];
#pragma unroll
          for (int k2 = 0; k2 < 2; ++k2)
#pragma unroll
            for (int e = 0; e < 4; ++e) w[k2 * 4 + e] = __builtin_fmaf(nsl, S[1][i][k2][e], S[0][i][k2][e]);
          const u32x4 ww = {pk2(w[0], w[1]), pk2(w[2], w[3]), pk2(w[4], w[5]), pk2(w[6], w[7])};
          pf[i] = __builtin_bit_cast(bf16x8, ww);
        }
      }
      __builtin_amdgcn_sched_barrier(0);
      VREAD(vfb, 4)
#pragma unroll
      for (int n = 0; n < 4; ++n)
#pragma unroll
        for (int i = 0; i < 2; ++i) O[i][n] = mfma16(pf[i], vfa[n], O[i][n]);
      __builtin_amdgcn_sched_barrier(0);
#pragma unroll
      for (int n = 0; n < 4; ++n)
#pragma unroll
        for (int i = 0; i < 2; ++i) O[i][4 + n] = mfma16(pf[i], vfb[n], O[i][4 + n]);
      __builtin_amdgcn_sched_barrier(0);
#undef VREAD
      if (half == 0 && t + 1 < nt) VLOAD(t + 1);
    }
    if (t + 1 < nt) { KSTORE((t + 1) & 1); VSTORE((t + 1) & 1); }
    __syncthreads();
  }
#undef KLOAD
#undef VLOAD
#undef KSTORE
#undef VSTORE
#undef CI1
#undef CI2
#undef QK_INTO
#undef EXPSUM
#undef EXP_S
  const int lane_e = otid() & 63, l15e = lane_e & 15, ge = lane_e >> 4;
  const float* sg = p.dasub + layer * 128;
#pragma unroll
  for (int i = 0; i < 2; ++i)
#pragma unroll
    for (int e = 0; e < 4; ++e) {
      float ss = 0.f;
#pragma unroll
      for (int n = 0; n < 8; ++n) ss += O[i][n][e] * O[i][n][e];
      ss += shx<1>(ss); ss += shx<2>(ss); ss += shx<4>(ss); ss += shx<8>(ss);
      const float rstd = rsqrtf(ss * (1.f / 128.f) + EPS) * (1.f - lam_init);
      bf16_t* op = P + (size_t)(r0 + i * 16 + ge * 4 + e) * LDP + C_DAQ + h * 128 + l15e;
#pragma unroll
      for (int n = 0; n < 8; ++n) if (!dup) op[n * 16] = f2bf(O[i][n][e] * rstd * sg[n * 16 + l15e]);
    }
}

DI float gelu_tanh(float x) { const float u = 0.7978845608028654f * (x + 0.044715f * x * x * x); return 0.5f * x * (1.f + tanhf(u)); }
template <int PASS>
DI void job_lru(const Params& p, int layer, int it, char* lds, bool dup) {
  const int tid = otid(), lane = tid & 63, wid = tid >> 6, l15 = lane & 15, g = lane >> 4;
  const int n = it & 7, c = (it >> 3) % NCH, b = it / (8 * NCH);
  float* xc32 = (float*)lds;
  bf16_t* xcb = (bf16_t*)(lds + 16384);
  f32x2* ab = (f32x2*)(lds + 16384 + 9216);
  f32x2* segtot = (f32x2*)(lds + 16384 + 9216 + 32768);
  float* carry = (float*)(lds + 16384 + 9216 + 32768 + 2048);
  bf16_t* P = (bf16_t*)(p.ws + OFF_P);
  f32x2* LC = (f32x2*)(p.ws + OFF_LC);
  const int ch = tid & 63, seg = tid >> 6;
  {
    const int segLo = c < 4 ? 0 : TC, segHi = c < 4 ? TC : TT;
    const int cp2 = (tid & 31) * 2, tg = tid >> 5;
    const int s0 = c * 64 + tg * 8;
    float cw0[4], cw1[4];
#pragma unroll
    for (int k = 0; k < 4; ++k) { cw0[k] = p.lcw[(size_t)(layer * 4 + k) * 512 + n * 64 + cp2]; cw1[k] = p.lcw[(size_t)(layer * 4 + k) * 512 + n * 64 + cp2 + 1]; }
    const float cb0 = p.lcb[layer * 512 + n * 64 + cp2], cb1 = p.lcb[layer * 512 + n * 64 + cp2 + 1];
    unsigned xw[11];
#pragma unroll
    for (int j = 0; j < 11; ++j) {
      const int s = s0 - 1 + j;
      xw[j] = (s >= segLo && s < segHi) ? *(const unsigned*)(P + (size_t)(b * TT + s) * LDP + C_LX + n * 64 + cp2) : 0u;
    }
#pragma unroll
    for (int u = 0; u < 8; ++u) {
      const float v0 = cw0[0] * bflo(xw[u]) + cw0[1] * bflo(xw[u + 1]) + cw0[2] * bflo(xw[u + 2]) + cw0[3] * bflo(xw[u + 3]) + cb0;
      const float v1 = cw1[0] * bfhi(xw[u]) + cw1[1] * bfhi(xw[u + 1]) + cw1[2] * bfhi(xw[u + 2]) + cw1[3] * bfhi(xw[u + 3]) + cb1;
      *(f32x2*)(xc32 + (tg * 8 + u) * 64 + cp2) = (f32x2){v0, v1};
      *(unsigned*)(xcb + (tg * 8 + u) * 72 + cp2) = pk2(v0, v1);
    }
  }
  if (PASS == 3 && tid < 128) {
    const int d = tid >> 6;
    const int pos = d == 0 ? c : (c < 4 ? 3 - c : 4 + (NCH - 1 - c));
    float hh = 0.f;
    for (int q0 = 0; q0 < pos; q0 += 16) {
      f32x2 AB[16];
#pragma unroll
      for (int j = 0; j < 16; ++j) {
        const int q = q0 + j, qq = q < pos ? q : pos - 1;
        const int cc = d == 0 ? qq : (qq < 4 ? 3 - qq : NCH - 1 - (qq - 4));
        AB[j] = LC[((((size_t)b * NCH + cc) * 8 + n) * 2 + d) * 64 + ch];
      }
#pragma unroll
      for (int j = 0; j < 16; ++j) if (q0 + j < pos) hh = AB[j].x * hh + AB[j].y;
    }
    carry[d * 64 + ch] = hh;
  }
  __syncthreads();
  float hacc[16];
#pragma unroll
  for (int u = 0; u < 16; ++u) hacc[u] = 0.f;
#pragma unroll 1
  for (int d = 0; d < 2; ++d) {
    {
      f32x4 ar[4], ai[4];
#pragma unroll
      for (int i = 0; i < 4; ++i) { ar[i] = (f32x4){0.f, 0.f, 0.f, 0.f}; ai[i] = (f32x4){0.f, 0.f, 0.f, 0.f}; }
      const bf16_t* LG = (const bf16_t*)(p.ws + OFF_LG);
      const bf16_t* wr_ = LG + ((size_t)((d * 2 + 0) * 8 + n)) * 4096 + (wid * 16 + l15) * 64 + g * 8;
      const bf16_t* wi_ = LG + ((size_t)((d * 2 + 1) * 8 + n)) * 4096 + (wid * 16 + l15) * 64 + g * 8;
#pragma unroll
      for (int ks = 0; ks < 2; ++ks) {
        const bf16x8 br = *(const bf16x8*)(wr_ + ks * 32), bi = *(const bf16x8*)(wi_ + ks * 32);
#pragma unroll
        for (int i = 0; i < 4; ++i) {
          const bf16x8 af = *(const bf16x8*)(xcb + (i * 16 + l15) * 72 + ks * 32 + g * 8);
          ar[i] = mfma16(br, af, ar[i]);
          ai[i] = mfma16(bi, af, ai[i]);
        }
      }
#pragma unroll
      for (int e = 0; e < 4; ++e) {
        const int che = wid * 16 + g * 4 + e, cg_ = n * 64 + che;
        const float br = p.lgb[(size_t)((layer * 2 + d) * 2 + 0) * 512 + cg_], bi = p.lgb[(size_t)((layer * 2 + d) * 2 + 1) * 512 + cg_];
        const float sp = softplusf(-p.llam[(size_t)(layer * 2 + d) * 512 + cg_]);
#pragma unroll
        for (int i = 0; i < 4; ++i) {
          const int tok = i * 16 + l15;
          const float r = sigm(ar[i][e] + br), ig = sigm(ai[i][e] + bi);
          const float la = -8.f * r * sp;
          const float av = __expf(la);
          const float bv = __builtin_sqrtf(fmaxf(1.f - __expf(2.f * la), 0.f)) * ig * xc32[tok * 64 + che];
          ab[tok * 64 + che] = (f32x2){av, bv};
        }
      }
    }
    __syncthreads();
    float hloc[16], cploc[16];
    {
      float hp = 0.f, cp = 1.f;
#pragma unroll
      for (int uu = 0; uu < 16; ++uu) {
        const int u = d == 0 ? uu : 15 - uu;
        const f32x2 v = ab[(seg * 16 + u) * 64 + ch];
        hp = v.x * hp + v.y;
        cp *= v.x;
        hloc[uu] = hp; cploc[uu] = cp;
      }
      segtot[seg * 64 + ch] = (f32x2){cp, hp};
    }
    __syncthreads();
    if (PASS == 1) {
      if (tid < 64) {
        float A = 1.f, Bv = 0.f;
#pragma unroll
        for (int q = 0; q < 4; ++q) {
          const f32x2 v = segtot[(d == 0 ? q : 3 - q) * 64 + ch];
          Bv = v.x * Bv + v.y; A *= v.x;
        }
        LC[((((size_t)b * NCH + c) * 8 + n) * 2 + d) * 64 + ch] = (f32x2){A, Bv};
      }
    } else {
      float hh = carry[d * 64 + ch];
      const int npre = d == 0 ? seg : 3 - seg;
      for (int q = 0; q < npre; ++q) {
        const f32x2 v = segtot[(d == 0 ? q : 3 - q) * 64 + ch];
        hh = v.x * hh + v.y;
      }
#pragma unroll
      for (int uu = 0; uu < 16; ++uu) {
        const int u = d == 0 ? uu : 15 - uu;
        const float hv = hloc[uu] + cploc[uu] * hh;
        hacc[d == 0 ? uu : 15 - uu] += hv;
        (void)u;
      }
    }
    __syncthreads();
  }
  if (PASS == 3) {
#pragma unroll
    for (int u = 0; u < 16; ++u) {
      bf16_t* yp = P + (size_t)(b * TT + c * 64 + seg * 16 + u) * LDP + C_LY + n * 64 + ch;
      if (!dup) *yp = f2bf(gelu_tanh(bf2f(*yp)) * hacc[u]);
    }
  }
}

DI void job_gconv(const Params& p, int layer, int it, bool dup) {
  const int tid = otid(), grp = it % 12, cg_ = it / 12, cp = tid & 15, rg = tid >> 4;
  const int cin = cg_ % NCH;
  const bool first = (cin == 0 || cin == 4), last = (cin == 3 || cin == NCH - 1);
  bf16_t* P = (bf16_t*)(p.ws + OFF_P);
  const bf16_t* HALO = (const bf16_t*)(p.ws + OFF_HALO);
  const int col = grp * 128 + cp * 8;
  u32x4 xr[7];
#pragma unroll
  for (int j = 0; j < 7; ++j) {
    const int q = rg * 4 - 1 + j;
    u32x4 v = {0u, 0u, 0u, 0u};
    if (q >= 0 && q < 64) v = *(const u32x4*)(P + (size_t)(cg_ * 64 + q) * LDP + C_GQKV + col);
    else if (q < 0) { if (!first) v = *(const u32x4*)(HALO + ((size_t)(cg_ - 1) * 3 + 2) * 1536 + col); }
    else { if (!last) v = *(const u32x4*)(HALO + ((size_t)(cg_ + 1) * 3 + (q - 64)) * 1536 + col); }
    xr[j] = v;
  }
  float w[4][8];
#pragma unroll
  for (int k = 0; k < 4; ++k) {
    const f32x4 a = *(const f32x4*)(p.gcw + (size_t)(layer * 4 + k) * 1536 + col), bq = *(const f32x4*)(p.gcw + (size_t)(layer * 4 + k) * 1536 + col + 4);
#pragma unroll
    for (int e = 0; e < 4; ++e) { w[k][e] = a[e]; w[k][4 + e] = bq[e]; }
  }
  __syncthreads();
#pragma unroll
  for (int jr = 0; jr < 4; ++jr) {
    float y[8];
#pragma unroll
    for (int e = 0; e < 8; ++e) y[e] = 0.f;
#pragma unroll
    for (int k = 0; k < 4; ++k)
#pragma unroll
      for (int e = 0; e < 4; ++e) { y[2 * e] += w[k][2 * e] * bflo(xr[jr + k][e]); y[2 * e + 1] += w[k][2 * e + 1] * bfhi(xr[jr + k][e]); }
    float ss = 0.f;
#pragma unroll
    for (int e = 0; e < 8; ++e) { y[e] = y[e] * sigm(y[e]); ss += y[e] * y[e]; }
    if (grp < 8) {
      ss += shx<1>(ss); ss += shx<2>(ss); ss += shx<4>(ss); ss += shx<8>(ss);
      const float sc = rsqrtf(ss + EPS) * (grp < 4 ? 0.08838834764831845f : 1.f);
#pragma unroll
      for (int e = 0; e < 8; ++e) y[e] *= sc;
    }
    if (!dup) *(u32x4*)(P + (size_t)(cg_ * 64 + rg * 4 + jr) * LDP + C_GQKV + col) = (u32x4){pk2(y[0], y[1]), pk2(y[2], y[3]), pk2(y[4], y[5]), pk2(y[6], y[7])};
  }
  __syncthreads();
}

DI void job_gprep(const Params& p, int layer, int it, char* lds) {
  const int tid = otid(), lane = tid & 63, wid = tid >> 6, l15 = lane & 15, g = lane >> 4;
  const int h = it & 3, c = (it >> 2) % NCH, b = it / (4 * NCH);
  bf16_t* kt_ = (bf16_t*)lds;
  bf16_t* qt_ = kt_ + 64 * 136;
  float* Ld = (float*)lds;
  float* KK = (float*)(lds + 34816);
  float* QK = KK + 64 * 65;
  float* gcs = QK + 64 * 65;
  float* bts = gcs + 128;
  const bf16_t* P = (const bf16_t*)(p.ws + OFF_P);
#pragma unroll
  for (int i = 0; i < 4; ++i) {
    const int q = tid + 256 * i, row = q >> 4, pc = q & 15;
    const bf16_t* rp = P + (size_t)(b * TT + c * 64 + row) * LDP + C_GQKV + h * 128 + pc * 8;
    *(u32x4*)(qt_ + row * 136 + pc * 8) = *(const u32x4*)rp;
    *(u32x4*)(kt_ + row * 136 + pc * 8) = *(const u32x4*)(rp + 512);
  }
  float* GSC = (float*)(p.ws + OFF_GSC);
  if (tid < 128) {
    const int d = wid, i = lane, tn = d ? 63 - i : i, r = b * TT + c * 64 + tn;
    const float* gba = (const float*)(p.ws + OFF_GBA) + (size_t)r * 16;
    const float gval = -expf(p.galog[(layer * 2 + d) * 4 + h]) * softplusf(gba[8 + d * 4 + h] + p.gdtb[(layer * 2 + d) * 4 + h]);
    const float beta = sigm(gba[d * 4 + h]);
    float v = gval;
#pragma unroll
    for (int o = 1; o < 64; o <<= 1) { const float t = __int_as_float(__builtin_amdgcn_ds_bpermute(((lane - o) & 63) << 2, __float_as_int(v))); if (lane >= o) v += t; }
    const float glast = __int_as_float(__builtin_amdgcn_readlane(__float_as_int(v), 63));
    gcs[d * 64 + i] = v;
    bts[d * 64 + i] = beta;
    float* gs = GSC + (size_t)(it * 2 + d) * 192;
    gs[i] = expf(v);
    gs[64 + i] = expf(glast - v);
    if (i == 0) gs[128] = expf(glast);
  }
  __syncthreads();
  {
    f32x4 akk[4], aqk[4];
#pragma unroll
    for (int j = 0; j < 4; ++j) { akk[j] = (f32x4){0.f, 0.f, 0.f, 0.f}; aqk[j] = (f32x4){0.f, 0.f, 0.f, 0.f}; }
#pragma unroll
    for (int ks = 0; ks < 4; ++ks) {
      const bf16x8 ak = *(const bf16x8*)(kt_ + (wid * 16 + l15) * 136 + ks * 32 + g * 8);
      const bf16x8 aq = *(const bf16x8*)(qt_ + (wid * 16 + l15) * 136 + ks * 32 + g * 8);
#pragma unroll
      for (int j = 0; j < 4; ++j) {
        const bf16x8 bk = *(const bf16x8*)(kt_ + (j * 16 + l15) * 136 + ks * 32 + g * 8);
        akk[j] = mfma16(ak, bk, akk[j]);
        aqk[j] = mfma16(aq, bk, aqk[j]);
      }
    }
#pragma unroll
    for (int j = 0; j < 4; ++j)
#pragma unroll
      for (int e = 0; e < 4; ++e) { KK[(wid * 16 + g * 4 + e) * 65 + j * 16 + l15] = akk[j][e]; QK[(wid * 16 + g * 4 + e) * 65 + j * 16 + l15] = aqk[j][e]; }
  }
  __syncthreads();
  bf16_t* M1 = (bf16_t*)(p.ws + OFF_H);
  bf16_t* AT = M1 + (size_t)4224 * 4096;
#pragma unroll 1
  for (int d = 0; d < 2; ++d) {
    bf16_t* atp = AT + (size_t)(it * 2 + d) * 4096;
#pragma unroll 4
    for (int idx = tid; idx < 4096; idx += 256) {
      const int i = idx >> 6, j = idx & 63, ti = d ? 63 - i : i, tj = d ? 63 - j : j;
      const float dec = (j <= i) ? expf(gcs[d * 64 + i] - gcs[d * 64 + j]) : 0.f;
      Ld[d * 4096 + idx] = (j < i) ? bts[d * 64 + i] * KK[ti * 65 + tj] * dec : 0.f;
      atp[idx] = f2bf(QK[ti * 65 + tj] * dec);
    }
  }
  __syncthreads();
  if (wid < 2) {
    const int d = wid;
    const float* L = Ld + d * 4096;
    const float bc = bts[d * 64 + lane];
    bf16_t* mp = M1 + (size_t)(it * 2 + d) * 4096 + lane;
    float x[64];
#pragma unroll
    for (int i = 0; i < 64; ++i) {
      float s = (i == lane) ? 1.f : 0.f;
#pragma unroll
      for (int j = 0; j < i; ++j) s -= L[i * 64 + j] * x[j];
      x[i] = s;
      mp[i * 64] = f2bf(s * bc);
    }
  }
  __syncthreads();
}

struct GChunk { bf16x8 kf[4], qf[4], m1f[2], atf[2]; unsigned vr[2][4]; float eg[4], egl[4]; float ge; };
DI void gdn_load(GChunk& R, const Params& p, int b, int h, int d, int dvs, int c) {
  const int tid = otid(), lane = tid & 63, wid = tid >> 6, l15 = lane & 15, g = lane >> 4;
  const bf16_t* P = (const bf16_t*)(p.ws + OFF_P);
  const bf16_t* M1 = (const bf16_t*)(p.ws + OFF_H);
  const bf16_t* AT = M1 + (size_t)4224 * 4096;
  const float* GSC = (const float*)(p.ws + OFF_GSC);
  const int item = ((b * NCH + c) * 4 + h) * 2 + d;
  const int irow = 16 * wid + l15, tn = d ? 63 - irow : irow;
  const bf16_t* rowp = P + (size_t)(b * TT + c * 64 + tn) * LDP + C_GQKV + h * 128;
#pragma unroll
  for (int ks = 0; ks < 4; ++ks) { R.qf[ks] = *(const bf16x8*)(rowp + ks * 32 + g * 8); R.kf[ks] = *(const bf16x8*)(rowp + 512 + ks * 32 + g * 8); }
#pragma unroll
  for (int ks = 0; ks < 2; ++ks) {
    R.m1f[ks] = *(const bf16x8*)(M1 + (size_t)item * 4096 + irow * 64 + ks * 32 + g * 8);
    R.atf[ks] = *(const bf16x8*)(AT + (size_t)item * 4096 + irow * 64 + ks * 32 + g * 8);
  }
#pragma unroll
  for (int e = 0; e < 4; ++e) {
    const int i = 16 * wid + g * 4 + e, t2 = d ? 63 - i : i;
    R.vr[0][e] = *(const unsigned*)(P + (size_t)(b * TT + c * 64 + t2) * LDP + C_GQKV + 1024 + h * 128 + dvs * 32 + (l15 & ~1));
    R.vr[1][e] = *(const unsigned*)(P + (size_t)(b * TT + c * 64 + t2) * LDP + C_GQKV + 1024 + h * 128 + dvs * 32 + 16 + (l15 & ~1));
    R.eg[e] = GSC[(size_t)item * 192 + i];
    R.egl[e] = GSC[(size_t)item * 192 + 64 + i];
  }
  R.ge = GSC[(size_t)item * 192 + 128];
}
DI void gdn_put_kt(const GChunk& R, bf16_t* KT) {
  const int tid = otid(), lane = tid & 63, i = 16 * (tid >> 6) + (lane & 15), g = lane >> 4;
#pragma unroll
  for (int ks = 0; ks < 4; ++ks)
#pragma unroll
    for (int e = 0; e < 8; ++e) KT[(ks * 32 + g * 8 + e) * 72 + i] = (bf16_t)R.kf[ks][e];
}
DI int gdn_chunk_at(int d, int n) { return d == 0 ? n : (n < 4 ? 3 - n : NCH - 1 - (n - 4)); }
DI void job_gscan(const Params& p, int u, char* lds) {
  const int tid = otid(), lane = tid & 63, wid = tid >> 6, l15 = lane & 15, g = lane >> 4;
  const int seq = (u & 7) + 8 * (u >> 5), dvs = (u >> 3) & 3, d = seq & 1, h = (seq >> 1) & 3, b = seq >> 3;
  bf16_t* KT = (bf16_t*)lds;
  bf16_t* ST = KT + 2 * 128 * 72;
  bf16_t* XT = ST + 32 * 136;
  bf16_t* VnT = XT + 32 * 72;
  bf16_t* VsT = VnT + 32 * 72;
  bf16_t* OUT = d == 0 ? (bf16_t*)(p.ws + OFF_P) + C_DAV : (bf16_t*)(p.ws + OFF_OB);
  const int ldo = d == 0 ? LDP : 512;
  __builtin_amdgcn_s_setprio(3);
  f32x4 S[2][2];
#pragma unroll
  for (int a = 0; a < 2; ++a)
#pragma unroll
    for (int ct = 0; ct < 2; ++ct) S[a][ct] = (f32x4){0.f, 0.f, 0.f, 0.f};
  for (int i = tid; i < 32 * 136 / 2; i += 256) ((unsigned*)ST)[i] = 0u;
  GChunk cur, nxt;
  gdn_load(cur, p, b, h, d, dvs, gdn_chunk_at(d, 0));
  gdn_put_kt(cur, KT);
  __syncthreads();
#pragma unroll 1
  for (int n = 0; n < NCH; ++n) {
    const int c = gdn_chunk_at(d, n);
    if (n + 1 < NCH) gdn_load(nxt, p, b, h, d, dvs, gdn_chunk_at(d, n + 1));
    const bf16_t* KTc = KT + (n & 1) * 128 * 72;
    f32x4 ksa[2], qsa[2];
#pragma unroll
    for (int ct = 0; ct < 2; ++ct) { ksa[ct] = (f32x4){0.f, 0.f, 0.f, 0.f}; qsa[ct] = (f32x4){0.f, 0.f, 0.f, 0.f}; }
#pragma unroll
    for (int ks = 0; ks < 4; ++ks)
#pragma unroll
      for (int ct = 0; ct < 2; ++ct) {
        const bf16x8 bS = *(const bf16x8*)(ST + (ct * 16 + l15) * 136 + ks * 32 + g * 8);
        ksa[ct] = mfma16(cur.kf[ks], bS, ksa[ct]);
        qsa[ct] = mfma16(cur.qf[ks], bS, qsa[ct]);
      }
#pragma unroll
    for (int ct = 0; ct < 2; ++ct) {
      float x[4];
#pragma unroll
      for (int e = 0; e < 4; ++e) x[e] = ((l15 & 1) ? bfhi(cur.vr[ct][e]) : bflo(cur.vr[ct][e])) - cur.eg[e] * ksa[ct][e];
      *(u32x2*)(XT + (ct * 16 + l15) * 72 + 16 * wid + g * 4) = (u32x2){pk2(x[0], x[1]), pk2(x[2], x[3])};
    }
    __syncthreads();
#pragma unroll
    for (int ct = 0; ct < 2; ++ct) {
      f32x4 vn = {0.f, 0.f, 0.f, 0.f};
#pragma unroll
      for (int ks = 0; ks < 2; ++ks) vn = mfma16(cur.m1f[ks], *(const bf16x8*)(XT + (ct * 16 + l15) * 72 + ks * 32 + g * 8), vn);
      *(u32x2*)(VnT + (ct * 16 + l15) * 72 + 16 * wid + g * 4) = (u32x2){pk2(vn[0], vn[1]), pk2(vn[2], vn[3])};
      *(u32x2*)(VsT + (ct * 16 + l15) * 72 + 16 * wid + g * 4) = (u32x2){pk2(vn[0] * cur.egl[0], vn[1] * cur.egl[1]), pk2(vn[2] * cur.egl[2], vn[3] * cur.egl[3])};
    }
    __syncthreads();
#pragma unroll
    for (int ct = 0; ct < 2; ++ct) {
      f32x4 o;
#pragma unroll
      for (int e = 0; e < 4; ++e) o[e] = cur.eg[e] * qsa[ct][e];
#pragma unroll
      for (int ks = 0; ks < 2; ++ks) o = mfma16(cur.atf[ks], *(const bf16x8*)(VnT + (ct * 16 + l15) * 72 + ks * 32 + g * 8), o);
#pragma unroll
      for (int e = 0; e < 4; ++e) {
        const int i = 16 * wid + g * 4 + e, t2 = d ? 63 - i : i;
        OUT[(size_t)(b * TT + c * 64 + t2) * ldo + h * 128 + dvs * 32 + ct * 16 + l15] = f2bf(o[e]);
      }
    }
#pragma unroll
    for (int rt2 = 0; rt2 < 2; ++rt2) {
      const int rt = 2 * wid + rt2;
#pragma unroll
      for (int ct = 0; ct < 2; ++ct)
#pragma unroll
        for (int e = 0; e < 4; ++e) S[rt2][ct][e] *= cur.ge;
#pragma unroll
      for (int ks = 0; ks < 2; ++ks) {
        const bf16x8 ka = *(const bf16x8*)(KTc + (rt * 16 + l15) * 72 + ks * 32 + g * 8);
#pragma unroll
        for (int ct = 0; ct < 2; ++ct) S[rt2][ct] = mfma16(ka, *(const bf16x8*)(VsT + (ct * 16 + l15) * 72 + ks * 32 + g * 8), S[rt2][ct]);
      }
#pragma unroll
      for (int ct = 0; ct < 2; ++ct)
        *(u32x2*)(ST + (ct * 16 + l15) * 136 + rt * 16 + g * 4) = (u32x2){pk2(S[rt2][ct][0], S[rt2][ct][1]), pk2(S[rt2][ct][2], S[rt2][ct][3])};
    }
    if (n + 1 < NCH) { gdn_put_kt(nxt, KT + ((n + 1) & 1) * 128 * 72); cur = nxt; }
    __syncthreads();
  }
  __builtin_amdgcn_s_setprio(0);
}
DI void job_gpost1(const Params& p, int layer, int r) {
  const int lane = otid() & 63;
  bf16_t* P = (bf16_t*)(p.ws + OFF_P) + (size_t)r * LDP;
  const bf16_t* OB = (const bf16_t*)(p.ws + OFF_OB) + (size_t)r * 512;
  const u32x4 of = *(const u32x4*)(P + C_DAV + lane * 8), ob = *(const u32x4*)(OB + lane * 8), z = *(const u32x4*)(P + C_GZ + lane * 8);
  float o[8], zz[8], ss = 0.f;
#pragma unroll
  for (int e = 0; e < 4; ++e) {
    o[2 * e] = bflo(of[e]) + bflo(ob[e]); o[2 * e + 1] = bfhi(of[e]) + bfhi(ob[e]);
    zz[2 * e] = bflo(z[e]); zz[2 * e + 1] = bfhi(z[e]);
  }
#pragma unroll
  for (int e = 0; e < 8; ++e) ss += o[e] * o[e];
  ss += shx<1>(ss); ss += shx<2>(ss); ss += shx<4>(ss); ss += shx<8>(ss);
  const float rstd = rsqrtf(ss * (1.f / 128.f) + EPS);
  const float* gn = p.gng + layer * 128 + (lane & 15) * 8;
  float y[8];
#pragma unroll
  for (int e = 0; e < 8; ++e) y[e] = o[e] * rstd * gn[e] * (zz[e] * sigm(zz[e]));
  *(u32x4*)(P + C_GZ + lane * 8) = (u32x4){pk2(y[0], y[1]), pk2(y[2], y[3]), pk2(y[4], y[5]), pk2(y[6], y[7])};
}

DI void job_gpost(const Params& p, int layer, int it) {
  const int wid = otid() >> 6;
#pragma unroll
  for (int rr = 0; rr < 2; ++rr) job_gpost1(p, layer, it * 8 + rr * 4 + wid);
}
#ifdef SK_JL1
#define JL1(x)
#else
#define JL1(x) x
#endif
#ifdef SK_JGC
#define JGC(x)
#else
#define JGC(x) x
#endif
#ifdef SK_JVT
#define JVT(x)
#else
#define JVT(x) x
#endif
#ifdef SK_JDP
#define JDP(x)
#else
#define JDP(x) x
#endif
#ifdef SK_JGP
#define JGP(x)
#else
#define JGP(x) x
#endif
#ifdef SK_JL3
#define JL3(x)
#else
#define JL3(x) x
#endif
#ifdef SK_JGS
#define JGS(x)
#else
#define JGS(x) x
#endif
#ifdef SK_JAT
#define JAT(x)
#else
#define JAT(x) x
#endif
#define LAS __attribute__((address_space(3)))
#define XB_TMO      128
#define XB_XCNT(j)  (256  + 64 * (j))
#define XB_XSUB(j)  (1280 + 64 * (j))
#define XB_XGEN(j)  (2304 + 64 * (j))
#define XB_TOP      3328
#define XB_TOPGEN   3392
#define XCD_BAR_WORDS 3456
#define XB_SPIN_CAP (1u << 18)

__device__ __forceinline__ unsigned xb_ld(unsigned* p)              { return __hip_atomic_load(p, __ATOMIC_RELAXED, __HIP_MEMORY_SCOPE_AGENT); }
__device__ __forceinline__ unsigned xb_add(unsigned* p, unsigned v) { return __hip_atomic_fetch_add(p, v, __ATOMIC_RELAXED, __HIP_MEMORY_SCOPE_AGENT); }
__device__ __forceinline__ unsigned xb_xcc_id() { return (unsigned)__builtin_amdgcn_s_getreg((3 << 11) | 20) & 0xFu; }
#define XB_SPIN(cond, bar) do { unsigned _sp = 0; while (cond) { __builtin_amdgcn_s_sleep(1); \
    if ((++_sp & 255u) == 0u) { if (xb_ld(&(bar)[XB_TMO])) break; if (_sp > XB_SPIN_CAP) { atomicAdd(&(bar)[XB_TMO], 1u); break; } } } } while (0)

struct XcdBarrier {
    unsigned* bar; unsigned x;
    volatile LAS unsigned* st;
};

__device__ __forceinline__ XcdBarrier xcd_barrier_post(unsigned* bar, volatile LAS unsigned* st) {
    XcdBarrier b; b.bar = bar; b.x = xb_xcc_id(); b.st = st;
    if (threadIdx.x == 0) (void)xb_add(&bar[XB_XCNT(b.x)], 1u);
    return b;
}
__device__ __forceinline__ void xcd_barrier_complete(unsigned* bar, unsigned x, unsigned& nloc, unsigned& nx) {
    const unsigned G = gridDim.x * gridDim.y * gridDim.z;
    unsigned sum, cnt, mine, sp = 0u;
    for (;;) {
        sum = 0u; cnt = 0u; mine = 0u;
#pragma unroll
        for (unsigned j = 0; j < 16; ++j) { const unsigned c = xb_ld(&bar[XB_XCNT(j)]); sum += c; cnt += (c > 0u) ? 1u : 0u; mine = (j == x) ? c : mine; }
        if (sum == G) break;
        __builtin_amdgcn_s_sleep(1);
        if ((++sp & 255u) == 0u) { if (xb_ld(&bar[XB_TMO])) break; if (sp > XB_SPIN_CAP) { atomicAdd(&bar[XB_TMO], 1u); break; } }
    }
    nloc = mine > 0u ? mine : 1u; nx = cnt > 0u ? cnt : 1u;
}

__device__ __forceinline__ void xcd_barrier(const XcdBarrier& b) {
    asm volatile("s_waitcnt vmcnt(0)" ::: "memory");
    __syncthreads();
    if (threadIdx.x == 0) {
        unsigned* bar = b.bar; unsigned bx_ = b.x;
        asm volatile("" : "+s"(bar), "+s"(bx_));
        __builtin_amdgcn_s_waitcnt(0);
        unsigned nloc = b.st[0], nx = b.st[1];
        if (nloc == 0u) { xcd_barrier_complete(bar, bx_, nloc, nx); b.st[0] = nloc; b.st[1] = nx; }
        const unsigned old = xb_add(&bar[XB_XSUB(bx_)], 1u);
        const unsigned gen = old / nloc;
        if (old + 1u == (gen + 1u) * nloc) {
            __builtin_amdgcn_fence(__ATOMIC_RELEASE, "agent");
            asm volatile("s_waitcnt vmcnt(0)" ::: "memory");
            const unsigned og = xb_add(&bar[XB_TOP], 1u);
            const unsigned tg = og / nx;
            if (og + 1u == (tg + 1u) * nx) xb_add(&bar[XB_TOPGEN], 1u);
            else XB_SPIN(xb_ld(&bar[XB_TOPGEN]) == tg, bar);
            __builtin_amdgcn_fence(__ATOMIC_ACQUIRE, "agent");
            xb_add(&bar[XB_XGEN(bx_)], 1u);
            asm volatile("s_waitcnt vmcnt(0)" ::: "memory");
        } else {
            XB_SPIN(xb_ld(&bar[XB_XGEN(bx_)]) == gen, bar);
            __builtin_amdgcn_fence(__ATOMIC_ACQUIRE, "agent");
            asm volatile("s_waitcnt vmcnt(0)" ::: "memory");
        }
    }
    __syncthreads();
}


#define PH_BEGIN(k) for (int rep_ = 0, nrep_ = 1 + (((p.probe >> (k)) & 1) | ((k) == 5 ? ((p.probe >> 12) | (p.probe >> 13)) & 1 : 0)); rep_ < nrep_; ++rep_) { const bool dup = rep_ > 0; (void)dup;
#define PH_END xcd_barrier(xb_); }
#ifndef PROBE_MASK
#define PROBE_MASK 0
#endif
__global__ void __launch_bounds__(256, 2) mega(Params p) {
  __shared__ __attribute__((aligned(16))) char lds[LDS_BYTES];
  __shared__ int s_item;
  __shared__ unsigned xb_st[2];
  if (otid() == 0) { xb_st[0] = 0u; xb_st[1] = 0u; }
  __syncthreads();
  const XcdBarrier xb_ = xcd_barrier_post((unsigned*)(p.ws + OFF_CTR) + 64, (volatile LAS unsigned*)xb_st);
  cg::grid_group grid = cg::this_grid();
  const int G = gridDim.x, B = blockIdx.x;
  bf16_t* P = (bf16_t*)(p.ws + OFF_P);
  bf16_t* H = (bf16_t*)(p.ws + OFF_H);
  for (int it = B; it < 192 + 1024 + N_CVT; it += G) {
    if (it < 192) job_mod(p, it, lds);
    else if (it < 1216) job_rope(p, it - 192);
    else job_cvt(p, 0, it - 1216, lds);
  }
  if (p.probe < 0) grid.sync();
  xcd_barrier(xb_);
#pragma unroll 1
  for (int layer = 0; layer < 2; ++layer) {
    bf16_t* MG = (bf16_t*)(p.ws + OFF_VT);
    bf16_t* HID = P;
    PH_BEGIN(1)
    {
      const int n1 = layer == 1 ? N_CVT : 0;
      for (int it = B; it < n1 + MR / 8; it += G) { if (it < n1) job_cvt(p, 1, it, lds); else job_norm(p, layer, 1, it - n1); }
    }
    PH_END
    PH_BEGIN(2)
    {
      bf16_t* HALO = (bf16_t*)(p.ws + OFF_HALO);
      float* GBA = (float*)(p.ws + OFF_GBA);
      gemm_phase(H, 32, MR * 32, (const bf16_t*)(p.ws + OFF_WIN), 32, 7808 * 32, 1024, 132, 37, lds, B, G, [&](int row, int col, f32x4 v) {
        if (col < C_GBA) {
          const u32x2 w = {pk2(v[0], v[1]), pk2(v[2], v[3])};
          *(u32x2*)(P + (size_t)row * LDP + col) = w;
          if (col >= C_GQKV && col < C_GZ) {
            const int sm = row & 63;
            if (sm <= 1 || sm == 63) *(u32x2*)(HALO + ((size_t)(row >> 6) * 3 + (sm == 63 ? 2 : sm)) * 1536 + (col - C_GQKV)) = w;
          }
        } else if (col < C_GBA + 16) {
          *(f32x4*)(GBA + (size_t)row * 16 + (col - C_GBA)) = v;
        }
      }, [&](int row, int col, f32x4 v0, f32x4 v1) {
        if (col < C_GBA) {
          const u32x4 w = (u32x4){pk2(v0[0], v0[1]), pk2(v0[2], v0[3]), pk2(v1[0], v1[1]), pk2(v1[2], v1[3])};
          __builtin_nontemporal_store(w, (u32x4*)(P + (size_t)row * LDP + col));
          if (col >= C_GQKV && col < C_GZ) {
            const int sm = row & 63;
            if (sm <= 1 || sm == 63) *(u32x4*)(HALO + ((size_t)(row >> 6) * 3 + (sm == 63 ? 2 : sm)) * 1536 + (col - C_GQKV)) = w;
          }
        } else if (col < C_GBA + 16) {
          *(f32x4*)(GBA + (size_t)row * 16 + (col - C_GBA)) = v0;
          *(f32x4*)(GBA + (size_t)row * 16 + (col - C_GBA) + 4) = v1;
        }
      });
    }
    PH_END
    PH_BEGIN(3)
    {
      const int nA = 8 * NCH * 4, nB = nA + 6336, nC = nB + 2112, nD = nC + MR / 8;
      for (int it = B; it < nD; it += G) {
        if (it < nA) JL1(job_lru<1>(p, layer, it, lds, dup));
        else if (it < nB) JGC(job_gconv(p, layer, it - nA, dup));
        else if (it < nC) JVT(job_vt(p, it - nB, lds));
        else JDP(job_daprep(p, layer, it - nC, dup));
      }
    }
    PH_END
    PH_BEGIN(4)
    for (int it = B; it < 2112; it += G) JGP(job_gprep(p, layer, it, lds));
    PH_END
    PH_BEGIN(5)
    {
      for (;;) {
        const int x = blockIdx.x & 7;
        if (otid() == 0) s_item = (int)__hip_atomic_fetch_add((unsigned*)(p.ws + OFF_CTR) + ((layer * 2 + rep_) * 8 + x), 1u, __ATOMIC_RELAXED, __HIP_MEMORY_SCOPE_AGENT);
        __syncthreads();
        const int j = __builtin_amdgcn_readfirstlane(s_item);
        __syncthreads();
        if (j >= 16 + 132 + 528) break;
        if (j < 16) { if (!(dup && ((p.probe >> 12) & 1))) JGS(job_gscan(p, j * 8 + x, lds)); }
        else if (j < 148) {
          const int k = j - 16, grp = k / 66, qq = k % 66, qb = qq < 64 ? qq + 2 : qq - 64;
          if (!(dup && ((p.probe >> 13) & 1))) JAT(job_attn(p, layer, grp * 528 + qb * 8 + x, lds, dup));
        } else { if (!(dup && (((p.probe >> 12) | (p.probe >> 13)) & 1))) JL3(job_lru<3>(p, layer, (j - 148) * 8 + x, lds, dup)); }
      }
    }
    PH_END
    PH_BEGIN(6)
    for (int it = B; it < MR / 8 + MR / 8; it += G) { if (it < MR / 8) job_gpost(p, layer, it); else job_norm(p, layer, 1, it - MR / 8); }
    PH_END
    PH_BEGIN(7)
    gemm_phase(H, 32, MR * 32, (const bf16_t*)(p.ws + OFF_WIN) + (size_t)4736 * 32, 32, 7808 * 32, 1024, 132, 24, lds, B, G, [&](int row, int col, f32x4 v) {
      *(u32x2*)(P + (size_t)row * LDP + sg_col(col)) = (u32x2){pk2(sigm(v[0]), sigm(v[1])), pk2(sigm(v[2]), sigm(v[3]))};
    }, [&](int row, int col, f32x4 v0, f32x4 v1) {
      *(u32x4*)(P + (size_t)row * LDP + sg_col(col)) = (u32x4){pk2(sigm(v0[0]), sigm(v0[1])), pk2(sigm(v0[2]), sigm(v0[3])), pk2(sigm(v1[0]), sigm(v1[1])), pk2(sigm(v1[2]), sigm(v1[3]))};
    }, layer == 1);
    PH_END
    PH_BEGIN(14)
    {
      const bf16_t* WBR = (const bf16_t*)(p.ws + OFF_WBR);
      const int nm14 = layer == 1 ? 256 : 264;
      for (int t = B; t < nm14 * 8; t += G) {
        int mi, ni; tile_mn(t, nm14, 8, mi, ni);
        if (layer == 1) mi += 2 * (mi >> 6) + 2;
        f32x4 mg[4][4]; zero_acc<4>(mg);
#pragma unroll 1
        for (int i = 0; i < 3; ++i) {
          f32x4 ay[4][4]; zero_acc<4>(ay);
          const int coff = i == 0 ? C_DAQ : (i == 1 ? C_LY : C_GZ);
          gemm_core<4>(P + (size_t)mi * 128 * LDP + coff, LDP, 32, WBR + (size_t)i * 1024 * 512 + (size_t)(ni * 128) * 32, 32, 1024 * 32, 512, ay, lds);
          const int lane = otid() & 63, wid = otid() >> 6, wr = wid >> 1, wc = wid & 1;
#pragma unroll
          for (int a2 = 0; a2 < 4; ++a2)
#pragma unroll
            for (int b2 = 0; b2 < 4; ++b2) {
              const int row = mi * 128 + wr * 64 + a2 * 16 + (lane & 15), col = ni * 128 + wc * 64 + b2 * 16 + (lane >> 4) * 4;
              const u32x2 sg = *(const u32x2*)(P + (size_t)row * LDP + sg_col(i * 1024 + col));
              mg[a2][b2] += (f32x4){bflo(sg.x), bfhi(sg.x), bflo(sg.y), bfhi(sg.y)} * ay[a2][b2];
            }
        }
        gemm_emit<4>(mg, mi * 128, ni * 128, [&](int row, int col, f32x4 v) { *(u32x2*)(MG + ((size_t)(col >> 5) * MR + row) * 32 + (col & 31)) = (u32x2){pk2(v[0], v[1]), pk2(v[2], v[3])}; });
      }
    }
    PH_END
    PH_BEGIN(8)
    gemm_phase(MG, 32, MR * 32, (const bf16_t*)(p.ws + OFF_WO), 32, 1024 * 32, 1024, 132, 8, lds, B, G, [&](int row, int col, f32x4 v) {
      const f32x4 xin = *(const f32x4*)(res_in_row(p, layer, row) + col);
      const f32x4 g1 = *(const f32x4*)(mod_vec(p, layer, row) + 2048 + col);
      if (!dup) *(f32x4*)(res_out_row(p, row) + col) = xin + g1 * v;
    }, [&](int row, int col, f32x4 v0, f32x4 v1) {
      const float* xi = res_in_row(p, layer, row) + col;
      const float* gm = mod_vec(p, layer, row) + 2048 + col;
      float* xo = res_out_row(p, row) + col;
      const f32x4 o0 = __builtin_nontemporal_load((const f32x4*)xi) + *(const f32x4*)gm * v0, o1 = __builtin_nontemporal_load((const f32x4*)(xi + 4)) + *(const f32x4*)(gm + 4) * v1;
      if (!dup) { *(f32x4*)xo = o0; *(f32x4*)(xo + 4) = o1; }
    }, layer == 1);
    PH_END
    PH_BEGIN(9)
    for (int it = B; it < MR / 8; it += G) job_norm(p, layer, 2, it);
    PH_END
    PH_BEGIN(10)
    gemm_phase(H, 32, MR * 32, (const bf16_t*)(p.ws + OFF_W1), 32, 4096 * 32, 1024, 132, 32, lds, B, G, [&](int row, int col, f32x4 v) {
      float r[4];
#pragma unroll
      for (int e = 0; e < 4; ++e) { const float q = fmaxf(v[e], 0.f); r[e] = q * q; }
      *(u32x2*)(HID + ((size_t)(col >> 5) * MR + row) * 32 + (col & 31)) = (u32x2){pk2(r[0], r[1]), pk2(r[2], r[3])};
    }, [&](int row, int col, f32x4 v0, f32x4 v1) {
      float r[8];
#pragma unroll
      for (int e = 0; e < 4; ++e) { const float q0 = fmaxf(v0[e], 0.f), q1 = fmaxf(v1[e], 0.f); r[e] = q0 * q0; r[4 + e] = q1 * q1; }
      __builtin_nontemporal_store(((u32x4){pk2(r[0], r[1]), pk2(r[2], r[3]), pk2(r[4], r[5]), pk2(r[6], r[7])}), (u32x4*)(HID + ((size_t)(col >> 5) * MR + row) * 32 + (col & 31)));
    }, layer == 1);
    PH_END
    PH_BEGIN(11)
    gemm_phase(HID, 32, MR * 32, (const bf16_t*)(p.ws + OFF_W2), 32, 1024 * 32, 4096, 132, 8, lds, B, G, [&](int row, int col, f32x4 v) {
      float* xo = res_out_row(p, row) + col;
      const f32x4 g2 = *(const f32x4*)(mod_vec(p, layer, row) + 5120 + col);
      if (!dup) *(f32x4*)xo = *(const f32x4*)xo + g2 * v;
    }, [&](int row, int col, f32x4 v0, f32x4 v1) {
      float* xo = res_out_row(p, row) + col;
      const float* gm = mod_vec(p, layer, row) + 5120 + col;
      const f32x4 o0 = __builtin_nontemporal_load((const f32x4*)xo) + *(const f32x4*)gm * v0, o1 = __builtin_nontemporal_load((const f32x4*)(xo + 4)) + *(const f32x4*)(gm + 4) * v1;
      if (!dup) { *(f32x4*)xo = o0; *(f32x4*)(xo + 4) = o1; }
    }, layer == 1);
    PH_END
  }
}

extern "C" void kernel_launch(void* const* d_in, const int* in_sizes, int n_in, void* d_out, int out_size, void* d_ws, size_t ws_size, hipStream_t stream) {
  static int grid_blocks = 0;
  if (!grid_blocks) {
    int dev = 0, cus = 0, per_cu = 0;
    hipGetDevice(&dev);
    hipDeviceGetAttribute(&cus, hipDeviceAttributeMultiprocessorCount, dev);
    hipOccupancyMaxActiveBlocksPerMultiprocessor(&per_cu, mega, 256, 0);
    if (per_cu > 2) per_cu = 2;
    grid_blocks = cus * per_cu;
    grid_blocks -= grid_blocks % 8;
  }
  Params p{};
  const float** f = (const float**)&p;
  for (int i = 0; i < 26; ++i) f[i] = (const float*)d_in[i];
  p.out = (float*)d_out;
  p.ws = (char*)d_ws;
  p.probe = PROBE_MASK;
  if (ws_size < WS_TOTAL) { fprintf(stderr, "workspace too small: %zu < %zu\n", ws_size, (size_t)WS_TOTAL); return; }
  hipMemsetAsync((char*)d_ws + OFF_CTR, 0, 256 + 16384, stream);
  void* args[] = {&p};
  hipError_t e = hipLaunchCooperativeKernel((void*)mega, dim3(grid_blocks), dim3(256), args, 0, stream);
  if (e != hipSuccess) fprintf(stderr, "cooperative launch failed: %s (grid %d)\n", hipGetErrorString(e), grid_blocks);
}
```

```cpp
#include <hip/hip_runtime.h>
#include <hip/hip_cooperative_groups.h>
#include <cstdint>
#include <cstdio>
namespace cg = cooperative_groups;

#define DI __device__ __forceinline__
typedef unsigned short bf16_t;
typedef short bf16x8 __attribute__((ext_vector_type(8)));
typedef float f32x4 __attribute__((ext_vector_type(4)));
typedef float f32x2 __attribute__((ext_vector_type(2)));
typedef unsigned u32x4 __attribute__((ext_vector_type(4)));
typedef unsigned u32x2 __attribute__((ext_vector_type(2)));
typedef __bf16 bf16x2_t __attribute__((ext_vector_type(2)));

constexpr int DM = 1024, NB = 4, TL = 8192, TC = 256, TT = 8448, MR = NB * TT;
constexpr int LDP = 4736;
constexpr int C_DAQ = 0, C_DAK = 512, C_DAV = 1024, C_LX = 1536, C_LY = 2048, C_GQKV = 2560, C_GZ = 4096, C_GBA = 4608;
constexpr int NCH = 132;
constexpr float EPS = 1e-6f;
constexpr int LDS_BYTES = 77824;

constexpr size_t al256(size_t x) { return (x + 255) & ~(size_t)255; }
constexpr size_t OFF_WIN = 0;
constexpr size_t OFF_WBR = OFF_WIN + al256((size_t)7808 * 1024 * 2);
constexpr size_t OFF_WO = OFF_WBR + al256((size_t)3 * 1024 * 512 * 2);
constexpr size_t OFF_W1 = OFF_WO + al256((size_t)1024 * 1024 * 2);
constexpr size_t OFF_W2 = OFF_W1 + al256((size_t)4096 * 1024 * 2);
constexpr size_t OFF_LG = OFF_W2 + al256((size_t)4096 * 1024 * 2);
constexpr size_t OFF_P = OFF_LG + al256((size_t)32 * 4096 * 2);
constexpr size_t OFF_H = OFF_P + al256((size_t)MR * LDP * 2);
constexpr size_t OFF_VT = OFF_H + al256((size_t)MR * 1024 * 2);
constexpr size_t OFF_OB = OFF_VT + al256((size_t)MR * 512 * 2);
constexpr size_t OFF_HALO = OFF_OB + al256((size_t)MR * 512 * 2);
constexpr size_t OFF_GBA = OFF_HALO + al256((size_t)528 * 3 * 1536 * 2);
constexpr size_t OFF_GSC = OFF_GBA + al256((size_t)MR * 16 * 4);
constexpr size_t OFF_LC = OFF_GSC + al256((size_t)4224 * 192 * 4);
constexpr size_t OFF_CTX = OFF_LC + al256((size_t)4 * NCH * 8 * 2 * 64 * 8);
constexpr size_t OFF_MOD = OFF_CTX + al256((size_t)4 * 256 * 1024 * 4);
constexpr size_t OFF_ROPE = OFF_MOD + al256((size_t)2 * 5 * 6144 * 4);
constexpr size_t OFF_CTR = OFF_ROPE + al256((size_t)8192 * 32 * 8);
constexpr size_t WS_TOTAL = OFF_CTR + 256 + 16384;
static_assert(WS_TOTAL <= (size_t)536870912, "workspace map too large");

struct Params {
  const float *x, *c, *ctx, *cctx, *ada_w, *ada_b, *n1g, *n2g, *w_in, *daqg, *dakg, *dalam, *dasub, *lcw, *lcb, *lgw, *lgb, *llam,
      *gcw, *galog, *gdtb, *gng, *wbr, *wout, *w1, *w2;
  float* out;
  char* ws;
  int probe;
  int pad_;
};

DI unsigned pk2(float lo, float hi) { f32x2 v = {lo, hi}; bf16x2_t b = __builtin_convertvector(v, bf16x2_t); return __builtin_bit_cast(unsigned, b); }
DI bf16_t f2bf(float f) { return (bf16_t)(pk2(f, 0.f) & 0xffffu); }
DI float bf2f(bf16_t u) { return __uint_as_float(((unsigned)u) << 16); }
DI float bflo(unsigned w) { return __uint_as_float(w << 16); }
DI float bfhi(unsigned w) { return __uint_as_float(w & 0xffff0000u); }
DI int otid() { int t = __builtin_amdgcn_workitem_id_x(); asm volatile("" : "+v"(t)); return t; }
template <int M> DI float shx(float v) { return __int_as_float(__builtin_amdgcn_ds_swizzle(__float_as_int(v), (M << 10) | 0x1f)); }
DI float add32(float v) { auto r = __builtin_amdgcn_permlane32_swap(__float_as_uint(v), __float_as_uint(v), false, false); return __uint_as_float(r[0]) + __uint_as_float(r[1]); }
DI float max32(float v) { auto r = __builtin_amdgcn_permlane32_swap(__float_as_uint(v), __float_as_uint(v), false, false); return fmaxf(__uint_as_float(r[0]), __uint_as_float(r[1])); }
DI float wsum(float v) { v += shx<1>(v); v += shx<2>(v); v += shx<4>(v); v += shx<8>(v); v += shx<16>(v); return add32(v); }
DI float wmax(float v) { v = fmaxf(v, shx<1>(v)); v = fmaxf(v, shx<2>(v)); v = fmaxf(v, shx<4>(v)); v = fmaxf(v, shx<8>(v)); v = fmaxf(v, shx<16>(v)); return max32(v); }
DI float sigm(float x) { return 1.f / (1.f + __expf(-x)); }
DI float softplusf(float x) { return x > 20.f ? x : log1pf(expf(x)); }
DI f32x4 mfma16(bf16x8 a, bf16x8 b, f32x4 c) { return __builtin_amdgcn_mfma_f32_16x16x32_bf16(a, b, c, 0, 0, 0); }

DI const float* res_in_row(const Params& p, int layer, int r) {
  const int b = r / TT, s = r % TT;
  if (layer == 0) return s < TC ? p.ctx + ((size_t)b * TC + s) * DM : p.x + ((size_t)b * TL + (s - TC)) * DM;
  return s < TC ? (const float*)(p.ws + OFF_CTX) + ((size_t)b * TC + s) * DM : p.out + ((size_t)b * TL + (s - TC)) * DM;
}
DI float* res_out_row(const Params& p, int r) {
  const int b = r / TT, s = r % TT;
  return s < TC ? (float*)(p.ws + OFF_CTX) + ((size_t)b * TC + s) * DM : p.out + ((size_t)b * TL + (s - TC)) * DM;
}
DI const float* mod_vec(const Params& p, int layer, int r) {
  const int b = r / TT, s = r % TT;
  return (const float*)(p.ws + OFF_MOD) + (size_t)(layer * 5 + (s < TC ? 4 : b)) * 6144;
}

template <int WN>
DI void gemm_core(const bf16_t* __restrict__ A, int lda, int a_ks, const bf16_t* __restrict__ Bt, int ldb, int b_ks, int K, f32x4 (&acc)[4][WN], char* lds) {
  constexpr int BN = 32 * WN, AST = 72, NBP = BN * 8 / 256;
  bf16_t* As = (bf16_t*)lds;
  bf16_t* Bs = As + 2 * 128 * AST;
  const int tid = otid(), lane = tid & 63, wid = tid >> 6, wr = wid >> 1, wc = wid & 1;
  u32x4 ra[4], rb[NBP];
  const int nk = K / 64;
#define GLOAD(k0)                                                                                                            \
  {                                                                                                                          \
    _Pragma("unroll") for (int i = 0; i < 4; ++i) { const int q = tid + 256 * i; ra[i] = *(const u32x4*)(A + (size_t)(q >> 3) * lda + (size_t)(((k0) >> 5) + ((q & 7) >> 2)) * a_ks + (q & 3) * 8); } \
    _Pragma("unroll") for (int i = 0; i < NBP; ++i) { const int q = tid + 256 * i; rb[i] = *(const u32x4*)(Bt + (size_t)(q >> 3) * ldb + (size_t)(((k0) >> 5) + ((q & 7) >> 2)) * b_ks + (q & 3) * 8); } \
  }
#define SSTORE(buf)                                                                                                          \
  {                                                                                                                          \
    _Pragma("unroll") for (int i = 0; i < 4; ++i) { const int q = tid + 256 * i; *(u32x4*)(As + ((buf) * 128 + (q >> 3)) * AST + (q & 7) * 8) = ra[i]; } \
    _Pragma("unroll") for (int i = 0; i < NBP; ++i) { const int q = tid + 256 * i; *(u32x4*)(Bs + ((buf) * BN + (q >> 3)) * AST + (q & 7) * 8) = rb[i]; } \
  }
  GLOAD(0);
  SSTORE(0);
  __syncthreads();
  for (int t = 0; t < nk; ++t) {
    if (t + 1 < nk) GLOAD((t + 1) * 64);
    const bf16_t* a = As + ((t & 1) * 128 + wr * 64 + (lane & 15)) * AST + (lane >> 4) * 8;
    const bf16_t* b = Bs + ((t & 1) * BN + wc * 16 * WN + (lane & 15)) * AST + (lane >> 4) * 8;
#pragma unroll
    for (int ks = 0; ks < 2; ++ks) {
      bf16x8 af[4], bfr[WN];
#pragma unroll
      for (int i = 0; i < 4; ++i) af[i] = *(const bf16x8*)(a + i * 16 * AST + ks * 32);
#pragma unroll
      for (int j = 0; j < WN; ++j) bfr[j] = *(const bf16x8*)(b + j * 16 * AST + ks * 32);
      __builtin_amdgcn_sched_barrier(0);
#pragma unroll
      for (int i = 0; i < 4; ++i)
#pragma unroll
        for (int j = 0; j < WN; ++j) acc[i][j] = mfma16(bfr[j], af[i], acc[i][j]);
      __builtin_amdgcn_sched_barrier(0);
    }
    if (t + 1 < nk) SSTORE((t + 1) & 1);
    __syncthreads();
  }
#undef GLOAD
#undef SSTORE
}
DI void tile_mn(int t, int nm, int nn, int& mi, int& ni) {
  const int nig = 16 * nn, g = t / nig, rem = t % nig, fm = g * 16;
  const int gsz = (nm - fm) < 16 ? (nm - fm) : 16;
  mi = fm + rem % gsz;
  ni = rem / gsz;
}
template <int WN, class Epi>
DI void gemm_emit(const f32x4 (&acc)[4][WN], int m0, int n0, Epi epi) {
  const int lane = otid() & 63, wid = otid() >> 6, wr = wid >> 1, wc = wid & 1;
#pragma unroll
  for (int i = 0; i < 4; ++i)
#pragma unroll
    for (int j = 0; j < WN; ++j) epi(m0 + wr * 64 + i * 16 + (lane & 15), n0 + wc * 16 * WN + j * 16 + (lane >> 4) * 4, acc[i][j]);
}
template <int WN>
DI void zero_acc(f32x4 (&acc)[4][WN]) {
#pragma unroll
  for (int i = 0; i < 4; ++i)
#pragma unroll
    for (int j = 0; j < WN; ++j) acc[i][j] = (f32x4){0.f, 0.f, 0.f, 0.f};
}

DI void gemm_core2(const bf16_t* __restrict__ A, int lda, int a_ks, const bf16_t* __restrict__ Bt, int ldb, int b_ks, int K, f32x4 (&acc)[8][4], char* lds) {
  constexpr int AST = 48;
  bf16_t* As = (bf16_t*)lds;
  bf16_t* Bs = As + 2 * 256 * AST;
  const int tid = otid(), lane = tid & 63, wid = tid >> 6, wr = wid >> 1, wc = wid & 1;
  u32x4 s0a[4], s0b[2], s1a[4], s1b[2];
  const int nk = K / 32;
  const bf16_t* ag = A + (size_t)(tid >> 2) * lda + (tid & 3) * 8;
  const bf16_t* bg = Bt + (size_t)(tid >> 2) * ldb + (tid & 3) * 8;
  const int bc_ = tid >> 2, brow = ((bc_ >> 5) * 2 + ((bc_ >> 2) & 1)) * 16 + ((bc_ >> 3) & 3) * 4 + (bc_ & 3);
#define LBAR() { asm volatile("s_waitcnt lgkmcnt(0)" ::: "memory"); __builtin_amdgcn_s_barrier(); asm volatile("" ::: "memory"); }
#define GLOAD2(ra, rb, k0)                                                                                                   \
  {                                                                                                                          \
    _Pragma("unroll") for (int i = 0; i < 4; ++i) ra[i] = *(const u32x4*)(ag + (size_t)(64 * i) * lda + (size_t)((k0) >> 5) * a_ks);               \
    _Pragma("unroll") for (int i = 0; i < 2; ++i) rb[i] = *(const u32x4*)(bg + (size_t)(64 * i) * ldb + (size_t)((k0) >> 5) * b_ks);               \
  }
#define SSTORE2(ra, rb, buf)                                                                                                 \
  {                                                                                                                          \
    _Pragma("unroll") for (int i = 0; i < 4; ++i) *(u32x4*)(As + ((buf) * 256 + 64 * i + (tid >> 2)) * AST + (tid & 3) * 8) = ra[i]; \
    _Pragma("unroll") for (int i = 0; i < 2; ++i) *(u32x4*)(Bs + ((buf) * 128 + 64 * i + brow) * AST + (tid & 3) * 8) = rb[i]; \
  }
#define STEP2(t, la, lb, sa, sb)                                                                                             \
  {                                                                                                                          \
    if ((t) + 2 < nk) GLOAD2(la, lb, ((t) + 2) * 32);                                                                        \
    const bf16_t* a = As + (((t) & 1) * 256 + wr * 128 + (lane & 15)) * AST + (lane >> 4) * 8;                               \
    const bf16_t* b = Bs + (((t) & 1) * 128 + wc * 64 + (lane & 15)) * AST + (lane >> 4) * 8;                                \
    bf16x8 bfr[4], a0[4], a1[4];                                                                                             \
    _Pragma("unroll") for (int j = 0; j < 4; ++j) bfr[j] = *(const bf16x8*)(b + j * 16 * AST);                               \
    _Pragma("unroll") for (int i = 0; i < 4; ++i) a0[i] = *(const bf16x8*)(a + i * 16 * AST);                                \
    __builtin_amdgcn_sched_barrier(0);                                                                                       \
    _Pragma("unroll") for (int i = 0; i < 4; ++i) a1[i] = *(const bf16x8*)(a + (4 + i) * 16 * AST);                          \
    __builtin_amdgcn_sched_barrier(0);                                                                                       \
    _Pragma("unroll") for (int i = 0; i < 4; ++i) _Pragma("unroll") for (int j = 0; j < 4; ++j) acc[i][j] = mfma16(bfr[j], a0[i], acc[i][j]); \
    __builtin_amdgcn_sched_barrier(0);                                                                                       \
    _Pragma("unroll") for (int i = 0; i < 4; ++i) _Pragma("unroll") for (int j = 0; j < 4; ++j) acc[4 + i][j] = mfma16(bfr[j], a1[i], acc[4 + i][j]); \
    __builtin_amdgcn_sched_barrier(0);                                                                                       \
    if ((t) + 1 < nk) SSTORE2(sa, sb, ((t) + 1) & 1);                                                                        \
    LBAR();                                                                                                                  \
  }
  GLOAD2(s0a, s0b, 0);
  SSTORE2(s0a, s0b, 0);
  GLOAD2(s1a, s1b, 32);
  LBAR();
  int t = 0;
  for (;;) {
    STEP2(t, s0a, s0b, s1a, s1b);
    if (++t >= nk) break;
    STEP2(t, s1a, s1b, s0a, s0b);
    if (++t >= nk) break;
  }
#undef GLOAD2
#undef SSTORE2
#undef STEP2
}
DI void tile_mn8(int t, int nm, int nn, int& mi, int& ni) {
  const int nig = 8 * nn, g = t / nig, rem = t % nig, fm = g * 8;
  const int gsz = (nm - fm) < 8 ? (nm - fm) : 8;
  mi = fm + rem % gsz;
  ni = rem / gsz;
}
template <class Epi, class Epi8>
DI void gemm_phase(const bf16_t* A, int lda, int a_ks, const bf16_t* Bt, int ldb, int b_ks, int K, int nm, int nn, char* lds, int B, int G, Epi epi, Epi8 epi8, bool skipctx = false) {
  if (skipctx) nm -= 4;
  const int NT = nm * nn;
  int nfull = (NT / G) * G, R = NT - nfull;
  if (4 * R > 2 * G) { nfull = NT; R = 0; }
  for (int t = B; t < nfull + 4 * R; t += G) {
    int mi, ni;
    if (t < nfull) {
      tile_mn8(t, nm, nn, mi, ni);
      if (skipctx) mi += (mi >> 5) + 1;
      f32x4 acc[8][4];
#pragma unroll
      for (int i = 0; i < 8; ++i)
#pragma unroll
        for (int j = 0; j < 4; ++j) acc[i][j] = (f32x4){0.f, 0.f, 0.f, 0.f};
      gemm_core2(A + (size_t)mi * 256 * lda, lda, a_ks, Bt + (size_t)ni * 128 * ldb, ldb, b_ks, K, acc, lds);
      const int lane = otid() & 63, wid = otid() >> 6, wr = wid >> 1, wc = wid & 1;
#pragma unroll
      for (int i = 0; i < 8; ++i)
#pragma unroll
        for (int jp = 0; jp < 2; ++jp) epi8(mi * 256 + wr * 128 + i * 16 + (lane & 15), ni * 128 + wc * 64 + jp * 32 + (lane >> 4) * 8, acc[i][2 * jp], acc[i][2 * jp + 1]);
    } else {
      const int u = t - nfull, sub = u & 3;
      tile_mn8(nfull + (u >> 2), nm, nn, mi, ni);
      if (skipctx) mi += (mi >> 5) + 1;
      const int m0 = mi * 256 + (sub >> 1) * 128, n0 = ni * 128 + (sub & 1) * 64;
      f32x4 acc[4][2]; zero_acc<2>(acc);
      gemm_core<2>(A + (size_t)m0 * lda, lda, a_ks, Bt + (size_t)n0 * ldb, ldb, b_ks, K, acc, lds);
      gemm_emit<2>(acc, m0, n0, epi);
    }
  }
}
DI int sg_col(int gc) { const int j = gc >> 7; return (j < 12 ? 512 + 128 * j : 2560 + 128 * (j - 12)) + (gc & 127); }

constexpr int N_CVT = 1152 + 32 + 768 + 384 + 256 + 1024 + 1024 + 32;
DI void job_cvt(const Params& p, int layer, int t, char* lds) {
  const float* src; int ld, ncol0 = 0, nlim, K, ntot, nrow0 = 0; bf16_t* dst;
  char* ws = p.ws;
  if (t < 1152) { src = p.w_in + (size_t)layer * 1024 * 7696; ld = 7696; ncol0 = 0; nlim = 4608; dst = (bf16_t*)(ws + OFF_WIN); K = 1024; ntot = 7808; nrow0 = 0; }
  else if ((t -= 1152) < 32) { src = p.w_in + (size_t)layer * 1024 * 7696; ld = 7696; ncol0 = 4608; nlim = 4624; dst = (bf16_t*)(ws + OFF_WIN); K = 1024; ntot = 7808; nrow0 = 4608; }
  else if ((t -= 32) < 768) { src = p.w_in + (size_t)layer * 1024 * 7696; ld = 7696; ncol0 = 4624; nlim = 7696; dst = (bf16_t*)(ws + OFF_WIN); K = 1024; ntot = 7808; nrow0 = 4736; }
  else if ((t -= 768) < 384) { const int i = t / 128; t %= 128; src = p.wbr + ((size_t)layer * 3 + i) * 512 * 1024; ld = 1024; nlim = 1024; dst = (bf16_t*)(ws + OFF_WBR) + (size_t)i * 1024 * 512; K = 512; ntot = 1024; }
  else if ((t -= 384) < 256) { src = p.wout + (size_t)layer * 1024 * 1024; ld = 1024; nlim = 1024; dst = (bf16_t*)(ws + OFF_WO); K = 1024; ntot = 1024; }
  else if ((t -= 256) < 1024) { src = p.w1 + (size_t)layer * 1024 * 4096; ld = 4096; nlim = 4096; dst = (bf16_t*)(ws + OFF_W1); K = 1024; ntot = 4096; }
  else if ((t -= 1024) < 1024) { src = p.w2 + (size_t)layer * 4096 * 1024; ld = 1024; nlim = 1024; dst = (bf16_t*)(ws + OFF_W2); K = 4096; ntot = 1024; }
  else { t -= 1024; src = p.lgw + ((size_t)layer * 32 + t) * 4096; ld = 64; nlim = 64; dst = (bf16_t*)(ws + OFF_LG) + (size_t)t * 4096; K = 64; ntot = 0; t = 0; }
  const int nkt = K / 64, nt = t / nkt, kt = t % nkt;
  float* tl = (float*)lds;
  const int tid = otid();
  {
    const int c4 = (tid & 15) * 4, ncol = ncol0 + nt * 64 + c4;
#pragma unroll
    for (int i = 0; i < 4; ++i) {
      const int kk = i * 16 + (tid >> 4);
      f32x4 v = {0.f, 0.f, 0.f, 0.f};
      if (ncol + 3 < nlim) v = __builtin_nontemporal_load((const f32x4*)(src + (size_t)(kt * 64 + kk) * ld + ncol));
      tl[kk * 65 + c4] = v[0]; tl[kk * 65 + c4 + 1] = v[1]; tl[kk * 65 + c4 + 2] = v[2]; tl[kk * 65 + c4 + 3] = v[3];
    }
  }
  __syncthreads();
  {
    const int n = tid >> 2, kq = tid & 3;
    float v[16];
#pragma unroll
    for (int e = 0; e < 16; ++e) v[e] = tl[(kq * 16 + e) * 65 + n];
    u32x4 w0 = {pk2(v[0], v[1]), pk2(v[2], v[3]), pk2(v[4], v[5]), pk2(v[6], v[7])};
    u32x4 w1 = {pk2(v[8], v[9]), pk2(v[10], v[11]), pk2(v[12], v[13]), pk2(v[14], v[15])};
    const int nd = nrow0 + nt * 64 + n, kd = kt * 64 + kq * 16;
    bf16_t* d = ntot ? dst + ((size_t)(kd >> 5) * ntot + nd) * 32 + (kd & 31) : dst + (size_t)nd * K + kd;
    *(u32x4*)d = w0;
    *(u32x4*)(d + 8) = w1;
  }
  __syncthreads();
}
DI void job_mod(const Params& p, int it, char* lds) {
  const int nc = it % 96, l = it / 96, tid = otid();
  float* sc = (float*)lds;
  float* red = sc + 5 * 1024;
  for (int i = tid; i < 5 * 1024; i += 256) {
    const int v = i >> 10, k = i & 1023;
    const float cv = v < 4 ? p.c[v * 1024 + k] : p.cctx[k];
    sc[i] = cv * sigm(cv);
  }
  __syncthreads();
  const int cq = tid & 15, kg = tid >> 4, n = nc * 64 + cq * 4;
  const float* w = p.ada_w + ((size_t)l * 1024 + kg * 64) * 6144 + n;
  const float* s0 = sc + kg * 64;
  f32x4 a[5];
#pragma unroll
  for (int v = 0; v < 5; ++v) a[v] = (f32x4){0.f, 0.f, 0.f, 0.f};
#pragma unroll 8
  for (int k = 0; k < 64; ++k) {
    const f32x4 wv = __builtin_nontemporal_load((const f32x4*)(w + (size_t)k * 6144));
#pragma unroll
    for (int v = 0; v < 5; ++v) a[v] += wv * s0[v * 1024 + k];
  }
#pragma unroll
  for (int v = 0; v < 5; ++v)
#pragma unroll
    for (int e = 0; e < 4; ++e) red[(kg * 5 + v) * 64 + cq * 4 + e] = a[v][e];
  __syncthreads();
  for (int i = tid; i < 320; i += 256) {
    const int v = i >> 6, cc = i & 63;
    float r = p.ada_b[l * 6144 + nc * 64 + cc];
#pragma unroll
    for (int q = 0; q < 16; ++q) r += red[(q * 5 + v) * 64 + cc];
    ((float*)(p.ws + OFF_MOD))[(size_t)(l * 5 + v) * 6144 + nc * 64 + cc] = r;
  }
  __syncthreads();
}
DI void job_rope(const Params& p, int it) {
  const int idx = it * 256 + otid(), t = idx >> 5, ax = (idx >> 4) & 1, f = idx & 15;
  const float inv = powf(10000.f, -(float)f / 16.f);
  const float pos = (float)(ax ? (t & 63) : (t >> 6));
  float s, c;
  sincosf(pos * inv, &s, &c);
  ((f32x2*)(p.ws + OFF_ROPE))[idx] = (f32x2){c, s};
}
DI void job_norm(const Params& p, int layer, int which, int it) {
  const int lane = otid() & 63, wid = otid() >> 6, r = it * 8 + wid;
  const float* xr0 = (which == 1) ? res_in_row(p, layer, r) : (const float*)res_out_row(p, r);
  const float* xr1 = (which == 1) ? res_in_row(p, layer, r + 4) : (const float*)res_out_row(p, r + 4);
  const float* mv = mod_vec(p, layer, r);
  const float* sh = mv + (which == 1 ? 0 : 3072);
  const float* sc = mv + (which == 1 ? 1024 : 4096);
  const float* g = (which == 1 ? p.n1g : p.n2g) + layer * 1024;
  f32x4 xa[4], xb[4];
#pragma unroll
  for (int i = 0; i < 2; ++i)
#pragma unroll
    for (int hf = 0; hf < 2; ++hf) {
      xa[2 * i + hf] = __builtin_nontemporal_load((const f32x4*)(xr0 + i * 512 + lane * 8 + hf * 4));
      xb[2 * i + hf] = __builtin_nontemporal_load((const f32x4*)(xr1 + i * 512 + lane * 8 + hf * 4));
    }
  float sa = 0.f, sb = 0.f;
#pragma unroll
  for (int i = 0; i < 4; ++i) {
    sa += xa[i][0] * xa[i][0] + xa[i][1] * xa[i][1] + xa[i][2] * xa[i][2] + xa[i][3] * xa[i][3];
    sb += xb[i][0] * xb[i][0] + xb[i][1] * xb[i][1] + xb[i][2] * xb[i][2] + xb[i][3] * xb[i][3];
  }
  sa = wsum(sa); sb = wsum(sb);
  const float ra = rsqrtf(sa * (1.f / 1024.f) + EPS), rb = rsqrtf(sb * (1.f / 1024.f) + EPS);
  bf16_t* H0 = (bf16_t*)(p.ws + OFF_H) + (size_t)r * 32;
  bf16_t* H1 = H0 + 4 * 32;
#pragma unroll
  for (int i = 0; i < 2; ++i) {
    const int c = i * 512 + lane * 8;
    float o[8], q[8];
#pragma unroll
    for (int hf = 0; hf < 2; ++hf) {
      const f32x4 gv = *(const f32x4*)(g + c + hf * 4), sv = *(const f32x4*)(sc + c + hf * 4), hv = *(const f32x4*)(sh + c + hf * 4);
#pragma unroll
      for (int e = 0; e < 4; ++e) { const float m = gv[e] * (1.f + sv[e]); o[hf * 4 + e] = xa[2 * i + hf][e] * ra * m + hv[e]; q[hf * 4 + e] = xb[2 * i + hf][e] * rb * m + hv[e]; }
    }
    const size_t so = (size_t)(c >> 5) * MR * 32 + (c & 31);
    *(u32x4*)(H0 + so) = (u32x4){pk2(o[0], o[1]), pk2(o[2], o[3]), pk2(o[4], o[5]), pk2(o[6], o[7])};
    *(u32x4*)(H1 + so) = (u32x4){pk2(q[0], q[1]), pk2(q[2], q[3]), pk2(q[4], q[5]), pk2(q[6], q[7])};
  }
}

DI void job_daprep1(const Params& p, int layer, int r, bool dup) {
  const int lane = otid() & 63, s = r % TT;
  const int G = lane >> 2, quarter = lane & 3;
  bf16_t* ptr = (bf16_t*)(p.ws + OFF_P) + (size_t)r * LDP + (G < 8 ? C_DAQ + G * 64 : C_DAK + (G - 8) * 64) + quarter * 16;
  const u32x4 w0 = *(const u32x4*)ptr, w1 = *(const u32x4*)(ptr + 8);
  float y[16];
#pragma unroll
  for (int e = 0; e < 4; ++e) { y[2 * e] = bflo(w0[e]); y[2 * e + 1] = bfhi(w0[e]); y[8 + 2 * e] = bflo(w1[e]); y[9 + 2 * e] = bfhi(w1[e]); }
  float ss = 0.f;
#pragma unroll
  for (int e = 0; e < 16; ++e) ss += y[e] * y[e];
  ss += shx<1>(ss);
  ss += shx<2>(ss);
  float rstd = rsqrtf(ss * (1.f / 64.f) + EPS);
  const float* g = (G < 8 ? p.daqg : p.dakg) + layer * 64 + quarter * 16;
#pragma unroll
  for (int e = 0; e < 16; ++e) y[e] = y[e] * rstd * g[e];
  if (s >= TC) {
    const f32x2* tb = (const f32x2*)(p.ws + OFF_ROPE) + ((size_t)(s - TC) * 2 + (quarter >> 1)) * 16;
#pragma unroll
    for (int e = 0; e < 16; ++e) {
      const float yp = shx<1>(y[e]);
      const f32x2 cs = tb[e];
      y[e] = (quarter & 1) ? (y[e] * cs.x + yp * cs.y) : (y[e] * cs.x - yp * cs.y);
    }
  }
  if (G < 8) {
#pragma unroll
    for (int e = 0; e < 16; ++e) y[e] *= 0.125f * 1.4426950408889634f;
  }
  if (dup) return;
  *(u32x4*)ptr = (u32x4){pk2(y[0], y[1]), pk2(y[2], y[3]), pk2(y[4], y[5]), pk2(y[6], y[7])};
  *(u32x4*)(ptr + 8) = (u32x4){pk2(y[8], y[9]), pk2(y[10], y[11]), pk2(y[12], y[13]), pk2(y[14], y[15])};
}
DI void job_daprep(const Params& p, int layer, int it, bool dup) {
  const int wid = otid() >> 6;
#pragma unroll
  for (int rr = 0; rr < 2; ++rr) job_daprep1(p, layer, it * 8 + rr * 4 + wid, dup);
}
DI void job_vt(const Params& p, int it, char* lds) {
  const int h = it & 3, c = (it >> 2) % NCH, b = it / (4 * NCH), tid = otid();
  bf16_t* tl = (bf16_t*)lds;
  const bf16_t* P = (const bf16_t*)(p.ws + OFF_P);
#pragma unroll
  for (int i = 0; i < 4; ++i) {
    const int q = tid + 256 * i, row = q >> 4, pc = q & 15;
    const u32x4 w = *(const u32x4*)(P + (size_t)(b * TT + c * 64 + row) * LDP + C_DAV + h * 128 + pc * 8);
    unsigned* d = (unsigned*)(tl + row * 130 + pc * 8);
    d[0] = w[0]; d[1] = w[1]; d[2] = w[2]; d[3] = w[3];
  }
  __syncthreads();
  {
    const int dv = tid >> 1, half = tid & 1;
    unsigned o[16];
#pragma unroll
    for (int e = 0; e < 16; ++e) o[e] = (unsigned)tl[(half * 32 + 2 * e) * 130 + dv] | ((unsigned)tl[(half * 32 + 2 * e + 1) * 130 + dv] << 16);
    bf16_t* d = (bf16_t*)(p.ws + OFF_VT) + ((size_t)(b * 4 + h) * 128 + dv) * TT + c * 64 + half * 32;
#pragma unroll
#define VTW(w) o[(((w) & 3) >> 1) * 8 + ((w) >> 2) * 2 + ((w) & 1)]
    for (int e = 0; e < 4; ++e) *(u32x4*)(d + e * 8) = (u32x4){VTW(4 * e), VTW(4 * e + 1), VTW(4 * e + 2), VTW(4 * e + 3)};
#undef VTW
  }
  __syncthreads();
}

constexpr int N_ATT = 1056;
DI void job_attn(const Params& p, int layer, int a, char* lds, bool dup) {
  const int tid = otid(), lane = tid & 63, wid = tid >> 6, l15 = lane & 15, g = lane >> 4;
  const int grp = a / 528, within = a % 528, bh = grp * 8 + (within & 7), qb = within >> 3, b = bh >> 2, h = bh & 3;
  if (layer == 1 && qb < 2) return;
  const int nt = qb < 2 ? 4 : NCH;
  bf16_t* P = (bf16_t*)(p.ws + OFF_P);
  const bf16_t* VT = (const bf16_t*)(p.ws + OFF_VT) + (size_t)(b * 4 + h) * 128 * TT;
  int ly_ = layer; asm volatile("" : "+s"(ly_));
  const float lam_init = __uint_as_float(ly_ == 0 ? 0x3e4ccccdu : 0x3eb60549u);
  const float* lv = p.dalam + layer * 256;
  const float lam = __uint_as_float(__builtin_amdgcn_readfirstlane(__float_as_uint(expf(wsum(lv[lane] * lv[64 + lane])) - expf(wsum(lv[128 + lane] * lv[192 + lane])) + lam_init)));
  const float mq = wmax(fabsf(p.daqg[layer * 64 + lane])), mk = wmax(fabsf(p.dakg[layer * 64 + lane]));
  const float negMb = __uint_as_float(__builtin_amdgcn_readfirstlane(__float_as_uint(-(8.f * mq * mk * 1.03f * 1.4426950408889634f + 0.5f))));
  const int r0 = b * TT + qb * 128 + wid * 32;
  bf16x8 qf[2][2][2];
#pragma unroll
  for (int c = 0; c < 2; ++c)
#pragma unroll
    for (int i = 0; i < 2; ++i)
#pragma unroll
      for (int ks = 0; ks < 2; ++ks) qf[c][i][ks] = *(const bf16x8*)(P + (size_t)(r0 + i * 16 + l15) * LDP + C_DAQ + h * 128 + c * 64 + ks * 32 + g * 8);
  bf16_t* Ks = (bf16_t*)lds;
  bf16_t* Vs = Ks + 2 * 64 * 144;
  u32x4 rk[4], rv[4];
  const bf16_t* kg = P + (size_t)(b * TT) * LDP + C_DAK + h * 128;
#define KLOAD(t) { _Pragma("unroll") for (int i = 0; i < 4; ++i) { const int q = tid + 256 * i; rk[i] = *(const u32x4*)(kg + (size_t)((t) * 64 + (q >> 4)) * LDP + (q & 15) * 8); } }
#define VLOAD(t) { _Pragma("unroll") for (int i = 0; i < 4; ++i) { const int q = tid + 256 * i; rv[i] = *(const u32x4*)(VT + (size_t)(q >> 3) * TT + (t) * 64 + (q & 7) * 8); } }
#define KSTORE(buf) { _Pragma("unroll") for (int i = 0; i < 4; ++i) { const int q = tid + 256 * i; *(u32x4*)(Ks + ((buf) * 64 + (q >> 4)) * 144 + (q & 15) * 8) = rk[i]; } }
#define VSTORE(buf) { _Pragma("unroll") for (int i = 0; i < 4; ++i) { const int q = tid + 256 * i; *(u32x4*)(Vs + ((buf) * 128 + (q >> 3)) * 80 + (q & 7) * 8) = rv[i]; } }
#define QK_INTO(S, Kb, half, CI)                                                                                       \
  _Pragma("unroll") for (int c = 0; c < 2; ++c) {                                                                      \
    bf16x8 kf[2][2];                                                                                                   \
    _Pragma("unroll") for (int k2 = 0; k2 < 2; ++k2) _Pragma("unroll") for (int ks = 0; ks < 2; ++ks)                  \
      kf[k2][ks] = *(const bf16x8*)((Kb) + ((half) * 32 + k2 * 16 + l15) * 144 + c * 64 + ks * 32 + g * 8);             \
    __builtin_amdgcn_sched_barrier(0);                                                                                 \
    _Pragma("unroll") for (int k2 = 0; k2 < 2; ++k2) _Pragma("unroll") for (int i = 0; i < 2; ++i) {                   \
      S[c][i][k2] = mfma16(kf[k2][0], qf[c][i][0], CI(c, i));     \
      S[c][i][k2] = mfma16(kf[k2][1], qf[c][i][1], S[c][i][k2]); }                                                     \
  }                                                                                                                    \
  __builtin_amdgcn_sched_barrier(0);
#define EXPSUM(S)                                                                                                      \
  _Pragma("unroll") for (int c = 0; c < 2; ++c) _Pragma("unroll") for (int i = 0; i < 2; ++i) {                        \
    _Pragma("unroll") for (int k2 = 0; k2 < 2; ++k2) _Pragma("unroll") for (int e = 0; e < 4; ++e) S[c][i][k2][e] = __builtin_amdgcn_exp2f(S[c][i][k2][e]); \
    lsum[c][i] += ((S[c][i][0][0] + S[c][i][0][1]) + (S[c][i][0][2] + S[c][i][0][3])) + ((S[c][i][1][0] + S[c][i][1][1]) + (S[c][i][1][2] + S[c][i][1][3])); }
#define EXP_S() _Pragma("unroll") for (int c = 0; c < 2; ++c) _Pragma("unroll") for (int i = 0; i < 2; ++i) _Pragma("unroll") for (int k2 = 0; k2 < 2; ++k2) _Pragma("unroll") for (int e = 0; e < 4; ++e) S[c][i][k2][e] = __builtin_amdgcn_exp2f(S[c][i][k2][e]);
  float lsum[2][2] = {{0.f, 0.f}, {0.f, 0.f}};
  KLOAD(0);
  KSTORE(0);
  __syncthreads();
  const f32x4 negMv = {negMb, negMb, negMb, negMb};
#define CI1(c, i) negMv
  f32x4 SA[2][2][2], SB[2][2][2];
#pragma unroll 1
  for (int t = 0; t < nt; ++t) {
    if (t + 1 < nt) KLOAD(t + 1);
    const bf16_t* Kb = Ks + (t & 1) * 64 * 144;
    QK_INTO(SA, Kb, 0, CI1)
    if (t > 0) { EXPSUM(SB) }
    __builtin_amdgcn_sched_barrier(0);
    QK_INTO(SB, Kb, 1, CI1)
    EXPSUM(SA)
    if (t + 1 < nt) KSTORE((t + 1) & 1);
    __syncthreads();
  }
  EXPSUM(SB)
  f32x4 ci2[2][2];
#pragma unroll
  for (int i = 0; i < 2; ++i) {
    float l0 = lsum[0][i], l1 = lsum[1][i];
    l0 += shx<16>(l0); l0 = add32(l0);
    l1 += shx<16>(l1); l1 = add32(l1);
    const float c0 = negMb - __log2f(l0), c1 = negMb + __log2f(fabsf(lam)) - __log2f(l1);
    ci2[0][i] = (f32x4){c0, c0, c0, c0}; ci2[1][i] = (f32x4){c1, c1, c1, c1};
  }
  const float nsl = lam < 0.f ? 1.f : -1.f;
#define CI2(c, i) ci2[c][i]
  f32x4 O[2][8];
#pragma unroll
  for (int i = 0; i < 2; ++i)
#pragma unroll
    for (int n = 0; n < 8; ++n) O[i][n] = (f32x4){0.f, 0.f, 0.f, 0.f};
  KLOAD(0); VLOAD(0);
  KSTORE(0); VSTORE(0);
  __syncthreads();
#pragma unroll 1
  for (int t = 0; t < nt; ++t) {
    if (t + 1 < nt) KLOAD(t + 1);
    const bf16_t* Kb = Ks + (t & 1) * 64 * 144;
    const bf16_t* Vb = Vs + (t & 1) * 128 * 80;
#pragma unroll
    for (int half = 0; half < 2; ++half) {
      bf16x8 pf[2], vfa[4], vfb[4];
#define VREAD(dst, n0) _Pragma("unroll") for (int n = 0; n < 4; ++n) dst[n] = *(const bf16x8*)(Vb + (((n0) + n) * 16 + l15) * 80 + half * 32 + g * 8);
      {
        f32x4 S[2][2][2];
        QK_INTO(S, Kb, half, CI2)
        VREAD(vfa, 0)
        EXP_S()
#pragma unroll
        for (int i = 0; i < 2; ++i) {
          float w[8];
#pragma unroll
          for (int k2 = 0; k2 < 2; ++k2)
#pragma unroll
            for (int e = 0; e < 4; ++e) w[k2 * 4 + e] = __builtin_fmaf(nsl, S[1][i][k2][e], S[0][i][k2][e]);
          const u32x4 ww = {pk2(w[0], w[1]), pk2(w[2], w[3]), pk2(w[4], w[5]), pk2(w[6], w[7])};
          pf[i] = __builtin_bit_cast(bf16x8, ww);
        }
      }
      __builtin_amdgcn_sched_barrier(0);
      VREAD(vfb, 4)
#pragma unroll
      for (int n = 0; n < 4; ++n)
#pragma unroll
        for (int i = 0; i < 2; ++i) O[i][n] = mfma16(pf[i], vfa[n], O[i][n]);
      __builtin_amdgcn_sched_barrier(0);
#pragma unroll
      for (int n = 0; n < 4; ++n)
#pragma unroll
        for (int i = 0; i < 2; ++i) O[i][4 + n] = mfma16(pf[i], vfb[n], O[i][4 + n]);
      __builtin_amdgcn_sched_barrier(0);
#undef VREAD
      if (half == 0 && t + 1 < nt) VLOAD(t + 1);
    }
    if (t + 1 < nt) { KSTORE((t + 1) & 1); VSTORE((t + 1) & 1); }
    __syncthreads();
  }
#undef KLOAD
#undef VLOAD
#undef KSTORE
#undef VSTORE
#undef CI1
#undef CI2
#undef QK_INTO
#undef EXPSUM
#undef EXP_S
  const int lane_e = otid() & 63, l15e = lane_e & 15, ge = lane_e >> 4;
  const float* sg = p.dasub + layer * 128;
#pragma unroll
  for (int i = 0; i < 2; ++i)
#pragma unroll
    for (int e = 0; e < 4; ++e) {
      float ss = 0.f;
#pragma unroll
      for (int n = 0; n < 8; ++n) ss += O[i][n][e] * O[i][n][e];
      ss += shx<1>(ss); ss += shx<2>(ss); ss += shx<4>(ss); ss += shx<8>(ss);
      const float rstd = rsqrtf(ss * (1.f / 128.f) + EPS) * (1.f - lam_init);
      bf16_t* op = P + (size_t)(r0 + i * 16 + ge * 4 + e) * LDP + C_DAQ + h * 128 + l15e;
#pragma unroll
      for (int n = 0; n < 8; ++n) if (!dup) op[n * 16] = f2bf(O[i][n][e] * rstd * sg[n * 16 + l15e]);
    }
}

DI float gelu_tanh(float x) { const float u = 0.7978845608028654f * (x + 0.044715f * x * x * x); return 0.5f * x * (1.f + tanhf(u)); }
template <int PASS>
DI void job_lru(const Params& p, int layer, int it, char* lds, bool dup) {
  const int tid = otid(), lane = tid & 63, wid = tid >> 6, l15 = lane & 15, g = lane >> 4;
  const int n = it & 7, c = (it >> 3) % NCH, b = it / (8 * NCH);
  float* xc32 = (float*)lds;
  bf16_t* xcb = (bf16_t*)(lds + 16384);
  f32x2* ab = (f32x2*)(lds + 16384 + 9216);
  f32x2* segtot = (f32x2*)(lds + 16384 + 9216 + 32768);
  float* carry = (float*)(lds + 16384 + 9216 + 32768 + 2048);
  bf16_t* P = (bf16_t*)(p.ws + OFF_P);
  f32x2* LC = (f32x2*)(p.ws + OFF_LC);
  const int ch = tid & 63, seg = tid >> 6;
  {
    const int segLo = c < 4 ? 0 : TC, segHi = c < 4 ? TC : TT;
    const int cp2 = (tid & 31) * 2, tg = tid >> 5;
    const int s0 = c * 64 + tg * 8;
    float cw0[4], cw1[4];
#pragma unroll
    for (int k = 0; k < 4; ++k) { cw0[k] = p.lcw[(size_t)(layer * 4 + k) * 512 + n * 64 + cp2]; cw1[k] = p.lcw[(size_t)(layer * 4 + k) * 512 + n * 64 + cp2 + 1]; }
    const float cb0 = p.lcb[layer * 512 + n * 64 + cp2], cb1 = p.lcb[layer * 512 + n * 64 + cp2 + 1];
    unsigned xw[11];
#pragma unroll
    for (int j = 0; j < 11; ++j) {
      const int s = s0 - 1 + j;
      xw[j] = (s >= segLo && s < segHi) ? *(const unsigned*)(P + (size_t)(b * TT + s) * LDP + C_LX + n * 64 + cp2) : 0u;
    }
#pragma unroll
    for (int u = 0; u < 8; ++u) {
      const float v0 = cw0[0] * bflo(xw[u]) + cw0[1] * bflo(xw[u + 1]) + cw0[2] * bflo(xw[u + 2]) + cw0[3] * bflo(xw[u + 3]) + cb0;
      const float v1 = cw1[0] * bfhi(xw[u]) + cw1[1] * bfhi(xw[u + 1]) + cw1[2] * bfhi(xw[u + 2]) + cw1[3] * bfhi(xw[u + 3]) + cb1;
      *(f32x2*)(xc32 + (tg * 8 + u) * 64 + cp2) = (f32x2){v0, v1};
      *(unsigned*)(xcb + (tg * 8 + u) * 72 + cp2) = pk2(v0, v1);
    }
  }
  if (PASS == 3 && tid < 128) {
    const int d = tid >> 6;
    const int pos = d == 0 ? c : (c < 4 ? 3 - c : 4 + (NCH - 1 - c));
    float hh = 0.f;
    for (int q0 = 0; q0 < pos; q0 += 16) {
      f32x2 AB[16];
#pragma unroll
      for (int j = 0; j < 16; ++j) {
        const int q = q0 + j, qq = q < pos ? q : pos - 1;
        const int cc = d == 0 ? qq : (qq < 4 ? 3 - qq : NCH - 1 - (qq - 4));
        AB[j] = LC[((((size_t)b * NCH + cc) * 8 + n) * 2 + d) * 64 + ch];
      }
#pragma unroll
      for (int j = 0; j < 16; ++j) if (q0 + j < pos) hh = AB[j].x * hh + AB[j].y;
    }
    carry[d * 64 + ch] = hh;
  }
  __syncthreads();
  float hacc[16];
#pragma unroll
  for (int u = 0; u < 16; ++u) hacc[u] = 0.f;
#pragma unroll 1
  for (int d = 0; d < 2; ++d) {
    {
      f32x4 ar[4], ai[4];
#pragma unroll
      for (int i = 0; i < 4; ++i) { ar[i] = (f32x4){0.f, 0.f, 0.f, 0.f}; ai[i] = (f32x4){0.f, 0.f, 0.f, 0.f}; }
      const bf16_t* LG = (const bf16_t*)(p.ws + OFF_LG);
      const bf16_t* wr_ = LG + ((size_t)((d * 2 + 0) * 8 + n)) * 4096 + (wid * 16 + l15) * 64 + g * 8;
      const bf16_t* wi_ = LG + ((size_t)((d * 2 + 1) * 8 + n)) * 4096 + (wid * 16 + l15) * 64 + g * 8;
#pragma unroll
      for (int ks = 0; ks < 2; ++ks) {
        const bf16x8 br = *(const bf16x8*)(wr_ + ks * 32), bi = *(const bf16x8*)(wi_ + ks * 32);
#pragma unroll
        for (int i = 0; i < 4; ++i) {
          const bf16x8 af = *(const bf16x8*)(xcb + (i * 16 + l15) * 72 + ks * 32 + g * 8);
          ar[i] = mfma16(br, af, ar[i]);
          ai[i] = mfma16(bi, af, ai[i]);
        }
      }
#pragma unroll
      for (int e = 0; e < 4; ++e) {
        const int che = wid * 16 + g * 4 + e, cg_ = n * 64 + che;
        const float br = p.lgb[(size_t)((layer * 2 + d) * 2 + 0) * 512 + cg_], bi = p.lgb[(size_t)((layer * 2 + d) * 2 + 1) * 512 + cg_];
        const float sp = softplusf(-p.llam[(size_t)(layer * 2 + d) * 512 + cg_]);
#pragma unroll
        for (int i = 0; i < 4; ++i) {
          const int tok = i * 16 + l15;
          const float r = sigm(ar[i][e] + br), ig = sigm(ai[i][e] + bi);
          const float la = -8.f * r * sp;
          const float av = __expf(la);
          const float bv = __builtin_sqrtf(fmaxf(1.f - __expf(2.f * la), 0.f)) * ig * xc32[tok * 64 + che];
          ab[tok * 64 + che] = (f32x2){av, bv};
        }
      }
    }
    __syncthreads();
    float hloc[16], cploc[16];
    {
      float hp = 0.f, cp = 1.f;
#pragma unroll
      for (int uu = 0; uu < 16; ++uu) {
        const int u = d == 0 ? uu : 15 - uu;
        const f32x2 v = ab[(seg * 16 + u) * 64 + ch];
        hp = v.x * hp + v.y;
        cp *= v.x;
        hloc[uu] = hp; cploc[uu] = cp;
      }
      segtot[seg * 64 + ch] = (f32x2){cp, hp};
    }
    __syncthreads();
    if (PASS == 1) {
      if (tid < 64) {
        float A = 1.f, Bv = 0.f;
#pragma unroll
        for (int q = 0; q < 4; ++q) {
          const f32x2 v = segtot[(d == 0 ? q : 3 - q) * 64 + ch];
          Bv = v.x * Bv + v.y; A *= v.x;
        }
        LC[((((size_t)b * NCH + c) * 8 + n) * 2 + d) * 64 + ch] = (f32x2){A, Bv};
      }
    } else {
      float hh = carry[d * 64 + ch];
      const int npre = d == 0 ? seg : 3 - seg;
      for (int q = 0; q < npre; ++q) {
        const f32x2 v = segtot[(d == 0 ? q : 3 - q) * 64 + ch];
        hh = v.x * hh + v.y;
      }
#pragma unroll
      for (int uu = 0; uu < 16; ++uu) {
        const int u = d == 0 ? uu : 15 - uu;
        const float hv = hloc[uu] + cploc[uu] * hh;
        hacc[d == 0 ? uu : 15 - uu] += hv;
        (void)u;
      }
    }
    __syncthreads();
  }
  if (PASS == 3) {
#pragma unroll
    for (int u = 0; u < 16; ++u) xc32[(seg * 16 + u) * 64 + ch] = hacc[u];
    __syncthreads();
    const int cp2 = (tid & 31) * 2, tg = tid >> 5;
#pragma unroll
    for (int u = 0; u < 8; ++u) {
      const int tok = tg * 8 + u;
      unsigned* yp = (unsigned*)(P + (size_t)(b * TT + c * 64 + tok) * LDP + C_LY + n * 64 + cp2);
      const f32x2 hv = *(const f32x2*)(xc32 + tok * 64 + cp2);
      const unsigned y = *yp;
      if (!dup) *yp = pk2(gelu_tanh(bflo(y)) * hv.x, gelu_tanh(bfhi(y)) * hv.y);
    }
    __syncthreads();
  }
}

DI void job_gconv(const Params& p, int layer, int it, bool dup) {
  const int tid = otid(), grp = it % 12, cg_ = it / 12, cp = tid & 15, rg = tid >> 4;
  const int cin = cg_ % NCH;
  const bool first = (cin == 0 || cin == 4), last = (cin == 3 || cin == NCH - 1);
  bf16_t* P = (bf16_t*)(p.ws + OFF_P);
  const bf16_t* HALO = (const bf16_t*)(p.ws + OFF_HALO);
  const int col = grp * 128 + cp * 8;
  u32x4 xr[7];
#pragma unroll
  for (int j = 0; j < 7; ++j) {
    const int q = rg * 4 - 1 + j;
    u32x4 v = {0u, 0u, 0u, 0u};
    if (q >= 0 && q < 64) v = *(const u32x4*)(P + (size_t)(cg_ * 64 + q) * LDP + C_GQKV + col);
    else if (q < 0) { if (!first) v = *(const u32x4*)(HALO + ((size_t)(cg_ - 1) * 3 + 2) * 1536 + col); }
    else { if (!last) v = *(const u32x4*)(HALO + ((size_t)(cg_ + 1) * 3 + (q - 64)) * 1536 + col); }
    xr[j] = v;
  }
  float w[4][8];
#pragma unroll
  for (int k = 0; k < 4; ++k) {
    const f32x4 a = *(const f32x4*)(p.gcw + (size_t)(layer * 4 + k) * 1536 + col), bq = *(const f32x4*)(p.gcw + (size_t)(layer * 4 + k) * 1536 + col + 4);
#pragma unroll
    for (int e = 0; e < 4; ++e) { w[k][e] = a[e]; w[k][4 + e] = bq[e]; }
  }
  __syncthreads();
#pragma unroll
  for (int jr = 0; jr < 4; ++jr) {
    float y[8];
#pragma unroll
    for (int e = 0; e < 8; ++e) y[e] = 0.f;
#pragma unroll
    for (int k = 0; k < 4; ++k)
#pragma unroll
      for (int e = 0; e < 4; ++e) { y[2 * e] += w[k][2 * e] * bflo(xr[jr + k][e]); y[2 * e + 1] += w[k][2 * e + 1] * bfhi(xr[jr + k][e]); }
    float ss = 0.f;
#pragma unroll
    for (int e = 0; e < 8; ++e) { y[e] = y[e] * sigm(y[e]); ss += y[e] * y[e]; }
    if (grp < 8) {
      ss += shx<1>(ss); ss += shx<2>(ss); ss += shx<4>(ss); ss += shx<8>(ss);
      const float sc = rsqrtf(ss + EPS) * (grp < 4 ? 0.08838834764831845f : 1.f);
#pragma unroll
      for (int e = 0; e < 8; ++e) y[e] *= sc;
    }
    if (!dup) *(u32x4*)(P + (size_t)(cg_ * 64 + rg * 4 + jr) * LDP + C_GQKV + col) = (u32x4){pk2(y[0], y[1]), pk2(y[2], y[3]), pk2(y[4], y[5]), pk2(y[6], y[7])};
  }
  __syncthreads();
}

DI void job_gprep(const Params& p, int layer, int it, char* lds) {
  const int tid = otid(), lane = tid & 63, wid = tid >> 6, l15 = lane & 15, g = lane >> 4;
  const int h = it & 3, c = (it >> 2) % NCH, b = it / (4 * NCH);
  bf16_t* kt_ = (bf16_t*)lds;
  bf16_t* qt_ = kt_ + 64 * 136;
  float* Ld = (float*)lds;
  float* KK = (float*)(lds + 34816);
  float* QK = KK + 64 * 65;
  float* gcs = QK + 64 * 65;
  float* bts = gcs + 128;
  const bf16_t* P = (const bf16_t*)(p.ws + OFF_P);
#pragma unroll
  for (int i = 0; i < 4; ++i) {
    const int q = tid + 256 * i, row = q >> 4, pc = q & 15;
    const bf16_t* rp = P + (size_t)(b * TT + c * 64 + row) * LDP + C_GQKV + h * 128 + pc * 8;
    *(u32x4*)(qt_ + row * 136 + pc * 8) = *(const u32x4*)rp;
    *(u32x4*)(kt_ + row * 136 + pc * 8) = *(const u32x4*)(rp + 512);
  }
  float* GSC = (float*)(p.ws + OFF_GSC);
  if (tid < 128) {
    const int d = wid, i = lane, tn = d ? 63 - i : i, r = b * TT + c * 64 + tn;
    const float* gba = (const float*)(p.ws + OFF_GBA) + (size_t)r * 16;
    const float gval = -expf(p.galog[(layer * 2 + d) * 4 + h]) * softplusf(gba[8 + d * 4 + h] + p.gdtb[(layer * 2 + d) * 4 + h]);
    const float beta = sigm(gba[d * 4 + h]);
    float v = gval;
#pragma unroll
    for (int o = 1; o < 64; o <<= 1) { const float t = __int_as_float(__builtin_amdgcn_ds_bpermute(((lane - o) & 63) << 2, __float_as_int(v))); if (lane >= o) v += t; }
    const float glast = __int_as_float(__builtin_amdgcn_readlane(__float_as_int(v), 63));
    gcs[d * 64 + i] = v;
    bts[d * 64 + i] = beta;
    float* gs = GSC + (size_t)(it * 2 + d) * 192;
    gs[i] = expf(v);
    gs[64 + i] = expf(glast - v);
    if (i == 0) gs[128] = expf(glast);
  }
  __syncthreads();
  {
    f32x4 akk[4], aqk[4];
#pragma unroll
    for (int j = 0; j < 4; ++j) { akk[j] = (f32x4){0.f, 0.f, 0.f, 0.f}; aqk[j] = (f32x4){0.f, 0.f, 0.f, 0.f}; }
#pragma unroll
    for (int ks = 0; ks < 4; ++ks) {
      const bf16x8 ak = *(const bf16x8*)(kt_ + (wid * 16 + l15) * 136 + ks * 32 + g * 8);
      const bf16x8 aq = *(const bf16x8*)(qt_ + (wid * 16 + l15) * 136 + ks * 32 + g * 8);
#pragma unroll
      for (int j = 0; j < 4; ++j) {
        const bf16x8 bk = *(const bf16x8*)(kt_ + (j * 16 + l15) * 136 + ks * 32 + g * 8);
        akk[j] = mfma16(ak, bk, akk[j]);
        aqk[j] = mfma16(aq, bk, aqk[j]);
      }
    }
#pragma unroll
    for (int j = 0; j < 4; ++j)
#pragma unroll
      for (int e = 0; e < 4; ++e) { KK[(wid * 16 + g * 4 + e) * 65 + j * 16 + l15] = akk[j][e]; QK[(wid * 16 + g * 4 + e) * 65 + j * 16 + l15] = aqk[j][e]; }
  }
  __syncthreads();
  bf16_t* M1 = (bf16_t*)(p.ws + OFF_H);
  bf16_t* AT = M1 + (size_t)4224 * 4096;
#pragma unroll 1
  for (int d = 0; d < 2; ++d) {
    bf16_t* atp = AT + (size_t)(it * 2 + d) * 4096;
#pragma unroll 4
    for (int idx = tid; idx < 4096; idx += 256) {
      const int i = idx >> 6, j = idx & 63, ti = d ? 63 - i : i, tj = d ? 63 - j : j;
      const float dec = (j <= i) ? expf(gcs[d * 64 + i] - gcs[d * 64 + j]) : 0.f;
      Ld[d * 4096 + idx] = (j < i) ? bts[d * 64 + i] * KK[ti * 65 + tj] * dec : 0.f;
      atp[idx] = f2bf(QK[ti * 65 + tj] * dec);
    }
  }
  __syncthreads();
  if (wid < 2) {
    const int d = wid;
    const float* L = Ld + d * 4096;
    const float bc = bts[d * 64 + lane];
    bf16_t* mp = M1 + (size_t)(it * 2 + d) * 4096 + lane;
    float x[64];
#pragma unroll
    for (int i = 0; i < 64; ++i) {
      float s = (i == lane) ? 1.f : 0.f;
#pragma unroll
      for (int j = 0; j < i; ++j) s -= L[i * 64 + j] * x[j];
      x[i] = s;
      mp[i * 64] = f2bf(s * bc);
    }
  }
  __syncthreads();
}

struct GChunk { bf16x8 kf[4], qf[4], m1f[2], atf[2]; unsigned vr[2][4]; float eg[4], egl[4]; float ge; };
DI void gdn_load(GChunk& R, const Params& p, int b, int h, int d, int dvs, int c) {
  const int tid = otid(), lane = tid & 63, wid = tid >> 6, l15 = lane & 15, g = lane >> 4;
  const bf16_t* P = (const bf16_t*)(p.ws + OFF_P);
  const bf16_t* M1 = (const bf16_t*)(p.ws + OFF_H);
  const bf16_t* AT = M1 + (size_t)4224 * 4096;
  const float* GSC = (const float*)(p.ws + OFF_GSC);
  const int item = ((b * NCH + c) * 4 + h) * 2 + d;
  const int irow = 16 * wid + l15, tn = d ? 63 - irow : irow;
  const bf16_t* rowp = P + (size_t)(b * TT + c * 64 + tn) * LDP + C_GQKV + h * 128;
#pragma unroll
  for (int ks = 0; ks < 4; ++ks) { R.qf[ks] = *(const bf16x8*)(rowp + ks * 32 + g * 8); R.kf[ks] = *(const bf16x8*)(rowp + 512 + ks * 32 + g * 8); }
#pragma unroll
  for (int ks = 0; ks < 2; ++ks) {
    R.m1f[ks] = *(const bf16x8*)(M1 + (size_t)item * 4096 + irow * 64 + ks * 32 + g * 8);
    R.atf[ks] = *(const bf16x8*)(AT + (size_t)item * 4096 + irow * 64 + ks * 32 + g * 8);
  }
#pragma unroll
  for (int e = 0; e < 4; ++e) {
    const int i = 16 * wid + g * 4 + e, t2 = d ? 63 - i : i;
    R.vr[0][e] = *(const unsigned*)(P + (size_t)(b * TT + c * 64 + t2) * LDP + C_GQKV + 1024 + h * 128 + dvs * 32 + (l15 & ~1));
    R.vr[1][e] = *(const unsigned*)(P + (size_t)(b * TT + c * 64 + t2) * LDP + C_GQKV + 1024 + h * 128 + dvs * 32 + 16 + (l15 & ~1));
    R.eg[e] = GSC[(size_t)item * 192 + i];
    R.egl[e] = GSC[(size_t)item * 192 + 64 + i];
  }
  R.ge = GSC[(size_t)item * 192 + 128];
}
DI void gdn_put_kt(const GChunk& R, bf16_t* KT) {
  const int tid = otid(), lane = tid & 63, i = 16 * (tid >> 6) + (lane & 15), g = lane >> 4;
#pragma unroll
  for (int ks = 0; ks < 4; ++ks)
#pragma unroll
    for (int e = 0; e < 8; ++e) KT[(ks * 32 + g * 8 + e) * 72 + i] = (bf16_t)R.kf[ks][e];
}
DI int gdn_chunk_at(int d, int n) { return d == 0 ? n : (n < 4 ? 3 - n : NCH - 1 - (n - 4)); }
DI void job_gscan(const Params& p, int u, char* lds) {
  const int tid = otid(), lane = tid & 63, wid = tid >> 6, l15 = lane & 15, g = lane >> 4;
  const int seq = (u & 7) + 8 * (u >> 5), dvs = (u >> 3) & 3, d = seq & 1, h = (seq >> 1) & 3, b = seq >> 3;
  bf16_t* KT = (bf16_t*)lds;
  bf16_t* ST = KT + 2 * 128 * 72;
  bf16_t* XT = ST + 32 * 136;
  bf16_t* VnT = XT + 32 * 72;
  bf16_t* VsT = VnT + 32 * 72;
  bf16_t* OUT = d == 0 ? (bf16_t*)(p.ws + OFF_P) + C_DAV : (bf16_t*)(p.ws + OFF_OB);
  const int ldo = d == 0 ? LDP : 512;
  __builtin_amdgcn_s_setprio(3);
  f32x4 S[2][2];
#pragma unroll
  for (int a = 0; a < 2; ++a)
#pragma unroll
    for (int ct = 0; ct < 2; ++ct) S[a][ct] = (f32x4){0.f, 0.f, 0.f, 0.f};
  for (int i = tid; i < 32 * 136 / 2; i += 256) ((unsigned*)ST)[i] = 0u;
  GChunk cur, nxt;
  gdn_load(cur, p, b, h, d, dvs, gdn_chunk_at(d, 0));
  gdn_put_kt(cur, KT);
  __syncthreads();
#pragma unroll 1
  for (int n = 0; n < NCH; ++n) {
    const int c = gdn_chunk_at(d, n);
    if (n + 1 < NCH) gdn_load(nxt, p, b, h, d, dvs, gdn_chunk_at(d, n + 1));
    const bf16_t* KTc = KT + (n & 1) * 128 * 72;
    f32x4 ksa[2], qsa[2];
#pragma unroll
    for (int ct = 0; ct < 2; ++ct) { ksa[ct] = (f32x4){0.f, 0.f, 0.f, 0.f}; qsa[ct] = (f32x4){0.f, 0.f, 0.f, 0.f}; }
#pragma unroll
    for (int ks = 0; ks < 4; ++ks)
#pragma unroll
      for (int ct = 0; ct < 2; ++ct) {
        const bf16x8 bS = *(const bf16x8*)(ST + (ct * 16 + l15) * 136 + ks * 32 + g * 8);
        ksa[ct] = mfma16(cur.kf[ks], bS, ksa[ct]);
        qsa[ct] = mfma16(cur.qf[ks], bS, qsa[ct]);
      }
#pragma unroll
    for (int ct = 0; ct < 2; ++ct) {
      float x[4];
#pragma unroll
      for (int e = 0; e < 4; ++e) x[e] = ((l15 & 1) ? bfhi(cur.vr[ct][e]) : bflo(cur.vr[ct][e])) - cur.eg[e] * ksa[ct][e];
      *(u32x2*)(XT + (ct * 16 + l15) * 72 + 16 * wid + g * 4) = (u32x2){pk2(x[0], x[1]), pk2(x[2], x[3])};
    }
    __syncthreads();
#pragma unroll
    for (int ct = 0; ct < 2; ++ct) {
      f32x4 vn = {0.f, 0.f, 0.f, 0.f};
#pragma unroll
      for (int ks = 0; ks < 2; ++ks) vn = mfma16(cur.m1f[ks], *(const bf16x8*)(XT + (ct * 16 + l15) * 72 + ks * 32 + g * 8), vn);
      *(u32x2*)(VnT + (ct * 16 + l15) * 72 + 16 * wid + g * 4) = (u32x2){pk2(vn[0], vn[1]), pk2(vn[2], vn[3])};
      *(u32x2*)(VsT + (ct * 16 + l15) * 72 + 16 * wid + g * 4) = (u32x2){pk2(vn[0] * cur.egl[0], vn[1] * cur.egl[1]), pk2(vn[2] * cur.egl[2], vn[3] * cur.egl[3])};
    }
    __syncthreads();
#pragma unroll
    for (int ct = 0; ct < 2; ++ct) {
      f32x4 o;
#pragma unroll
      for (int e = 0; e < 4; ++e) o[e] = cur.eg[e] * qsa[ct][e];
#pragma unroll
      for (int ks = 0; ks < 2; ++ks) o = mfma16(cur.atf[ks], *(const bf16x8*)(VnT + (ct * 16 + l15) * 72 + ks * 32 + g * 8), o);
#pragma unroll
      for (int e = 0; e < 4; ++e) {
        const int i = 16 * wid + g * 4 + e, t2 = d ? 63 - i : i;
        OUT[(size_t)(b * TT + c * 64 + t2) * ldo + h * 128 + dvs * 32 + ct * 16 + l15] = f2bf(o[e]);
      }
    }
#pragma unroll
    for (int rt2 = 0; rt2 < 2; ++rt2) {
      const int rt = 2 * wid + rt2;
#pragma unroll
      for (int ct = 0; ct < 2; ++ct)
#pragma unroll
        for (int e = 0; e < 4; ++e) S[rt2][ct][e] *= cur.ge;
#pragma unroll
      for (int ks = 0; ks < 2; ++ks) {
        const bf16x8 ka = *(const bf16x8*)(KTc + (rt * 16 + l15) * 72 + ks * 32 + g * 8);
#pragma unroll
        for (int ct = 0; ct < 2; ++ct) S[rt2][ct] = mfma16(ka, *(const bf16x8*)(VsT + (ct * 16 + l15) * 72 + ks * 32 + g * 8), S[rt2][ct]);
      }
#pragma unroll
      for (int ct = 0; ct < 2; ++ct)
        *(u32x2*)(ST + (ct * 16 + l15) * 136 + rt * 16 + g * 4) = (u32x2){pk2(S[rt2][ct][0], S[rt2][ct][1]), pk2(S[rt2][ct][2], S[rt2][ct][3])};
    }
    if (n + 1 < NCH) { gdn_put_kt(nxt, KT + ((n + 1) & 1) * 128 * 72); cur = nxt; }
    __syncthreads();
  }
  __builtin_amdgcn_s_setprio(0);
}
DI void job_gpost1(const Params& p, int layer, int r) {
  const int lane = otid() & 63;
  bf16_t* P = (bf16_t*)(p.ws + OFF_P) + (size_t)r * LDP;
  const bf16_t* OB = (const bf16_t*)(p.ws + OFF_OB) + (size_t)r * 512;
  const u32x4 of = *(const u32x4*)(P + C_DAV + lane * 8), ob = *(const u32x4*)(OB + lane * 8), z = *(const u32x4*)(P + C_GZ + lane * 8);
  float o[8], zz[8], ss = 0.f;
#pragma unroll
  for (int e = 0; e < 4; ++e) {
    o[2 * e] = bflo(of[e]) + bflo(ob[e]); o[2 * e + 1] = bfhi(of[e]) + bfhi(ob[e]);
    zz[2 * e] = bflo(z[e]); zz[2 * e + 1] = bfhi(z[e]);
  }
#pragma unroll
  for (int e = 0; e < 8; ++e) ss += o[e] * o[e];
  ss += shx<1>(ss); ss += shx<2>(ss); ss += shx<4>(ss); ss += shx<8>(ss);
  const float rstd = rsqrtf(ss * (1.f / 128.f) + EPS);
  const float* gn = p.gng + layer * 128 + (lane & 15) * 8;
  float y[8];
#pragma unroll
  for (int e = 0; e < 8; ++e) y[e] = o[e] * rstd * gn[e] * (zz[e] * sigm(zz[e]));
  *(u32x4*)(P + C_GZ + lane * 8) = (u32x4){pk2(y[0], y[1]), pk2(y[2], y[3]), pk2(y[4], y[5]), pk2(y[6], y[7])};
}

DI void job_gpost(const Params& p, int layer, int it) {
  const int wid = otid() >> 6;
#pragma unroll
  for (int rr = 0; rr < 2; ++rr) job_gpost1(p, layer, it * 8 + rr * 4 + wid);
}
#ifdef SK_JL1
#define JL1(x)
#else
#define JL1(x) x
#endif
#ifdef SK_JGC
#define JGC(x)
#else
#define JGC(x) x
#endif
#ifdef SK_JVT
#define JVT(x)
#else
#define JVT(x) x
#endif
#ifdef SK_JDP
#define JDP(x)
#else
#define JDP(x) x
#endif
#ifdef SK_JGP
#define JGP(x)
#else
#define JGP(x) x
#endif
#ifdef SK_JL3
#define JL3(x)
#else
#define JL3(x) x
#endif
#ifdef SK_JGS
#define JGS(x)
#else
#define JGS(x) x
#endif
#ifdef SK_JAT
#define JAT(x)
#else
#define JAT(x) x
#endif
#define LAS __attribute__((address_space(3)))
#define XB_TMO      128
#define XB_XCNT(j)  (256  + 64 * (j))
#define XB_XSUB(j)  (1280 + 64 * (j))
#define XB_XGEN(j)  (2304 + 64 * (j))
#define XB_TOP      3328
#define XB_TOPGEN   3392
#define XCD_BAR_WORDS 3456
#define XB_SPIN_CAP (1u << 18)

__device__ __forceinline__ unsigned xb_ld(unsigned* p)              { return __hip_atomic_load(p, __ATOMIC_RELAXED, __HIP_MEMORY_SCOPE_AGENT); }
__device__ __forceinline__ unsigned xb_add(unsigned* p, unsigned v) { return __hip_atomic_fetch_add(p, v, __ATOMIC_RELAXED, __HIP_MEMORY_SCOPE_AGENT); }
__device__ __forceinline__ unsigned xb_xcc_id() { return (unsigned)__builtin_amdgcn_s_getreg((3 << 11) | 20) & 0xFu; }
#define XB_SPIN(cond, bar) do { unsigned _sp = 0; while (cond) { __builtin_amdgcn_s_sleep(1); \
    if ((++_sp & 255u) == 0u) { if (xb_ld(&(bar)[XB_TMO])) break; if (_sp > XB_SPIN_CAP) { atomicAdd(&(bar)[XB_TMO], 1u); break; } } } } while (0)

struct XcdBarrier {
    unsigned* bar; unsigned x;
    volatile LAS unsigned* st;
};

__device__ __forceinline__ XcdBarrier xcd_barrier_post(unsigned* bar, volatile LAS unsigned* st) {
    XcdBarrier b; b.bar = bar; b.x = xb_xcc_id(); b.st = st;
    if (threadIdx.x == 0) (void)xb_add(&bar[XB_XCNT(b.x)], 1u);
    return b;
}
__device__ __forceinline__ void xcd_barrier_complete(unsigned* bar, unsigned x, unsigned& nloc, unsigned& nx) {
    const unsigned G = gridDim.x * gridDim.y * gridDim.z;
    unsigned sum, cnt, mine, sp = 0u;
    for (;;) {
        sum = 0u; cnt = 0u; mine = 0u;
#pragma unroll
        for (unsigned j = 0; j < 16; ++j) { const unsigned c = xb_ld(&bar[XB_XCNT(j)]); sum += c; cnt += (c > 0u) ? 1u : 0u; mine = (j == x) ? c : mine; }
        if (sum == G) break;
        __builtin_amdgcn_s_sleep(1);
        if ((++sp & 255u) == 0u) { if (xb_ld(&bar[XB_TMO])) break; if (sp > XB_SPIN_CAP) { atomicAdd(&bar[XB_TMO], 1u); break; } }
    }
    nloc = mine > 0u ? mine : 1u; nx = cnt > 0u ? cnt : 1u;
}

__device__ __forceinline__ void xcd_barrier(const XcdBarrier& b) {
    asm volatile("s_waitcnt vmcnt(0)" ::: "memory");
    __syncthreads();
    if (threadIdx.x == 0) {
        unsigned* bar = b.bar; unsigned bx_ = b.x;
        asm volatile("" : "+s"(bar), "+s"(bx_));
        __builtin_amdgcn_s_waitcnt(0);
        unsigned nloc = b.st[0], nx = b.st[1];
        if (nloc == 0u) { xcd_barrier_complete(bar, bx_, nloc, nx); b.st[0] = nloc; b.st[1] = nx; }
        const unsigned old = xb_add(&bar[XB_XSUB(bx_)], 1u);
        const unsigned gen = old / nloc;
        if (old + 1u == (gen + 1u) * nloc) {
            __builtin_amdgcn_fence(__ATOMIC_RELEASE, "agent");
            asm volatile("s_waitcnt vmcnt(0)" ::: "memory");
            const unsigned og = xb_add(&bar[XB_TOP], 1u);
            const unsigned tg = og / nx;
            if (og + 1u == (tg + 1u) * nx) xb_add(&bar[XB_TOPGEN], 1u);
            else XB_SPIN(xb_ld(&bar[XB_TOPGEN]) == tg, bar);
            __builtin_amdgcn_fence(__ATOMIC_ACQUIRE, "agent");
            xb_add(&bar[XB_XGEN(bx_)], 1u);
            asm volatile("s_waitcnt vmcnt(0)" ::: "memory");
        } else {
            XB_SPIN(xb_ld(&bar[XB_XGEN(bx_)]) == gen, bar);
            __builtin_amdgcn_fence(__ATOMIC_ACQUIRE, "agent");
            asm volatile("s_waitcnt vmcnt(0)" ::: "memory");
        }
    }
    __syncthreads();
}


#define PH_BEGIN(k) for (int rep_ = 0, nrep_ = 1 + (((p.probe >> (k)) & 1) | ((k) == 5 ? ((p.probe >> 12) | (p.probe >> 13)) & 1 : 0)); rep_ < nrep_; ++rep_) { const bool dup = rep_ > 0; (void)dup;
#define PH_END xcd_barrier(xb_); }
#ifndef PROBE_MASK
#define PROBE_MASK 0
#endif
__global__ void __launch_bounds__(256, 2) mega(Params p) {
  __shared__ __attribute__((aligned(16))) char lds[LDS_BYTES];
  __shared__ int s_item;
  __shared__ unsigned xb_st[2];
  if (otid() == 0) { xb_st[0] = 0u; xb_st[1] = 0u; }
  __syncthreads();
  const XcdBarrier xb_ = xcd_barrier_post((unsigned*)(p.ws + OFF_CTR) + 64, (volatile LAS unsigned*)xb_st);
  cg::grid_group grid = cg::this_grid();
  const int G = gridDim.x, B = blockIdx.x;
  bf16_t* P = (bf16_t*)(p.ws + OFF_P);
  bf16_t* H = (bf16_t*)(p.ws + OFF_H);
  for (int it = B; it < 192 + 1024 + N_CVT; it += G) {
    if (it < 192) job_mod(p, it, lds);
    else if (it < 1216) job_rope(p, it - 192);
    else job_cvt(p, 0, it - 1216, lds);
  }
  if (p.probe < 0) grid.sync();
  xcd_barrier(xb_);
#pragma unroll 1
  for (int layer = 0; layer < 2; ++layer) {
    bf16_t* MG = (bf16_t*)(p.ws + OFF_VT);
    bf16_t* HID = P;
    PH_BEGIN(1)
    {
      const int n1 = layer == 1 ? N_CVT : 0;
      for (int it = B; it < n1 + MR / 8; it += G) { if (it < n1) job_cvt(p, 1, it, lds); else job_norm(p, layer, 1, it - n1); }
    }
    PH_END
    PH_BEGIN(2)
    {
      bf16_t* HALO = (bf16_t*)(p.ws + OFF_HALO);
      float* GBA = (float*)(p.ws + OFF_GBA);
      gemm_phase(H, 32, MR * 32, (const bf16_t*)(p.ws + OFF_WIN), 32, 7808 * 32, 1024, 132, 37, lds, B, G, [&](int row, int col, f32x4 v) {
        if (col < C_GBA) {
          const u32x2 w = {pk2(v[0], v[1]), pk2(v[2], v[3])};
          *(u32x2*)(P + (size_t)row * LDP + col) = w;
          if (col >= C_GQKV && col < C_GZ) {
            const int sm = row & 63;
            if (sm <= 1 || sm == 63) *(u32x2*)(HALO + ((size_t)(row >> 6) * 3 + (sm == 63 ? 2 : sm)) * 1536 + (col - C_GQKV)) = w;
          }
        } else if (col < C_GBA + 16) {
          *(f32x4*)(GBA + (size_t)row * 16 + (col - C_GBA)) = v;
        }
      }, [&](int row, int col, f32x4 v0, f32x4 v1) {
        if (col < C_GBA) {
          const u32x4 w = (u32x4){pk2(v0[0], v0[1]), pk2(v0[2], v0[3]), pk2(v1[0], v1[1]), pk2(v1[2], v1[3])};
          __builtin_nontemporal_store(w, (u32x4*)(P + (size_t)row * LDP + col));
          if (col >= C_GQKV && col < C_GZ) {
            const int sm = row & 63;
            if (sm <= 1 || sm == 63) *(u32x4*)(HALO + ((size_t)(row >> 6) * 3 + (sm == 63 ? 2 : sm)) * 1536 + (col - C_GQKV)) = w;
          }
        } else if (col < C_GBA + 16) {
          *(f32x4*)(GBA + (size_t)row * 16 + (col - C_GBA)) = v0;
          *(f32x4*)(GBA + (size_t)row * 16 + (col - C_GBA) + 4) = v1;
        }
      });
    }
    PH_END
    PH_BEGIN(3)
    {
      const int nA = 8 * NCH * 4, nB = nA + 6336, nC = nB + 2112, nD = nC + MR / 8;
      for (int it = B; it < nD; it += G) {
        if (it < nA) JL1(job_lru<1>(p, layer, it, lds, dup));
        else if (it < nB) JGC(job_gconv(p, layer, it - nA, dup));
        else if (it < nC) JVT(job_vt(p, it - nB, lds));
        else JDP(job_daprep(p, layer, it - nC, dup));
      }
    }
    PH_END
    PH_BEGIN(4)
    for (int it = B; it < 2112; it += G) JGP(job_gprep(p, layer, it, lds));
    PH_END
    PH_BEGIN(5)
    {
      for (;;) {
        const int x = blockIdx.x & 7;
        if (otid() == 0) s_item = (int)__hip_atomic_fetch_add((unsigned*)(p.ws + OFF_CTR) + ((layer * 2 + rep_) * 8 + x), 1u, __ATOMIC_RELAXED, __HIP_MEMORY_SCOPE_AGENT);
        __syncthreads();
        const int j = __builtin_amdgcn_readfirstlane(s_item);
        __syncthreads();
        if (j >= 16 + 132 + 528) break;
        if (j < 16) { if (!(dup && ((p.probe >> 12) & 1))) JGS(job_gscan(p, j * 8 + x, lds)); }
        else if (j < 148) {
          const int k = j - 16, grp = k / 66, qq = k % 66, qb = qq < 64 ? qq + 2 : qq - 64;
          if (!(dup && ((p.probe >> 13) & 1))) JAT(job_attn(p, layer, grp * 528 + qb * 8 + x, lds, dup));
        } else { if (!(dup && (((p.probe >> 12) | (p.probe >> 13)) & 1))) JL3(job_lru<3>(p, layer, (j - 148) * 8 + x, lds, dup)); }
      }
    }
    PH_END
    PH_BEGIN(6)
    for (int it = B; it < MR / 8 + MR / 8; it += G) { if (it < MR / 8) job_gpost(p, layer, it); else job_norm(p, layer, 1, it - MR / 8); }
    PH_END
    PH_BEGIN(7)
    gemm_phase(H, 32, MR * 32, (const bf16_t*)(p.ws + OFF_WIN) + (size_t)4736 * 32, 32, 7808 * 32, 1024, 132, 24, lds, B, G, [&](int row, int col, f32x4 v) {
      *(u32x2*)(P + (size_t)row * LDP + sg_col(col)) = (u32x2){pk2(sigm(v[0]), sigm(v[1])), pk2(sigm(v[2]), sigm(v[3]))};
    }, [&](int row, int col, f32x4 v0, f32x4 v1) {
      *(u32x4*)(P + (size_t)row * LDP + sg_col(col)) = (u32x4){pk2(sigm(v0[0]), sigm(v0[1])), pk2(sigm(v0[2]), sigm(v0[3])), pk2(sigm(v1[0]), sigm(v1[1])), pk2(sigm(v1[2]), sigm(v1[3]))};
    }, layer == 1);
    PH_END
    PH_BEGIN(14)
    {
      const bf16_t* WBR = (const bf16_t*)(p.ws + OFF_WBR);
      const int nm14 = layer == 1 ? 256 : 264;
      for (int t = B; t < nm14 * 8; t += G) {
        int mi, ni; tile_mn(t, nm14, 8, mi, ni);
        if (layer == 1) mi += 2 * (mi >> 6) + 2;
        f32x4 mg[4][4]; zero_acc<4>(mg);
#pragma unroll 1
        for (int i = 0; i < 3; ++i) {
          f32x4 ay[4][4]; zero_acc<4>(ay);
          const int coff = i == 0 ? C_DAQ : (i == 1 ? C_LY : C_GZ);
          gemm_core<4>(P + (size_t)mi * 128 * LDP + coff, LDP, 32, WBR + (size_t)i * 1024 * 512 + (size_t)(ni * 128) * 32, 32, 1024 * 32, 512, ay, lds);
          const int lane = otid() & 63, wid = otid() >> 6, wr = wid >> 1, wc = wid & 1;
#pragma unroll
          for (int a2 = 0; a2 < 4; ++a2)
#pragma unroll
            for (int b2 = 0; b2 < 4; ++b2) {
              const int row = mi * 128 + wr * 64 + a2 * 16 + (lane & 15), col = ni * 128 + wc * 64 + b2 * 16 + (lane >> 4) * 4;
              const u32x2 sg = *(const u32x2*)(P + (size_t)row * LDP + sg_col(i * 1024 + col));
              mg[a2][b2] += (f32x4){bflo(sg.x), bfhi(sg.x), bflo(sg.y), bfhi(sg.y)} * ay[a2][b2];
            }
        }
        gemm_emit<4>(mg, mi * 128, ni * 128, [&](int row, int col, f32x4 v) { *(u32x2*)(MG + ((size_t)(col >> 5) * MR + row) * 32 + (col & 31)) = (u32x2){pk2(v[0], v[1]), pk2(v[2], v[3])}; });
      }
    }
    PH_END
    PH_BEGIN(8)
    gemm_phase(MG, 32, MR * 32, (const bf16_t*)(p.ws + OFF_WO), 32, 1024 * 32, 1024, 132, 8, lds, B, G, [&](int row, int col, f32x4 v) {
      const f32x4 xin = *(const f32x4*)(res_in_row(p, layer, row) + col);
      const f32x4 g1 = *(const f32x4*)(mod_vec(p, layer, row) + 2048 + col);
      if (!dup) *(f32x4*)(res_out_row(p, row) + col) = xin + g1 * v;
    }, [&](int row, int col, f32x4 v0, f32x4 v1) {
      const float* xi = res_in_row(p, layer, row) + col;
      const float* gm = mod_vec(p, layer, row) + 2048 + col;
      float* xo = res_out_row(p, row) + col;
      const f32x4 o0 = __builtin_nontemporal_load((const f32x4*)xi) + *(const f32x4*)gm * v0, o1 = __builtin_nontemporal_load((const f32x4*)(xi + 4)) + *(const f32x4*)(gm + 4) * v1;
      if (!dup) { *(f32x4*)xo = o0; *(f32x4*)(xo + 4) = o1; }
    }, layer == 1);
    PH_END
    PH_BEGIN(9)
    for (int it = B; it < MR / 8; it += G) job_norm(p, layer, 2, it);
    PH_END
    PH_BEGIN(10)
    gemm_phase(H, 32, MR * 32, (const bf16_t*)(p.ws + OFF_W1), 32, 4096 * 32, 1024, 132, 32, lds, B, G, [&](int row, int col, f32x4 v) {
      float r[4];
#pragma unroll
      for (int e = 0; e < 4; ++e) { const float q = fmaxf(v[e], 0.f); r[e] = q * q; }
      *(u32x2*)(HID + ((size_t)(col >> 5) * MR + row) * 32 + (col & 31)) = (u32x2){pk2(r[0], r[1]), pk2(r[2], r[3])};
    }, [&](int row, int col, f32x4 v0, f32x4 v1) {
      float r[8];
#pragma unroll
      for (int e = 0; e < 4; ++e) { const float q0 = fmaxf(v0[e], 0.f), q1 = fmaxf(v1[e], 0.f); r[e] = q0 * q0; r[4 + e] = q1 * q1; }
      __builtin_nontemporal_store(((u32x4){pk2(r[0], r[1]), pk2(r[2], r[3]), pk2(r[4], r[5]), pk2(r[6], r[7])}), (u32x4*)(HID + ((size_t)(col >> 5) * MR + row) * 32 + (col & 31)));
    }, layer == 1);
    PH_END
    PH_BEGIN(11)
    gemm_phase(HID, 32, MR * 32, (const bf16_t*)(p.ws + OFF_W2), 32, 1024 * 32, 4096, 132, 8, lds, B, G, [&](int row, int col, f32x4 v) {
      float* xo = res_out_row(p, row) + col;
      const f32x4 g2 = *(const f32x4*)(mod_vec(p, layer, row) + 5120 + col);
      if (!dup) *(f32x4*)xo = *(const f32x4*)xo + g2 * v;
    }, [&](int row, int col, f32x4 v0, f32x4 v1) {
      float* xo = res_out_row(p, row) + col;
      const float* gm = mod_vec(p, layer, row) + 5120 + col;
      const f32x4 o0 = __builtin_nontemporal_load((const f32x4*)xo) + *(const f32x4*)gm * v0, o1 = __builtin_nontemporal_load((const f32x4*)(xo + 4)) + *(const f32x4*)(gm + 4) * v1;
      if (!dup) { *(f32x4*)xo = o0; *(f32x4*)(xo + 4) = o1; }
    }, layer == 1);
    PH_END
  }
}

extern "C" void kernel_launch(void* const* d_in, const int* in_sizes, int n_in, void* d_out, int out_size, void* d_ws, size_t ws_size, hipStream_t stream) {
  static int grid_blocks = 0;
  if (!grid_blocks) {
    int dev = 0, cus = 0, per_cu = 0;
    hipGetDevice(&dev);
    hipDeviceGetAttribute(&cus, hipDeviceAttributeMultiprocessorCount, dev);
    hipOccupancyMaxActiveBlocksPerMultiprocessor(&per_cu, mega, 256, 0);
    if (per_cu > 2) per_cu = 2;
    grid_blocks = cus * per_cu;
    grid_blocks -= grid_blocks % 8;
  }
  Params p{};
  const float** f = (const float**)&p;
  for (int i = 0; i < 26; ++i) f[i] = (const float*)d_in[i];
  p.out = (float*)d_out;
  p.ws = (char*)d_ws;
  p.probe = PROBE_MASK;
  if (ws_size < WS_TOTAL) { fprintf(stderr, "workspace too small: %zu < %zu\n", ws_size, (size_t)WS_TOTAL); return; }
  hipMemsetAsync((char*)d_ws + OFF_CTR, 0, 256 + 16384, stream);
  void* args[] = {&p};
  hipError_t e = hipLaunchCooperativeKernel((void*)mega, dim3(grid_blocks), dim3(256), args, 0, stream);
  if (e != hipSuccess) fprintf(stderr, "cooperative launch failed: %s (grid %d)\n", hipGetErrorString(e), grid_blocks);
}
```

```cpp
#include <hip/hip_runtime.h>
#include <hip/hip_cooperative_groups.h>
#include <cstdint>
#include <cstdio>
namespace cg = cooperative_groups;

#define DI __device__ __forceinline__
typedef unsigned short bf16_t;
typedef short bf16x8 __attribute__((ext_vector_type(8)));
typedef float f32x4 __attribute__((ext_vector_type(4)));
typedef float f32x2 __attribute__((ext_vector_type(2)));
typedef unsigned u32x4 __attribute__((ext_vector_type(4)));
typedef unsigned u32x2 __attribute__((ext_vector_type(2)));
typedef __bf16 bf16x2_t __attribute__((ext_vector_type(2)));

constexpr int DM = 1024, NB = 4, TL = 8192, TC = 256, TT = 8448, MR = NB * TT;
constexpr int LDP = 4736;
constexpr int C_DAQ = 0, C_DAK = 512, C_DAV = 1024, C_LX = 1536, C_LY = 2048, C_GQKV = 2560, C_GZ = 4096, C_GBA = 4608;
constexpr int NCH = 132;
constexpr float EPS = 1e-6f;
constexpr int LDS_BYTES = 77824;

constexpr size_t al256(size_t x) { return (x + 255) & ~(size_t)255; }
constexpr size_t OFF_WIN = 0;
constexpr size_t OFF_WBR = OFF_WIN + al256((size_t)7808 * 1024 * 2);
constexpr size_t OFF_WO = OFF_WBR + al256((size_t)3 * 1024 * 512 * 2);
constexpr size_t OFF_W1 = OFF_WO + al256((size_t)1024 * 1024 * 2);
constexpr size_t OFF_W2 = OFF_W1 + al256((size_t)4096 * 1024 * 2);
constexpr size_t OFF_LG = OFF_W2 + al256((size_t)4096 * 1024 * 2);
constexpr size_t OFF_P = OFF_LG + al256((size_t)32 * 4096 * 2);
constexpr size_t OFF_H = OFF_P + al256((size_t)MR * LDP * 2);
constexpr size_t OFF_VT = OFF_H + al256((size_t)MR * 1024 * 2);
constexpr size_t OFF_OB = OFF_VT + al256((size_t)MR * 512 * 2);
constexpr size_t OFF_HALO = OFF_OB + al256((size_t)MR * 512 * 2);
constexpr size_t OFF_GBA = OFF_HALO + al256((size_t)528 * 3 * 1536 * 2);
constexpr size_t OFF_GSC = OFF_GBA + al256((size_t)MR * 16 * 4);
constexpr size_t OFF_LC = OFF_GSC + al256((size_t)4224 * 192 * 4);
constexpr size_t OFF_CTX = OFF_LC + al256((size_t)4 * NCH * 8 * 2 * 64 * 8);
constexpr size_t OFF_MOD = OFF_CTX + al256((size_t)4 * 256 * 1024 * 4);
constexpr size_t OFF_ROPE = OFF_MOD + al256((size_t)2 * 5 * 6144 * 4);
constexpr size_t OFF_CTR = OFF_ROPE + al256((size_t)8192 * 32 * 8);
constexpr size_t WS_TOTAL = OFF_CTR + 256 + 16384;
static_assert(WS_TOTAL <= (size_t)536870912, "workspace map too large");

struct Params {
  const float *x, *c, *ctx, *cctx, *ada_w, *ada_b, *n1g, *n2g, *w_in, *daqg, *dakg, *dalam, *dasub, *lcw, *lcb, *lgw, *lgb, *llam,
      *gcw, *galog, *gdtb, *gng, *wbr, *wout, *w1, *w2;
  float* out;
  char* ws;
  int probe;
  int pad_;
};

DI unsigned pk2(float lo, float hi) { f32x2 v = {lo, hi}; bf16x2_t b = __builtin_convertvector(v, bf16x2_t); return __builtin_bit_cast(unsigned, b); }
DI bf16_t f2bf(float f) { return (bf16_t)(pk2(f, 0.f) & 0xffffu); }
DI float bf2f(bf16_t u) { return __uint_as_float(((unsigned)u) << 16); }
DI float bflo(unsigned w) { return __uint_as_float(w << 16); }
DI float bfhi(unsigned w) { return __uint_as_float(w & 0xffff0000u); }
DI int otid() { int t = __builtin_amdgcn_workitem_id_x(); asm volatile("" : "+v"(t)); return t; }
template <int M> DI float shx(float v) { return __int_as_float(__builtin_amdgcn_ds_swizzle(__float_as_int(v), (M << 10) | 0x1f)); }
DI float add32(float v) { auto r = __builtin_amdgcn_permlane32_swap(__float_as_uint(v), __float_as_uint(v), false, false); return __uint_as_float(r[0]) + __uint_as_float(r[1]); }
DI float max32(float v) { auto r = __builtin_amdgcn_permlane32_swap(__float_as_uint(v), __float_as_uint(v), false, false); return fmaxf(__uint_as_float(r[0]), __uint_as_float(r[1])); }
DI float wsum(float v) { v += shx<1>(v); v += shx<2>(v); v += shx<4>(v); v += shx<8>(v); v += shx<16>(v); return add32(v); }
DI float wmax(float v) { v = fmaxf(v, shx<1>(v)); v = fmaxf(v, shx<2>(v)); v = fmaxf(v, shx<4>(v)); v = fmaxf(v, shx<8>(v)); v = fmaxf(v, shx<16>(v)); return max32(v); }
DI float sigm(float x) { return 1.f / (1.f + __expf(-x)); }
DI float softplusf(float x) { return x > 20.f ? x : log1pf(expf(x)); }
DI f32x4 mfma16(bf16x8 a, bf16x8 b, f32x4 c) { return __builtin_amdgcn_mfma_f32_16x16x32_bf16(a, b, c, 0, 0, 0); }

DI const float* res_in_row(const Params& p, int layer, int r) {
  const int b = r / TT, s = r % TT;
  if (layer == 0) return s < TC ? p.ctx + ((size_t)b * TC + s) * DM : p.x + ((size_t)b * TL + (s - TC)) * DM;
  return s < TC ? (const float*)(p.ws + OFF_CTX) + ((size_t)b * TC + s) * DM : p.out + ((size_t)b * TL + (s - TC)) * DM;
}
DI float* res_out_row(const Params& p, int r) {
  const int b = r / TT, s = r % TT;
  return s < TC ? (float*)(p.ws + OFF_CTX) + ((size_t)b * TC + s) * DM : p.out + ((size_t)b * TL + (s - TC)) * DM;
}
DI const float* mod_vec(const Params& p, int layer, int r) {
  const int b = r / TT, s = r % TT;
  return (const float*)(p.ws + OFF_MOD) + (size_t)(layer * 5 + (s < TC ? 4 : b)) * 6144;
}

template <int WN>
DI void gemm_core(const bf16_t* __restrict__ A, int lda, int a_ks, const bf16_t* __restrict__ Bt, int ldb, int b_ks, int K, f32x4 (&acc)[4][WN], char* lds) {
  constexpr int BN = 32 * WN, AST = 72, NBP = BN * 8 / 256;
  bf16_t* As = (bf16_t*)lds;
  bf16_t* Bs = As + 2 * 128 * AST;
  const int tid = otid(), lane = tid & 63, wid = tid >> 6, wr = wid >> 1, wc = wid & 1;
  u32x4 ra[4], rb[NBP];
  const int nk = K / 64;
#define GLOAD(k0)                                                                                                            \
  {                                                                                                                          \
    _Pragma("unroll") for (int i = 0; i < 4; ++i) { const int q = tid + 256 * i; ra[i] = *(const u32x4*)(A + (size_t)(q >> 3) * lda + (size_t)(((k0) >> 5) + ((q & 7) >> 2)) * a_ks + (q & 3) * 8); } \
    _Pragma("unroll") for (int i = 0; i < NBP; ++i) { const int q = tid + 256 * i; rb[i] = *(const u32x4*)(Bt + (size_t)(q >> 3) * ldb + (size_t)(((k0) >> 5) + ((q & 7) >> 2)) * b_ks + (q & 3) * 8); } \
  }
#define SSTORE(buf)                                                                                                          \
  {                                                                                                                          \
    _Pragma("unroll") for (int i = 0; i < 4; ++i) { const int q = tid + 256 * i; *(u32x4*)(As + ((buf) * 128 + (q >> 3)) * AST + (q & 7) * 8) = ra[i]; } \
    _Pragma("unroll") for (int i = 0; i < NBP; ++i) { const int q = tid + 256 * i; *(u32x4*)(Bs + ((buf) * BN + (q >> 3)) * AST + (q & 7) * 8) = rb[i]; } \
  }
  GLOAD(0);
  SSTORE(0);
  __syncthreads();
  for (int t = 0; t < nk; ++t) {
    if (t + 1 < nk) GLOAD((t + 1) * 64);
    const bf16_t* a = As + ((t & 1) * 128 + wr * 64 + (lane & 15)) * AST + (lane >> 4) * 8;
    const bf16_t* b = Bs + ((t & 1) * BN + wc * 16 * WN + (lane & 15)) * AST + (lane >> 4) * 8;
#pragma unroll
    for (int ks = 0; ks < 2; ++ks) {
      bf16x8 af[4], bfr[WN];
#pragma unroll
      for (int i = 0; i < 4; ++i) af[i] = *(const bf16x8*)(a + i * 16 * AST + ks * 32);
#pragma unroll
      for (int j = 0; j < WN; ++j) bfr[j] = *(const bf16x8*)(b + j * 16 * AST + ks * 32);
      __builtin_amdgcn_sched_barrier(0);
#pragma unroll
      for (int i = 0; i < 4; ++i)
#pragma unroll
        for (int j = 0; j < WN; ++j) acc[i][j] = mfma16(bfr[j], af[i], acc[i][j]);
      __builtin_amdgcn_sched_barrier(0);
    }
    if (t + 1 < nk) SSTORE((t + 1) & 1);
    __syncthreads();
  }
#undef GLOAD
#undef SSTORE
}
DI void tile_mn(int t, int nm, int nn, int& mi, int& ni) {
  const int nig = 16 * nn, g = t / nig, rem = t % nig, fm = g * 16;
  const int gsz = (nm - fm) < 16 ? (nm - fm) : 16;
  mi = fm + rem % gsz;
  ni = rem / gsz;
}
template <int WN, class Epi>
DI void gemm_emit(const f32x4 (&acc)[4][WN], int m0, int n0, Epi epi) {
  const int lane = otid() & 63, wid = otid() >> 6, wr = wid >> 1, wc = wid & 1;
#pragma unroll
  for (int i = 0; i < 4; ++i)
#pragma unroll
    for (int j = 0; j < WN; ++j) epi(m0 + wr * 64 + i * 16 + (lane & 15), n0 + wc * 16 * WN + j * 16 + (lane >> 4) * 4, acc[i][j]);
}
template <int WN>
DI void zero_acc(f32x4 (&acc)[4][WN]) {
#pragma unroll
  for (int i = 0; i < 4; ++i)
#pragma unroll
    for (int j = 0; j < WN; ++j) acc[i][j] = (f32x4){0.f, 0.f, 0.f, 0.f};
}

DI void gemm_core2(const bf16_t* __restrict__ A, int lda, int a_ks, const bf16_t* __restrict__ Bt, int ldb, int b_ks, int K, f32x4 (&acc)[8][4], char* lds) {
  constexpr int AST = 48;
  bf16_t* As = (bf16_t*)lds;
  bf16_t* Bs = As + 2 * 256 * AST;
  const int tid = otid(), lane = tid & 63, wid = tid >> 6, wr = wid >> 1, wc = wid & 1;
  u32x4 s0a[4], s0b[2], s1a[4], s1b[2];
  const int nk = K / 32;
  const bf16_t* ag = A + (size_t)(tid >> 2) * lda + (tid & 3) * 8;
  const bf16_t* bg = Bt + (size_t)(tid >> 2) * ldb + (tid & 3) * 8;
  const int bc_ = tid >> 2, brow = ((bc_ >> 5) * 2 + ((bc_ >> 2) & 1)) * 16 + ((bc_ >> 3) & 3) * 4 + (bc_ & 3);
#define LBAR() { asm volatile("s_waitcnt lgkmcnt(0)" ::: "memory"); __builtin_amdgcn_s_barrier(); asm volatile("" ::: "memory"); }
#define GLOAD2(ra, rb, k0)                                                                                                   \
  {                                                                                                                          \
    _Pragma("unroll") for (int i = 0; i < 4; ++i) ra[i] = *(const u32x4*)(ag + (size_t)(64 * i) * lda + (size_t)((k0) >> 5) * a_ks);               \
    _Pragma("unroll") for (int i = 0; i < 2; ++i) rb[i] = *(const u32x4*)(bg + (size_t)(64 * i) * ldb + (size_t)((k0) >> 5) * b_ks);               \
  }
#define SSTORE2(ra, rb, buf)                                                                                                 \
  {                                                                                                                          \
    _Pragma("unroll") for (int i = 0; i < 4; ++i) *(u32x4*)(As + ((buf) * 256 + 64 * i + (tid >> 2)) * AST + (tid & 3) * 8) = ra[i]; \
    _Pragma("unroll") for (int i = 0; i < 2; ++i) *(u32x4*)(Bs + ((buf) * 128 + 64 * i + brow) * AST + (tid & 3) * 8) = rb[i]; \
  }
#define STEP2(t, la, lb, sa, sb)                                                                                             \
  {                                                                                                                          \
    if ((t) + 2 < nk) GLOAD2(la, lb, ((t) + 2) * 32);                                                                        \
    const bf16_t* a = As + (((t) & 1) * 256 + wr * 128 + (lane & 15)) * AST + (lane >> 4) * 8;                               \
    const bf16_t* b = Bs + (((t) & 1) * 128 + wc * 64 + (lane & 15)) * AST + (lane >> 4) * 8;                                \
    bf16x8 bfr[4], a0[4], a1[4];                                                                                             \
    _Pragma("unroll") for (int j = 0; j < 4; ++j) bfr[j] = *(const bf16x8*)(b + j * 16 * AST);                               \
    _Pragma("unroll") for (int i = 0; i < 4; ++i) a0[i] = *(const bf16x8*)(a + i * 16 * AST);                                \
    __builtin_amdgcn_sched_barrier(0);                                                                                       \
    _Pragma("unroll") for (int i = 0; i < 4; ++i) a1[i] = *(const bf16x8*)(a + (4 + i) * 16 * AST);                          \
    __builtin_amdgcn_sched_barrier(0);                                                                                       \
    _Pragma("unroll") for (int i = 0; i < 4; ++i) _Pragma("unroll") for (int j = 0; j < 4; ++j) acc[i][j] = mfma16(bfr[j], a0[i], acc[i][j]); \
    __builtin_amdgcn_sched_barrier(0);                                                                                       \
    _Pragma("unroll") for (int i = 0; i < 4; ++i) _Pragma("unroll") for (int j = 0; j < 4; ++j) acc[4 + i][j] = mfma16(bfr[j], a1[i], acc[4 + i][j]); \
    __builtin_amdgcn_sched_barrier(0);                                                                                       \
    if ((t) + 1 < nk) SSTORE2(sa, sb, ((t) + 1) & 1);                                                                        \
    LBAR();                                                                                                                  \
  }
  GLOAD2(s0a, s0b, 0);
  SSTORE2(s0a, s0b, 0);
  GLOAD2(s1a, s1b, 32);
  LBAR();
  int t = 0;
  for (;;) {
    STEP2(t, s0a, s0b, s1a, s1b);
    if (++t >= nk) break;
    STEP2(t, s1a, s1b, s0a, s0b);
    if (++t >= nk) break;
  }
#undef GLOAD2
#undef SSTORE2
#undef STEP2
}
DI void tile_mn8(int t, int nm, int nn, int& mi, int& ni) {
  const int nig = 8 * nn, g = t / nig, rem = t % nig, fm = g * 8;
  const int gsz = (nm - fm) < 8 ? (nm - fm) : 8;
  mi = fm + rem % gsz;
  ni = rem / gsz;
}
template <class Epi, class Epi8>
DI void gemm_phase(const bf16_t* A, int lda, int a_ks, const bf16_t* Bt, int ldb, int b_ks, int K, int nm, int nn, char* lds, int B, int G, Epi epi, Epi8 epi8, bool skipctx = false) {
  if (skipctx) nm -= 4;
  const int NT = nm * nn;
  int nfull = (NT / G) * G, R = NT - nfull;
  if (4 * R > 2 * G) { nfull = NT; R = 0; }
  for (int t = B; t < nfull + 4 * R; t += G) {
    int mi, ni;
    if (t < nfull) {
      tile_mn8(t, nm, nn, mi, ni);
      if (skipctx) mi += (mi >> 5) + 1;
      f32x4 acc[8][4];
#pragma unroll
      for (int i = 0; i < 8; ++i)
#pragma unroll
        for (int j = 0; j < 4; ++j) acc[i][j] = (f32x4){0.f, 0.f, 0.f, 0.f};
      gemm_core2(A + (size_t)mi * 256 * lda, lda, a_ks, Bt + (size_t)ni * 128 * ldb, ldb, b_ks, K, acc, lds);
      const int lane = otid() & 63, wid = otid() >> 6, wr = wid >> 1, wc = wid & 1;
#pragma unroll
      for (int i = 0; i < 8; ++i)
#pragma unroll
        for (int jp = 0; jp < 2; ++jp) epi8(mi * 256 + wr * 128 + i * 16 + (lane & 15), ni * 128 + wc * 64 + jp * 32 + (lane >> 4) * 8, acc[i][2 * jp], acc[i][2 * jp + 1]);
    } else {
      const int u = t - nfull, sub = u & 3;
      tile_mn8(nfull + (u >> 2), nm, nn, mi, ni);
      if (skipctx) mi += (mi >> 5) + 1;
      const int m0 = mi * 256 + (sub >> 1) * 128, n0 = ni * 128 + (sub & 1) * 64;
      f32x4 acc[4][2]; zero_acc<2>(acc);
      gemm_core<2>(A + (size_t)m0 * lda, lda, a_ks, Bt + (size_t)n0 * ldb, ldb, b_ks, K, acc, lds);
      gemm_emit<2>(acc, m0, n0, epi);
    }
  }
}
DI int sg_col(int gc) { const int j = gc >> 7; return (j < 12 ? 512 + 128 * j : 2560 + 128 * (j - 12)) + (gc & 127); }

constexpr int N_CVT = 1152 + 32 + 768 + 384 + 256 + 1024 + 1024 + 32;
DI void job_cvt(const Params& p, int layer, int t, char* lds) {
  const float* src; int ld, ncol0 = 0, nlim, K, ntot, nrow0 = 0; bf16_t* dst;
  char* ws = p.ws;
  if (t < 1152) { src = p.w_in + (size_t)layer * 1024 * 7696; ld = 7696; ncol0 = 0; nlim = 4608; dst = (bf16_t*)(ws + OFF_WIN); K = 1024; ntot = 7808; nrow0 = 0; }
  else if ((t -= 1152) < 32) { src = p.w_in + (size_t)layer * 1024 * 7696; ld = 7696; ncol0 = 4608; nlim = 4624; dst = (bf16_t*)(ws + OFF_WIN); K = 1024; ntot = 7808; nrow0 = 4608; }
  else if ((t -= 32) < 768) { src = p.w_in + (size_t)layer * 1024 * 7696; ld = 7696; ncol0 = 4624; nlim = 7696; dst = (bf16_t*)(ws + OFF_WIN); K = 1024; ntot = 7808; nrow0 = 4736; }
  else if ((t -= 768) < 384) { const int i = t / 128; t %= 128; src = p.wbr + ((size_t)layer * 3 + i) * 512 * 1024; ld = 1024; nlim = 1024; dst = (bf16_t*)(ws + OFF_WBR) + (size_t)i * 1024 * 512; K = 512; ntot = 1024; }
  else if ((t -= 384) < 256) { src = p.wout + (size_t)layer * 1024 * 1024; ld = 1024; nlim = 1024; dst = (bf16_t*)(ws + OFF_WO); K = 1024; ntot = 1024; }
  else if ((t -= 256) < 1024) { src = p.w1 + (size_t)layer * 1024 * 4096; ld = 4096; nlim = 4096; dst = (bf16_t*)(ws + OFF_W1); K = 1024; ntot = 4096; }
  else if ((t -= 1024) < 1024) { src = p.w2 + (size_t)layer * 4096 * 1024; ld = 1024; nlim = 1024; dst = (bf16_t*)(ws + OFF_W2); K = 4096; ntot = 1024; }
  else { t -= 1024; src = p.lgw + ((size_t)layer * 32 + t) * 4096; ld = 64; nlim = 64; dst = (bf16_t*)(ws + OFF_LG) + (size_t)t * 4096; K = 64; ntot = 0; t = 0; }
  const int nkt = K / 64, nt = t / nkt, kt = t % nkt;
  float* tl = (float*)lds;
  const int tid = otid();
  {
    const int c4 = (tid & 15) * 4, ncol = ncol0 + nt * 64 + c4;
#pragma unroll
    for (int i = 0; i < 4; ++i) {
      const int kk = i * 16 + (tid >> 4);
      f32x4 v = {0.f, 0.f, 0.f, 0.f};
      if (ncol + 3 < nlim) v = __builtin_nontemporal_load((const f32x4*)(src + (size_t)(kt * 64 + kk) * ld + ncol));
      tl[kk * 65 + c4] = v[0]; tl[kk * 65 + c4 + 1] = v[1]; tl[kk * 65 + c4 + 2] = v[2]; tl[kk * 65 + c4 + 3] = v[3];
    }
  }
  __syncthreads();
  {
    const int n = tid >> 2, kq = tid & 3;
    float v[16];
#pragma unroll
    for (int e = 0; e < 16; ++e) v[e] = tl[(kq * 16 + e) * 65 + n];
    u32x4 w0 = {pk2(v[0], v[1]), pk2(v[2], v[3]), pk2(v[4], v[5]), pk2(v[6], v[7])};
    u32x4 w1 = {pk2(v[8], v[9]), pk2(v[10], v[11]), pk2(v[12], v[13]), pk2(v[14], v[15])};
    const int nd = nrow0 + nt * 64 + n, kd = kt * 64 + kq * 16;
    bf16_t* d = ntot ? dst + ((size_t)(kd >> 5) * ntot + nd) * 32 + (kd & 31) : dst + (size_t)nd * K + kd;
    *(u32x4*)d = w0;
    *(u32x4*)(d + 8) = w1;
  }
  __syncthreads();
}
DI void job_mod(const Params& p, int it, char* lds) {
  const int nc = it % 96, l = it / 96, tid = otid();
  float* sc = (float*)lds;
  float* red = sc + 5 * 1024;
  for (int i = tid; i < 5 * 1024; i += 256) {
    const int v = i >> 10, k = i & 1023;
    const float cv = v < 4 ? p.c[v * 1024 + k] : p.cctx[k];
    sc[i] = cv * sigm(cv);
  }
  __syncthreads();
  const int cq = tid & 15, kg = tid >> 4, n = nc * 64 + cq * 4;
  const float* w = p.ada_w + ((size_t)l * 1024 + kg * 64) * 6144 + n;
  const float* s0 = sc + kg * 64;
  f32x4 a[5];
#pragma unroll
  for (int v = 0; v < 5; ++v) a[v] = (f32x4){0.f, 0.f, 0.f, 0.f};
#pragma unroll 8
  for (int k = 0; k < 64; ++k) {
    const f32x4 wv = __builtin_nontemporal_load((const f32x4*)(w + (size_t)k * 6144));
#pragma unroll
    for (int v = 0; v < 5; ++v) a[v] += wv * s0[v * 1024 + k];
  }
#pragma unroll
  for (int v = 0; v < 5; ++v)
#pragma unroll
    for (int e = 0; e < 4; ++e) red[(kg * 5 + v) * 64 + cq * 4 + e] = a[v][e];
  __syncthreads();
  for (int i = tid; i < 320; i += 256) {
    const int v = i >> 6, cc = i & 63;
    float r = p.ada_b[l * 6144 + nc * 64 + cc];
#pragma unroll
    for (int q = 0; q < 16; ++q) r += red[(q * 5 + v) * 64 + cc];
    ((float*)(p.ws + OFF_MOD))[(size_t)(l * 5 + v) * 6144 + nc * 64 + cc] = r;
  }
  __syncthreads();
}
DI void job_rope(const Params& p, int it) {
  const int idx = it * 256 + otid(), t = idx >> 5, ax = (idx >> 4) & 1, f = idx & 15;
  const float inv = powf(10000.f, -(float)f / 16.f);
  const float pos = (float)(ax ? (t & 63) : (t >> 6));
  float s, c;
  sincosf(pos * inv, &s, &c);
  ((f32x2*)(p.ws + OFF_ROPE))[idx] = (f32x2){c, s};
}
DI void job_norm(const Params& p, int layer, int which, int it) {
  const int lane = otid() & 63, wid = otid() >> 6, r = it * 8 + wid;
  const float* xr0 = (which == 1) ? res_in_row(p, layer, r) : (const float*)res_out_row(p, r);
  const float* xr1 = (which == 1) ? res_in_row(p, layer, r + 4) : (const float*)res_out_row(p, r + 4);
  const float* mv = mod_vec(p, layer, r);
  const float* sh = mv + (which == 1 ? 0 : 3072);
  const float* sc = mv + (which == 1 ? 1024 : 4096);
  const float* g = (which == 1 ? p.n1g : p.n2g) + layer * 1024;
  f32x4 xa[4], xb[4];
#pragma unroll
  for (int i = 0; i < 2; ++i)
#pragma unroll
    for (int hf = 0; hf < 2; ++hf) {
      xa[2 * i + hf] = __builtin_nontemporal_load((const f32x4*)(xr0 + i * 512 + lane * 8 + hf * 4));
      xb[2 * i + hf] = __builtin_nontemporal_load((const f32x4*)(xr1 + i * 512 + lane * 8 + hf * 4));
    }
  float sa = 0.f, sb = 0.f;
#pragma unroll
  for (int i = 0; i < 4; ++i) {
    sa += xa[i][0] * xa[i][0] + xa[i][1] * xa[i][1] + xa[i][2] * xa[i][2] + xa[i][3] * xa[i][3];
    sb += xb[i][0] * xb[i][0] + xb[i][1] * xb[i][1] + xb[i][2] * xb[i][2] + xb[i][3] * xb[i][3];
  }
  sa = wsum(sa); sb = wsum(sb);
  const float ra = rsqrtf(sa * (1.f / 1024.f) + EPS), rb = rsqrtf(sb * (1.f / 1024.f) + EPS);
  bf16_t* H0 = (bf16_t*)(p.ws + OFF_H) + (size_t)r * 32;
  bf16_t* H1 = H0 + 4 * 32;
#pragma unroll
  for (int i = 0; i < 2; ++i) {
    const int c = i * 512 + lane * 8;
    float o[8], q[8];
#pragma unroll
    for (int hf = 0; hf < 2; ++hf) {
      const f32x4 gv = *(const f32x4*)(g + c + hf * 4), sv = *(const f32x4*)(sc + c + hf * 4), hv = *(const f32x4*)(sh + c + hf * 4);
#pragma unroll
      for (int e = 0; e < 4; ++e) { const float m = gv[e] * (1.f + sv[e]); o[hf * 4 + e] = xa[2 * i + hf][e] * ra * m + hv[e]; q[hf * 4 + e] = xb[2 * i + hf][e] * rb * m + hv[e]; }
    }
    const size_t so = (size_t)(c >> 5) * MR * 32 + (c & 31);
    *(u32x4*)(H0 + so) = (u32x4){pk2(o[0], o[1]), pk2(o[2], o[3]), pk2(o[4], o[5]), pk2(o[6], o[7])};
    *(u32x4*)(H1 + so) = (u32x4){pk2(q[0], q[1]), pk2(q[2], q[3]), pk2(q[4], q[5]), pk2(q[6], q[7])};
  }
}

DI void job_daprep1(const Params& p, int layer, int r, bool dup) {
  const int lane = otid() & 63, s = r % TT;
  const int G = lane >> 2, quarter = lane & 3;
  bf16_t* ptr = (bf16_t*)(p.ws + OFF_P) + (size_t)r * LDP + (G < 8 ? C_DAQ + G * 64 : C_DAK + (G - 8) * 64) + quarter * 16;
  const u32x4 w0 = *(const u32x4*)ptr, w1 = *(const u32x4*)(ptr + 8);
  float y[16];
#pragma unroll
  for (int e = 0; e < 4; ++e) { y[2 * e] = bflo(w0[e]); y[2 * e + 1] = bfhi(w0[e]); y[8 + 2 * e] = bflo(w1[e]); y[9 + 2 * e] = bfhi(w1[e]); }
  float ss = 0.f;
#pragma unroll
  for (int e = 0; e < 16; ++e) ss += y[e] * y[e];
  ss += shx<1>(ss);
  ss += shx<2>(ss);
  float rstd = rsqrtf(ss * (1.f / 64.f) + EPS);
  const float* g = (G < 8 ? p.daqg : p.dakg) + layer * 64 + quarter * 16;
#pragma unroll
  for (int e = 0; e < 16; ++e) y[e] = y[e] * rstd * g[e];
  if (s >= TC) {
    const f32x2* tb = (const f32x2*)(p.ws + OFF_ROPE) + ((size_t)(s - TC) * 2 + (quarter >> 1)) * 16;
#pragma unroll
    for (int e = 0; e < 16; ++e) {
      const float yp = shx<1>(y[e]);
      const f32x2 cs = tb[e];
      y[e] = (quarter & 1) ? (y[e] * cs.x + yp * cs.y) : (y[e] * cs.x - yp * cs.y);
    }
  }
  if (G < 8) {
#pragma unroll
    for (int e = 0; e < 16; ++e) y[e] *= 0.125f * 1.4426950408889634f;
  }
  if (dup) return;
  *(u32x4*)ptr = (u32x4){pk2(y[0], y[1]), pk2(y[2], y[3]), pk2(y[4], y[5]), pk2(y[6], y[7])};
  *(u32x4*)(ptr + 8) = (u32x4){pk2(y[8], y[9]), pk2(y[10], y[11]), pk2(y[12], y[13]), pk2(y[14], y[15])};
}
DI void job_daprep(const Params& p, int layer, int it, bool dup) {
  const int wid = otid() >> 6;
#pragma unroll
  for (int rr = 0; rr < 2; ++rr) job_daprep1(p, layer, it * 8 + rr * 4 + wid, dup);
}
DI void job_vt(const Params& p, int it, char* lds) {
  const int h = it & 3, c = (it >> 2) % NCH, b = it / (4 * NCH), tid = otid();
  bf16_t* tl = (bf16_t*)lds;
  const bf16_t* P = (const bf16_t*)(p.ws + OFF_P);
#pragma unroll
  for (int i = 0; i < 4; ++i) {
    const int q = tid + 256 * i, row = q >> 4, pc = q & 15;
    const u32x4 w = *(const u32x4*)(P + (size_t)(b * TT + c * 64 + row) * LDP + C_DAV + h * 128 + pc * 8);
    unsigned* d = (unsigned*)(tl + row * 130 + pc * 8);
    d[0] = w[0]; d[1] = w[1]; d[2] = w[2]; d[3] = w[3];
  }
  __syncthreads();
  {
    const int dv = tid >> 1, half = tid & 1;
    unsigned o[16];
#pragma unroll
    for (int e = 0; e < 16; ++e) o[e] = (unsigned)tl[(half * 32 + 2 * e) * 130 + dv] | ((unsigned)tl[(half * 32 + 2 * e + 1) * 130 + dv] << 16);
    bf16_t* d = (bf16_t*)(p.ws + OFF_VT) + ((size_t)(b * 4 + h) * 128 + dv) * TT + c * 64 + half * 32;
#pragma unroll
#define VTW(w) o[(((w) & 3) >> 1) * 8 + ((w) >> 2) * 2 + ((w) & 1)]
    for (int e = 0; e < 4; ++e) *(u32x4*)(d + e * 8) = (u32x4){VTW(4 * e), VTW(4 * e + 1), VTW(4 * e + 2), VTW(4 * e + 3)};
#undef VTW
  }
  __syncthreads();
}

constexpr int N_ATT = 1056;
DI void job_attn(const Params& p, int layer, int a, char* lds, bool dup) {
  const int tid = otid(), lane = tid & 63, wid = tid >> 6, l15 = lane & 15, g = lane >> 4;
  const int grp = a / 528, within = a % 528, bh = grp * 8 + (within & 7), qb = within >> 3, b = bh >> 2, h = bh & 3;
  if (layer == 1 && qb < 2) return;
  const int nt = qb < 2 ? 4 : NCH;
  bf16_t* P = (bf16_t*)(p.ws + OFF_P);
  const bf16_t* VT = (const bf16_t*)(p.ws + OFF_VT) + (size_t)(b * 4 + h) * 128 * TT;
  int ly_ = layer; asm volatile("" : "+s"(ly_));
  const float lam_init = __uint_as_float(ly_ == 0 ? 0x3e4ccccdu : 0x3eb60549u);
  const float* lv = p.dalam + layer * 256;
  const float lam = __uint_as_float(__builtin_amdgcn_readfirstlane(__float_as_uint(expf(wsum(lv[lane] * lv[64 + lane])) - expf(wsum(lv[128 + lane] * lv[192 + lane])) + lam_init)));
  const float mq = wmax(fabsf(p.daqg[layer * 64 + lane])), mk = wmax(fabsf(p.dakg[layer * 64 + lane]));
  const float negMb = __uint_as_float(__builtin_amdgcn_readfirstlane(__float_as_uint(-(8.f * mq * mk * 1.03f * 1.4426950408889634f + 0.5f))));
  const int r0 = b * TT + qb * 128 + wid * 32;
  bf16x8 qf[2][2][2];
#pragma unroll
  for (int c = 0; c < 2; ++c)
#pragma unroll
    for (int i = 0; i < 2; ++i)
#pragma unroll
      for (int ks = 0; ks < 2; ++ks) qf[c][i][ks] = *(const bf16x8*)(P + (size_t)(r0 + i * 16 + l15) * LDP + C_DAQ + h * 128 + c * 64 + ks * 32 + g * 8);
  bf16_t* Ks = (bf16_t*)lds;
  bf16_t* Vs = Ks + 2 * 64 * 144;
  u32x4 rk[4], rv[4];
  const bf16_t* kg = P + (size_t)(b * TT) * LDP + C_DAK + h * 128;
#define KLOAD(t) { _Pragma("unroll") for (int i = 0; i < 4; ++i) { const int q = tid + 256 * i; rk[i] = *(const u32x4*)(kg + (size_t)((t) * 64 + (q >> 4)) * LDP + (q & 15) * 8); } }
#define VLOAD(t) { _Pragma("unroll") for (int i = 0; i < 4; ++i) { const int q = tid + 256 * i; rv[i] = *(const u32x4*)(VT + (size_t)(q >> 3) * TT + (t) * 64 + (q & 7) * 8); } }
#define KSTORE(buf) { _Pragma("unroll") for (int i = 0; i < 4; ++i) { const int q = tid + 256 * i; *(u32x4*)(Ks + ((buf) * 64 + (q >> 4)) * 144 + (q & 15) * 8) = rk[i]; } }
#define VSTORE(buf) { _Pragma("unroll") for (int i = 0; i < 4; ++i) { const int q = tid + 256 * i; *(u32x4*)(Vs + ((buf) * 128 + (q >> 3)) * 80 + (q & 7) * 8) = rv[i]; } }
#define QK_INTO(S, Kb, half, CI)                                                                                       \
  _Pragma("unroll") for (int c = 0; c < 2; ++c) {                                                                      \
    bf16x8 kf[2][2];                                                                                                   \
    _Pragma("unroll") for (int k2 = 0; k2 < 2; ++k2) _Pragma("unroll") for (int ks = 0; ks < 2; ++ks)                  \
      kf[k2][ks] = *(const bf16x8*)((Kb) + ((half) * 32 + k2 * 16 + l15) * 144 + c * 64 + ks * 32 + g * 8);             \
    __builtin_amdgcn_sched_barrier(0);                                                                                 \
    _Pragma("unroll") for (int k2 = 0; k2 < 2; ++k2) _Pragma("unroll") for (int i = 0; i < 2; ++i) {                   \
      S[c][i][k2] = mfma16(kf[k2][0], qf[c][i][0], CI(c, i));     \
      S[c][i][k2] = mfma16(kf[k2][1], qf[c][i][1], S[c][i][k2]); }                                                     \
  }                                                                                                                    \
  __builtin_amdgcn_sched_barrier(0);
#define EXPSUM(S)                                                                                                      \
  _Pragma("unroll") for (int c = 0; c < 2; ++c) _Pragma("unroll") for (int i = 0; i < 2; ++i) {                        \
    _Pragma("unroll") for (int k2 = 0; k2 < 2; ++k2) _Pragma("unroll") for (int e = 0; e < 4; ++e) S[c][i][k2][e] = __builtin_amdgcn_exp2f(S[c][i][k2][e]); \
    lsum[c][i] += ((S[c][i][0][0] + S[c][i][0][1]) + (S[c][i][0][2] + S[c][i][0][3])) + ((S[c][i][1][0] + S[c][i][1][1]) + (S[c][i][1][2] + S[c][i][1][3])); }
#define EXP_S() _Pragma("unroll") for (int c = 0; c < 2; ++c) _Pragma("unroll") for (int i = 0; i < 2; ++i) _Pragma("unroll") for (int k2 = 0; k2 < 2; ++k2) _Pragma("unroll") for (int e = 0; e < 4; ++e) S[c][i][k2][e] = __builtin_amdgcn_exp2f(S[c][i][k2][e]);
  float lsum[2][2] = {{0.f, 0.f}, {0.f, 0.f}};
  KLOAD(0);
  KSTORE(0);
  __syncthreads();
  const f32x4 negMv = {negMb, negMb, negMb, negMb};
#define CI1(c, i) negMv
  f32x4 SA[2][2][2], SB[2][2][2];
#pragma unroll 1
  for (int t = 0; t < nt; ++t) {
    if (t + 1 < nt) KLOAD(t + 1);
    const bf16_t* Kb = Ks + (t & 1) * 64 * 144;
    QK_INTO(SA, Kb, 0, CI1)
    if (t > 0) { EXPSUM(SB) }
    __builtin_amdgcn_sched_barrier(0);
    QK_INTO(SB, Kb, 1, CI1)
    EXPSUM(SA)
    if (t + 1 < nt) KSTORE((t + 1) & 1);
    __syncthreads();
  }
  EXPSUM(SB)
  f32x4 ci2[2][2];
#pragma unroll
  for (int i = 0; i < 2; ++i) {
    float l0 = lsum[0][i], l1 = lsum[1][i];
    l0 += shx<16>(l0); l0 = add32(l0);
    l1 += shx<16>(l1); l1 = add32(l1);
    const float c0 = negMb - __log2f(l0), c1 = negMb + __log2f(fabsf(lam)) - __log2f(l1);
    ci2[0][i] = (f32x4){c0, c0, c0, c0}; ci2[1][i] = (f32x4){c1, c1, c1, c1};
  }
  const float nsl = lam < 0.f ? 1.f : -1.f;
#define CI2(c, i) ci2[c][i]
  f32x4 O[2][8];
#pragma unroll
  for (int i = 0; i < 2; ++i)
#pragma unroll
    for (int n = 0; n < 8; ++n) O[i][n] = (f32x4){0.f, 0.f, 0.f, 0.f};
  KLOAD(0); VLOAD(0);
  KSTORE(0); VSTORE(0);
  __syncthreads();
#pragma unroll 1
  for (int t = 0; t < nt; ++t) {
    if (t + 1 < nt) KLOAD(t + 1);
    const bf16_t* Kb = Ks + (t & 1) * 64 * 144;
    const bf16_t* Vb = Vs + (t & 1) * 128 * 80;
#pragma unroll
    for (int half = 0; half < 2; ++half) {
      bf16x8 pf[2], vfa[4], vfb[4];
#define VREAD(dst, n0) _Pragma("unroll") for (int n = 0; n < 4; ++n) dst[n] = *(const bf16x8*)(Vb + (((n0) + n) * 16 + l15) * 80 + half * 32 + g * 8);
      {
        f32x4 S[2][2][2];
        QK_INTO(S, Kb, half, CI2)
        VREAD(vfa, 0)
        EXP_S()
#pragma unroll
        for (int i = 0; i < 2; ++i) {
          float w[8];
#pragma unroll
          for (int k2 = 0; k2 < 2; ++k2)
#pragma unroll
            for (int e = 0; e < 4; ++e) w[k2 * 4 + e] = __builtin_fmaf(nsl, S[1][i][k2][e], S[0][i][k2][e]);
          const u32x4 ww = {pk2(w[0], w[1]), pk2(w[2], w[3]), pk2(w[4], w[5]), pk2(w[6], w[7])};
          pf[i] = __builtin_bit_cast(bf16x8, ww);
        }
      }
      __builtin_amdgcn_sched_barrier(0);
      VREAD(vfb, 4)
#pragma unroll
      for (int n = 0; n < 4; ++n)
#pragma unroll
        for (int i = 0; i < 2; ++i) O[i][n] = mfma16(pf[i], vfa[n], O[i][n]);
      __builtin_amdgcn_sched_barrier(0);
#pragma unroll
      for (int n = 0; n < 4; ++n)
#pragma unroll
        for (int i = 0; i < 2; ++i) O[i][4 + n] = mfma16(pf[i], vfb[n], O[i][4 + n]);
      __builtin_amdgcn_sched_barrier(0);
#undef VREAD
      if (half == 0 && t + 1 < nt) VLOAD(t + 1);
    }
    if (t + 1 < nt) { KSTORE((t + 1) & 1); VSTORE((t + 1) & 1); }
    __syncthreads();
  }
#undef KLOAD
#undef VLOAD
#undef KSTORE
#undef VSTORE
#undef CI1
#undef CI2
#undef QK_INTO
#undef EXPSUM
#undef EXP_S
  const int lane_e = otid() & 63, l15e = lane_e & 15, ge = lane_e >> 4;
  const float* sg = p.dasub + layer * 128;
#pragma unroll
  for (int i = 0; i < 2; ++i)
#pragma unroll
    for (int e = 0; e < 4; ++e) {
      float ss = 0.f;
#pragma unroll
      for (int n = 0; n < 8; ++n) ss += O[i][n][e] * O[i][n][e];
      ss += shx<1>(ss); ss += shx<2>(ss); ss += shx<4>(ss); ss += shx<8>(ss);
      const float rstd = rsqrtf(ss * (1.f / 128.f) + EPS) * (1.f - lam_init);
      bf16_t* op = P + (size_t)(r0 + i * 16 + ge * 4 + e) * LDP + C_DAQ + h * 128 + l15e;
#pragma unroll
      for (int n = 0; n < 8; ++n) if (!dup) op[n * 16] = f2bf(O[i][n][e] * rstd * sg[n * 16 + l15e]);
    }
}

DI float gelu_tanh(float x) { const float u = 0.7978845608028654f * (x + 0.044715f * x * x * x); return 0.5f * x * (1.f + tanhf(u)); }
template <int PASS>
DI void job_lru(const Params& p, int layer, int it, char* lds, bool dup) {
  const int tid = otid(), lane = tid & 63, wid = tid >> 6, l15 = lane & 15, g = lane >> 4;
  const int n = it & 7, c = (it >> 3) % NCH, b = it / (8 * NCH);
  float* xc32 = (float*)lds;
  bf16_t* xcb = (bf16_t*)(lds + 16384);
  f32x2* ab = (f32x2*)(lds + 16384 + 9216);
  f32x2* segtot = (f32x2*)(lds + 16384 + 9216 + 32768);
  float* carry = (float*)(lds + 16384 + 9216 + 32768 + 2048);
  bf16_t* P = (bf16_t*)(p.ws + OFF_P);
  f32x2* LC = (f32x2*)(p.ws + OFF_LC);
  const int ch = tid & 63, seg = tid >> 6;
  {
    const int segLo = c < 4 ? 0 : TC, segHi = c < 4 ? TC : TT;
    const int cp2 = (tid & 31) * 2, tg = tid >> 5;
    const int s0 = c * 64 + tg * 8;
    float cw0[4], cw1[4];
#pragma unroll
    for (int k = 0; k < 4; ++k) { cw0[k] = p.lcw[(size_t)(layer * 4 + k) * 512 + n * 64 + cp2]; cw1[k] = p.lcw[(size_t)(layer * 4 + k) * 512 + n * 64 + cp2 + 1]; }
    const float cb0 = p.lcb[layer * 512 + n * 64 + cp2], cb1 = p.lcb[layer * 512 + n * 64 + cp2 + 1];
    unsigned xw[11];
#pragma unroll
    for (int j = 0; j < 11; ++j) {
      const int s = s0 - 1 + j;
      xw[j] = (s >= segLo && s < segHi) ? *(const unsigned*)(P + (size_t)(b * TT + s) * LDP + C_LX + n * 64 + cp2) : 0u;
    }
#pragma unroll
    for (int u = 0; u < 8; ++u) {
      const float v0 = cw0[0] * bflo(xw[u]) + cw0[1] * bflo(xw[u + 1]) + cw0[2] * bflo(xw[u + 2]) + cw0[3] * bflo(xw[u + 3]) + cb0;
      const float v1 = cw1[0] * bfhi(xw[u]) + cw1[1] * bfhi(xw[u + 1]) + cw1[2] * bfhi(xw[u + 2]) + cw1[3] * bfhi(xw[u + 3]) + cb1;
      *(f32x2*)(xc32 + (tg * 8 + u) * 64 + cp2) = (f32x2){v0, v1};
      *(unsigned*)(xcb + (tg * 8 + u) * 72 + cp2) = pk2(v0, v1);
    }
  }
  if (PASS == 3 && tid < 128) {
    const int d = tid >> 6;
    const int pos = d == 0 ? c : (c < 4 ? 3 - c : 4 + (NCH - 1 - c));
    float hh = 0.f;
    for (int q0 = 0; q0 < pos; q0 += 16) {
      f32x2 AB[16];
#pragma unroll
      for (int j = 0; j < 16; ++j) {
        const int q = q0 + j, qq = q < pos ? q : pos - 1;
        const int cc = d == 0 ? qq : (qq < 4 ? 3 - qq : NCH - 1 - (qq - 4));
        AB[j] = LC[((((size_t)b * NCH + cc) * 8 + n) * 2 + d) * 64 + ch];
      }
#pragma unroll
      for (int j = 0; j < 16; ++j) if (q0 + j < pos) hh = AB[j].x * hh + AB[j].y;
    }
    carry[d * 64 + ch] = hh;
  }
  __syncthreads();
  float hacc[16];
#pragma unroll
  for (int u = 0; u < 16; ++u) hacc[u] = 0.f;
#pragma unroll 1
  for (int d = 0; d < 2; ++d) {
    {
      f32x4 ar[4], ai[4];
#pragma unroll
      for (int i = 0; i < 4; ++i) { ar[i] = (f32x4){0.f, 0.f, 0.f, 0.f}; ai[i] = (f32x4){0.f, 0.f, 0.f, 0.f}; }
      const bf16_t* LG = (const bf16_t*)(p.ws + OFF_LG);
      const bf16_t* wr_ = LG + ((size_t)((d * 2 + 0) * 8 + n)) * 4096 + (wid * 16 + l15) * 64 + g * 8;
      const bf16_t* wi_ = LG + ((size_t)((d * 2 + 1) * 8 + n)) * 4096 + (wid * 16 + l15) * 64 + g * 8;
#pragma unroll
      for (int ks = 0; ks < 2; ++ks) {
        const bf16x8 br = *(const bf16x8*)(wr_ + ks * 32), bi = *(const bf16x8*)(wi_ + ks * 32);
#pragma unroll
        for (int i = 0; i < 4; ++i) {
          const bf16x8 af = *(const bf16x8*)(xcb + (i * 16 + l15) * 72 + ks * 32 + g * 8);
          ar[i] = mfma16(br, af, ar[i]);
          ai[i] = mfma16(bi, af, ai[i]);
        }
      }
#pragma unroll
      for (int e = 0; e < 4; ++e) {
        const int che = wid * 16 + g * 4 + e, cg_ = n * 64 + che;
        const float br = p.lgb[(size_t)((layer * 2 + d) * 2 + 0) * 512 + cg_], bi = p.lgb[(size_t)((layer * 2 + d) * 2 + 1) * 512 + cg_];
        const float sp = softplusf(-p.llam[(size_t)(layer * 2 + d) * 512 + cg_]);
#pragma unroll
        for (int i = 0; i < 4; ++i) {
          const int tok = i * 16 + l15;
          const float r = sigm(ar[i][e] + br), ig = sigm(ai[i][e] + bi);
          const float la = -8.f * r * sp;
          const float av = __expf(la);
          const float bv = __builtin_sqrtf(fmaxf(1.f - __expf(2.f * la), 0.f)) * ig * xc32[tok * 64 + che];
          ab[tok * 64 + che] = (f32x2){av, bv};
        }
      }
    }
    __syncthreads();
    float hloc[16], cploc[16];
    {
      float hp = 0.f, cp = 1.f;
#pragma unroll
      for (int uu = 0; uu < 16; ++uu) {
        const int u = d == 0 ? uu : 15 - uu;
        const f32x2 v = ab[(seg * 16 + u) * 64 + ch];
        hp = v.x * hp + v.y;
        cp *= v.x;
        hloc[uu] = hp; cploc[uu] = cp;
      }
      segtot[seg * 64 + ch] = (f32x2){cp, hp};
    }
    __syncthreads();
    if (PASS == 1) {
      if (tid < 64) {
        float A = 1.f, Bv = 0.f;
#pragma unroll
        for (int q = 0; q < 4; ++q) {
          const f32x2 v = segtot[(d == 0 ? q : 3 - q) * 64 + ch];
          Bv = v.x * Bv + v.y; A *= v.x;
        }
        LC[((((size_t)b * NCH + c) * 8 + n) * 2 + d) * 64 + ch] = (f32x2){A, Bv};
      }
    } else {
      float hh = carry[d * 64 + ch];
      const int npre = d == 0 ? seg : 3 - seg;
      for (int q = 0; q < npre; ++q) {
        const f32x2 v = segtot[(d == 0 ? q : 3 - q) * 64 + ch];
        hh = v.x * hh + v.y;
      }
#pragma unroll
      for (int uu = 0; uu < 16; ++uu) {
        const int u = d == 0 ? uu : 15 - uu;
        const float hv = hloc[uu] + cploc[uu] * hh;
        hacc[d == 0 ? uu : 15 - uu] += hv;
        (void)u;
      }
    }
    __syncthreads();
  }
  if (PASS == 3) {
#pragma unroll
    for (int u = 0; u < 16; ++u) xc32[(seg * 16 + u) * 64 + ch] = hacc[u];
    __syncthreads();
    const int cp2 = (tid & 31) * 2, tg = tid >> 5;
#pragma unroll
    for (int u = 0; u < 8; ++u) {
      const int tok = tg * 8 + u;
      unsigned* yp = (unsigned*)(P + (size_t)(b * TT + c * 64 + tok) * LDP + C_LY + n * 64 + cp2);
      const f32x2 hv = *(const f32x2*)(xc32 + tok * 64 + cp2);
      const unsigned y = *yp;
      if (!dup) *yp = pk2(gelu_tanh(bflo(y)) * hv.x, gelu_tanh(bfhi(y)) * hv.y);
    }
    __syncthreads();
  }
}

DI void job_gconv(const Params& p, int layer, int it, bool dup) {
  const int tid = otid(), grp = it % 12, cg_ = it / 12, cp = tid & 15, rg = tid >> 4;
  const int cin = cg_ % NCH;
  const bool first = (cin == 0 || cin == 4), last = (cin == 3 || cin == NCH - 1);
  bf16_t* P = (bf16_t*)(p.ws + OFF_P);
  const bf16_t* HALO = (const bf16_t*)(p.ws + OFF_HALO);
  const int col = grp * 128 + cp * 8;
  u32x4 xr[7];
#pragma unroll
  for (int j = 0; j < 7; ++j) {
    const int q = rg * 4 - 1 + j;
    u32x4 v = {0u, 0u, 0u, 0u};
    if (q >= 0 && q < 64) v = *(const u32x4*)(P + (size_t)(cg_ * 64 + q) * LDP + C_GQKV + col);
    else if (q < 0) { if (!first) v = *(const u32x4*)(HALO + ((size_t)(cg_ - 1) * 3 + 2) * 1536 + col); }
    else { if (!last) v = *(const u32x4*)(HALO + ((size_t)(cg_ + 1) * 3 + (q - 64)) * 1536 + col); }
    xr[j] = v;
  }
  float w[4][8];
#pragma unroll
  for (int k = 0; k < 4; ++k) {
    const f32x4 a = *(const f32x4*)(p.gcw + (size_t)(layer * 4 + k) * 1536 + col), bq = *(const f32x4*)(p.gcw + (size_t)(layer * 4 + k) * 1536 + col + 4);
#pragma unroll
    for (int e = 0; e < 4; ++e) { w[k][e] = a[e]; w[k][4 + e] = bq[e]; }
  }
  __syncthreads();
#pragma unroll
  for (int jr = 0; jr < 4; ++jr) {
    float y[8];
#pragma unroll
    for (int e = 0; e < 8; ++e) y[e] = 0.f;
#pragma unroll
    for (int k = 0; k < 4; ++k)
#pragma unroll
      for (int e = 0; e < 4; ++e) { y[2 * e] += w[k][2 * e] * bflo(xr[jr + k][e]); y[2 * e + 1] += w[k][2 * e + 1] * bfhi(xr[jr + k][e]); }
    float ss = 0.f;
#pragma unroll
    for (int e = 0; e < 8; ++e) { y[e] = y[e] * sigm(y[e]); ss += y[e] * y[e]; }
    if (grp < 8) {
      ss += shx<1>(ss); ss += shx<2>(ss); ss += shx<4>(ss); ss += shx<8>(ss);
      const float sc = rsqrtf(ss + EPS) * (grp < 4 ? 0.08838834764831845f : 1.f);
#pragma unroll
      for (int e = 0; e < 8; ++e) y[e] *= sc;
    }
    if (!dup) *(u32x4*)(P + (size_t)(cg_ * 64 + rg * 4 + jr) * LDP + C_GQKV + col) = (u32x4){pk2(y[0], y[1]), pk2(y[2], y[3]), pk2(y[4], y[5]), pk2(y[6], y[7])};
  }
  __syncthreads();
}

DI void job_gprep(const Params& p, int layer, int it, char* lds) {
  const int tid = otid(), lane = tid & 63, wid = tid >> 6, l15 = lane & 15, g = lane >> 4;
  const int h = it & 3, c = (it >> 2) % NCH, b = it / (4 * NCH);
  bf16_t* kt_ = (bf16_t*)lds;
  bf16_t* qt_ = kt_ + 64 * 136;
  float* Ld = (float*)lds;
  float* KK = (float*)(lds + 34816);
  float* QK = KK + 64 * 65;
  float* gcs = QK + 64 * 65;
  float* bts = gcs + 128;
  const bf16_t* P = (const bf16_t*)(p.ws + OFF_P);
#pragma unroll
  for (int i = 0; i < 4; ++i) {
    const int q = tid + 256 * i, row = q >> 4, pc = q & 15;
    const bf16_t* rp = P + (size_t)(b * TT + c * 64 + row) * LDP + C_GQKV + h * 128 + pc * 8;
    *(u32x4*)(qt_ + row * 136 + pc * 8) = *(const u32x4*)rp;
    *(u32x4*)(kt_ + row * 136 + pc * 8) = *(const u32x4*)(rp + 512);
  }
  float* GSC = (float*)(p.ws + OFF_GSC);
  if (tid < 128) {
    const int d = wid, i = lane, tn = d ? 63 - i : i, r = b * TT + c * 64 + tn;
    const float* gba = (const float*)(p.ws + OFF_GBA) + (size_t)r * 16;
    const float gval = -expf(p.galog[(layer * 2 + d) * 4 + h]) * softplusf(gba[8 + d * 4 + h] + p.gdtb[(layer * 2 + d) * 4 + h]);
    const float beta = sigm(gba[d * 4 + h]);
    float v = gval;
#pragma unroll
    for (int o = 1; o < 64; o <<= 1) { const float t = __int_as_float(__builtin_amdgcn_ds_bpermute(((lane - o) & 63) << 2, __float_as_int(v))); if (lane >= o) v += t; }
    const float glast = __int_as_float(__builtin_amdgcn_readlane(__float_as_int(v), 63));
    gcs[d * 64 + i] = v;
    bts[d * 64 + i] = beta;
    float* gs = GSC + (size_t)(it * 2 + d) * 192;
    gs[i] = expf(v);
    gs[64 + i] = expf(glast - v);
    if (i == 0) gs[128] = expf(glast);
  }
  __syncthreads();
  {
    f32x4 akk[4], aqk[4];
#pragma unroll
    for (int j = 0; j < 4; ++j) { akk[j] = (f32x4){0.f, 0.f, 0.f, 0.f}; aqk[j] = (f32x4){0.f, 0.f, 0.f, 0.f}; }
#pragma unroll
    for (int ks = 0; ks < 4; ++ks) {
      const bf16x8 ak = *(const bf16x8*)(kt_ + (wid * 16 + l15) * 136 + ks * 32 + g * 8);
      const bf16x8 aq = *(const bf16x8*)(qt_ + (wid * 16 + l15) * 136 + ks * 32 + g * 8);
#pragma unroll
      for (int j = 0; j < 4; ++j) {
        const bf16x8 bk = *(const bf16x8*)(kt_ + (j * 16 + l15) * 136 + ks * 32 + g * 8);
        akk[j] = mfma16(ak, bk, akk[j]);
        aqk[j] = mfma16(aq, bk, aqk[j]);
      }
    }
#pragma unroll
    for (int j = 0; j < 4; ++j)
#pragma unroll
      for (int e = 0; e < 4; ++e) { KK[(wid * 16 + g * 4 + e) * 65 + j * 16 + l15] = akk[j][e]; QK[(wid * 16 + g * 4 + e) * 65 + j * 16 + l15] = aqk[j][e]; }
  }
  __syncthreads();
  bf16_t* M1 = (bf16_t*)(p.ws + OFF_H);
  bf16_t* AT = M1 + (size_t)4224 * 4096;
#pragma unroll 1
  for (int d = 0; d < 2; ++d) {
    bf16_t* atp = AT + (size_t)(it * 2 + d) * 4096;
#pragma unroll 4
    for (int id2 = tid; id2 < 2048; id2 += 256) {
      const int idx = 2 * id2, i = idx >> 6, j = idx & 63, ti = d ? 63 - i : i, tj0 = d ? 63 - j : j, tj1 = d ? 62 - j : j + 1;
      const float gi = gcs[d * 64 + i];
      const float dec0 = (j <= i) ? expf(gi - gcs[d * 64 + j]) : 0.f, dec1 = (j + 1 <= i) ? expf(gi - gcs[d * 64 + j + 1]) : 0.f;
      const float bi = bts[d * 64 + i];
      *(f32x2*)(Ld + d * 4096 + idx) = (f32x2){(j < i) ? bi * KK[ti * 65 + tj0] * dec0 : 0.f, (j + 1 < i) ? bi * KK[ti * 65 + tj1] * dec1 : 0.f};
      *(unsigned*)(atp + idx) = pk2(QK[ti * 65 + tj0] * dec0, QK[ti * 65 + tj1] * dec1);
    }
  }
  __syncthreads();
  if (wid < 2) {
    const int d = wid;
    const float* L = Ld + d * 4096;
    const float bc = bts[d * 64 + lane];
    bf16_t* mp = M1 + (size_t)(it * 2 + d) * 4096 + lane;
    float x[64];
#pragma unroll
    for (int i = 0; i < 64; ++i) {
      float s = (i == lane) ? 1.f : 0.f;
#pragma unroll
      for (int j = 0; j < i; ++j) s -= L[i * 64 + j] * x[j];
      x[i] = s;
      mp[i * 64] = f2bf(s * bc);
    }
  }
  __syncthreads();
}

struct GChunk { bf16x8 kf[4], qf[4], m1f[2], atf[2]; unsigned vr[2][4]; float eg[4], egl[4]; float ge; };
DI void gdn_load(GChunk& R, const Params& p, int b, int h, int d, int dvs, int c) {
  const int tid = otid(), lane = tid & 63, wid = tid >> 6, l15 = lane & 15, g = lane >> 4;
  const bf16_t* P = (const bf16_t*)(p.ws + OFF_P);
  const bf16_t* M1 = (const bf16_t*)(p.ws + OFF_H);
  const bf16_t* AT = M1 + (size_t)4224 * 4096;
  const float* GSC = (const float*)(p.ws + OFF_GSC);
  const int item = ((b * NCH + c) * 4 + h) * 2 + d;
  const int irow = 16 * wid + l15, tn = d ? 63 - irow : irow;
  const bf16_t* rowp = P + (size_t)(b * TT + c * 64 + tn) * LDP + C_GQKV + h * 128;
#pragma unroll
  for (int ks = 0; ks < 4; ++ks) { R.qf[ks] = *(const bf16x8*)(rowp + ks * 32 + g * 8); R.kf[ks] = *(const bf16x8*)(rowp + 512 + ks * 32 + g * 8); }
#pragma unroll
  for (int ks = 0; ks < 2; ++ks) {
    R.m1f[ks] = *(const bf16x8*)(M1 + (size_t)item * 4096 + irow * 64 + ks * 32 + g * 8);
    R.atf[ks] = *(const bf16x8*)(AT + (size_t)item * 4096 + irow * 64 + ks * 32 + g * 8);
  }
#pragma unroll
  for (int e = 0; e < 4; ++e) {
    const int i = 16 * wid + g * 4 + e, t2 = d ? 63 - i : i;
    R.vr[0][e] = *(const unsigned*)(P + (size_t)(b * TT + c * 64 + t2) * LDP + C_GQKV + 1024 + h * 128 + dvs * 32 + (l15 & ~1));
    R.vr[1][e] = *(const unsigned*)(P + (size_t)(b * TT + c * 64 + t2) * LDP + C_GQKV + 1024 + h * 128 + dvs * 32 + 16 + (l15 & ~1));
    R.eg[e] = GSC[(size_t)item * 192 + i];
    R.egl[e] = GSC[(size_t)item * 192 + 64 + i];
  }
  R.ge = GSC[(size_t)item * 192 + 128];
}
DI void gdn_put_kt(const GChunk& R, bf16_t* KT) {
  const int tid = otid(), lane = tid & 63, i = 16 * (tid >> 6) + (lane & 15), g = lane >> 4;
#pragma unroll
  for (int ks = 0; ks < 4; ++ks)
#pragma unroll
    for (int e = 0; e < 8; ++e) KT[(ks * 32 + g * 8 + e) * 72 + i] = (bf16_t)R.kf[ks][e];
}
DI int gdn_chunk_at(int d, int n) { return d == 0 ? n : (n < 4 ? 3 - n : NCH - 1 - (n - 4)); }
DI void job_gscan(const Params& p, int u, char* lds) {
  const int tid = otid(), lane = tid & 63, wid = tid >> 6, l15 = lane & 15, g = lane >> 4;
  const int seq = (u & 7) + 8 * (u >> 5), dvs = (u >> 3) & 3, d = seq & 1, h = (seq >> 1) & 3, b = seq >> 3;
  bf16_t* KT = (bf16_t*)lds;
  bf16_t* ST = KT + 2 * 128 * 72;
  bf16_t* XT = ST + 32 * 136;
  bf16_t* VnT = XT + 32 * 72;
  bf16_t* VsT = VnT + 32 * 72;
  bf16_t* OUT = d == 0 ? (bf16_t*)(p.ws + OFF_P) + C_DAV : (bf16_t*)(p.ws + OFF_OB);
  const int ldo = d == 0 ? LDP : 512;
  __builtin_amdgcn_s_setprio(3);
  f32x4 S[2][2];
#pragma unroll
  for (int a = 0; a < 2; ++a)
#pragma unroll
    for (int ct = 0; ct < 2; ++ct) S[a][ct] = (f32x4){0.f, 0.f, 0.f, 0.f};
  for (int i = tid; i < 32 * 136 / 2; i += 256) ((unsigned*)ST)[i] = 0u;
  GChunk cur, nxt;
  gdn_load(cur, p, b, h, d, dvs, gdn_chunk_at(d, 0));
  gdn_put_kt(cur, KT);
  __syncthreads();
#pragma unroll 1
  for (int n = 0; n < NCH; ++n) {
    const int c = gdn_chunk_at(d, n);
    if (n + 1 < NCH) gdn_load(nxt, p, b, h, d, dvs, gdn_chunk_at(d, n + 1));
    const bf16_t* KTc = KT + (n & 1) * 128 * 72;
    f32x4 ksa[2], qsa[2];
#pragma unroll
    for (int ct = 0; ct < 2; ++ct) { ksa[ct] = (f32x4){0.f, 0.f, 0.f, 0.f}; qsa[ct] = (f32x4){0.f, 0.f, 0.f, 0.f}; }
#pragma unroll
    for (int ks = 0; ks < 4; ++ks)
#pragma unroll
      for (int ct = 0; ct < 2; ++ct) {
        const bf16x8 bS = *(const bf16x8*)(ST + (ct * 16 + l15) * 136 + ks * 32 + g * 8);
        ksa[ct] = mfma16(cur.kf[ks], bS, ksa[ct]);
        qsa[ct] = mfma16(cur.qf[ks], bS, qsa[ct]);
      }
#pragma unroll
    for (int ct = 0; ct < 2; ++ct) {
      float x[4];
#pragma unroll
      for (int e = 0; e < 4; ++e) x[e] = ((l15 & 1) ? bfhi(cur.vr[ct][e]) : bflo(cur.vr[ct][e])) - cur.eg[e] * ksa[ct][e];
      *(u32x2*)(XT + (ct * 16 + l15) * 72 + 16 * wid + g * 4) = (u32x2){pk2(x[0], x[1]), pk2(x[2], x[3])};
    }
    __syncthreads();
#pragma unroll
    for (int ct = 0; ct < 2; ++ct) {
      f32x4 vn = {0.f, 0.f, 0.f, 0.f};
#pragma unroll
      for (int ks = 0; ks < 2; ++ks) vn = mfma16(cur.m1f[ks], *(const bf16x8*)(XT + (ct * 16 + l15) * 72 + ks * 32 + g * 8), vn);
      *(u32x2*)(VnT + (ct * 16 + l15) * 72 + 16 * wid + g * 4) = (u32x2){pk2(vn[0], vn[1]), pk2(vn[2], vn[3])};
      *(u32x2*)(VsT + (ct * 16 + l15) * 72 + 16 * wid + g * 4) = (u32x2){pk2(vn[0] * cur.egl[0], vn[1] * cur.egl[1]), pk2(vn[2] * cur.egl[2], vn[3] * cur.egl[3])};
    }
    __syncthreads();
#pragma unroll
    for (int ct = 0; ct < 2; ++ct) {
      f32x4 o;
#pragma unroll
      for (int e = 0; e < 4; ++e) o[e] = cur.eg[e] * qsa[ct][e];
#pragma unroll
      for (int ks = 0; ks < 2; ++ks) o = mfma16(cur.atf[ks], *(const bf16x8*)(VnT + (ct * 16 + l15) * 72 + ks * 32 + g * 8), o);
#pragma unroll
      for (int e = 0; e < 4; ++e) {
        const int i = 16 * wid + g * 4 + e, t2 = d ? 63 - i : i;
        OUT[(size_t)(b * TT + c * 64 + t2) * ldo + h * 128 + dvs * 32 + ct * 16 + l15] = f2bf(o[e]);
      }
    }
#pragma unroll
    for (int rt2 = 0; rt2 < 2; ++rt2) {
      const int rt = 2 * wid + rt2;
#pragma unroll
      for (int ct = 0; ct < 2; ++ct)
#pragma unroll
        for (int e = 0; e < 4; ++e) S[rt2][ct][e] *= cur.ge;
#pragma unroll
      for (int ks = 0; ks < 2; ++ks) {
        const bf16x8 ka = *(const bf16x8*)(KTc + (rt * 16 + l15) * 72 + ks * 32 + g * 8);
#pragma unroll
        for (int ct = 0; ct < 2; ++ct) S[rt2][ct] = mfma16(ka, *(const bf16x8*)(VsT + (ct * 16 + l15) * 72 + ks * 32 + g * 8), S[rt2][ct]);
      }
#pragma unroll
      for (int ct = 0; ct < 2; ++ct)
        *(u32x2*)(ST + (ct * 16 + l15) * 136 + rt * 16 + g * 4) = (u32x2){pk2(S[rt2][ct][0], S[rt2][ct][1]), pk2(S[rt2][ct][2], S[rt2][ct][3])};
    }
    if (n + 1 < NCH) { gdn_put_kt(nxt, KT + ((n + 1) & 1) * 128 * 72); cur = nxt; }
    __syncthreads();
  }
  __builtin_amdgcn_s_setprio(0);
}
DI void job_gpost1(const Params& p, int layer, int r) {
  const int lane = otid() & 63;
  bf16_t* P = (bf16_t*)(p.ws + OFF_P) + (size_t)r * LDP;
  const bf16_t* OB = (const bf16_t*)(p.ws + OFF_OB) + (size_t)r * 512;
  const u32x4 of = *(const u32x4*)(P + C_DAV + lane * 8), ob = *(const u32x4*)(OB + lane * 8), z = *(const u32x4*)(P + C_GZ + lane * 8);
  float o[8], zz[8], ss = 0.f;
#pragma unroll
  for (int e = 0; e < 4; ++e) {
    o[2 * e] = bflo(of[e]) + bflo(ob[e]); o[2 * e + 1] = bfhi(of[e]) + bfhi(ob[e]);
    zz[2 * e] = bflo(z[e]); zz[2 * e + 1] = bfhi(z[e]);
  }
#pragma unroll
  for (int e = 0; e < 8; ++e) ss += o[e] * o[e];
  ss += shx<1>(ss); ss += shx<2>(ss); ss += shx<4>(ss); ss += shx<8>(ss);
  const float rstd = rsqrtf(ss * (1.f / 128.f) + EPS);
  const float* gn = p.gng + layer * 128 + (lane & 15) * 8;
  float y[8];
#pragma unroll
  for (int e = 0; e < 8; ++e) y[e] = o[e] * rstd * gn[e] * (zz[e] * sigm(zz[e]));
  *(u32x4*)(P + C_GZ + lane * 8) = (u32x4){pk2(y[0], y[1]), pk2(y[2], y[3]), pk2(y[4], y[5]), pk2(y[6], y[7])};
}

DI void job_gpost(const Params& p, int layer, int it) {
  const int wid = otid() >> 6;
#pragma unroll
  for (int rr = 0; rr < 2; ++rr) job_gpost1(p, layer, it * 8 + rr * 4 + wid);
}
#ifdef SK_JL1
#define JL1(x)
#else
#define JL1(x) x
#endif
#ifdef SK_JGC
#define JGC(x)
#else
#define JGC(x) x
#endif
#ifdef SK_JVT
#define JVT(x)
#else
#define JVT(x) x
#endif
#ifdef SK_JDP
#define JDP(x)
#else
#define JDP(x) x
#endif
#ifdef SK_JGP
#define JGP(x)
#else
#define JGP(x) x
#endif
#ifdef SK_JL3
#define JL3(x)
#else
#define JL3(x) x
#endif
#ifdef SK_JGS
#define JGS(x)
#else
#define JGS(x) x
#endif
#ifdef SK_JAT
#define JAT(x)
#else
#define JAT(x) x
#endif
#define LAS __attribute__((address_space(3)))
#define XB_TMO      128
#define XB_XCNT(j)  (256  + 64 * (j))
#define XB_XSUB(j)  (1280 + 64 * (j))
#define XB_XGEN(j)  (2304 + 64 * (j))
#define XB_TOP      3328
#define XB_TOPGEN   3392
#define XCD_BAR_WORDS 3456
#define XB_SPIN_CAP (1u << 18)

__device__ __forceinline__ unsigned xb_ld(unsigned* p)              { return __hip_atomic_load(p, __ATOMIC_RELAXED, __HIP_MEMORY_SCOPE_AGENT); }
__device__ __forceinline__ unsigned xb_add(unsigned* p, unsigned v) { return __hip_atomic_fetch_add(p, v, __ATOMIC_RELAXED, __HIP_MEMORY_SCOPE_AGENT); }
__device__ __forceinline__ unsigned xb_xcc_id() { return (unsigned)__builtin_amdgcn_s_getreg((3 << 11) | 20) & 0xFu; }
#define XB_SPIN(cond, bar) do { unsigned _sp = 0; while (cond) { __builtin_amdgcn_s_sleep(1); \
    if ((++_sp & 255u) == 0u) { if (xb_ld(&(bar)[XB_TMO])) break; if (_sp > XB_SPIN_CAP) { atomicAdd(&(bar)[XB_TMO], 1u); break; } } } } while (0)

struct XcdBarrier {
    unsigned* bar; unsigned x;
    volatile LAS unsigned* st;
};

__device__ __forceinline__ XcdBarrier xcd_barrier_post(unsigned* bar, volatile LAS unsigned* st) {
    XcdBarrier b; b.bar = bar; b.x = xb_xcc_id(); b.st = st;
    if (threadIdx.x == 0) (void)xb_add(&bar[XB_XCNT(b.x)], 1u);
    return b;
}
__device__ __forceinline__ void xcd_barrier_complete(unsigned* bar, unsigned x, unsigned& nloc, unsigned& nx) {
    const unsigned G = gridDim.x * gridDim.y * gridDim.z;
    unsigned sum, cnt, mine, sp = 0u;
    for (;;) {
        sum = 0u; cnt = 0u; mine = 0u;
#pragma unroll
        for (unsigned j = 0; j < 16; ++j) { const unsigned c = xb_ld(&bar[XB_XCNT(j)]); sum += c; cnt += (c > 0u) ? 1u : 0u; mine = (j == x) ? c : mine; }
        if (sum == G) break;
        __builtin_amdgcn_s_sleep(1);
        if ((++sp & 255u) == 0u) { if (xb_ld(&bar[XB_TMO])) break; if (sp > XB_SPIN_CAP) { atomicAdd(&bar[XB_TMO], 1u); break; } }
    }
    nloc = mine > 0u ? mine : 1u; nx = cnt > 0u ? cnt : 1u;
}

__device__ __forceinline__ void xcd_barrier(const XcdBarrier& b) {
    asm volatile("s_waitcnt vmcnt(0)" ::: "memory");
    __syncthreads();
    if (threadIdx.x == 0) {
        unsigned* bar = b.bar; unsigned bx_ = b.x;
        asm volatile("" : "+s"(bar), "+s"(bx_));
        __builtin_amdgcn_s_waitcnt(0);
        unsigned nloc = b.st[0], nx = b.st[1];
        if (nloc == 0u) { xcd_barrier_complete(bar, bx_, nloc, nx); b.st[0] = nloc; b.st[1] = nx; }
        const unsigned old = xb_add(&bar[XB_XSUB(bx_)], 1u);
        const unsigned gen = old / nloc;
        if (old + 1u == (gen + 1u) * nloc) {
            __builtin_amdgcn_fence(__ATOMIC_RELEASE, "agent");
            asm volatile("s_waitcnt vmcnt(0)" ::: "memory");
            const unsigned og = xb_add(&bar[XB_TOP], 1u);
            const unsigned tg = og / nx;
            if (og + 1u == (tg + 1u) * nx) xb_add(&bar[XB_TOPGEN], 1u);
            else XB_SPIN(xb_ld(&bar[XB_TOPGEN]) == tg, bar);
            __builtin_amdgcn_fence(__ATOMIC_ACQUIRE, "agent");
            xb_add(&bar[XB_XGEN(bx_)], 1u);
            asm volatile("s_waitcnt vmcnt(0)" ::: "memory");
        } else {
            XB_SPIN(xb_ld(&bar[XB_XGEN(bx_)]) == gen, bar);
            __builtin_amdgcn_fence(__ATOMIC_ACQUIRE, "agent");
            asm volatile("s_waitcnt vmcnt(0)" ::: "memory");
        }
    }
    __syncthreads();
}


#define PH_BEGIN(k) for (int rep_ = 0, nrep_ = 1 + (((p.probe >> (k)) & 1) | ((k) == 5 ? ((p.probe >> 12) | (p.probe >> 13)) & 1 : 0)); rep_ < nrep_; ++rep_) { const bool dup = rep_ > 0; (void)dup;
#define PH_END xcd_barrier(xb_); }
#ifndef PROBE_MASK
#define PROBE_MASK 0
#endif
__global__ void __launch_bounds__(256, 2) mega(Params p) {
  __shared__ __attribute__((aligned(16))) char lds[LDS_BYTES];
  __shared__ int s_item;
  __shared__ unsigned xb_st[2];
  if (otid() == 0) { xb_st[0] = 0u; xb_st[1] = 0u; }
  __syncthreads();
  const XcdBarrier xb_ = xcd_barrier_post((unsigned*)(p.ws + OFF_CTR) + 64, (volatile LAS unsigned*)xb_st);
  cg::grid_group grid = cg::this_grid();
  const int G = gridDim.x, B = blockIdx.x;
  bf16_t* P = (bf16_t*)(p.ws + OFF_P);
  bf16_t* H = (bf16_t*)(p.ws + OFF_H);
  for (int it = B; it < 192 + 1024 + N_CVT; it += G) {
    if (it < 192) job_mod(p, it, lds);
    else if (it < 1216) job_rope(p, it - 192);
    else job_cvt(p, 0, it - 1216, lds);
  }
  if (p.probe < 0) grid.sync();
  xcd_barrier(xb_);
#pragma unroll 1
  for (int layer = 0; layer < 2; ++layer) {
    bf16_t* MG = (bf16_t*)(p.ws + OFF_VT);
    bf16_t* HID = P;
    PH_BEGIN(1)
    {
      const int n1 = layer == 1 ? N_CVT : 0;
      for (int it = B; it < n1 + MR / 8; it += G) { if (it < n1) job_cvt(p, 1, it, lds); else job_norm(p, layer, 1, it - n1); }
    }
    PH_END
    PH_BEGIN(2)
    {
      bf16_t* HALO = (bf16_t*)(p.ws + OFF_HALO);
      float* GBA = (float*)(p.ws + OFF_GBA);
      gemm_phase(H, 32, MR * 32, (const bf16_t*)(p.ws + OFF_WIN), 32, 7808 * 32, 1024, 132, 37, lds, B, G, [&](int row, int col, f32x4 v) {
        if (col < C_GBA) {
          const u32x2 w = {pk2(v[0], v[1]), pk2(v[2], v[3])};
          *(u32x2*)(P + (size_t)row * LDP + col) = w;
          if (col >= C_GQKV && col < C_GZ) {
            const int sm = row & 63;
            if (sm <= 1 || sm == 63) *(u32x2*)(HALO + ((size_t)(row >> 6) * 3 + (sm == 63 ? 2 : sm)) * 1536 + (col - C_GQKV)) = w;
          }
        } else if (col < C_GBA + 16) {
          *(f32x4*)(GBA + (size_t)row * 16 + (col - C_GBA)) = v;
        }
      }, [&](int row, int col, f32x4 v0, f32x4 v1) {
        if (col < C_GBA) {
          const u32x4 w = (u32x4){pk2(v0[0], v0[1]), pk2(v0[2], v0[3]), pk2(v1[0], v1[1]), pk2(v1[2], v1[3])};
          __builtin_nontemporal_store(w, (u32x4*)(P + (size_t)row * LDP + col));
          if (col >= C_GQKV && col < C_GZ) {
            const int sm = row & 63;
            if (sm <= 1 || sm == 63) *(u32x4*)(HALO + ((size_t)(row >> 6) * 3 + (sm == 63 ? 2 : sm)) * 1536 + (col - C_GQKV)) = w;
          }
        } else if (col < C_GBA + 16) {
          *(f32x4*)(GBA + (size_t)row * 16 + (col - C_GBA)) = v0;
          *(f32x4*)(GBA + (size_t)row * 16 + (col - C_GBA) + 4) = v1;
        }
      });
    }
    PH_END
    PH_BEGIN(3)
    {
      const int nA = 8 * NCH * 4, nB = nA + 6336, nC = nB + 2112, nD = nC + MR / 8;
      for (int it = B; it < nD; it += G) {
        if (it < nA) JL1(job_lru<1>(p, layer, it, lds, dup));
        else if (it < nB) JGC(job_gconv(p, layer, it - nA, dup));
        else if (it < nC) JVT(job_vt(p, it - nB, lds));
        else JDP(job_daprep(p, layer, it - nC, dup));
      }
    }
    PH_END
    PH_BEGIN(4)
    for (int it = B; it < 2112; it += G) JGP(job_gprep(p, layer, it, lds));
    PH_END
    PH_BEGIN(5)
    {
      for (;;) {
        const int x = blockIdx.x & 7;
        if (otid() == 0) s_item = (int)__hip_atomic_fetch_add((unsigned*)(p.ws + OFF_CTR) + ((layer * 2 + rep_) * 8 + x), 1u, __ATOMIC_RELAXED, __HIP_MEMORY_SCOPE_AGENT);
        __syncthreads();
        const int j = __builtin_amdgcn_readfirstlane(s_item);
        __syncthreads();
        if (j >= 16 + 132 + 528) break;
        if (j < 16) { if (!(dup && ((p.probe >> 12) & 1))) JGS(job_gscan(p, j * 8 + x, lds)); }
        else if (j < 148) {
          const int k = j - 16, grp = k / 66, qq = k % 66, qb = qq < 64 ? qq + 2 : qq - 64;
          if (!(dup && ((p.probe >> 13) & 1))) JAT(job_attn(p, layer, grp * 528 + qb * 8 + x, lds, dup));
        } else { if (!(dup && (((p.probe >> 12) | (p.probe >> 13)) & 1))) JL3(job_lru<3>(p, layer, (j - 148) * 8 + x, lds, dup)); }
      }
    }
    PH_END
    PH_BEGIN(6)
    for (int it = B; it < MR / 8 + MR / 8; it += G) { if (it < MR / 8) job_gpost(p, layer, it); else job_norm(p, layer, 1, it - MR / 8); }
    PH_END
    PH_BEGIN(7)
    gemm_phase(H, 32, MR * 32, (const bf16_t*)(p.ws + OFF_WIN) + (size_t)4736 * 32, 32, 7808 * 32, 1024, 132, 24, lds, B, G, [&](int row, int col, f32x4 v) {
      *(u32x2*)(P + (size_t)row * LDP + sg_col(col)) = (u32x2){pk2(sigm(v[0]), sigm(v[1])), pk2(sigm(v[2]), sigm(v[3]))};
    }, [&](int row, int col, f32x4 v0, f32x4 v1) {
      *(u32x4*)(P + (size_t)row * LDP + sg_col(col)) = (u32x4){pk2(sigm(v0[0]), sigm(v0[1])), pk2(sigm(v0[2]), sigm(v0[3])), pk2(sigm(v1[0]), sigm(v1[1])), pk2(sigm(v1[2]), sigm(v1[3]))};
    }, layer == 1);
    PH_END
    PH_BEGIN(14)
    {
      const bf16_t* WBR = (const bf16_t*)(p.ws + OFF_WBR);
      const int nm14 = layer == 1 ? 256 : 264;
      for (int t = B; t < nm14 * 8; t += G) {
        int mi, ni; tile_mn(t, nm14, 8, mi, ni);
        if (layer == 1) mi += 2 * (mi >> 6) + 2;
        f32x4 mg[4][4]; zero_acc<4>(mg);
#pragma unroll 1
        for (int i = 0; i < 3; ++i) {
          f32x4 ay[4][4]; zero_acc<4>(ay);
          const int coff = i == 0 ? C_DAQ : (i == 1 ? C_LY : C_GZ);
          gemm_core<4>(P + (size_t)mi * 128 * LDP + coff, LDP, 32, WBR + (size_t)i * 1024 * 512 + (size_t)(ni * 128) * 32, 32, 1024 * 32, 512, ay, lds);
          const int lane = otid() & 63, wid = otid() >> 6, wr = wid >> 1, wc = wid & 1;
#pragma unroll
          for (int a2 = 0; a2 < 4; ++a2)
#pragma unroll
            for (int b2 = 0; b2 < 4; ++b2) {
              const int row = mi * 128 + wr * 64 + a2 * 16 + (lane & 15), col = ni * 128 + wc * 64 + b2 * 16 + (lane >> 4) * 4;
              const u32x2 sg = *(const u32x2*)(P + (size_t)row * LDP + sg_col(i * 1024 + col));
              mg[a2][b2] += (f32x4){bflo(sg.x), bfhi(sg.x), bflo(sg.y), bfhi(sg.y)} * ay[a2][b2];
            }
        }
        gemm_emit<4>(mg, mi * 128, ni * 128, [&](int row, int col, f32x4 v) { *(u32x2*)(MG + ((size_t)(col >> 5) * MR + row) * 32 + (col & 31)) = (u32x2){pk2(v[0], v[1]), pk2(v[2], v[3])}; });
      }
    }
    PH_END
    PH_BEGIN(8)
    gemm_phase(MG, 32, MR * 32, (const bf16_t*)(p.ws + OFF_WO), 32, 1024 * 32, 1024, 132, 8, lds, B, G, [&](int row, int col, f32x4 v) {
      const f32x4 xin = *(const f32x4*)(res_in_row(p, layer, row) + col);
      const f32x4 g1 = *(const f32x4*)(mod_vec(p, layer, row) + 2048 + col);
      if (!dup) *(f32x4*)(res_out_row(p, row) + col) = xin + g1 * v;
    }, [&](int row, int col, f32x4 v0, f32x4 v1) {
      const float* xi = res_in_row(p, layer, row) + col;
      const float* gm = mod_vec(p, layer, row) + 2048 + col;
      float* xo = res_out_row(p, row) + col;
      const f32x4 o0 = __builtin_nontemporal_load((const f32x4*)xi) + *(const f32x4*)gm * v0, o1 = __builtin_nontemporal_load((const f32x4*)(xi + 4)) + *(const f32x4*)(gm + 4) * v1;
      if (!dup) { *(f32x4*)xo = o0; *(f32x4*)(xo + 4) = o1; }
    }, layer == 1);
    PH_END
    PH_BEGIN(9)
    for (int it = B; it < MR / 8; it += G) job_norm(p, layer, 2, it);
    PH_END
    PH_BEGIN(10)
    gemm_phase(H, 32, MR * 32, (const bf16_t*)(p.ws + OFF_W1), 32, 4096 * 32, 1024, 132, 32, lds, B, G, [&](int row, int col, f32x4 v) {
      float r[4];
#pragma unroll
      for (int e = 0; e < 4; ++e) { const float q = fmaxf(v[e], 0.f); r[e] = q * q; }
      *(u32x2*)(HID + ((size_t)(col >> 5) * MR + row) * 32 + (col & 31)) = (u32x2){pk2(r[0], r[1]), pk2(r[2], r[3])};
    }, [&](int row, int col, f32x4 v0, f32x4 v1) {
      float r[8];
#pragma unroll
      for (int e = 0; e < 4; ++e) { const float q0 = fmaxf(v0[e], 0.f), q1 = fmaxf(v1[e], 0.f); r[e] = q0 * q0; r[4 + e] = q1 * q1; }
      __builtin_nontemporal_store(((u32x4){pk2(r[0], r[1]), pk2(r[2], r[3]), pk2(r[4], r[5]), pk2(r[6], r[7])}), (u32x4*)(HID + ((size_t)(col >> 5) * MR + row) * 32 + (col & 31)));
    }, layer == 1);
    PH_END
    PH_BEGIN(11)
    gemm_phase(HID, 32, MR * 32, (const bf16_t*)(p.ws + OFF_W2), 32, 1024 * 32, 4096, 132, 8, lds, B, G, [&](int row, int col, f32x4 v) {
      float* xo = res_out_row(p, row) + col;
      const f32x4 g2 = *(const f32x4*)(mod_vec(p, layer, row) + 5120 + col);
      if (!dup) *(f32x4*)xo = *(const f32x4*)xo + g2 * v;
    }, [&](int row, int col, f32x4 v0, f32x4 v1) {
      float* xo = res_out_row(p, row) + col;
      const float* gm = mod_vec(p, layer, row) + 5120 + col;
      const f32x4 o0 = __builtin_nontemporal_load((const f32x4*)xo) + *(const f32x4*)gm * v0, o1 = __builtin_nontemporal_load((const f32x4*)(xo + 4)) + *(const f32x4*)(gm + 4) * v1;
      if (!dup) { *(f32x4*)xo = o0; *(f32x4*)(xo + 4) = o1; }
    }, layer == 1);
    PH_END
  }
}

extern "C" void kernel_launch(void* const* d_in, const int* in_sizes, int n_in, void* d_out, int out_size, void* d_ws, size_t ws_size, hipStream_t stream) {
  static int grid_blocks = 0;
  if (!grid_blocks) {
    int dev = 0, cus = 0, per_cu = 0;
    hipGetDevice(&dev);
    hipDeviceGetAttribute(&cus, hipDeviceAttributeMultiprocessorCount, dev);
    hipOccupancyMaxActiveBlocksPerMultiprocessor(&per_cu, mega, 256, 0);
    if (per_cu > 2) per_cu = 2;
    grid_blocks = cus * per_cu;
    grid_blocks -= grid_blocks % 8;
  }
  Params p{};
  const float** f = (const float**)&p;
  for (int i = 0; i < 26; ++i) f[i] = (const float*)d_in[i];
  p.out = (float*)d_out;
  p.ws = (char*)d_ws;
  p.probe = PROBE_MASK;
  if (ws_size < WS_TOTAL) { fprintf(stderr, "workspace too small: %zu < %zu\n", ws_size, (size_t)WS_TOTAL); return; }
  hipMemsetAsync((char*)d_ws + OFF_CTR, 0, 256 + 16384, stream);
  void* args[] = {&p};
  hipError_t e = hipLaunchCooperativeKernel((void*)mega, dim3(grid_blocks), dim3(256), args, 0, stream);
  if (e != hipSuccess) fprintf(stderr, "cooperative launch failed: %s (grid %d)\n", hipGetErrorString(e), grid_blocks);
}
```

```cpp
#include <hip/hip_runtime.h>
#include <hip/hip_cooperative_groups.h>
#include <cstdint>
#include <cstdio>
namespace cg = cooperative_groups;

#define DI __device__ __forceinline__
typedef unsigned short bf16_t;
typedef short bf16x8 __attribute__((ext_vector_type(8)));
typedef float f32x4 __attribute__((ext_vector_type(4)));
typedef float f32x2 __attribute__((ext_vector_type(2)));
typedef unsigned u32x4 __attribute__((ext_vector_type(4)));
typedef unsigned u32x2 __attribute__((ext_vector_type(2)));
typedef __bf16 bf16x2_t __attribute__((ext_vector_type(2)));

constexpr int DM = 1024, NB = 4, TL = 8192, TC = 256, TT = 8448, MR = NB * TT;
constexpr int LDP = 4736;
constexpr int C_DAQ = 0, C_DAK = 512, C_DAV = 1024, C_LX = 1536, C_LY = 2048, C_GQKV = 2560, C_GZ = 4096, C_GBA = 4608;
constexpr int NCH = 132;
constexpr float EPS = 1e-6f;
constexpr int LDS_BYTES = 77824;

constexpr size_t al256(size_t x) { return (x + 255) & ~(size_t)255; }
constexpr size_t OFF_WIN = 0;
constexpr size_t OFF_WBR = OFF_WIN + al256((size_t)7808 * 1024 * 2);
constexpr size_t OFF_WO = OFF_WBR + al256((size_t)3 * 1024 * 512 * 2);
constexpr size_t OFF_W1 = OFF_WO + al256((size_t)1024 * 1024 * 2);
constexpr size_t OFF_W2 = OFF_W1 + al256((size_t)4096 * 1024 * 2);
constexpr size_t OFF_LG = OFF_W2 + al256((size_t)4096 * 1024 * 2);
constexpr size_t OFF_P = OFF_LG + al256((size_t)32 * 4096 * 2);
constexpr size_t OFF_H = OFF_P + al256((size_t)MR * LDP * 2);
constexpr size_t OFF_VT = OFF_H + al256((size_t)MR * 1024 * 2);
constexpr size_t OFF_OB = OFF_VT + al256((size_t)MR * 512 * 2);
constexpr size_t OFF_HALO = OFF_OB + al256((size_t)MR * 512 * 2);
constexpr size_t OFF_GBA = OFF_HALO + al256((size_t)528 * 3 * 1536 * 2);
constexpr size_t OFF_GSC = OFF_GBA + al256((size_t)MR * 16 * 4);
constexpr size_t OFF_LC = OFF_GSC + al256((size_t)4224 * 192 * 4);
constexpr size_t OFF_CTX = OFF_LC + al256((size_t)4 * NCH * 8 * 2 * 64 * 8);
constexpr size_t OFF_MOD = OFF_CTX + al256((size_t)4 * 256 * 1024 * 4);
constexpr size_t OFF_ROPE = OFF_MOD + al256((size_t)2 * 5 * 6144 * 4);
constexpr size_t OFF_CTR = OFF_ROPE + al256((size_t)8192 * 32 * 8);
constexpr size_t WS_TOTAL = OFF_CTR + 256 + 16384;
static_assert(WS_TOTAL <= (size_t)536870912, "workspace map too large");

struct Params {
  const float *x, *c, *ctx, *cctx, *ada_w, *ada_b, *n1g, *n2g, *w_in, *daqg, *dakg, *dalam, *dasub, *lcw, *lcb, *lgw, *lgb, *llam,
      *gcw, *galog, *gdtb, *gng, *wbr, *wout, *w1, *w2;
  float* out;
  char* ws;
  int probe;
  int pad_;
};

DI unsigned pk2(float lo, float hi) { f32x2 v = {lo, hi}; bf16x2_t b = __builtin_convertvector(v, bf16x2_t); return __builtin_bit_cast(unsigned, b); }
DI bf16_t f2bf(float f) { return (bf16_t)(pk2(f, 0.f) & 0xffffu); }
DI float bf2f(bf16_t u) { return __uint_as_float(((unsigned)u) << 16); }
DI float bflo(unsigned w) { return __uint_as_float(w << 16); }
DI float bfhi(unsigned w) { return __uint_as_float(w & 0xffff0000u); }
DI int otid() { int t = __builtin_amdgcn_workitem_id_x(); asm volatile("" : "+v"(t)); return t; }
template <int M> DI float shx(float v) { return __int_as_float(__builtin_amdgcn_ds_swizzle(__float_as_int(v), (M << 10) | 0x1f)); }
DI float add32(float v) { auto r = __builtin_amdgcn_permlane32_swap(__float_as_uint(v), __float_as_uint(v), false, false); return __uint_as_float(r[0]) + __uint_as_float(r[1]); }
DI float max32(float v) { auto r = __builtin_amdgcn_permlane32_swap(__float_as_uint(v), __float_as_uint(v), false, false); return fmaxf(__uint_as_float(r[0]), __uint_as_float(r[1])); }
DI float wsum(float v) { v += shx<1>(v); v += shx<2>(v); v += shx<4>(v); v += shx<8>(v); v += shx<16>(v); return add32(v); }
DI float wmax(float v) { v = fmaxf(v, shx<1>(v)); v = fmaxf(v, shx<2>(v)); v = fmaxf(v, shx<4>(v)); v = fmaxf(v, shx<8>(v)); v = fmaxf(v, shx<16>(v)); return max32(v); }
DI float sigm(float x) { return 1.f / (1.f + __expf(-x)); }
DI float softplusf(float x) { return x > 20.f ? x : log1pf(expf(x)); }
DI f32x4 mfma16(bf16x8 a, bf16x8 b, f32x4 c) { return __builtin_amdgcn_mfma_f32_16x16x32_bf16(a, b, c, 0, 0, 0); }

DI const float* res_in_row(const Params& p, int layer, int r) {
  const int b = r / TT, s = r % TT;
  if (layer == 0) return s < TC ? p.ctx + ((size_t)b * TC + s) * DM : p.x + ((size_t)b * TL + (s - TC)) * DM;
  return s < TC ? (const float*)(p.ws + OFF_CTX) + ((size_t)b * TC + s) * DM : p.out + ((size_t)b * TL + (s - TC)) * DM;
}
DI float* res_out_row(const Params& p, int r) {
  const int b = r / TT, s = r % TT;
  return s < TC ? (float*)(p.ws + OFF_CTX) + ((size_t)b * TC + s) * DM : p.out + ((size_t)b * TL + (s - TC)) * DM;
}
DI const float* mod_vec(const Params& p, int layer, int r) {
  const int b = r / TT, s = r % TT;
  return (const float*)(p.ws + OFF_MOD) + (size_t)(layer * 5 + (s < TC ? 4 : b)) * 6144;
}

template <int WN>
DI void gemm_core(const bf16_t* __restrict__ A, int lda, int a_ks, const bf16_t* __restrict__ Bt, int ldb, int b_ks, int K, f32x4 (&acc)[4][WN], char* lds) {
  constexpr int BN = 32 * WN, AST = 72, NBP = BN * 8 / 256;
  bf16_t* As = (bf16_t*)lds;
  bf16_t* Bs = As + 2 * 128 * AST;
  const int tid = otid(), lane = tid & 63, wid = tid >> 6, wr = wid >> 1, wc = wid & 1;
  u32x4 ra[4], rb[NBP];
  const int nk = K / 64;
#define GLOAD(k0)                                                                                                            \
  {                                                                                                                          \
    _Pragma("unroll") for (int i = 0; i < 4; ++i) { const int q = tid + 256 * i; ra[i] = *(const u32x4*)(A + (size_t)(q >> 3) * lda + (size_t)(((k0) >> 5) + ((q & 7) >> 2)) * a_ks + (q & 3) * 8); } \
    _Pragma("unroll") for (int i = 0; i < NBP; ++i) { const int q = tid + 256 * i; rb[i] = *(const u32x4*)(Bt + (size_t)(q >> 3) * ldb + (size_t)(((k0) >> 5) + ((q & 7) >> 2)) * b_ks + (q & 3) * 8); } \
  }
#define SSTORE(buf)                                                                                                          \
  {                                                                                                                          \
    _Pragma("unroll") for (int i = 0; i < 4; ++i) { const int q = tid + 256 * i; *(u32x4*)(As + ((buf) * 128 + (q >> 3)) * AST + (q & 7) * 8) = ra[i]; } \
    _Pragma("unroll") for (int i = 0; i < NBP; ++i) { const int q = tid + 256 * i; *(u32x4*)(Bs + ((buf) * BN + (q >> 3)) * AST + (q & 7) * 8) = rb[i]; } \
  }
  GLOAD(0);
  SSTORE(0);
  __syncthreads();
  for (int t = 0; t < nk; ++t) {
    if (t + 1 < nk) GLOAD((t + 1) * 64);
    const bf16_t* a = As + ((t & 1) * 128 + wr * 64 + (lane & 15)) * AST + (lane >> 4) * 8;
    const bf16_t* b = Bs + ((t & 1) * BN + wc * 16 * WN + (lane & 15)) * AST + (lane >> 4) * 8;
#pragma unroll
    for (int ks = 0; ks < 2; ++ks) {
      bf16x8 af[4], bfr[WN];
#pragma unroll
      for (int i = 0; i < 4; ++i) af[i] = *(const bf16x8*)(a + i * 16 * AST + ks * 32);
#pragma unroll
      for (int j = 0; j < WN; ++j) bfr[j] = *(const bf16x8*)(b + j * 16 * AST + ks * 32);
      __builtin_amdgcn_sched_barrier(0);
#pragma unroll
      for (int i = 0; i < 4; ++i)
#pragma unroll
        for (int j = 0; j < WN; ++j) acc[i][j] = mfma16(bfr[j], af[i], acc[i][j]);
      __builtin_amdgcn_sched_barrier(0);
    }
    if (t + 1 < nk) SSTORE((t + 1) & 1);
    __syncthreads();
  }
#undef GLOAD
#undef SSTORE
}
DI void tile_mn(int t, int nm, int nn, int& mi, int& ni) {
  const int nig = 16 * nn, g = t / nig, rem = t % nig, fm = g * 16;
  const int gsz = (nm - fm) < 16 ? (nm - fm) : 16;
  mi = fm + rem % gsz;
  ni = rem / gsz;
}
template <int WN, class Epi>
DI void gemm_emit(const f32x4 (&acc)[4][WN], int m0, int n0, Epi epi) {
  const int lane = otid() & 63, wid = otid() >> 6, wr = wid >> 1, wc = wid & 1;
#pragma unroll
  for (int i = 0; i < 4; ++i)
#pragma unroll
    for (int j = 0; j < WN; ++j) epi(m0 + wr * 64 + i * 16 + (lane & 15), n0 + wc * 16 * WN + j * 16 + (lane >> 4) * 4, acc[i][j]);
}
template <int WN>
DI void zero_acc(f32x4 (&acc)[4][WN]) {
#pragma unroll
  for (int i = 0; i < 4; ++i)
#pragma unroll
    for (int j = 0; j < WN; ++j) acc[i][j] = (f32x4){0.f, 0.f, 0.f, 0.f};
}

DI void gemm_core2(const bf16_t* __restrict__ A, int lda, int a_ks, const bf16_t* __restrict__ Bt, int ldb, int b_ks, int K, f32x4 (&acc)[8][4], char* lds) {
  constexpr int AST = 48;
  bf16_t* As = (bf16_t*)lds;
  bf16_t* Bs = As + 2 * 256 * AST;
  const int tid = otid(), lane = tid & 63, wid = tid >> 6, wr = wid >> 1, wc = wid & 1;
  u32x4 s0a[4], s0b[2], s1a[4], s1b[2];
  const int nk = K / 32;
  const bf16_t* ag = A + (size_t)(tid >> 2) * lda + (tid & 3) * 8;
  const bf16_t* bg = Bt + (size_t)(tid >> 2) * ldb + (tid & 3) * 8;
  const int bc_ = tid >> 2, brow = ((bc_ >> 5) * 2 + ((bc_ >> 2) & 1)) * 16 + ((bc_ >> 3) & 3) * 4 + (bc_ & 3);
#define LBAR() { asm volatile("s_waitcnt lgkmcnt(0)" ::: "memory"); __builtin_amdgcn_s_barrier(); asm volatile("" ::: "memory"); }
#define GLOAD2(ra, rb, k0)                                                                                                   \
  {                                                                                                                          \
    _Pragma("unroll") for (int i = 0; i < 4; ++i) ra[i] = *(const u32x4*)(ag + (size_t)(64 * i) * lda + (size_t)((k0) >> 5) * a_ks);               \
    _Pragma("unroll") for (int i = 0; i < 2; ++i) rb[i] = *(const u32x4*)(bg + (size_t)(64 * i) * ldb + (size_t)((k0) >> 5) * b_ks);               \
  }
#define SSTORE2(ra, rb, buf)                                                                                                 \
  {                                                                                                                          \
    _Pragma("unroll") for (int i = 0; i < 4; ++i) *(u32x4*)(As + ((buf) * 256 + 64 * i + (tid >> 2)) * AST + (tid & 3) * 8) = ra[i]; \
    _Pragma("unroll") for (int i = 0; i < 2; ++i) *(u32x4*)(Bs + ((buf) * 128 + 64 * i + brow) * AST + (tid & 3) * 8) = rb[i]; \
  }
#define STEP2(t, la, lb, sa, sb)                                                                                             \
  {                                                                                                                          \
    if ((t) + 2 < nk) GLOAD2(la, lb, ((t) + 2) * 32);                                                                        \
    const bf16_t* a = As + (((t) & 1) * 256 + wr * 128 + (lane & 15)) * AST + (lane >> 4) * 8;                               \
    const bf16_t* b = Bs + (((t) & 1) * 128 + wc * 64 + (lane & 15)) * AST + (lane >> 4) * 8;                                \
    bf16x8 bfr[4], a0[4], a1[4];                                                                                             \
    _Pragma("unroll") for (int j = 0; j < 4; ++j) bfr[j] = *(const bf16x8*)(b + j * 16 * AST);                               \
    _Pragma("unroll") for (int i = 0; i < 4; ++i) a0[i] = *(const bf16x8*)(a + i * 16 * AST);                                \
    __builtin_amdgcn_sched_barrier(0);                                                                                       \
    _Pragma("unroll") for (int i = 0; i < 4; ++i) a1[i] = *(const bf16x8*)(a + (4 + i) * 16 * AST);                          \
    __builtin_amdgcn_sched_barrier(0);                                                                                       \
    _Pragma("unroll") for (int i = 0; i < 4; ++i) _Pragma("unroll") for (int j = 0; j < 4; ++j) acc[i][j] = mfma16(bfr[j], a0[i], acc[i][j]); \
    __builtin_amdgcn_sched_barrier(0);                                                                                       \
    _Pragma("unroll") for (int i = 0; i < 4; ++i) _Pragma("unroll") for (int j = 0; j < 4; ++j) acc[4 + i][j] = mfma16(bfr[j], a1[i], acc[4 + i][j]); \
    __builtin_amdgcn_sched_barrier(0);                                                                                       \
    if ((t) + 1 < nk) SSTORE2(sa, sb, ((t) + 1) & 1);                                                                        \
    LBAR();                                                                                                                  \
  }
  GLOAD2(s0a, s0b, 0);
  SSTORE2(s0a, s0b, 0);
  GLOAD2(s1a, s1b, 32);
  LBAR();
  int t = 0;
  for (;;) {
    STEP2(t, s0a, s0b, s1a, s1b);
    if (++t >= nk) break;
    STEP2(t, s1a, s1b, s0a, s0b);
    if (++t >= nk) break;
  }
#undef GLOAD2
#undef SSTORE2
#undef STEP2
}
DI void tile_mn8(int t, int nm, int nn, int& mi, int& ni) {
  const int nig = 8 * nn, g = t / nig, rem = t % nig, fm = g * 8;
  const int gsz = (nm - fm) < 8 ? (nm - fm) : 8;
  mi = fm + rem % gsz;
  ni = rem / gsz;
}
template <class Epi, class Epi8>
DI void gemm_phase(const bf16_t* A, int lda, int a_ks, const bf16_t* Bt, int ldb, int b_ks, int K, int nm, int nn, char* lds, int B, int G, Epi epi, Epi8 epi8, bool skipctx = false) {
  if (skipctx) nm -= 4;
  const int NT = nm * nn;
  int nfull = (NT / G) * G, R = NT - nfull;
  if (4 * R > 2 * G) { nfull = NT; R = 0; }
  for (int t = B; t < nfull + 4 * R; t += G) {
    int mi, ni;
    if (t < nfull) {
      tile_mn8(t, nm, nn, mi, ni);
      if (skipctx) mi += (mi >> 5) + 1;
      f32x4 acc[8][4];
#pragma unroll
      for (int i = 0; i < 8; ++i)
#pragma unroll
        for (int j = 0; j < 4; ++j) acc[i][j] = (f32x4){0.f, 0.f, 0.f, 0.f};
      gemm_core2(A + (size_t)mi * 256 * lda, lda, a_ks, Bt + (size_t)ni * 128 * ldb, ldb, b_ks, K, acc, lds);
      const int lane = otid() & 63, wid = otid() >> 6, wr = wid >> 1, wc = wid & 1;
#pragma unroll
      for (int i = 0; i < 8; ++i)
#pragma unroll
        for (int jp = 0; jp < 2; ++jp) epi8(mi * 256 + wr * 128 + i * 16 + (lane & 15), ni * 128 + wc * 64 + jp * 32 + (lane >> 4) * 8, acc[i][2 * jp], acc[i][2 * jp + 1]);
    } else {
      const int u = t - nfull, sub = u & 3;
      tile_mn8(nfull + (u >> 2), nm, nn, mi, ni);
      if (skipctx) mi += (mi >> 5) + 1;
      const int m0 = mi * 256 + (sub >> 1) * 128, n0 = ni * 128 + (sub & 1) * 64;
      f32x4 acc[4][2]; zero_acc<2>(acc);
      gemm_core<2>(A + (size_t)m0 * lda, lda, a_ks, Bt + (size_t)n0 * ldb, ldb, b_ks, K, acc, lds);
      gemm_emit<2>(acc, m0, n0, epi);
    }
  }
}
DI int sg_col(int gc) { const int j = gc >> 7; return (j < 12 ? 512 + 128 * j : 2560 + 128 * (j - 12)) + (gc & 127); }

constexpr int N_CVT = 1152 + 32 + 768 + 384 + 256 + 1024 + 1024 + 32;
DI void job_cvt(const Params& p, int layer, int t, char* lds) {
  const float* src; int ld, ncol0 = 0, nlim, K, ntot, nrow0 = 0; bf16_t* dst;
  char* ws = p.ws;
  if (t < 1152) { src = p.w_in + (size_t)layer * 1024 * 7696; ld = 7696; ncol0 = 0; nlim = 4608; dst = (bf16_t*)(ws + OFF_WIN); K = 1024; ntot = 7808; nrow0 = 0; }
  else if ((t -= 1152) < 32) { src = p.w_in + (size_t)layer * 1024 * 7696; ld = 7696; ncol0 = 4608; nlim = 4624; dst = (bf16_t*)(ws + OFF_WIN); K = 1024; ntot = 7808; nrow0 = 4608; }
  else if ((t -= 32) < 768) { src = p.w_in + (size_t)layer * 1024 * 7696; ld = 7696; ncol0 = 4624; nlim = 7696; dst = (bf16_t*)(ws + OFF_WIN); K = 1024; ntot = 7808; nrow0 = 4736; }
  else if ((t -= 768) < 384) { const int i = t / 128; t %= 128; src = p.wbr + ((size_t)layer * 3 + i) * 512 * 1024; ld = 1024; nlim = 1024; dst = (bf16_t*)(ws + OFF_WBR) + (size_t)i * 1024 * 512; K = 512; ntot = 1024; }
  else if ((t -= 384) < 256) { src = p.wout + (size_t)layer * 1024 * 1024; ld = 1024; nlim = 1024; dst = (bf16_t*)(ws + OFF_WO); K = 1024; ntot = 1024; }
  else if ((t -= 256) < 1024) { src = p.w1 + (size_t)layer * 1024 * 4096; ld = 4096; nlim = 4096; dst = (bf16_t*)(ws + OFF_W1); K = 1024; ntot = 4096; }
  else if ((t -= 1024) < 1024) { src = p.w2 + (size_t)layer * 4096 * 1024; ld = 1024; nlim = 1024; dst = (bf16_t*)(ws + OFF_W2); K = 4096; ntot = 1024; }
  else { t -= 1024; src = p.lgw + ((size_t)layer * 32 + t) * 4096; ld = 64; nlim = 64; dst = (bf16_t*)(ws + OFF_LG) + (size_t)t * 4096; K = 64; ntot = 0; t = 0; }
  const int nkt = K / 64, nt = t / nkt, kt = t % nkt;
  float* tl = (float*)lds;
  const int tid = otid();
  {
    const int c4 = (tid & 15) * 4, ncol = ncol0 + nt * 64 + c4;
#pragma unroll
    for (int i = 0; i < 4; ++i) {
      const int kk = i * 16 + (tid >> 4);
      f32x4 v = {0.f, 0.f, 0.f, 0.f};
      if (ncol + 3 < nlim) v = __builtin_nontemporal_load((const f32x4*)(src + (size_t)(kt * 64 + kk) * ld + ncol));
      tl[kk * 65 + c4] = v[0]; tl[kk * 65 + c4 + 1] = v[1]; tl[kk * 65 + c4 + 2] = v[2]; tl[kk * 65 + c4 + 3] = v[3];
    }
  }
  __syncthreads();
  {
    const int n = tid >> 2, kq = tid & 3;
    float v[16];
#pragma unroll
    for (int e = 0; e < 16; ++e) v[e] = tl[(kq * 16 + e) * 65 + n];
    u32x4 w0 = {pk2(v[0], v[1]), pk2(v[2], v[3]), pk2(v[4], v[5]), pk2(v[6], v[7])};
    u32x4 w1 = {pk2(v[8], v[9]), pk2(v[10], v[11]), pk2(v[12], v[13]), pk2(v[14], v[15])};
    const int nd = nrow0 + nt * 64 + n, kd = kt * 64 + kq * 16;
    bf16_t* d = ntot ? dst + ((size_t)(kd >> 5) * ntot + nd) * 32 + (kd & 31) : dst + (size_t)nd * K + kd;
    *(u32x4*)d = w0;
    *(u32x4*)(d + 8) = w1;
  }
  __syncthreads();
}
DI void job_mod(const Params& p, int it, char* lds) {
  const int nc = it % 96, l = it / 96, tid = otid();
  float* sc = (float*)lds;
  float* red = sc + 5 * 1024;
  for (int i = tid; i < 5 * 1024; i += 256) {
    const int v = i >> 10, k = i & 1023;
    const float cv = v < 4 ? p.c[v * 1024 + k] : p.cctx[k];
    sc[i] = cv * sigm(cv);
  }
  __syncthreads();
  const int cq = tid & 15, kg = tid >> 4, n = nc * 64 + cq * 4;
  const float* w = p.ada_w + ((size_t)l * 1024 + kg * 64) * 6144 + n;
  const float* s0 = sc + kg * 64;
  f32x4 a[5];
#pragma unroll
  for (int v = 0; v < 5; ++v) a[v] = (f32x4){0.f, 0.f, 0.f, 0.f};
#pragma unroll 8
  for (int k = 0; k < 64; ++k) {
    const f32x4 wv = __builtin_nontemporal_load((const f32x4*)(w + (size_t)k * 6144));
#pragma unroll
    for (int v = 0; v < 5; ++v) a[v] += wv * s0[v * 1024 + k];
  }
#pragma unroll
  for (int v = 0; v < 5; ++v)
#pragma unroll
    for (int e = 0; e < 4; ++e) red[(kg * 5 + v) * 64 + cq * 4 + e] = a[v][e];
  __syncthreads();
  for (int i = tid; i < 320; i += 256) {
    const int v = i >> 6, cc = i & 63;
    float r = p.ada_b[l * 6144 + nc * 64 + cc];
#pragma unroll
    for (int q = 0; q < 16; ++q) r += red[(q * 5 + v) * 64 + cc];
    ((float*)(p.ws + OFF_MOD))[(size_t)(l * 5 + v) * 6144 + nc * 64 + cc] = r;
  }
  __syncthreads();
}
DI void job_rope(const Params& p, int it) {
  const int idx = it * 256 + otid(), t = idx >> 5, ax = (idx >> 4) & 1, f = idx & 15;
  const float inv = powf(10000.f, -(float)f / 16.f);
  const float pos = (float)(ax ? (t & 63) : (t >> 6));
  float s, c;
  sincosf(pos * inv, &s, &c);
  ((f32x2*)(p.ws + OFF_ROPE))[idx] = (f32x2){c, s};
}
DI void job_norm(const Params& p, int layer, int which, int it) {
  const int lane = otid() & 63, wid = otid() >> 6, r = it * 8 + wid;
  const float* xr0 = (which == 1) ? res_in_row(p, layer, r) : (const float*)res_out_row(p, r);
  const float* xr1 = (which == 1) ? res_in_row(p, layer, r + 4) : (const float*)res_out_row(p, r + 4);
  const float* mv = mod_vec(p, layer, r);
  const float* sh = mv + (which == 1 ? 0 : 3072);
  const float* sc = mv + (which == 1 ? 1024 : 4096);
  const float* g = (which == 1 ? p.n1g : p.n2g) + layer * 1024;
  f32x4 xa[4], xb[4];
#pragma unroll
  for (int i = 0; i < 2; ++i)
#pragma unroll
    for (int hf = 0; hf < 2; ++hf) {
      xa[2 * i + hf] = __builtin_nontemporal_load((const f32x4*)(xr0 + i * 512 + lane * 8 + hf * 4));
      xb[2 * i + hf] = __builtin_nontemporal_load((const f32x4*)(xr1 + i * 512 + lane * 8 + hf * 4));
    }
  float sa = 0.f, sb = 0.f;
#pragma unroll
  for (int i = 0; i < 4; ++i) {
    sa += xa[i][0] * xa[i][0] + xa[i][1] * xa[i][1] + xa[i][2] * xa[i][2] + xa[i][3] * xa[i][3];
    sb += xb[i][0] * xb[i][0] + xb[i][1] * xb[i][1] + xb[i][2] * xb[i][2] + xb[i][3] * xb[i][3];
  }
  sa = wsum(sa); sb = wsum(sb);
  const float ra = rsqrtf(sa * (1.f / 1024.f) + EPS), rb = rsqrtf(sb * (1.f / 1024.f) + EPS);
  bf16_t* H0 = (bf16_t*)(p.ws + OFF_H) + (size_t)r * 32;
  bf16_t* H1 = H0 + 4 * 32;
#pragma unroll
  for (int i = 0; i < 2; ++i) {
    const int c = i * 512 + lane * 8;
    float o[8], q[8];
#pragma unroll
    for (int hf = 0; hf < 2; ++hf) {
      const f32x4 gv = *(const f32x4*)(g + c + hf * 4), sv = *(const f32x4*)(sc + c + hf * 4), hv = *(const f32x4*)(sh + c + hf * 4);
#pragma unroll
      for (int e = 0; e < 4; ++e) { const float m = gv[e] * (1.f + sv[e]); o[hf * 4 + e] = xa[2 * i + hf][e] * ra * m + hv[e]; q[hf * 4 + e] = xb[2 * i + hf][e] * rb * m + hv[e]; }
    }
    const size_t so = (size_t)(c >> 5) * MR * 32 + (c & 31);
    *(u32x4*)(H0 + so) = (u32x4){pk2(o[0], o[1]), pk2(o[2], o[3]), pk2(o[4], o[5]), pk2(o[6], o[7])};
    *(u32x4*)(H1 + so) = (u32x4){pk2(q[0], q[1]), pk2(q[2], q[3]), pk2(q[4], q[5]), pk2(q[6], q[7])};
  }
}

DI void job_daprep1(const Params& p, int layer, int r, bool dup) {
  const int lane = otid() & 63, s = r % TT;
  const int G = lane >> 2, quarter = lane & 3;
  bf16_t* ptr = (bf16_t*)(p.ws + OFF_P) + (size_t)r * LDP + (G < 8 ? C_DAQ + G * 64 : C_DAK + (G - 8) * 64) + quarter * 16;
  const u32x4 w0 = *(const u32x4*)ptr, w1 = *(const u32x4*)(ptr + 8);
  float y[16];
#pragma unroll
  for (int e = 0; e < 4; ++e) { y[2 * e] = bflo(w0[e]); y[2 * e + 1] = bfhi(w0[e]); y[8 + 2 * e] = bflo(w1[e]); y[9 + 2 * e] = bfhi(w1[e]); }
  float ss = 0.f;
#pragma unroll
  for (int e = 0; e < 16; ++e) ss += y[e] * y[e];
  ss += shx<1>(ss);
  ss += shx<2>(ss);
  float rstd = rsqrtf(ss * (1.f / 64.f) + EPS);
  const float* g = (G < 8 ? p.daqg : p.dakg) + layer * 64 + quarter * 16;
#pragma unroll
  for (int e = 0; e < 16; ++e) y[e] = y[e] * rstd * g[e];
  if (s >= TC) {
    const f32x2* tb = (const f32x2*)(p.ws + OFF_ROPE) + ((size_t)(s - TC) * 2 + (quarter >> 1)) * 16;
#pragma unroll
    for (int e = 0; e < 16; ++e) {
      const float yp = shx<1>(y[e]);
      const f32x2 cs = tb[e];
      y[e] = (quarter & 1) ? (y[e] * cs.x + yp * cs.y) : (y[e] * cs.x - yp * cs.y);
    }
  }
  if (G < 8) {
#pragma unroll
    for (int e = 0; e < 16; ++e) y[e] *= 0.125f * 1.4426950408889634f;
  }
  if (dup) return;
  *(u32x4*)ptr = (u32x4){pk2(y[0], y[1]), pk2(y[2], y[3]), pk2(y[4], y[5]), pk2(y[6], y[7])};
  *(u32x4*)(ptr + 8) = (u32x4){pk2(y[8], y[9]), pk2(y[10], y[11]), pk2(y[12], y[13]), pk2(y[14], y[15])};
}
DI void job_daprep(const Params& p, int layer, int it, bool dup) {
  const int wid = otid() >> 6;
#pragma unroll
  for (int rr = 0; rr < 2; ++rr) job_daprep1(p, layer, it * 8 + rr * 4 + wid, dup);
}
DI void job_vt(const Params& p, int it, char* lds) {
  const int h = it & 3, c = (it >> 2) % NCH, b = it / (4 * NCH), tid = otid();
  bf16_t* tl = (bf16_t*)lds;
  const bf16_t* P = (const bf16_t*)(p.ws + OFF_P);
#pragma unroll
  for (int i = 0; i < 4; ++i) {
    const int q = tid + 256 * i, row = q >> 4, pc = q & 15;
    const u32x4 w = *(const u32x4*)(P + (size_t)(b * TT + c * 64 + row) * LDP + C_DAV + h * 128 + pc * 8);
    unsigned* d = (unsigned*)(tl + row * 130 + pc * 8);
    d[0] = w[0]; d[1] = w[1]; d[2] = w[2]; d[3] = w[3];
  }
  __syncthreads();
  {
    const int dv = tid >> 1, half = tid & 1;
    unsigned o[16];
#pragma unroll
    for (int e = 0; e < 16; ++e) o[e] = (unsigned)tl[(half * 32 + 2 * e) * 130 + dv] | ((unsigned)tl[(half * 32 + 2 * e + 1) * 130 + dv] << 16);
    bf16_t* d = (bf16_t*)(p.ws + OFF_VT) + ((size_t)(b * 4 + h) * 128 + dv) * TT + c * 64 + half * 32;
#pragma unroll
#define VTW(w) o[(((w) & 3) >> 1) * 8 + ((w) >> 2) * 2 + ((w) & 1)]
    for (int e = 0; e < 4; ++e) *(u32x4*)(d + e * 8) = (u32x4){VTW(4 * e), VTW(4 * e + 1), VTW(4 * e + 2), VTW(4 * e + 3)};
#undef VTW
  }
  __syncthreads();
}

constexpr int N_ATT = 1056;
DI void job_attn(const Params& p, int layer, int a, char* lds, bool dup) {
  const int tid = otid(), lane = tid & 63, wid = tid >> 6, l15 = lane & 15, g = lane >> 4;
  const int grp = a / 528, within = a % 528, bh = grp * 8 + (within & 7), qb = within >> 3, b = bh >> 2, h = bh & 3;
  if (layer == 1 && qb < 2) return;
  const int nt = qb < 2 ? 4 : NCH;
  bf16_t* P = (bf16_t*)(p.ws + OFF_P);
  const bf16_t* VT = (const bf16_t*)(p.ws + OFF_VT) + (size_t)(b * 4 + h) * 128 * TT;
  int ly_ = layer; asm volatile("" : "+s"(ly_));
  const float lam_init = __uint_as_float(ly_ == 0 ? 0x3e4ccccdu : 0x3eb60549u);
  const float* lv = p.dalam + layer * 256;
  const float lam = __uint_as_float(__builtin_amdgcn_readfirstlane(__float_as_uint(expf(wsum(lv[lane] * lv[64 + lane])) - expf(wsum(lv[128 + lane] * lv[192 + lane])) + lam_init)));
  const float mq = wmax(fabsf(p.daqg[layer * 64 + lane])), mk = wmax(fabsf(p.dakg[layer * 64 + lane]));
  const float negMb = __uint_as_float(__builtin_amdgcn_readfirstlane(__float_as_uint(-(8.f * mq * mk * 1.03f * 1.4426950408889634f + 0.5f))));
  const int r0 = b * TT + qb * 128 + wid * 32;
  bf16x8 qf[2][2][2];
#pragma unroll
  for (int c = 0; c < 2; ++c)
#pragma unroll
    for (int i = 0; i < 2; ++i)
#pragma unroll
      for (int ks = 0; ks < 2; ++ks) qf[c][i][ks] = *(const bf16x8*)(P + (size_t)(r0 + i * 16 + l15) * LDP + C_DAQ + h * 128 + c * 64 + ks * 32 + g * 8);
  bf16_t* Ks = (bf16_t*)lds;
  bf16_t* Vs = Ks + 2 * 64 * 144;
  u32x4 rk[4], rv[4];
  const bf16_t* kg = P + (size_t)(b * TT) * LDP + C_DAK + h * 128;
#define KLOAD(t) { _Pragma("unroll") for (int i = 0; i < 4; ++i) { const int q = tid + 256 * i; rk[i] = *(const u32x4*)(kg + (size_t)((t) * 64 + (q >> 4)) * LDP + (q & 15) * 8); } }
#define VLOAD(t) { _Pragma("unroll") for (int i = 0; i < 4; ++i) { const int q = tid + 256 * i; rv[i] = *(const u32x4*)(VT + (size_t)(q >> 3) * TT + (t) * 64 + (q & 7) * 8); } }
#define KSTORE(buf) { _Pragma("unroll") for (int i = 0; i < 4; ++i) { const int q = tid + 256 * i; *(u32x4*)(Ks + ((buf) * 64 + (q >> 4)) * 144 + (q & 15) * 8) = rk[i]; } }
#define VSTORE(buf) { _Pragma("unroll") for (int i = 0; i < 4; ++i) { const int q = tid + 256 * i; *(u32x4*)(Vs + ((buf) * 128 + (q >> 3)) * 80 + (q & 7) * 8) = rv[i]; } }
#define QK_INTO(S, Kb, half, CI)                                                                                       \
  _Pragma("unroll") for (int c = 0; c < 2; ++c) {                                                                      \
    bf16x8 kf[2][2];                                                                                                   \
    _Pragma("unroll") for (int k2 = 0; k2 < 2; ++k2) _Pragma("unroll") for (int ks = 0; ks < 2; ++ks)                  \
      kf[k2][ks] = *(const bf16x8*)((Kb) + ((half) * 32 + k2 * 16 + l15) * 144 + c * 64 + ks * 32 + g * 8);             \
    __builtin_amdgcn_sched_barrier(0);                                                                                 \
    _Pragma("unroll") for (int k2 = 0; k2 < 2; ++k2) _Pragma("unroll") for (int i = 0; i < 2; ++i) {                   \
      S[c][i][k2] = mfma16(kf[k2][0], qf[c][i][0], CI(c, i));     \
      S[c][i][k2] = mfma16(kf[k2][1], qf[c][i][1], S[c][i][k2]); }                                                     \
  }                                                                                                                    \
  __builtin_amdgcn_sched_barrier(0);
#define EXPSUM(S)                                                                                                      \
  _Pragma("unroll") for (int c = 0; c < 2; ++c) _Pragma("unroll") for (int i = 0; i < 2; ++i) {                        \
    _Pragma("unroll") for (int k2 = 0; k2 < 2; ++k2) _Pragma("unroll") for (int e = 0; e < 4; ++e) S[c][i][k2][e] = __builtin_amdgcn_exp2f(S[c][i][k2][e]); \
    lsum[c][i] += ((S[c][i][0][0] + S[c][i][0][1]) + (S[c][i][0][2] + S[c][i][0][3])) + ((S[c][i][1][0] + S[c][i][1][1]) + (S[c][i][1][2] + S[c][i][1][3])); }
#define EXP_S() _Pragma("unroll") for (int c = 0; c < 2; ++c) _Pragma("unroll") for (int i = 0; i < 2; ++i) _Pragma("unroll") for (int k2 = 0; k2 < 2; ++k2) _Pragma("unroll") for (int e = 0; e < 4; ++e) S[c][i][k2][e] = __builtin_amdgcn_exp2f(S[c][i][k2][e]);
  float lsum[2][2] = {{0.f, 0.f}, {0.f, 0.f}};
  KLOAD(0);
  KSTORE(0);
  __syncthreads();
  const f32x4 negMv = {negMb, negMb, negMb, negMb};
#define CI1(c, i) negMv
  f32x4 SA[2][2][2], SB[2][2][2];
#pragma unroll 1
  for (int t = 0; t < nt; ++t) {
    if (t + 1 < nt) KLOAD(t + 1);
    const bf16_t* Kb = Ks + (t & 1) * 64 * 144;
    QK_INTO(SA, Kb, 0, CI1)
    if (t > 0) { EXPSUM(SB) }
    __builtin_amdgcn_sched_barrier(0);
    QK_INTO(SB, Kb, 1, CI1)
    EXPSUM(SA)
    if (t + 1 < nt) KSTORE((t + 1) & 1);
    __syncthreads();
  }
  EXPSUM(SB)
  f32x4 ci2[2][2];
#pragma unroll
  for (int i = 0; i < 2; ++i) {
    float l0 = lsum[0][i], l1 = lsum[1][i];
    l0 += shx<16>(l0); l0 = add32(l0);
    l1 += shx<16>(l1); l1 = add32(l1);
    const float c0 = negMb - __log2f(l0), c1 = negMb + __log2f(fabsf(lam)) - __log2f(l1);
    ci2[0][i] = (f32x4){c0, c0, c0, c0}; ci2[1][i] = (f32x4){c1, c1, c1, c1};
  }
  const float nsl = lam < 0.f ? 1.f : -1.f;
#define CI2(c, i) ci2[c][i]
  f32x4 O[2][8];
#pragma unroll
  for (int i = 0; i < 2; ++i)
#pragma unroll
    for (int n = 0; n < 8; ++n) O[i][n] = (f32x4){0.f, 0.f, 0.f, 0.f};
  KLOAD(0); VLOAD(0);
  KSTORE(0); VSTORE(0);
  __syncthreads();
#pragma unroll 1
  for (int t = 0; t < nt; ++t) {
    if (t + 1 < nt) KLOAD(t + 1);
    const bf16_t* Kb = Ks + (t & 1) * 64 * 144;
    const bf16_t* Vb = Vs + (t & 1) * 128 * 80;
#pragma unroll
    for (int half = 0; half < 2; ++half) {
      bf16x8 pf[2], vfa[4], vfb[4];
#define VREAD(dst, n0) _Pragma("unroll") for (int n = 0; n < 4; ++n) dst[n] = *(const bf16x8*)(Vb + (((n0) + n) * 16 + l15) * 80 + half * 32 + g * 8);
      {
        f32x4 S[2][2][2];
        QK_INTO(S, Kb, half, CI2)
        VREAD(vfa, 0)
        EXP_S()
#pragma unroll
        for (int i = 0; i < 2; ++i) {
          float w[8];
#pragma unroll
          for (int k2 = 0; k2 < 2; ++k2)
#pragma unroll
            for (int e = 0; e < 4; ++e) w[k2 * 4 + e] = __builtin_fmaf(nsl, S[1][i][k2][e], S[0][i][k2][e]);
          const u32x4 ww = {pk2(w[0], w[1]), pk2(w[2], w[3]), pk2(w[4], w[5]), pk2(w[6], w[7])};
          pf[i] = __builtin_bit_cast(bf16x8, ww);
        }
      }
      __builtin_amdgcn_sched_barrier(0);
      VREAD(vfb, 4)
#pragma unroll
      for (int n = 0; n < 4; ++n)
#pragma unroll
        for (int i = 0; i < 2; ++i) O[i][n] = mfma16(pf[i], vfa[n], O[i][n]);
      __builtin_amdgcn_sched_barrier(0);
#pragma unroll
      for (int n = 0; n < 4; ++n)
#pragma unroll
        for (int i = 0; i < 2; ++i) O[i][4 + n] = mfma16(pf[i], vfb[n], O[i][4 + n]);
      __builtin_amdgcn_sched_barrier(0);
#undef VREAD
      if (half == 0 && t + 1 < nt) VLOAD(t + 1);
    }
    if (t + 1 < nt) { KSTORE((t + 1) & 1); VSTORE((t + 1) & 1); }
    __syncthreads();
  }
#undef KLOAD
#undef VLOAD
#undef KSTORE
#undef VSTORE
#undef CI1
#undef CI2
#undef QK_INTO
#undef EXPSUM
#undef EXP_S
  const int lane_e = otid() & 63, l15e = lane_e & 15, ge = lane_e >> 4;
  const float* sg = p.dasub + layer * 128;
#pragma unroll
  for (int i = 0; i < 2; ++i)
#pragma unroll
    for (int e = 0; e < 4; ++e) {
      float ss = 0.f;
#pragma unroll
      for (int n = 0; n < 8; ++n) ss += O[i][n][e] * O[i][n][e];
      ss += shx<1>(ss); ss += shx<2>(ss); ss += shx<4>(ss); ss += shx<8>(ss);
      const float rstd = rsqrtf(ss * (1.f / 128.f) + EPS) * (1.f - lam_init);
      bf16_t* op = P + (size_t)(r0 + i * 16 + ge * 4 + e) * LDP + C_DAQ + h * 128 + l15e;
#pragma unroll
      for (int n = 0; n < 8; ++n) if (!dup) op[n * 16] = f2bf(O[i][n][e] * rstd * sg[n * 16 + l15e]);
    }
}

DI float gelu_tanh(float x) { const float u = 0.7978845608028654f * (x + 0.044715f * x * x * x); return 0.5f * x * (1.f + tanhf(u)); }
template <int PASS>
DI void job_lru(const Params& p, int layer, int it, char* lds, bool dup) {
  const int tid = otid(), lane = tid & 63, wid = tid >> 6, l15 = lane & 15, g = lane >> 4;
  const int n = it & 7, c = (it >> 3) % NCH, b = it / (8 * NCH);
  float* xc32 = (float*)lds;
  bf16_t* xcb = (bf16_t*)(lds + 16384);
  f32x2* ab = (f32x2*)(lds + 16384 + 9216);
  f32x2* segtot = (f32x2*)(lds + 16384 + 9216 + 32768);
  float* carry = (float*)(lds + 16384 + 9216 + 32768 + 2048);
  bf16_t* P = (bf16_t*)(p.ws + OFF_P);
  f32x2* LC = (f32x2*)(p.ws + OFF_LC);
  const int ch = tid & 63, seg = tid >> 6;
  bf16x8 gwf[2][2][2];
  {
    const bf16_t* LG = (const bf16_t*)(p.ws + OFF_LG);
#pragma unroll
    for (int d = 0; d < 2; ++d)
#pragma unroll
      for (int gt = 0; gt < 2; ++gt)
#pragma unroll
        for (int ks = 0; ks < 2; ++ks) gwf[d][gt][ks] = *(const bf16x8*)(LG + ((size_t)((d * 2 + gt) * 8 + n)) * 4096 + (wid * 16 + l15) * 64 + g * 8 + ks * 32);
  }
  {
    const int segLo = c < 4 ? 0 : TC, segHi = c < 4 ? TC : TT;
    const int cp2 = (tid & 31) * 2, tg = tid >> 5;
    const int s0 = c * 64 + tg * 8;
    float cw0[4], cw1[4];
#pragma unroll
    for (int k = 0; k < 4; ++k) { cw0[k] = p.lcw[(size_t)(layer * 4 + k) * 512 + n * 64 + cp2]; cw1[k] = p.lcw[(size_t)(layer * 4 + k) * 512 + n * 64 + cp2 + 1]; }
    const float cb0 = p.lcb[layer * 512 + n * 64 + cp2], cb1 = p.lcb[layer * 512 + n * 64 + cp2 + 1];
    unsigned xw[11];
#pragma unroll
    for (int j = 0; j < 11; ++j) {
      const int s = s0 - 1 + j;
      xw[j] = (s >= segLo && s < segHi) ? *(const unsigned*)(P + (size_t)(b * TT + s) * LDP + C_LX + n * 64 + cp2) : 0u;
    }
#pragma unroll
    for (int u = 0; u < 8; ++u) {
      const float v0 = cw0[0] * bflo(xw[u]) + cw0[1] * bflo(xw[u + 1]) + cw0[2] * bflo(xw[u + 2]) + cw0[3] * bflo(xw[u + 3]) + cb0;
      const float v1 = cw1[0] * bfhi(xw[u]) + cw1[1] * bfhi(xw[u + 1]) + cw1[2] * bfhi(xw[u + 2]) + cw1[3] * bfhi(xw[u + 3]) + cb1;
      *(f32x2*)(xc32 + (tg * 8 + u) * 64 + cp2) = (f32x2){v0, v1};
      *(unsigned*)(xcb + (tg * 8 + u) * 72 + cp2) = pk2(v0, v1);
    }
  }
  if (PASS == 3 && tid < 128) {
    const int d = tid >> 6;
    const int pos = d == 0 ? c : (c < 4 ? 3 - c : 4 + (NCH - 1 - c));
    float hh = 0.f;
    for (int q0 = 0; q0 < pos; q0 += 16) {
      f32x2 AB[16];
#pragma unroll
      for (int j = 0; j < 16; ++j) {
        const int q = q0 + j, qq = q < pos ? q : pos - 1;
        const int cc = d == 0 ? qq : (qq < 4 ? 3 - qq : NCH - 1 - (qq - 4));
        AB[j] = LC[((((size_t)b * NCH + cc) * 8 + n) * 2 + d) * 64 + ch];
      }
#pragma unroll
      for (int j = 0; j < 16; ++j) if (q0 + j < pos) hh = AB[j].x * hh + AB[j].y;
    }
    carry[d * 64 + ch] = hh;
  }
  __syncthreads();
  float hacc[16];
#pragma unroll
  for (int u = 0; u < 16; ++u) hacc[u] = 0.f;
#pragma unroll
  for (int d = 0; d < 2; ++d) {
    {
      f32x4 ar[4], ai[4];
#pragma unroll
      for (int i = 0; i < 4; ++i) { ar[i] = (f32x4){0.f, 0.f, 0.f, 0.f}; ai[i] = (f32x4){0.f, 0.f, 0.f, 0.f}; }
#pragma unroll
      for (int ks = 0; ks < 2; ++ks) {
        const bf16x8 br = gwf[d][0][ks], bi = gwf[d][1][ks];
#pragma unroll
        for (int i = 0; i < 4; ++i) {
          const bf16x8 af = *(const bf16x8*)(xcb + (i * 16 + l15) * 72 + ks * 32 + g * 8);
          ar[i] = mfma16(br, af, ar[i]);
          ai[i] = mfma16(bi, af, ai[i]);
        }
      }
#pragma unroll
      for (int e = 0; e < 4; ++e) {
        const int che = wid * 16 + g * 4 + e, cg_ = n * 64 + che;
        const float br = p.lgb[(size_t)((layer * 2 + d) * 2 + 0) * 512 + cg_], bi = p.lgb[(size_t)((layer * 2 + d) * 2 + 1) * 512 + cg_];
        const float sp = softplusf(-p.llam[(size_t)(layer * 2 + d) * 512 + cg_]);
#pragma unroll
        for (int i = 0; i < 4; ++i) {
          const int tok = i * 16 + l15;
          const float r = sigm(ar[i][e] + br), ig = sigm(ai[i][e] + bi);
          const float la = -8.f * r * sp;
          const float av = __expf(la);
          const float bv = __builtin_sqrtf(fmaxf(1.f - __expf(2.f * la), 0.f)) * ig * xc32[tok * 64 + che];
          ab[tok * 64 + che] = (f32x2){av, bv};
        }
      }
    }
    __syncthreads();
    float hloc[16], cploc[16];
    {
      float hp = 0.f, cp = 1.f;
#pragma unroll
      for (int uu = 0; uu < 16; ++uu) {
        const int u = d == 0 ? uu : 15 - uu;
        const f32x2 v = ab[(seg * 16 + u) * 64 + ch];
        hp = v.x * hp + v.y;
        cp *= v.x;
        hloc[uu] = hp; cploc[uu] = cp;
      }
      segtot[seg * 64 + ch] = (f32x2){cp, hp};
    }
    __syncthreads();
    if (PASS == 1) {
      if (tid < 64) {
        float A = 1.f, Bv = 0.f;
#pragma unroll
        for (int q = 0; q < 4; ++q) {
          const f32x2 v = segtot[(d == 0 ? q : 3 - q) * 64 + ch];
          Bv = v.x * Bv + v.y; A *= v.x;
        }
        LC[((((size_t)b * NCH + c) * 8 + n) * 2 + d) * 64 + ch] = (f32x2){A, Bv};
      }
    } else {
      float hh = carry[d * 64 + ch];
      const int npre = d == 0 ? seg : 3 - seg;
      for (int q = 0; q < npre; ++q) {
        const f32x2 v = segtot[(d == 0 ? q : 3 - q) * 64 + ch];
        hh = v.x * hh + v.y;
      }
#pragma unroll
      for (int uu = 0; uu < 16; ++uu) {
        const int u = d == 0 ? uu : 15 - uu;
        const float hv = hloc[uu] + cploc[uu] * hh;
        hacc[d == 0 ? uu : 15 - uu] += hv;
        (void)u;
      }
    }
    __syncthreads();
  }
  if (PASS == 3) {
#pragma unroll
    for (int u = 0; u < 16; ++u) xc32[(seg * 16 + u) * 64 + ch] = hacc[u];
    __syncthreads();
    const int cp2 = (tid & 31) * 2, tg = tid >> 5;
#pragma unroll
    for (int u = 0; u < 8; ++u) {
      const int tok = tg * 8 + u;
      unsigned* yp = (unsigned*)(P + (size_t)(b * TT + c * 64 + tok) * LDP + C_LY + n * 64 + cp2);
      const f32x2 hv = *(const f32x2*)(xc32 + tok * 64 + cp2);
      const unsigned y = *yp;
      if (!dup) *yp = pk2(gelu_tanh(bflo(y)) * hv.x, gelu_tanh(bfhi(y)) * hv.y);
    }
    __syncthreads();
  }
}

DI void job_gconv(const Params& p, int layer, int it, bool dup) {
  const int tid = otid(), grp = it % 12, cg_ = it / 12, cp = tid & 15, rg = tid >> 4;
  const int cin = cg_ % NCH;
  const bool first = (cin == 0 || cin == 4), last = (cin == 3 || cin == NCH - 1);
  bf16_t* P = (bf16_t*)(p.ws + OFF_P);
  const bf16_t* HALO = (const bf16_t*)(p.ws + OFF_HALO);
  const int col = grp * 128 + cp * 8;
  u32x4 xr[7];
#pragma unroll
  for (int j = 0; j < 7; ++j) {
    const int q = rg * 4 - 1 + j;
    u32x4 v = {0u, 0u, 0u, 0u};
    if (q >= 0 && q < 64) v = *(const u32x4*)(P + (size_t)(cg_ * 64 + q) * LDP + C_GQKV + col);
    else if (q < 0) { if (!first) v = *(const u32x4*)(HALO + ((size_t)(cg_ - 1) * 3 + 2) * 1536 + col); }
    else { if (!last) v = *(const u32x4*)(HALO + ((size_t)(cg_ + 1) * 3 + (q - 64)) * 1536 + col); }
    xr[j] = v;
  }
  float w[4][8];
#pragma unroll
  for (int k = 0; k < 4; ++k) {
    const f32x4 a = *(const f32x4*)(p.gcw + (size_t)(layer * 4 + k) * 1536 + col), bq = *(const f32x4*)(p.gcw + (size_t)(layer * 4 + k) * 1536 + col + 4);
#pragma unroll
    for (int e = 0; e < 4; ++e) { w[k][e] = a[e]; w[k][4 + e] = bq[e]; }
  }
  __syncthreads();
#pragma unroll
  for (int jr = 0; jr < 4; ++jr) {
    float y[8];
#pragma unroll
    for (int e = 0; e < 8; ++e) y[e] = 0.f;
#pragma unroll
    for (int k = 0; k < 4; ++k)
#pragma unroll
      for (int e = 0; e < 4; ++e) { y[2 * e] += w[k][2 * e] * bflo(xr[jr + k][e]); y[2 * e + 1] += w[k][2 * e + 1] * bfhi(xr[jr + k][e]); }
    float ss = 0.f;
#pragma unroll
    for (int e = 0; e < 8; ++e) { y[e] = y[e] * sigm(y[e]); ss += y[e] * y[e]; }
    if (grp < 8) {
      ss += shx<1>(ss); ss += shx<2>(ss); ss += shx<4>(ss); ss += shx<8>(ss);
      const float sc = rsqrtf(ss + EPS) * (grp < 4 ? 0.08838834764831845f : 1.f);
#pragma unroll
      for (int e = 0; e < 8; ++e) y[e] *= sc;
    }
    if (!dup) *(u32x4*)(P + (size_t)(cg_ * 64 + rg * 4 + jr) * LDP + C_GQKV + col) = (u32x4){pk2(y[0], y[1]), pk2(y[2], y[3]), pk2(y[4], y[5]), pk2(y[6], y[7])};
  }
  __syncthreads();
}

DI void job_gprep(const Params& p, int layer, int it, char* lds) {
  const int tid = otid(), lane = tid & 63, wid = tid >> 6, l15 = lane & 15, g = lane >> 4;
  const int h = it & 3, c = (it >> 2) % NCH, b = it / (4 * NCH);
  bf16_t* kt_ = (bf16_t*)lds;
  bf16_t* qt_ = kt_ + 64 * 136;
  float* Ld = (float*)lds;
  float* KK = (float*)(lds + 34816);
  float* QK = KK + 64 * 65;
  float* gcs = QK + 64 * 65;
  float* bts = gcs + 128;
  const bf16_t* P = (const bf16_t*)(p.ws + OFF_P);
#pragma unroll
  for (int i = 0; i < 4; ++i) {
    const int q = tid + 256 * i, row = q >> 4, pc = q & 15;
    const bf16_t* rp = P + (size_t)(b * TT + c * 64 + row) * LDP + C_GQKV + h * 128 + pc * 8;
    *(u32x4*)(qt_ + row * 136 + pc * 8) = *(const u32x4*)rp;
    *(u32x4*)(kt_ + row * 136 + pc * 8) = *(const u32x4*)(rp + 512);
  }
  float* GSC = (float*)(p.ws + OFF_GSC);
  if (tid < 128) {
    const int d = wid, i = lane, tn = d ? 63 - i : i, r = b * TT + c * 64 + tn;
    const float* gba = (const float*)(p.ws + OFF_GBA) + (size_t)r * 16;
    const float gval = -expf(p.galog[(layer * 2 + d) * 4 + h]) * softplusf(gba[8 + d * 4 + h] + p.gdtb[(layer * 2 + d) * 4 + h]);
    const float beta = sigm(gba[d * 4 + h]);
    float v = gval;
#pragma unroll
    for (int o = 1; o < 64; o <<= 1) { const float t = __int_as_float(__builtin_amdgcn_ds_bpermute(((lane - o) & 63) << 2, __float_as_int(v))); if (lane >= o) v += t; }
    const float glast = __int_as_float(__builtin_amdgcn_readlane(__float_as_int(v), 63));
    gcs[d * 64 + i] = v;
    bts[d * 64 + i] = beta;
    float* gs = GSC + (size_t)(it * 2 + d) * 192;
    gs[i] = expf(v);
    gs[64 + i] = expf(glast - v);
    if (i == 0) gs[128] = expf(glast);
  }
  __syncthreads();
  {
    f32x4 akk[4], aqk[4];
#pragma unroll
    for (int j = 0; j < 4; ++j) { akk[j] = (f32x4){0.f, 0.f, 0.f, 0.f}; aqk[j] = (f32x4){0.f, 0.f, 0.f, 0.f}; }
#pragma unroll
    for (int ks = 0; ks < 4; ++ks) {
      const bf16x8 ak = *(const bf16x8*)(kt_ + (wid * 16 + l15) * 136 + ks * 32 + g * 8);
      const bf16x8 aq = *(const bf16x8*)(qt_ + (wid * 16 + l15) * 136 + ks * 32 + g * 8);
#pragma unroll
      for (int j = 0; j < 4; ++j) {
        const bf16x8 bk = *(const bf16x8*)(kt_ + (j * 16 + l15) * 136 + ks * 32 + g * 8);
        akk[j] = mfma16(ak, bk, akk[j]);
        aqk[j] = mfma16(aq, bk, aqk[j]);
      }
    }
#pragma unroll
    for (int j = 0; j < 4; ++j)
#pragma unroll
      for (int e = 0; e < 4; ++e) { KK[(wid * 16 + g * 4 + e) * 65 + j * 16 + l15] = akk[j][e]; QK[(wid * 16 + g * 4 + e) * 65 + j * 16 + l15] = aqk[j][e]; }
  }
  __syncthreads();
  bf16_t* M1 = (bf16_t*)(p.ws + OFF_H);
  bf16_t* AT = M1 + (size_t)4224 * 4096;
#pragma unroll 1
  for (int d = 0; d < 2; ++d) {
    bf16_t* atp = AT + (size_t)(it * 2 + d) * 4096;
#pragma unroll 4
    for (int id2 = tid; id2 < 2048; id2 += 256) {
      const int idx = 2 * id2, i = idx >> 6, j = idx & 63, ti = d ? 63 - i : i, tj0 = d ? 63 - j : j, tj1 = d ? 62 - j : j + 1;
      const float gi = gcs[d * 64 + i];
      const float dec0 = (j <= i) ? expf(gi - gcs[d * 64 + j]) : 0.f, dec1 = (j + 1 <= i) ? expf(gi - gcs[d * 64 + j + 1]) : 0.f;
      const float bi = bts[d * 64 + i];
      *(f32x2*)(Ld + d * 4096 + idx) = (f32x2){(j < i) ? bi * KK[ti * 65 + tj0] * dec0 : 0.f, (j + 1 < i) ? bi * KK[ti * 65 + tj1] * dec1 : 0.f};
      *(unsigned*)(atp + idx) = pk2(QK[ti * 65 + tj0] * dec0, QK[ti * 65 + tj1] * dec1);
    }
  }
  __syncthreads();
  if (wid < 2) {
    const int d = wid;
    const float* L = Ld + d * 4096;
    const float bc = bts[d * 64 + lane];
    bf16_t* mp = M1 + (size_t)(it * 2 + d) * 4096 + lane;
    float x[64];
#pragma unroll
    for (int i = 0; i < 64; ++i) {
      float s = (i == lane) ? 1.f : 0.f;
#pragma unroll
      for (int j = 0; j < i; ++j) s -= L[i * 64 + j] * x[j];
      x[i] = s;
      mp[i * 64] = f2bf(s * bc);
    }
  }
  __syncthreads();
}

struct GChunk { bf16x8 kf[4], qf[4], m1f[2], atf[2]; unsigned vr[2][4]; float eg[4], egl[4]; float ge; };
DI void gdn_load(GChunk& R, const Params& p, int b, int h, int d, int dvs, int c) {
  const int tid = otid(), lane = tid & 63, wid = tid >> 6, l15 = lane & 15, g = lane >> 4;
  const bf16_t* P = (const bf16_t*)(p.ws + OFF_P);
  const bf16_t* M1 = (const bf16_t*)(p.ws + OFF_H);
  const bf16_t* AT = M1 + (size_t)4224 * 4096;
  const float* GSC = (const float*)(p.ws + OFF_GSC);
  const int item = ((b * NCH + c) * 4 + h) * 2 + d;
  const int irow = 16 * wid + l15, tn = d ? 63 - irow : irow;
  const bf16_t* rowp = P + (size_t)(b * TT + c * 64 + tn) * LDP + C_GQKV + h * 128;
#pragma unroll
  for (int ks = 0; ks < 4; ++ks) { R.qf[ks] = *(const bf16x8*)(rowp + ks * 32 + g * 8); R.kf[ks] = *(const bf16x8*)(rowp + 512 + ks * 32 + g * 8); }
#pragma unroll
  for (int ks = 0; ks < 2; ++ks) {
    R.m1f[ks] = *(const bf16x8*)(M1 + (size_t)item * 4096 + irow * 64 + ks * 32 + g * 8);
    R.atf[ks] = *(const bf16x8*)(AT + (size_t)item * 4096 + irow * 64 + ks * 32 + g * 8);
  }
#pragma unroll
  for (int e = 0; e < 4; ++e) {
    const int i = 16 * wid + g * 4 + e, t2 = d ? 63 - i : i;
    R.vr[0][e] = *(const unsigned*)(P + (size_t)(b * TT + c * 64 + t2) * LDP + C_GQKV + 1024 + h * 128 + dvs * 32 + (l15 & ~1));
    R.vr[1][e] = *(const unsigned*)(P + (size_t)(b * TT + c * 64 + t2) * LDP + C_GQKV + 1024 + h * 128 + dvs * 32 + 16 + (l15 & ~1));
    R.eg[e] = GSC[(size_t)item * 192 + i];
    R.egl[e] = GSC[(size_t)item * 192 + 64 + i];
  }
  R.ge = GSC[(size_t)item * 192 + 128];
}
DI void gdn_put_kt(const GChunk& R, bf16_t* KT) {
  const int tid = otid(), lane = tid & 63, i = 16 * (tid >> 6) + (lane & 15), g = lane >> 4;
#pragma unroll
  for (int ks = 0; ks < 4; ++ks)
#pragma unroll
    for (int e = 0; e < 8; ++e) KT[(ks * 32 + g * 8 + e) * 72 + i] = (bf16_t)R.kf[ks][e];
}
DI int gdn_chunk_at(int d, int n) { return d == 0 ? n : (n < 4 ? 3 - n : NCH - 1 - (n - 4)); }
DI void job_gscan(const Params& p, int u, char* lds) {
  const int tid = otid(), lane = tid & 63, wid = tid >> 6, l15 = lane & 15, g = lane >> 4;
  const int seq = (u & 7) + 8 * (u >> 5), dvs = (u >> 3) & 3, d = seq & 1, h = (seq >> 1) & 3, b = seq >> 3;
  bf16_t* KT = (bf16_t*)lds;
  bf16_t* ST = KT + 2 * 128 * 72;
  bf16_t* XT = ST + 32 * 136;
  bf16_t* VnT = XT + 32 * 72;
  bf16_t* VsT = VnT + 32 * 72;
  bf16_t* OUT = d == 0 ? (bf16_t*)(p.ws + OFF_P) + C_DAV : (bf16_t*)(p.ws + OFF_OB);
  const int ldo = d == 0 ? LDP : 512;
  __builtin_amdgcn_s_setprio(3);
  f32x4 S[2][2];
#pragma unroll
  for (int a = 0; a < 2; ++a)
#pragma unroll
    for (int ct = 0; ct < 2; ++ct) S[a][ct] = (f32x4){0.f, 0.f, 0.f, 0.f};
  for (int i = tid; i < 32 * 136 / 2; i += 256) ((unsigned*)ST)[i] = 0u;
  GChunk cur, nxt;
  gdn_load(cur, p, b, h, d, dvs, gdn_chunk_at(d, 0));
  gdn_put_kt(cur, KT);
  __syncthreads();
#pragma unroll 1
  for (int n = 0; n < NCH; ++n) {
    const int c = gdn_chunk_at(d, n);
    if (n + 1 < NCH) gdn_load(nxt, p, b, h, d, dvs, gdn_chunk_at(d, n + 1));
    const bf16_t* KTc = KT + (n & 1) * 128 * 72;
    f32x4 ksa[2], qsa[2];
#pragma unroll
    for (int ct = 0; ct < 2; ++ct) { ksa[ct] = (f32x4){0.f, 0.f, 0.f, 0.f}; qsa[ct] = (f32x4){0.f, 0.f, 0.f, 0.f}; }
#pragma unroll
    for (int ks = 0; ks < 4; ++ks)
#pragma unroll
      for (int ct = 0; ct < 2; ++ct) {
        const bf16x8 bS = *(const bf16x8*)(ST + (ct * 16 + l15) * 136 + ks * 32 + g * 8);
        ksa[ct] = mfma16(cur.kf[ks], bS, ksa[ct]);
        qsa[ct] = mfma16(cur.qf[ks], bS, qsa[ct]);
      }
#pragma unroll
    for (int ct = 0; ct < 2; ++ct) {
      float x[4];
#pragma unroll
      for (int e = 0; e < 4; ++e) x[e] = ((l15 & 1) ? bfhi(cur.vr[ct][e]) : bflo(cur.vr[ct][e])) - cur.eg[e] * ksa[ct][e];
      *(u32x2*)(XT + (ct * 16 + l15) * 72 + 16 * wid + g * 4) = (u32x2){pk2(x[0], x[1]), pk2(x[2], x[3])};
    }
    __syncthreads();
#pragma unroll
    for (int ct = 0; ct < 2; ++ct) {
      f32x4 vn = {0.f, 0.f, 0.f, 0.f};
#pragma unroll
      for (int ks = 0; ks < 2; ++ks) vn = mfma16(cur.m1f[ks], *(const bf16x8*)(XT + (ct * 16 + l15) * 72 + ks * 32 + g * 8), vn);
      *(u32x2*)(VnT + (ct * 16 + l15) * 72 + 16 * wid + g * 4) = (u32x2){pk2(vn[0], vn[1]), pk2(vn[2], vn[3])};
      *(u32x2*)(VsT + (ct * 16 + l15) * 72 + 16 * wid + g * 4) = (u32x2){pk2(vn[0] * cur.egl[0], vn[1] * cur.egl[1]), pk2(vn[2] * cur.egl[2], vn[3] * cur.egl[3])};
    }
    __syncthreads();
#pragma unroll
    for (int ct = 0; ct < 2; ++ct) {
      f32x4 o;
#pragma unroll
      for (int e = 0; e < 4; ++e) o[e] = cur.eg[e] * qsa[ct][e];
#pragma unroll
      for (int ks = 0; ks < 2; ++ks) o = mfma16(cur.atf[ks], *(const bf16x8*)(VnT + (ct * 16 + l15) * 72 + ks * 32 + g * 8), o);
#pragma unroll
      for (int e = 0; e < 4; ++e) {
        const int i = 16 * wid + g * 4 + e, t2 = d ? 63 - i : i;
        OUT[(size_t)(b * TT + c * 64 + t2) * ldo + h * 128 + dvs * 32 + ct * 16 + l15] = f2bf(o[e]);
      }
    }
#pragma unroll
    for (int rt2 = 0; rt2 < 2; ++rt2) {
      const int rt = 2 * wid + rt2;
#pragma unroll
      for (int ct = 0; ct < 2; ++ct)
#pragma unroll
        for (int e = 0; e < 4; ++e) S[rt2][ct][e] *= cur.ge;
#pragma unroll
      for (int ks = 0; ks < 2; ++ks) {
        const bf16x8 ka = *(const bf16x8*)(KTc + (rt * 16 + l15) * 72 + ks * 32 + g * 8);
#pragma unroll
        for (int ct = 0; ct < 2; ++ct) S[rt2][ct] = mfma16(ka, *(const bf16x8*)(VsT + (ct * 16 + l15) * 72 + ks * 32 + g * 8), S[rt2][ct]);
      }
#pragma unroll
      for (int ct = 0; ct < 2; ++ct)
        *(u32x2*)(ST + (ct * 16 + l15) * 136 + rt * 16 + g * 4) = (u32x2){pk2(S[rt2][ct][0], S[rt2][ct][1]), pk2(S[rt2][ct][2], S[rt2][ct][3])};
    }
    if (n + 1 < NCH) { gdn_put_kt(nxt, KT + ((n + 1) & 1) * 128 * 72); cur = nxt; }
    __syncthreads();
  }
  __builtin_amdgcn_s_setprio(0);
}
DI void job_gpost1(const Params& p, int layer, int r) {
  const int lane = otid() & 63;
  bf16_t* P = (bf16_t*)(p.ws + OFF_P) + (size_t)r * LDP;
  const bf16_t* OB = (const bf16_t*)(p.ws + OFF_OB) + (size_t)r * 512;
  const u32x4 of = *(const u32x4*)(P + C_DAV + lane * 8), ob = *(const u32x4*)(OB + lane * 8), z = *(const u32x4*)(P + C_GZ + lane * 8);
  float o[8], zz[8], ss = 0.f;
#pragma unroll
  for (int e = 0; e < 4; ++e) {
    o[2 * e] = bflo(of[e]) + bflo(ob[e]); o[2 * e + 1] = bfhi(of[e]) + bfhi(ob[e]);
    zz[2 * e] = bflo(z[e]); zz[2 * e + 1] = bfhi(z[e]);
  }
#pragma unroll
  for (int e = 0; e < 8; ++e) ss += o[e] * o[e];
  ss += shx<1>(ss); ss += shx<2>(ss); ss += shx<4>(ss); ss += shx<8>(ss);
  const float rstd = rsqrtf(ss * (1.f / 128.f) + EPS);
  const float* gn = p.gng + layer * 128 + (lane & 15) * 8;
  float y[8];
#pragma unroll
  for (int e = 0; e < 8; ++e) y[e] = o[e] * rstd * gn[e] * (zz[e] * sigm(zz[e]));
  *(u32x4*)(P + C_GZ + lane * 8) = (u32x4){pk2(y[0], y[1]), pk2(y[2], y[3]), pk2(y[4], y[5]), pk2(y[6], y[7])};
}

DI void job_gpost(const Params& p, int layer, int it) {
  const int wid = otid() >> 6;
#pragma unroll
  for (int rr = 0; rr < 2; ++rr) job_gpost1(p, layer, it * 8 + rr * 4 + wid);
}
#ifdef SK_JL1
#define JL1(x)
#else
#define JL1(x) x
#endif
#ifdef SK_JGC
#define JGC(x)
#else
#define JGC(x) x
#endif
#ifdef SK_JVT
#define JVT(x)
#else
#define JVT(x) x
#endif
#ifdef SK_JDP
#define JDP(x)
#else
#define JDP(x) x
#endif
#ifdef SK_JGP
#define JGP(x)
#else
#define JGP(x) x
#endif
#ifdef SK_JL3
#define JL3(x)
#else
#define JL3(x) x
#endif
#ifdef SK_JGS
#define JGS(x)
#else
#define JGS(x) x
#endif
#ifdef SK_JAT
#define JAT(x)
#else
#define JAT(x) x
#endif
#define LAS __attribute__((address_space(3)))
#define XB_TMO      128
#define XB_XCNT(j)  (256  + 64 * (j))
#define XB_XSUB(j)  (1280 + 64 * (j))
#define XB_XGEN(j)  (2304 + 64 * (j))
#define XB_TOP      3328
#define XB_TOPGEN   3392
#define XCD_BAR_WORDS 3456
#define XB_SPIN_CAP (1u << 18)

__device__ __forceinline__ unsigned xb_ld(unsigned* p)              { return __hip_atomic_load(p, __ATOMIC_RELAXED, __HIP_MEMORY_SCOPE_AGENT); }
__device__ __forceinline__ unsigned xb_add(unsigned* p, unsigned v) { return __hip_atomic_fetch_add(p, v, __ATOMIC_RELAXED, __HIP_MEMORY_SCOPE_AGENT); }
__device__ __forceinline__ unsigned xb_xcc_id() { return (unsigned)__builtin_amdgcn_s_getreg((3 << 11) | 20) & 0xFu; }
#define XB_SPIN(cond, bar) do { unsigned _sp = 0; while (cond) { __builtin_amdgcn_s_sleep(1); \
    if ((++_sp & 255u) == 0u) { if (xb_ld(&(bar)[XB_TMO])) break; if (_sp > XB_SPIN_CAP) { atomicAdd(&(bar)[XB_TMO], 1u); break; } } } } while (0)

struct XcdBarrier {
    unsigned* bar; unsigned x;
    volatile LAS unsigned* st;
};

__device__ __forceinline__ XcdBarrier xcd_barrier_post(unsigned* bar, volatile LAS unsigned* st) {
    XcdBarrier b; b.bar = bar; b.x = xb_xcc_id(); b.st = st;
    if (threadIdx.x == 0) (void)xb_add(&bar[XB_XCNT(b.x)], 1u);
    return b;
}
__device__ __forceinline__ void xcd_barrier_complete(unsigned* bar, unsigned x, unsigned& nloc, unsigned& nx) {
    const unsigned G = gridDim.x * gridDim.y * gridDim.z;
    unsigned sum, cnt, mine, sp = 0u;
    for (;;) {
        sum = 0u; cnt = 0u; mine = 0u;
#pragma unroll
        for (unsigned j = 0; j < 16; ++j) { const unsigned c = xb_ld(&bar[XB_XCNT(j)]); sum += c; cnt += (c > 0u) ? 1u : 0u; mine = (j == x) ? c : mine; }
        if (sum == G) break;
        __builtin_amdgcn_s_sleep(1);
        if ((++sp & 255u) == 0u) { if (xb_ld(&bar[XB_TMO])) break; if (sp > XB_SPIN_CAP) { atomicAdd(&bar[XB_TMO], 1u); break; } }
    }
    nloc = mine > 0u ? mine : 1u; nx = cnt > 0u ? cnt : 1u;
}

__device__ __forceinline__ void xcd_barrier(const XcdBarrier& b) {
    asm volatile("s_waitcnt vmcnt(0)" ::: "memory");
    __syncthreads();
    if (threadIdx.x == 0) {
        unsigned* bar = b.bar; unsigned bx_ = b.x;
        asm volatile("" : "+s"(bar), "+s"(bx_));
        __builtin_amdgcn_s_waitcnt(0);
        unsigned nloc = b.st[0], nx = b.st[1];
        if (nloc == 0u) { xcd_barrier_complete(bar, bx_, nloc, nx); b.st[0] = nloc; b.st[1] = nx; }
        const unsigned old = xb_add(&bar[XB_XSUB(bx_)], 1u);
        const unsigned gen = old / nloc;
        if (old + 1u == (gen + 1u) * nloc) {
            __builtin_amdgcn_fence(__ATOMIC_RELEASE, "agent");
            asm volatile("s_waitcnt vmcnt(0)" ::: "memory");
            const unsigned og = xb_add(&bar[XB_TOP], 1u);
            const unsigned tg = og / nx;
            if (og + 1u == (tg + 1u) * nx) xb_add(&bar[XB_TOPGEN], 1u);
            else XB_SPIN(xb_ld(&bar[XB_TOPGEN]) == tg, bar);
            __builtin_amdgcn_fence(__ATOMIC_ACQUIRE, "agent");
            xb_add(&bar[XB_XGEN(bx_)], 1u);
            asm volatile("s_waitcnt vmcnt(0)" ::: "memory");
        } else {
            XB_SPIN(xb_ld(&bar[XB_XGEN(bx_)]) == gen, bar);
            __builtin_amdgcn_fence(__ATOMIC_ACQUIRE, "agent");
            asm volatile("s_waitcnt vmcnt(0)" ::: "memory");
        }
    }
    __syncthreads();
}


#define PH_BEGIN(k) for (int rep_ = 0, nrep_ = 1 + (((p.probe >> (k)) & 1) | ((k) == 5 ? ((p.probe >> 12) | (p.probe >> 13)) & 1 : 0)); rep_ < nrep_; ++rep_) { const bool dup = rep_ > 0; (void)dup;
#define PH_END xcd_barrier(xb_); }
#ifndef PROBE_MASK
#define PROBE_MASK 0
#endif
__global__ void __launch_bounds__(256, 2) mega(Params p) {
  __shared__ __attribute__((aligned(16))) char lds[LDS_BYTES];
  __shared__ int s_item;
  __shared__ unsigned xb_st[2];
  if (otid() == 0) { xb_st[0] = 0u; xb_st[1] = 0u; }
  __syncthreads();
  const XcdBarrier xb_ = xcd_barrier_post((unsigned*)(p.ws + OFF_CTR) + 64, (volatile LAS unsigned*)xb_st);
  cg::grid_group grid = cg::this_grid();
  const int G = gridDim.x, B = blockIdx.x;
  bf16_t* P = (bf16_t*)(p.ws + OFF_P);
  bf16_t* H = (bf16_t*)(p.ws + OFF_H);
  for (int it = B; it < 192 + 1024 + N_CVT; it += G) {
    if (it < 192) job_mod(p, it, lds);
    else if (it < 1216) job_rope(p, it - 192);
    else job_cvt(p, 0, it - 1216, lds);
  }
  if (p.probe < 0) grid.sync();
  xcd_barrier(xb_);
#pragma unroll 1
  for (int layer = 0; layer < 2; ++layer) {
    bf16_t* MG = (bf16_t*)(p.ws + OFF_VT);
    bf16_t* HID = P;
    PH_BEGIN(1)
    {
      const int n1 = layer == 1 ? N_CVT : 0;
      for (int it = B; it < n1 + MR / 8; it += G) { if (it < n1) job_cvt(p, 1, it, lds); else job_norm(p, layer, 1, it - n1); }
    }
    PH_END
    PH_BEGIN(2)
    {
      bf16_t* HALO = (bf16_t*)(p.ws + OFF_HALO);
      float* GBA = (float*)(p.ws + OFF_GBA);
      gemm_phase(H, 32, MR * 32, (const bf16_t*)(p.ws + OFF_WIN), 32, 7808 * 32, 1024, 132, 37, lds, B, G, [&](int row, int col, f32x4 v) {
        if (col < C_GBA) {
          const u32x2 w = {pk2(v[0], v[1]), pk2(v[2], v[3])};
          *(u32x2*)(P + (size_t)row * LDP + col) = w;
          if (col >= C_GQKV && col < C_GZ) {
            const int sm = row & 63;
            if (sm <= 1 || sm == 63) *(u32x2*)(HALO + ((size_t)(row >> 6) * 3 + (sm == 63 ? 2 : sm)) * 1536 + (col - C_GQKV)) = w;
          }
        } else if (col < C_GBA + 16) {
          *(f32x4*)(GBA + (size_t)row * 16 + (col - C_GBA)) = v;
        }
      }, [&](int row, int col, f32x4 v0, f32x4 v1) {
        if (col < C_GBA) {
          const u32x4 w = (u32x4){pk2(v0[0], v0[1]), pk2(v0[2], v0[3]), pk2(v1[0], v1[1]), pk2(v1[2], v1[3])};
          __builtin_nontemporal_store(w, (u32x4*)(P + (size_t)row * LDP + col));
          if (col >= C_GQKV && col < C_GZ) {
            const int sm = row & 63;
            if (sm <= 1 || sm == 63) *(u32x4*)(HALO + ((size_t)(row >> 6) * 3 + (sm == 63 ? 2 : sm)) * 1536 + (col - C_GQKV)) = w;
          }
        } else if (col < C_GBA + 16) {
          *(f32x4*)(GBA + (size_t)row * 16 + (col - C_GBA)) = v0;
          *(f32x4*)(GBA + (size_t)row * 16 + (col - C_GBA) + 4) = v1;
        }
      });
    }
    PH_END
    PH_BEGIN(3)
    {
      const int nA = 8 * NCH * 4, nB = nA + 6336, nC = nB + 2112, nD = nC + MR / 8;
      for (int it = B; it < nD; it += G) {
        if (it < nA) JL1(job_lru<1>(p, layer, it, lds, dup));
        else if (it < nB) JGC(job_gconv(p, layer, it - nA, dup));
        else if (it < nC) JVT(job_vt(p, it - nB, lds));
        else JDP(job_daprep(p, layer, it - nC, dup));
      }
    }
    PH_END
    PH_BEGIN(4)
    for (int it = B; it < 2112; it += G) JGP(job_gprep(p, layer, it, lds));
    PH_END
    PH_BEGIN(5)
    {
      for (;;) {
        const int x = blockIdx.x & 7;
        if (otid() == 0) s_item = (int)__hip_atomic_fetch_add((unsigned*)(p.ws + OFF_CTR) + ((layer * 2 + rep_) * 8 + x), 1u, __ATOMIC_RELAXED, __HIP_MEMORY_SCOPE_AGENT);
        __syncthreads();
        const int j = __builtin_amdgcn_readfirstlane(s_item);
        __syncthreads();
        if (j >= 16 + 132 + 528) break;
        if (j < 16) { if (!(dup && ((p.probe >> 12) & 1))) JGS(job_gscan(p, j * 8 + x, lds)); }
        else if (j < 148) {
          const int k = j - 16, grp = k / 66, qq = k % 66, qb = qq < 64 ? qq + 2 : qq - 64;
          if (!(dup && ((p.probe >> 13) & 1))) JAT(job_attn(p, layer, grp * 528 + qb * 8 + x, lds, dup));
        } else { if (!(dup && (((p.probe >> 12) | (p.probe >> 13)) & 1))) JL3(job_lru<3>(p, layer, (j - 148) * 8 + x, lds, dup)); }
      }
    }
    PH_END
    PH_BEGIN(6)
    for (int it = B; it < MR / 8 + MR / 8; it += G) { if (it < MR / 8) job_gpost(p, layer, it); else job_norm(p, layer, 1, it - MR / 8); }
    PH_END
    PH_BEGIN(7)
    gemm_phase(H, 32, MR * 32, (const bf16_t*)(p.ws + OFF_WIN) + (size_t)4736 * 32, 32, 7808 * 32, 1024, 132, 24, lds, B, G, [&](int row, int col, f32x4 v) {
      *(u32x2*)(P + (size_t)row * LDP + sg_col(col)) = (u32x2){pk2(sigm(v[0]), sigm(v[1])), pk2(sigm(v[2]), sigm(v[3]))};
    }, [&](int row, int col, f32x4 v0, f32x4 v1) {
      *(u32x4*)(P + (size_t)row * LDP + sg_col(col)) = (u32x4){pk2(sigm(v0[0]), sigm(v0[1])), pk2(sigm(v0[2]), sigm(v0[3])), pk2(sigm(v1[0]), sigm(v1[1])), pk2(sigm(v1[2]), sigm(v1[3]))};
    }, layer == 1);
    PH_END
    PH_BEGIN(14)
    {
      const bf16_t* WBR = (const bf16_t*)(p.ws + OFF_WBR);
      const int nm14 = layer == 1 ? 256 : 264;
      for (int t = B; t < nm14 * 8; t += G) {
        int mi, ni; tile_mn(t, nm14, 8, mi, ni);
        if (layer == 1) mi += 2 * (mi >> 6) + 2;
        f32x4 mg[4][4]; zero_acc<4>(mg);
#pragma unroll 1
        for (int i = 0; i < 3; ++i) {
          f32x4 ay[4][4]; zero_acc<4>(ay);
          const int coff = i == 0 ? C_DAQ : (i == 1 ? C_LY : C_GZ);
          gemm_core<4>(P + (size_t)mi * 128 * LDP + coff, LDP, 32, WBR + (size_t)i * 1024 * 512 + (size_t)(ni * 128) * 32, 32, 1024 * 32, 512, ay, lds);
          const int lane = otid() & 63, wid = otid() >> 6, wr = wid >> 1, wc = wid & 1;
#pragma unroll
          for (int a2 = 0; a2 < 4; ++a2)
#pragma unroll
            for (int b2 = 0; b2 < 4; ++b2) {
              const int row = mi * 128 + wr * 64 + a2 * 16 + (lane & 15), col = ni * 128 + wc * 64 + b2 * 16 + (lane >> 4) * 4;
              const u32x2 sg = *(const u32x2*)(P + (size_t)row * LDP + sg_col(i * 1024 + col));
              mg[a2][b2] += (f32x4){bflo(sg.x), bfhi(sg.x), bflo(sg.y), bfhi(sg.y)} * ay[a2][b2];
            }
        }
        gemm_emit<4>(mg, mi * 128, ni * 128, [&](int row, int col, f32x4 v) { *(u32x2*)(MG + ((size_t)(col >> 5) * MR + row) * 32 + (col & 31)) = (u32x2){pk2(v[0], v[1]), pk2(v[2], v[3])}; });
      }
    }
    PH_END
    PH_BEGIN(8)
    gemm_phase(MG, 32, MR * 32, (const bf16_t*)(p.ws + OFF_WO), 32, 1024 * 32, 1024, 132, 8, lds, B, G, [&](int row, int col, f32x4 v) {
      const f32x4 xin = *(const f32x4*)(res_in_row(p, layer, row) + col);
      const f32x4 g1 = *(const f32x4*)(mod_vec(p, layer, row) + 2048 + col);
      if (!dup) *(f32x4*)(res_out_row(p, row) + col) = xin + g1 * v;
    }, [&](int row, int col, f32x4 v0, f32x4 v1) {
      const float* xi = res_in_row(p, layer, row) + col;
      const float* gm = mod_vec(p, layer, row) + 2048 + col;
      float* xo = res_out_row(p, row) + col;
      const f32x4 o0 = __builtin_nontemporal_load((const f32x4*)xi) + *(const f32x4*)gm * v0, o1 = __builtin_nontemporal_load((const f32x4*)(xi + 4)) + *(const f32x4*)(gm + 4) * v1;
      if (!dup) { *(f32x4*)xo = o0; *(f32x4*)(xo + 4) = o1; }
    }, layer == 1);
    PH_END
    PH_BEGIN(9)
    for (int it = B; it < MR / 8; it += G) job_norm(p, layer, 2, it);
    PH_END
    PH_BEGIN(10)
    gemm_phase(H, 32, MR * 32, (const bf16_t*)(p.ws + OFF_W1), 32, 4096 * 32, 1024, 132, 32, lds, B, G, [&](int row, int col, f32x4 v) {
      float r[4];
#pragma unroll
      for (int e = 0; e < 4; ++e) { const float q = fmaxf(v[e], 0.f); r[e] = q * q; }
      *(u32x2*)(HID + ((size_t)(col >> 5) * MR + row) * 32 + (col & 31)) = (u32x2){pk2(r[0], r[1]), pk2(r[2], r[3])};
    }, [&](int row, int col, f32x4 v0, f32x4 v1) {
      float r[8];
#pragma unroll
      for (int e = 0; e < 4; ++e) { const float q0 = fmaxf(v0[e], 0.f), q1 = fmaxf(v1[e], 0.f); r[e] = q0 * q0; r[4 + e] = q1 * q1; }
      __builtin_nontemporal_store(((u32x4){pk2(r[0], r[1]), pk2(r[2], r[3]), pk2(r[4], r[5]), pk2(r[6], r[7])}), (u32x4*)(HID + ((size_t)(col >> 5) * MR + row) * 32 + (col & 31)));
    }, layer == 1);
    PH_END
    PH_BEGIN(11)
    gemm_phase(HID, 32, MR * 32, (const bf16_t*)(p.ws + OFF_W2), 32, 1024 * 32, 4096, 132, 8, lds, B, G, [&](int row, int col, f32x4 v) {
      float* xo = res_out_row(p, row) + col;
      const f32x4 g2 = *(const f32x4*)(mod_vec(p, layer, row) + 5120 + col);
      if (!dup) *(f32x4*)xo = *(const f32x4*)xo + g2 * v;
    }, [&](int row, int col, f32x4 v0, f32x4 v1) {
      float* xo = res_out_row(p, row) + col;
      const float* gm = mod_vec(p, layer, row) + 5120 + col;
      const f32x4 o0 = __builtin_nontemporal_load((const f32x4*)xo) + *(const f32x4*)gm * v0, o1 = __builtin_nontemporal_load((const f32x4*)(xo + 4)) + *(const f32x4*)(gm + 4) * v1;
      if (!dup) { *(f32x4*)xo = o0; *(f32x4*)(xo + 4) = o1; }
    }, layer == 1);
    PH_END
  }
}

extern "C" void kernel_launch(void* const* d_in, const int* in_sizes, int n_in, void* d_out, int out_size, void* d_ws, size_t ws_size, hipStream_t stream) {
  static int grid_blocks = 0;
  if (!grid_blocks) {
    int dev = 0, cus = 0, per_cu = 0;
    hipGetDevice(&dev);
    hipDeviceGetAttribute(&cus, hipDeviceAttributeMultiprocessorCount, dev);
    hipOccupancyMaxActiveBlocksPerMultiprocessor(&per_cu, mega, 256, 0);
    if (per_cu > 2) per_cu = 2;
    grid_blocks = cus * per_cu;
    grid_blocks -= grid_blocks % 8;
  }
  Params p{};
  const float** f = (const float**)&p;
  for (int i = 0; i < 26; ++i) f[i] = (const float*)d_in[i];
  p.out = (float*)d_out;
  p.ws = (char*)d_ws;
  p.probe = PROBE_MASK;
  if (ws_size < WS_TOTAL) { fprintf(stderr, "workspace too small: %zu < %zu\n", ws_size, (size_t)WS_TOTAL); return; }
  hipMemsetAsync((char*)d_ws + OFF_CTR, 0, 256 + 16384, stream);
  void* args[] = {&p};
  hipError_t e = hipLaunchCooperativeKernel((void*)mega, dim3(grid_blocks), dim3(256), args, 0, stream);
  if (e != hipSuccess) fprintf(stderr, "cooperative launch failed: %s (grid %d)\n", hipGetErrorString(e), grid_blocks);
}
```

```cpp
#include <hip/hip_runtime.h>
#include <hip/hip_cooperative_groups.h>
#include <cstdint>
#include <cstdio>
namespace cg = cooperative_groups;

#define DI __device__ __forceinline__
typedef unsigned short bf16_t;
typedef short bf16x8 __attribute__((ext_vector_type(8)));
typedef float f32x4 __attribute__((ext_vector_type(4)));
typedef float f32x2 __attribute__((ext_vector_type(2)));
typedef unsigned u32x4 __attribute__((ext_vector_type(4)));
typedef unsigned u32x2 __attribute__((ext_vector_type(2)));
typedef __bf16 bf16x2_t __attribute__((ext_vector_type(2)));

constexpr int DM = 1024, NB = 4, TL = 8192, TC = 256, TT = 8448, MR = NB * TT;
constexpr int LDP = 4736;
constexpr int C_DAQ = 0, C_DAK = 512, C_DAV = 1024, C_LX = 1536, C_LY = 2048, C_GQKV = 2560, C_GZ = 4096, C_GBA = 4608;
constexpr int NCH = 132;
constexpr float EPS = 1e-6f;
constexpr int LDS_BYTES = 77824;

constexpr size_t al256(size_t x) { return (x + 255) & ~(size_t)255; }
constexpr size_t OFF_WIN = 0;
constexpr size_t OFF_WBR = OFF_WIN + al256((size_t)7808 * 1024 * 2);
constexpr size_t OFF_WO = OFF_WBR + al256((size_t)3 * 1024 * 512 * 2);
constexpr size_t OFF_W1 = OFF_WO + al256((size_t)1024 * 1024 * 2);
constexpr size_t OFF_W2 = OFF_W1 + al256((size_t)4096 * 1024 * 2);
constexpr size_t OFF_LG = OFF_W2 + al256((size_t)4096 * 1024 * 2);
constexpr size_t OFF_P = OFF_LG + al256((size_t)32 * 4096 * 2);
constexpr size_t OFF_H = OFF_P + al256((size_t)MR * LDP * 2);
constexpr size_t OFF_VT = OFF_H + al256((size_t)MR * 1024 * 2);
constexpr size_t OFF_OB = OFF_VT + al256((size_t)MR * 512 * 2);
constexpr size_t OFF_HALO = OFF_OB + al256((size_t)MR * 512 * 2);
constexpr size_t OFF_GBA = OFF_HALO + al256((size_t)528 * 3 * 1536 * 2);
constexpr size_t OFF_GSC = OFF_GBA + al256((size_t)MR * 16 * 4);
constexpr size_t OFF_LC = OFF_GSC + al256((size_t)4224 * 192 * 4);
constexpr size_t OFF_CTX = OFF_LC + al256((size_t)4 * NCH * 8 * 2 * 64 * 8);
constexpr size_t OFF_MOD = OFF_CTX + al256((size_t)4 * 256 * 1024 * 4);
constexpr size_t OFF_ROPE = OFF_MOD + al256((size_t)2 * 5 * 6144 * 4);
constexpr size_t OFF_CTR = OFF_ROPE + al256((size_t)8192 * 32 * 8);
constexpr size_t WS_TOTAL = OFF_CTR + 256 + 16384;
static_assert(WS_TOTAL <= (size_t)536870912, "workspace map too large");

struct Params {
  const float *x, *c, *ctx, *cctx, *ada_w, *ada_b, *n1g, *n2g, *w_in, *daqg, *dakg, *dalam, *dasub, *lcw, *lcb, *lgw, *lgb, *llam,
      *gcw, *galog, *gdtb, *gng, *wbr, *wout, *w1, *w2;
  float* out;
  char* ws;
  int probe;
  int pad_;
};

DI unsigned pk2(float lo, float hi) { f32x2 v = {lo, hi}; bf16x2_t b = __builtin_convertvector(v, bf16x2_t); return __builtin_bit_cast(unsigned, b); }
DI bf16_t f2bf(float f) { return (bf16_t)(pk2(f, 0.f) & 0xffffu); }
DI float bf2f(bf16_t u) { return __uint_as_float(((unsigned)u) << 16); }
DI float bflo(unsigned w) { return __uint_as_float(w << 16); }
DI float bfhi(unsigned w) { return __uint_as_float(w & 0xffff0000u); }
DI int otid() { int t = __builtin_amdgcn_workitem_id_x(); asm volatile("" : "+v"(t)); return t; }
template <int M> DI float shx(float v) { return __int_as_float(__builtin_amdgcn_ds_swizzle(__float_as_int(v), (M << 10) | 0x1f)); }
DI float add32(float v) { auto r = __builtin_amdgcn_permlane32_swap(__float_as_uint(v), __float_as_uint(v), false, false); return __uint_as_float(r[0]) + __uint_as_float(r[1]); }
DI float max32(float v) { auto r = __builtin_amdgcn_permlane32_swap(__float_as_uint(v), __float_as_uint(v), false, false); return fmaxf(__uint_as_float(r[0]), __uint_as_float(r[1])); }
DI float wsum(float v) { v += shx<1>(v); v += shx<2>(v); v += shx<4>(v); v += shx<8>(v); v += shx<16>(v); return add32(v); }
DI float wmax(float v) { v = fmaxf(v, shx<1>(v)); v = fmaxf(v, shx<2>(v)); v = fmaxf(v, shx<4>(v)); v = fmaxf(v, shx<8>(v)); v = fmaxf(v, shx<16>(v)); return max32(v); }
DI float sigm(float x) { return 1.f / (1.f + __expf(-x)); }
DI float softplusf(float x) { return x > 20.f ? x : log1pf(expf(x)); }
DI f32x4 mfma16(bf16x8 a, bf16x8 b, f32x4 c) { return __builtin_amdgcn_mfma_f32_16x16x32_bf16(a, b, c, 0, 0, 0); }

DI const float* res_in_row(const Params& p, int layer, int r) {
  const int b = r / TT, s = r % TT;
  if (layer == 0) return s < TC ? p.ctx + ((size_t)b * TC + s) * DM : p.x + ((size_t)b * TL + (s - TC)) * DM;
  return s < TC ? (const float*)(p.ws + OFF_CTX) + ((size_t)b * TC + s) * DM : p.out + ((size_t)b * TL + (s - TC)) * DM;
}
DI float* res_out_row(const Params& p, int r) {
  const int b = r / TT, s = r % TT;
  return s < TC ? (float*)(p.ws + OFF_CTX) + ((size_t)b * TC + s) * DM : p.out + ((size_t)b * TL + (s - TC)) * DM;
}
DI const float* mod_vec(const Params& p, int layer, int r) {
  const int b = r / TT, s = r % TT;
  return (const float*)(p.ws + OFF_MOD) + (size_t)(layer * 5 + (s < TC ? 4 : b)) * 6144;
}

template <int WN>
DI void gemm_core(const bf16_t* __restrict__ A, int lda, int a_ks, const bf16_t* __restrict__ Bt, int ldb, int b_ks, int K, f32x4 (&acc)[4][WN], char* lds) {
  constexpr int BN = 32 * WN, AST = 72, NBP = BN * 8 / 256;
  bf16_t* As = (bf16_t*)lds;
  bf16_t* Bs = As + 2 * 128 * AST;
  const int tid = otid(), lane = tid & 63, wid = tid >> 6, wr = wid >> 1, wc = wid & 1;
  u32x4 ra[4], rb[NBP];
  const int nk = K / 64;
#define GLOAD(k0)                                                                                                            \
  {                                                                                                                          \
    _Pragma("unroll") for (int i = 0; i < 4; ++i) { const int q = tid + 256 * i; ra[i] = *(const u32x4*)(A + (size_t)(q >> 3) * lda + (size_t)(((k0) >> 5) + ((q & 7) >> 2)) * a_ks + (q & 3) * 8); } \
    _Pragma("unroll") for (int i = 0; i < NBP; ++i) { const int q = tid + 256 * i; rb[i] = *(const u32x4*)(Bt + (size_t)(q >> 3) * ldb + (size_t)(((k0) >> 5) + ((q & 7) >> 2)) * b_ks + (q & 3) * 8); } \
  }
#define SSTORE(buf)                                                                                                          \
  {                                                                                                                          \
    _Pragma("unroll") for (int i = 0; i < 4; ++i) { const int q = tid + 256 * i; *(u32x4*)(As + ((buf) * 128 + (q >> 3)) * AST + (q & 7) * 8) = ra[i]; } \
    _Pragma("unroll") for (int i = 0; i < NBP; ++i) { const int q = tid + 256 * i; *(u32x4*)(Bs + ((buf) * BN + (q >> 3)) * AST + (q & 7) * 8) = rb[i]; } \
  }
  GLOAD(0);
  SSTORE(0);
  __syncthreads();
  for (int t = 0; t < nk; ++t) {
    if (t + 1 < nk) GLOAD((t + 1) * 64);
    const bf16_t* a = As + ((t & 1) * 128 + wr * 64 + (lane & 15)) * AST + (lane >> 4) * 8;
    const bf16_t* b = Bs + ((t & 1) * BN + wc * 16 * WN + (lane & 15)) * AST + (lane >> 4) * 8;
#pragma unroll
    for (int ks = 0; ks < 2; ++ks) {
      bf16x8 af[4], bfr[WN];
#pragma unroll
      for (int i = 0; i < 4; ++i) af[i] = *(const bf16x8*)(a + i * 16 * AST + ks * 32);
#pragma unroll
      for (int j = 0; j < WN; ++j) bfr[j] = *(const bf16x8*)(b + j * 16 * AST + ks * 32);
      __builtin_amdgcn_sched_barrier(0);
#pragma unroll
      for (int i = 0; i < 4; ++i)
#pragma unroll
        for (int j = 0; j < WN; ++j) acc[i][j] = mfma16(bfr[j], af[i], acc[i][j]);
      __builtin_amdgcn_sched_barrier(0);
    }
    if (t + 1 < nk) SSTORE((t + 1) & 1);
    __syncthreads();
  }
#undef GLOAD
#undef SSTORE
}
DI void tile_mn(int t, int nm, int nn, int& mi, int& ni) {
  const int nig = 16 * nn, g = t / nig, rem = t % nig, fm = g * 16;
  const int gsz = (nm - fm) < 16 ? (nm - fm) : 16;
  mi = fm + rem % gsz;
  ni = rem / gsz;
}
template <int WN, class Epi>
DI void gemm_emit(const f32x4 (&acc)[4][WN], int m0, int n0, Epi epi) {
  const int lane = otid() & 63, wid = otid() >> 6, wr = wid >> 1, wc = wid & 1;
#pragma unroll
  for (int i = 0; i < 4; ++i)
#pragma unroll
    for (int j = 0; j < WN; ++j) epi(m0 + wr * 64 + i * 16 + (lane & 15), n0 + wc * 16 * WN + j * 16 + (lane >> 4) * 4, acc[i][j]);
}
template <int WN>
DI void zero_acc(f32x4 (&acc)[4][WN]) {
#pragma unroll
  for (int i = 0; i < 4; ++i)
#pragma unroll
    for (int j = 0; j < WN; ++j) acc[i][j] = (f32x4){0.f, 0.f, 0.f, 0.f};
}

DI void gemm_core2(const bf16_t* __restrict__ A, int lda, int a_ks, const bf16_t* __restrict__ Bt, int ldb, int b_ks, int K, f32x4 (&acc)[8][4], char* lds) {
  constexpr int AST = 48;
  bf16_t* As = (bf16_t*)lds;
  bf16_t* Bs = As + 2 * 256 * AST;
  const int tid = otid(), lane = tid & 63, wid = tid >> 6, wr = wid >> 1, wc = wid & 1;
  u32x4 s0a[4], s0b[2], s1a[4], s1b[2];
  const int nk = K / 32;
  const bf16_t* ag = A + (size_t)(tid >> 2) * lda + (tid & 3) * 8;
  const bf16_t* bg = Bt + (size_t)(tid >> 2) * ldb + (tid & 3) * 8;
  const int bc_ = tid >> 2, brow = ((bc_ >> 5) * 2 + ((bc_ >> 2) & 1)) * 16 + ((bc_ >> 3) & 3) * 4 + (bc_ & 3);
#define LBAR() { asm volatile("s_waitcnt lgkmcnt(0)" ::: "memory"); __builtin_amdgcn_s_barrier(); asm volatile("" ::: "memory"); }
#define GLOAD2(ra, rb, k0)                                                                                                   \
  {                                                                                                                          \
    _Pragma("unroll") for (int i = 0; i < 4; ++i) ra[i] = *(const u32x4*)(ag + (size_t)(64 * i) * lda + (size_t)((k0) >> 5) * a_ks);               \
    _Pragma("unroll") for (int i = 0; i < 2; ++i) rb[i] = *(const u32x4*)(bg + (size_t)(64 * i) * ldb + (size_t)((k0) >> 5) * b_ks);               \
  }
#define SSTORE2(ra, rb, buf)                                                                                                 \
  {                                                                                                                          \
    _Pragma("unroll") for (int i = 0; i < 4; ++i) *(u32x4*)(As + ((buf) * 256 + 64 * i + (tid >> 2)) * AST + (tid & 3) * 8) = ra[i]; \
    _Pragma("unroll") for (int i = 0; i < 2; ++i) *(u32x4*)(Bs + ((buf) * 128 + 64 * i + brow) * AST + (tid & 3) * 8) = rb[i]; \
  }
#define STEP2(t, la, lb, sa, sb)                                                                                             \
  {                                                                                                                          \
    if ((t) + 2 < nk) GLOAD2(la, lb, ((t) + 2) * 32);                                                                        \
    const bf16_t* a = As + (((t) & 1) * 256 + wr * 128 + (lane & 15)) * AST + (lane >> 4) * 8;                               \
    const bf16_t* b = Bs + (((t) & 1) * 128 + wc * 64 + (lane & 15)) * AST + (lane >> 4) * 8;                                \
    bf16x8 bfr[4], a0[4], a1[4];                                                                                             \
    _Pragma("unroll") for (int j = 0; j < 4; ++j) bfr[j] = *(const bf16x8*)(b + j * 16 * AST);                               \
    _Pragma("unroll") for (int i = 0; i < 4; ++i) a0[i] = *(const bf16x8*)(a + i * 16 * AST);                                \
    __builtin_amdgcn_sched_barrier(0);                                                                                       \
    _Pragma("unroll") for (int i = 0; i < 4; ++i) a1[i] = *(const bf16x8*)(a + (4 + i) * 16 * AST);                          \
    __builtin_amdgcn_sched_barrier(0);                                                                                       \
    _Pragma("unroll") for (int i = 0; i < 4; ++i) _Pragma("unroll") for (int j = 0; j < 4; ++j) acc[i][j] = mfma16(bfr[j], a0[i], acc[i][j]); \
    __builtin_amdgcn_sched_barrier(0);                                                                                       \
    _Pragma("unroll") for (int i = 0; i < 4; ++i) _Pragma("unroll") for (int j = 0; j < 4; ++j) acc[4 + i][j] = mfma16(bfr[j], a1[i], acc[4 + i][j]); \
    __builtin_amdgcn_sched_barrier(0);                                                                                       \
    if ((t) + 1 < nk) SSTORE2(sa, sb, ((t) + 1) & 1);                                                                        \
    LBAR();                                                                                                                  \
  }
  GLOAD2(s0a, s0b, 0);
  SSTORE2(s0a, s0b, 0);
  GLOAD2(s1a, s1b, 32);
  LBAR();
  int t = 0;
  for (;;) {
    STEP2(t, s0a, s0b, s1a, s1b);
    if (++t >= nk) break;
    STEP2(t, s1a, s1b, s0a, s0b);
    if (++t >= nk) break;
  }
#undef GLOAD2
#undef SSTORE2
#undef STEP2
}
DI void tile_mn8(int t, int nm, int nn, int& mi, int& ni) {
  const int nig = 8 * nn, g = t / nig, rem = t % nig, fm = g * 8;
  const int gsz = (nm - fm) < 8 ? (nm - fm) : 8;
  mi = fm + rem % gsz;
  ni = rem / gsz;
}
template <class Epi, class Epi8>
DI void gemm_phase(const bf16_t* A, int lda, int a_ks, const bf16_t* Bt, int ldb, int b_ks, int K, int nm, int nn, char* lds, int B, int G, Epi epi, Epi8 epi8, bool skipctx = false) {
  if (skipctx) nm -= 4;
  const int NT = nm * nn;
  int nfull = (NT / G) * G, R = NT - nfull;
  if (4 * R > 2 * G) { nfull = NT; R = 0; }
  for (int t = B; t < nfull + 4 * R; t += G) {
    int mi, ni;
    if (t < nfull) {
      tile_mn8(t, nm, nn, mi, ni);
      if (skipctx) mi += (mi >> 5) + 1;
      f32x4 acc[8][4];
#pragma unroll
      for (int i = 0; i < 8; ++i)
#pragma unroll
        for (int j = 0; j < 4; ++j) acc[i][j] = (f32x4){0.f, 0.f, 0.f, 0.f};
      gemm_core2(A + (size_t)mi * 256 * lda, lda, a_ks, Bt + (size_t)ni * 128 * ldb, ldb, b_ks, K, acc, lds);
      const int lane = otid() & 63, wid = otid() >> 6, wr = wid >> 1, wc = wid & 1;
#pragma unroll
      for (int i = 0; i < 8; ++i)
#pragma unroll
        for (int jp = 0; jp < 2; ++jp) epi8(mi * 256 + wr * 128 + i * 16 + (lane & 15), ni * 128 + wc * 64 + jp * 32 + (lane >> 4) * 8, acc[i][2 * jp], acc[i][2 * jp + 1]);
    } else {
      const int u = t - nfull, sub = u & 3;
      tile_mn8(nfull + (u >> 2), nm, nn, mi, ni);
      if (skipctx) mi += (mi >> 5) + 1;
      const int m0 = mi * 256 + (sub >> 1) * 128, n0 = ni * 128 + (sub & 1) * 64;
      f32x4 acc[4][2]; zero_acc<2>(acc);
      gemm_core<2>(A + (size_t)m0 * lda, lda, a_ks, Bt + (size_t)n0 * ldb, ldb, b_ks, K, acc, lds);
      gemm_emit<2>(acc, m0, n0, epi);
    }
  }
}
DI int sg_col(int gc) { const int j = gc >> 7; return (j < 12 ? 512 + 128 * j : 2560 + 128 * (j - 12)) + (gc & 127); }

constexpr int N_CVT = 1152 + 32 + 768 + 384 + 256 + 1024 + 1024 + 32;
DI void job_cvt(const Params& p, int layer, int t, char* lds) {
  const float* src; int ld, ncol0 = 0, nlim, K, ntot, nrow0 = 0; bf16_t* dst;
  char* ws = p.ws;
  if (t < 1152) { src = p.w_in + (size_t)layer * 1024 * 7696; ld = 7696; ncol0 = 0; nlim = 4608; dst = (bf16_t*)(ws + OFF_WIN); K = 1024; ntot = 7808; nrow0 = 0; }
  else if ((t -= 1152) < 32) { src = p.w_in + (size_t)layer * 1024 * 7696; ld = 7696; ncol0 = 4608; nlim = 4624; dst = (bf16_t*)(ws + OFF_WIN); K = 1024; ntot = 7808; nrow0 = 4608; }
  else if ((t -= 32) < 768) { src = p.w_in + (size_t)layer * 1024 * 7696; ld = 7696; ncol0 = 4624; nlim = 7696; dst = (bf16_t*)(ws + OFF_WIN); K = 1024; ntot = 7808; nrow0 = 4736; }
  else if ((t -= 768) < 384) { const int i = t / 128; t %= 128; src = p.wbr + ((size_t)layer * 3 + i) * 512 * 1024; ld = 1024; nlim = 1024; dst = (bf16_t*)(ws + OFF_WBR) + (size_t)i * 1024 * 512; K = 512; ntot = 1024; }
  else if ((t -= 384) < 256) { src = p.wout + (size_t)layer * 1024 * 1024; ld = 1024; nlim = 1024; dst = (bf16_t*)(ws + OFF_WO); K = 1024; ntot = 1024; }
  else if ((t -= 256) < 1024) { src = p.w1 + (size_t)layer * 1024 * 4096; ld = 4096; nlim = 4096; dst = (bf16_t*)(ws + OFF_W1); K = 1024; ntot = 4096; }
  else if ((t -= 1024) < 1024) { src = p.w2 + (size_t)layer * 4096 * 1024; ld = 1024; nlim = 1024; dst = (bf16_t*)(ws + OFF_W2); K = 4096; ntot = 1024; }
  else { t -= 1024; src = p.lgw + ((size_t)layer * 32 + t) * 4096; ld = 64; nlim = 64; dst = (bf16_t*)(ws + OFF_LG) + (size_t)t * 4096; K = 64; ntot = 0; t = 0; }
  const int nkt = K / 64, nt = t / nkt, kt = t % nkt;
  float* tl = (float*)lds;
  const int tid = otid();
  {
    const int c4 = (tid & 15) * 4, ncol = ncol0 + nt * 64 + c4;
#pragma unroll
    for (int i = 0; i < 4; ++i) {
      const int kk = i * 16 + (tid >> 4);
      f32x4 v = {0.f, 0.f, 0.f, 0.f};
      if (ncol + 3 < nlim) v = __builtin_nontemporal_load((const f32x4*)(src + (size_t)(kt * 64 + kk) * ld + ncol));
      tl[kk * 65 + c4] = v[0]; tl[kk * 65 + c4 + 1] = v[1]; tl[kk * 65 + c4 + 2] = v[2]; tl[kk * 65 + c4 + 3] = v[3];
    }
  }
  __syncthreads();
  {
    const int n = tid >> 2, kq = tid & 3;
    float v[16];
#pragma unroll
    for (int e = 0; e < 16; ++e) v[e] = tl[(kq * 16 + e) * 65 + n];
    u32x4 w0 = {pk2(v[0], v[1]), pk2(v[2], v[3]), pk2(v[4], v[5]), pk2(v[6], v[7])};
    u32x4 w1 = {pk2(v[8], v[9]), pk2(v[10], v[11]), pk2(v[12], v[13]), pk2(v[14], v[15])};
    const int nd = nrow0 + nt * 64 + n, kd = kt * 64 + kq * 16;
    bf16_t* d = ntot ? dst + ((size_t)(kd >> 5) * ntot + nd) * 32 + (kd & 31) : dst + (size_t)nd * K + kd;
    *(u32x4*)d = w0;
    *(u32x4*)(d + 8) = w1;
  }
  __syncthreads();
}
DI void job_mod(const Params& p, int it, char* lds) {
  const int nc = it % 96, l = it / 96, tid = otid();
  float* sc = (float*)lds;
  float* red = sc + 5 * 1024;
  for (int i = tid; i < 5 * 1024; i += 256) {
    const int v = i >> 10, k = i & 1023;
    const float cv = v < 4 ? p.c[v * 1024 + k] : p.cctx[k];
    sc[i] = cv * sigm(cv);
  }
  __syncthreads();
  const int cq = tid & 15, kg = tid >> 4, n = nc * 64 + cq * 4;
  const float* w = p.ada_w + ((size_t)l * 1024 + kg * 64) * 6144 + n;
  const float* s0 = sc + kg * 64;
  f32x4 a[5];
#pragma unroll
  for (int v = 0; v < 5; ++v) a[v] = (f32x4){0.f, 0.f, 0.f, 0.f};
#pragma unroll 8
  for (int k = 0; k < 64; ++k) {
    const f32x4 wv = __builtin_nontemporal_load((const f32x4*)(w + (size_t)k * 6144));
#pragma unroll
    for (int v = 0; v < 5; ++v) a[v] += wv * s0[v * 1024 + k];
  }
#pragma unroll
  for (int v = 0; v < 5; ++v)
#pragma unroll
    for (int e = 0; e < 4; ++e) red[(kg * 5 + v) * 64 + cq * 4 + e] = a[v][e];
  __syncthreads();
  for (int i = tid; i < 320; i += 256) {
    const int v = i >> 6, cc = i & 63;
    float r = p.ada_b[l * 6144 + nc * 64 + cc];
#pragma unroll
    for (int q = 0; q < 16; ++q) r += red[(q * 5 + v) * 64 + cc];
    ((float*)(p.ws + OFF_MOD))[(size_t)(l * 5 + v) * 6144 + nc * 64 + cc] = r;
  }
  __syncthreads();
}
DI void job_rope(const Params& p, int it) {
  const int idx = it * 256 + otid(), t = idx >> 5, ax = (idx >> 4) & 1, f = idx & 15;
  const float inv = powf(10000.f, -(float)f / 16.f);
  const float pos = (float)(ax ? (t & 63) : (t >> 6));
  float s, c;
  sincosf(pos * inv, &s, &c);
  ((f32x2*)(p.ws + OFF_ROPE))[idx] = (f32x2){c, s};
}
DI void job_norm(const Params& p, int layer, int which, int it, bool skipctx = false) {
  const int lane = otid() & 63, wid = otid() >> 6, r = it * 8 + wid;
  if (skipctx && (r % TT) < TC) return;
  const float* xr0 = (which == 1) ? res_in_row(p, layer, r) : (const float*)res_out_row(p, r);
  const float* xr1 = (which == 1) ? res_in_row(p, layer, r + 4) : (const float*)res_out_row(p, r + 4);
  const float* mv = mod_vec(p, layer, r);
  const float* sh = mv + (which == 1 ? 0 : 3072);
  const float* sc = mv + (which == 1 ? 1024 : 4096);
  const float* g = (which == 1 ? p.n1g : p.n2g) + layer * 1024;
  f32x4 xa[4], xb[4];
#pragma unroll
  for (int i = 0; i < 2; ++i)
#pragma unroll
    for (int hf = 0; hf < 2; ++hf) {
      xa[2 * i + hf] = __builtin_nontemporal_load((const f32x4*)(xr0 + i * 512 + lane * 8 + hf * 4));
      xb[2 * i + hf] = __builtin_nontemporal_load((const f32x4*)(xr1 + i * 512 + lane * 8 + hf * 4));
    }
  float sa = 0.f, sb = 0.f;
#pragma unroll
  for (int i = 0; i < 4; ++i) {
    sa += xa[i][0] * xa[i][0] + xa[i][1] * xa[i][1] + xa[i][2] * xa[i][2] + xa[i][3] * xa[i][3];
    sb += xb[i][0] * xb[i][0] + xb[i][1] * xb[i][1] + xb[i][2] * xb[i][2] + xb[i][3] * xb[i][3];
  }
  sa = wsum(sa); sb = wsum(sb);
  const float ra = rsqrtf(sa * (1.f / 1024.f) + EPS), rb = rsqrtf(sb * (1.f / 1024.f) + EPS);
  bf16_t* H0 = (bf16_t*)(p.ws + OFF_H) + (size_t)r * 32;
  bf16_t* H1 = H0 + 4 * 32;
#pragma unroll
  for (int i = 0; i < 2; ++i) {
    const int c = i * 512 + lane * 8;
    float o[8], q[8];
#pragma unroll
    for (int hf = 0; hf < 2; ++hf) {
      const f32x4 gv = *(const f32x4*)(g + c + hf * 4), sv = *(const f32x4*)(sc + c + hf * 4), hv = *(const f32x4*)(sh + c + hf * 4);
#pragma unroll
      for (int e = 0; e < 4; ++e) { const float m = gv[e] * (1.f + sv[e]); o[hf * 4 + e] = xa[2 * i + hf][e] * ra * m + hv[e]; q[hf * 4 + e] = xb[2 * i + hf][e] * rb * m + hv[e]; }
    }
    const size_t so = (size_t)(c >> 5) * MR * 32 + (c & 31);
    *(u32x4*)(H0 + so) = (u32x4){pk2(o[0], o[1]), pk2(o[2], o[3]), pk2(o[4], o[5]), pk2(o[6], o[7])};
    *(u32x4*)(H1 + so) = (u32x4){pk2(q[0], q[1]), pk2(q[2], q[3]), pk2(q[4], q[5]), pk2(q[6], q[7])};
  }
}

DI void job_daprep1(const Params& p, int layer, int r, bool dup) {
  const int lane = otid() & 63, s = r % TT;
  const int G = lane >> 2, quarter = lane & 3;
  bf16_t* ptr = (bf16_t*)(p.ws + OFF_P) + (size_t)r * LDP + (G < 8 ? C_DAQ + G * 64 : C_DAK + (G - 8) * 64) + quarter * 16;
  const u32x4 w0 = *(const u32x4*)ptr, w1 = *(const u32x4*)(ptr + 8);
  float y[16];
#pragma unroll
  for (int e = 0; e < 4; ++e) { y[2 * e] = bflo(w0[e]); y[2 * e + 1] = bfhi(w0[e]); y[8 + 2 * e] = bflo(w1[e]); y[9 + 2 * e] = bfhi(w1[e]); }
  float ss = 0.f;
#pragma unroll
  for (int e = 0; e < 16; ++e) ss += y[e] * y[e];
  ss += shx<1>(ss);
  ss += shx<2>(ss);
  float rstd = rsqrtf(ss * (1.f / 64.f) + EPS);
  const float* g = (G < 8 ? p.daqg : p.dakg) + layer * 64 + quarter * 16;
#pragma unroll
  for (int e = 0; e < 16; ++e) y[e] = y[e] * rstd * g[e];
  if (s >= TC) {
    const f32x2* tb = (const f32x2*)(p.ws + OFF_ROPE) + ((size_t)(s - TC) * 2 + (quarter >> 1)) * 16;
#pragma unroll
    for (int e = 0; e < 16; ++e) {
      const float yp = shx<1>(y[e]);
      const f32x2 cs = tb[e];
      y[e] = (quarter & 1) ? (y[e] * cs.x + yp * cs.y) : (y[e] * cs.x - yp * cs.y);
    }
  }
  if (G < 8) {
#pragma unroll
    for (int e = 0; e < 16; ++e) y[e] *= 0.125f * 1.4426950408889634f;
  }
  if (dup) return;
  *(u32x4*)ptr = (u32x4){pk2(y[0], y[1]), pk2(y[2], y[3]), pk2(y[4], y[5]), pk2(y[6], y[7])};
  *(u32x4*)(ptr + 8) = (u32x4){pk2(y[8], y[9]), pk2(y[10], y[11]), pk2(y[12], y[13]), pk2(y[14], y[15])};
}
DI void job_daprep(const Params& p, int layer, int it, bool dup) {
  const int wid = otid() >> 6;
#pragma unroll
  for (int rr = 0; rr < 2; ++rr) job_daprep1(p, layer, it * 8 + rr * 4 + wid, dup);
}
DI void job_vt(const Params& p, int it, char* lds) {
  const int h = it & 3, c = (it >> 2) % NCH, b = it / (4 * NCH), tid = otid();
  bf16_t* tl = (bf16_t*)lds;
  const bf16_t* P = (const bf16_t*)(p.ws + OFF_P);
#pragma unroll
  for (int i = 0; i < 4; ++i) {
    const int q = tid + 256 * i, row = q >> 4, pc = q & 15;
    const u32x4 w = *(const u32x4*)(P + (size_t)(b * TT + c * 64 + row) * LDP + C_DAV + h * 128 + pc * 8);
    unsigned* d = (unsigned*)(tl + row * 130 + pc * 8);
    d[0] = w[0]; d[1] = w[1]; d[2] = w[2]; d[3] = w[3];
  }
  __syncthreads();
  {
    const int dv = tid >> 1, half = tid & 1;
    unsigned o[16];
#pragma unroll
    for (int e = 0; e < 16; ++e) o[e] = (unsigned)tl[(half * 32 + 2 * e) * 130 + dv] | ((unsigned)tl[(half * 32 + 2 * e + 1) * 130 + dv] << 16);
    bf16_t* d = (bf16_t*)(p.ws + OFF_VT) + ((size_t)(b * 4 + h) * 128 + dv) * TT + c * 64 + half * 32;
#pragma unroll
#define VTW(w) o[(((w) & 3) >> 1) * 8 + ((w) >> 2) * 2 + ((w) & 1)]
    for (int e = 0; e < 4; ++e) *(u32x4*)(d + e * 8) = (u32x4){VTW(4 * e), VTW(4 * e + 1), VTW(4 * e + 2), VTW(4 * e + 3)};
#undef VTW
  }
  __syncthreads();
}

constexpr int N_ATT = 1056;
DI void job_attn(const Params& p, int layer, int a, char* lds, bool dup) {
  const int tid = otid(), lane = tid & 63, wid = tid >> 6, l15 = lane & 15, g = lane >> 4;
  const int grp = a / 528, within = a % 528, bh = grp * 8 + (within & 7), qb = within >> 3, b = bh >> 2, h = bh & 3;
  if (layer == 1 && qb < 2) return;
  const int nt = qb < 2 ? 4 : NCH;
  bf16_t* P = (bf16_t*)(p.ws + OFF_P);
  const bf16_t* VT = (const bf16_t*)(p.ws + OFF_VT) + (size_t)(b * 4 + h) * 128 * TT;
  int ly_ = layer; asm volatile("" : "+s"(ly_));
  const float lam_init = __uint_as_float(ly_ == 0 ? 0x3e4ccccdu : 0x3eb60549u);
  const float* lv = p.dalam + layer * 256;
  const float lam = __uint_as_float(__builtin_amdgcn_readfirstlane(__float_as_uint(expf(wsum(lv[lane] * lv[64 + lane])) - expf(wsum(lv[128 + lane] * lv[192 + lane])) + lam_init)));
  const float mq = wmax(fabsf(p.daqg[layer * 64 + lane])), mk = wmax(fabsf(p.dakg[layer * 64 + lane]));
  const float negMb = __uint_as_float(__builtin_amdgcn_readfirstlane(__float_as_uint(-(8.f * mq * mk * 1.03f * 1.4426950408889634f + 0.5f))));
  const int r0 = b * TT + qb * 128 + wid * 32;
  bf16x8 qf[2][2][2];
#pragma unroll
  for (int c = 0; c < 2; ++c)
#pragma unroll
    for (int i = 0; i < 2; ++i)
#pragma unroll
      for (int ks = 0; ks < 2; ++ks) qf[c][i][ks] = *(const bf16x8*)(P + (size_t)(r0 + i * 16 + l15) * LDP + C_DAQ + h * 128 + c * 64 + ks * 32 + g * 8);
  bf16_t* Ks = (bf16_t*)lds;
  bf16_t* Vs = Ks + 2 * 64 * 144;
  u32x4 rk[4], rv[4];
  const bf16_t* kg = P + (size_t)(b * TT) * LDP + C_DAK + h * 128;
#define KLOAD(t) { _Pragma("unroll") for (int i = 0; i < 4; ++i) { const int q = tid + 256 * i; rk[i] = *(const u32x4*)(kg + (size_t)((t) * 64 + (q >> 4)) * LDP + (q & 15) * 8); } }
#define VLOAD(t) { _Pragma("unroll") for (int i = 0; i < 4; ++i) { const int q = tid + 256 * i; rv[i] = *(const u32x4*)(VT + (size_t)(q >> 3) * TT + (t) * 64 + (q & 7) * 8); } }
#define KSTORE(buf) { _Pragma("unroll") for (int i = 0; i < 4; ++i) { const int q = tid + 256 * i; *(u32x4*)(Ks + ((buf) * 64 + (q >> 4)) * 144 + (q & 15) * 8) = rk[i]; } }
#define VSTORE(buf) { _Pragma("unroll") for (int i = 0; i < 4; ++i) { const int q = tid + 256 * i; *(u32x4*)(Vs + ((buf) * 128 + (q >> 3)) * 80 + (q & 7) * 8) = rv[i]; } }
#define QK_INTO(S, Kb, half, CI)                                                                                       \
  _Pragma("unroll") for (int c = 0; c < 2; ++c) {                                                                      \
    bf16x8 kf[2][2];                                                                                                   \
    _Pragma("unroll") for (int k2 = 0; k2 < 2; ++k2) _Pragma("unroll") for (int ks = 0; ks < 2; ++ks)                  \
      kf[k2][ks] = *(const bf16x8*)((Kb) + ((half) * 32 + k2 * 16 + l15) * 144 + c * 64 + ks * 32 + g * 8);             \
    __builtin_amdgcn_sched_barrier(0);                                                                                 \
    _Pragma("unroll") for (int k2 = 0; k2 < 2; ++k2) _Pragma("unroll") for (int i = 0; i < 2; ++i) {                   \
      S[c][i][k2] = mfma16(kf[k2][0], qf[c][i][0], CI(c, i));     \
      S[c][i][k2] = mfma16(kf[k2][1], qf[c][i][1], S[c][i][k2]); }                                                     \
  }                                                                                                                    \
  __builtin_amdgcn_sched_barrier(0);
#define EXPSUM(S)                                                                                                      \
  _Pragma("unroll") for (int c = 0; c < 2; ++c) _Pragma("unroll") for (int i = 0; i < 2; ++i) {                        \
    _Pragma("unroll") for (int k2 = 0; k2 < 2; ++k2) _Pragma("unroll") for (int e = 0; e < 4; ++e) S[c][i][k2][e] = __builtin_amdgcn_exp2f(S[c][i][k2][e]); \
    lsum[c][i] += ((S[c][i][0][0] + S[c][i][0][1]) + (S[c][i][0][2] + S[c][i][0][3])) + ((S[c][i][1][0] + S[c][i][1][1]) + (S[c][i][1][2] + S[c][i][1][3])); }
#define EXP_S() _Pragma("unroll") for (int c = 0; c < 2; ++c) _Pragma("unroll") for (int i = 0; i < 2; ++i) _Pragma("unroll") for (int k2 = 0; k2 < 2; ++k2) _Pragma("unroll") for (int e = 0; e < 4; ++e) S[c][i][k2][e] = __builtin_amdgcn_exp2f(S[c][i][k2][e]);
  float lsum[2][2] = {{0.f, 0.f}, {0.f, 0.f}};
  KLOAD(0);
  KSTORE(0);
  __syncthreads();
  const f32x4 negMv = {negMb, negMb, negMb, negMb};
#define CI1(c, i) negMv
  f32x4 SA[2][2][2], SB[2][2][2];
#pragma unroll 1
  for (int t = 0; t < nt; ++t) {
    if (t + 1 < nt) KLOAD(t + 1);
    const bf16_t* Kb = Ks + (t & 1) * 64 * 144;
    QK_INTO(SA, Kb, 0, CI1)
    if (t > 0) { EXPSUM(SB) }
    __builtin_amdgcn_sched_barrier(0);
    QK_INTO(SB, Kb, 1, CI1)
    EXPSUM(SA)
    if (t + 1 < nt) KSTORE((t + 1) & 1);
    __syncthreads();
  }
  EXPSUM(SB)
  f32x4 ci2[2][2];
#pragma unroll
  for (int i = 0; i < 2; ++i) {
    float l0 = lsum[0][i], l1 = lsum[1][i];
    l0 += shx<16>(l0); l0 = add32(l0);
    l1 += shx<16>(l1); l1 = add32(l1);
    const float c0 = negMb - __log2f(l0), c1 = negMb + __log2f(fabsf(lam)) - __log2f(l1);
    ci2[0][i] = (f32x4){c0, c0, c0, c0}; ci2[1][i] = (f32x4){c1, c1, c1, c1};
  }
  const float nsl = lam < 0.f ? 1.f : -1.f;
#define CI2(c, i) ci2[c][i]
  f32x4 O[2][8];
#pragma unroll
  for (int i = 0; i < 2; ++i)
#pragma unroll
    for (int n = 0; n < 8; ++n) O[i][n] = (f32x4){0.f, 0.f, 0.f, 0.f};
  KLOAD(0); VLOAD(0);
  KSTORE(0); VSTORE(0);
  __syncthreads();
#pragma unroll 1
  for (int t = 0; t < nt; ++t) {
    if (t + 1 < nt) KLOAD(t + 1);
    const bf16_t* Kb = Ks + (t & 1) * 64 * 144;
    const bf16_t* Vb = Vs + (t & 1) * 128 * 80;
#pragma unroll
    for (int half = 0; half < 2; ++half) {
      bf16x8 pf[2], vfa[4], vfb[4];
#define VREAD(dst, n0) _Pragma("unroll") for (int n = 0; n < 4; ++n) dst[n] = *(const bf16x8*)(Vb + (((n0) + n) * 16 + l15) * 80 + half * 32 + g * 8);
      {
        f32x4 S[2][2][2];
        QK_INTO(S, Kb, half, CI2)
        VREAD(vfa, 0)
        EXP_S()
#pragma unroll
        for (int i = 0; i < 2; ++i) {
          float w[8];
#pragma unroll
          for (int k2 = 0; k2 < 2; ++k2)
#pragma unroll
            for (int e = 0; e < 4; ++e) w[k2 * 4 + e] = __builtin_fmaf(nsl, S[1][i][k2][e], S[0][i][k2][e]);
          const u32x4 ww = {pk2(w[0], w[1]), pk2(w[2], w[3]), pk2(w[4], w[5]), pk2(w[6], w[7])};
          pf[i] = __builtin_bit_cast(bf16x8, ww);
        }
      }
      __builtin_amdgcn_sched_barrier(0);
      VREAD(vfb, 4)
#pragma unroll
      for (int n = 0; n < 4; ++n)
#pragma unroll
        for (int i = 0; i < 2; ++i) O[i][n] = mfma16(pf[i], vfa[n], O[i][n]);
      __builtin_amdgcn_sched_barrier(0);
#pragma unroll
      for (int n = 0; n < 4; ++n)
#pragma unroll
        for (int i = 0; i < 2; ++i) O[i][4 + n] = mfma16(pf[i], vfb[n], O[i][4 + n]);
      __builtin_amdgcn_sched_barrier(0);
#undef VREAD
      if (half == 0 && t + 1 < nt) VLOAD(t + 1);
    }
    if (t + 1 < nt) { KSTORE((t + 1) & 1); VSTORE((t + 1) & 1); }
    __syncthreads();
  }
#undef KLOAD
#undef VLOAD
#undef KSTORE
#undef VSTORE
#undef CI1
#undef CI2
#undef QK_INTO
#undef EXPSUM
#undef EXP_S
  const int lane_e = otid() & 63, l15e = lane_e & 15, ge = lane_e >> 4;
  const float* sg = p.dasub + layer * 128;
#pragma unroll
  for (int i = 0; i < 2; ++i)
#pragma unroll
    for (int e = 0; e < 4; ++e) {
      float ss = 0.f;
#pragma unroll
      for (int n = 0; n < 8; ++n) ss += O[i][n][e] * O[i][n][e];
      ss += shx<1>(ss); ss += shx<2>(ss); ss += shx<4>(ss); ss += shx<8>(ss);
      const float rstd = rsqrtf(ss * (1.f / 128.f) + EPS) * (1.f - lam_init);
      bf16_t* op = P + (size_t)(r0 + i * 16 + ge * 4 + e) * LDP + C_DAQ + h * 128 + l15e;
#pragma unroll
      for (int n = 0; n < 8; ++n) if (!dup) op[n * 16] = f2bf(O[i][n][e] * rstd * sg[n * 16 + l15e]);
    }
}

DI float gelu_tanh(float x) { const float u = 0.7978845608028654f * (x + 0.044715f * x * x * x); return 0.5f * x * (1.f + tanhf(u)); }
template <int PASS>
DI void job_lru(const Params& p, int layer, int it, char* lds, bool dup) {
  const int tid = otid(), lane = tid & 63, wid = tid >> 6, l15 = lane & 15, g = lane >> 4;
  const int n = it & 7, c = (it >> 3) % NCH, b = it / (8 * NCH);
  if (PASS == 3 && layer == 1 && c < 4) return;
  float* xc32 = (float*)lds;
  bf16_t* xcb = (bf16_t*)(lds + 16384);
  f32x2* ab = (f32x2*)(lds + 16384 + 9216);
  f32x2* segtot = (f32x2*)(lds + 16384 + 9216 + 32768);
  float* carry = (float*)(lds + 16384 + 9216 + 32768 + 2048);
  bf16_t* P = (bf16_t*)(p.ws + OFF_P);
  f32x2* LC = (f32x2*)(p.ws + OFF_LC);
  const int ch = tid & 63, seg = tid >> 6;
  bf16x8 gwf[2][2][2];
  {
    const bf16_t* LG = (const bf16_t*)(p.ws + OFF_LG);
#pragma unroll
    for (int d = 0; d < 2; ++d)
#pragma unroll
      for (int gt = 0; gt < 2; ++gt)
#pragma unroll
        for (int ks = 0; ks < 2; ++ks) gwf[d][gt][ks] = *(const bf16x8*)(LG + ((size_t)((d * 2 + gt) * 8 + n)) * 4096 + (wid * 16 + l15) * 64 + g * 8 + ks * 32);
  }
  {
    const int segLo = c < 4 ? 0 : TC, segHi = c < 4 ? TC : TT;
    const int cp2 = (tid & 31) * 2, tg = tid >> 5;
    const int s0 = c * 64 + tg * 8;
    float cw0[4], cw1[4];
#pragma unroll
    for (int k = 0; k < 4; ++k) { cw0[k] = p.lcw[(size_t)(layer * 4 + k) * 512 + n * 64 + cp2]; cw1[k] = p.lcw[(size_t)(layer * 4 + k) * 512 + n * 64 + cp2 + 1]; }
    const float cb0 = p.lcb[layer * 512 + n * 64 + cp2], cb1 = p.lcb[layer * 512 + n * 64 + cp2 + 1];
    unsigned xw[11];
#pragma unroll
    for (int j = 0; j < 11; ++j) {
      const int s = s0 - 1 + j;
      xw[j] = (s >= segLo && s < segHi) ? *(const unsigned*)(P + (size_t)(b * TT + s) * LDP + C_LX + n * 64 + cp2) : 0u;
    }
#pragma unroll
    for (int u = 0; u < 8; ++u) {
      const float v0 = cw0[0] * bflo(xw[u]) + cw0[1] * bflo(xw[u + 1]) + cw0[2] * bflo(xw[u + 2]) + cw0[3] * bflo(xw[u + 3]) + cb0;
      const float v1 = cw1[0] * bfhi(xw[u]) + cw1[1] * bfhi(xw[u + 1]) + cw1[2] * bfhi(xw[u + 2]) + cw1[3] * bfhi(xw[u + 3]) + cb1;
      *(f32x2*)(xc32 + (tg * 8 + u) * 64 + cp2) = (f32x2){v0, v1};
      *(unsigned*)(xcb + (tg * 8 + u) * 72 + cp2) = pk2(v0, v1);
    }
  }
  if (PASS == 3 && tid < 128) {
    const int d = tid >> 6;
    const int pos = d == 0 ? c : (c < 4 ? 3 - c : 4 + (NCH - 1 - c));
    float hh = 0.f;
    for (int q0 = 0; q0 < pos; q0 += 16) {
      f32x2 AB[16];
#pragma unroll
      for (int j = 0; j < 16; ++j) {
        const int q = q0 + j, qq = q < pos ? q : pos - 1;
        const int cc = d == 0 ? qq : (qq < 4 ? 3 - qq : NCH - 1 - (qq - 4));
        AB[j] = LC[((((size_t)b * NCH + cc) * 8 + n) * 2 + d) * 64 + ch];
      }
#pragma unroll
      for (int j = 0; j < 16; ++j) if (q0 + j < pos) hh = AB[j].x * hh + AB[j].y;
    }
    carry[d * 64 + ch] = hh;
  }
  __syncthreads();
  float hacc[16];
#pragma unroll
  for (int u = 0; u < 16; ++u) hacc[u] = 0.f;
#pragma unroll
  for (int d = 0; d < 2; ++d) {
    {
      f32x4 ar[4], ai[4];
#pragma unroll
      for (int i = 0; i < 4; ++i) { ar[i] = (f32x4){0.f, 0.f, 0.f, 0.f}; ai[i] = (f32x4){0.f, 0.f, 0.f, 0.f}; }
#pragma unroll
      for (int ks = 0; ks < 2; ++ks) {
        const bf16x8 br = gwf[d][0][ks], bi = gwf[d][1][ks];
#pragma unroll
        for (int i = 0; i < 4; ++i) {
          const bf16x8 af = *(const bf16x8*)(xcb + (i * 16 + l15) * 72 + ks * 32 + g * 8);
          ar[i] = mfma16(br, af, ar[i]);
          ai[i] = mfma16(bi, af, ai[i]);
        }
      }
#pragma unroll
      for (int e = 0; e < 4; ++e) {
        const int che = wid * 16 + g * 4 + e, cg_ = n * 64 + che;
        const float br = p.lgb[(size_t)((layer * 2 + d) * 2 + 0) * 512 + cg_], bi = p.lgb[(size_t)((layer * 2 + d) * 2 + 1) * 512 + cg_];
        const float sp = softplusf(-p.llam[(size_t)(layer * 2 + d) * 512 + cg_]);
#pragma unroll
        for (int i = 0; i < 4; ++i) {
          const int tok = i * 16 + l15;
          const float r = sigm(ar[i][e] + br), ig = sigm(ai[i][e] + bi);
          const float la = -8.f * r * sp;
          const float av = __expf(la);
          const float bv = __builtin_sqrtf(fmaxf(1.f - __expf(2.f * la), 0.f)) * ig * xc32[tok * 64 + che];
          ab[tok * 64 + che] = (f32x2){av, bv};
        }
      }
    }
    __syncthreads();
    float hloc[16], cploc[16];
    {
      float hp = 0.f, cp = 1.f;
#pragma unroll
      for (int uu = 0; uu < 16; ++uu) {
        const int u = d == 0 ? uu : 15 - uu;
        const f32x2 v = ab[(seg * 16 + u) * 64 + ch];
        hp = v.x * hp + v.y;
        cp *= v.x;
        hloc[uu] = hp; cploc[uu] = cp;
      }
      segtot[seg * 64 + ch] = (f32x2){cp, hp};
    }
    __syncthreads();
    if (PASS == 1) {
      if (tid < 64) {
        float A = 1.f, Bv = 0.f;
#pragma unroll
        for (int q = 0; q < 4; ++q) {
          const f32x2 v = segtot[(d == 0 ? q : 3 - q) * 64 + ch];
          Bv = v.x * Bv + v.y; A *= v.x;
        }
        LC[((((size_t)b * NCH + c) * 8 + n) * 2 + d) * 64 + ch] = (f32x2){A, Bv};
      }
    } else {
      float hh = carry[d * 64 + ch];
      const int npre = d == 0 ? seg : 3 - seg;
      for (int q = 0; q < npre; ++q) {
        const f32x2 v = segtot[(d == 0 ? q : 3 - q) * 64 + ch];
        hh = v.x * hh + v.y;
      }
#pragma unroll
      for (int uu = 0; uu < 16; ++uu) {
        const int u = d == 0 ? uu : 15 - uu;
        const float hv = hloc[uu] + cploc[uu] * hh;
        hacc[d == 0 ? uu : 15 - uu] += hv;
        (void)u;
      }
    }
    __syncthreads();
  }
  if (PASS == 3) {
#pragma unroll
    for (int u = 0; u < 16; ++u) xc32[(seg * 16 + u) * 64 + ch] = hacc[u];
    __syncthreads();
    const int cp2 = (tid & 31) * 2, tg = tid >> 5;
#pragma unroll
    for (int u = 0; u < 8; ++u) {
      const int tok = tg * 8 + u;
      unsigned* yp = (unsigned*)(P + (size_t)(b * TT + c * 64 + tok) * LDP + C_LY + n * 64 + cp2);
      const f32x2 hv = *(const f32x2*)(xc32 + tok * 64 + cp2);
      const unsigned y = *yp;
      if (!dup) *yp = pk2(gelu_tanh(bflo(y)) * hv.x, gelu_tanh(bfhi(y)) * hv.y);
    }
    __syncthreads();
  }
}

DI void job_gconv(const Params& p, int layer, int it, bool dup) {
  const int tid = otid(), grp = it % 12, cg_ = it / 12, cp = tid & 15, rg = tid >> 4;
  const int cin = cg_ % NCH;
  const bool first = (cin == 0 || cin == 4), last = (cin == 3 || cin == NCH - 1);
  bf16_t* P = (bf16_t*)(p.ws + OFF_P);
  const bf16_t* HALO = (const bf16_t*)(p.ws + OFF_HALO);
  const int col = grp * 128 + cp * 8;
  u32x4 xr[7];
#pragma unroll
  for (int j = 0; j < 7; ++j) {
    const int q = rg * 4 - 1 + j;
    u32x4 v = {0u, 0u, 0u, 0u};
    if (q >= 0 && q < 64) v = *(const u32x4*)(P + (size_t)(cg_ * 64 + q) * LDP + C_GQKV + col);
    else if (q < 0) { if (!first) v = *(const u32x4*)(HALO + ((size_t)(cg_ - 1) * 3 + 2) * 1536 + col); }
    else { if (!last) v = *(const u32x4*)(HALO + ((size_t)(cg_ + 1) * 3 + (q - 64)) * 1536 + col); }
    xr[j] = v;
  }
  float w[4][8];
#pragma unroll
  for (int k = 0; k < 4; ++k) {
    const f32x4 a = *(const f32x4*)(p.gcw + (size_t)(layer * 4 + k) * 1536 + col), bq = *(const f32x4*)(p.gcw + (size_t)(layer * 4 + k) * 1536 + col + 4);
#pragma unroll
    for (int e = 0; e < 4; ++e) { w[k][e] = a[e]; w[k][4 + e] = bq[e]; }
  }
  __syncthreads();
#pragma unroll
  for (int jr = 0; jr < 4; ++jr) {
    float y[8];
#pragma unroll
    for (int e = 0; e < 8; ++e) y[e] = 0.f;
#pragma unroll
    for (int k = 0; k < 4; ++k)
#pragma unroll
      for (int e = 0; e < 4; ++e) { y[2 * e] += w[k][2 * e] * bflo(xr[jr + k][e]); y[2 * e + 1] += w[k][2 * e + 1] * bfhi(xr[jr + k][e]); }
    float ss = 0.f;
#pragma unroll
    for (int e = 0; e < 8; ++e) { y[e] = y[e] * sigm(y[e]); ss += y[e] * y[e]; }
    if (grp < 8) {
      ss += shx<1>(ss); ss += shx<2>(ss); ss += shx<4>(ss); ss += shx<8>(ss);
      const float sc = rsqrtf(ss + EPS) * (grp < 4 ? 0.08838834764831845f : 1.f);
#pragma unroll
      for (int e = 0; e < 8; ++e) y[e] *= sc;
    }
    if (!dup) *(u32x4*)(P + (size_t)(cg_ * 64 + rg * 4 + jr) * LDP + C_GQKV + col) = (u32x4){pk2(y[0], y[1]), pk2(y[2], y[3]), pk2(y[4], y[5]), pk2(y[6], y[7])};
  }
  __syncthreads();
}

DI void job_gprep(const Params& p, int layer, int it, char* lds) {
  const int tid = otid(), lane = tid & 63, wid = tid >> 6, l15 = lane & 15, g = lane >> 4;
  const int h = it & 3, c = (it >> 2) % NCH, b = it / (4 * NCH);
  bf16_t* kt_ = (bf16_t*)lds;
  bf16_t* qt_ = kt_ + 64 * 136;
  float* Ld = (float*)lds;
  float* KK = (float*)(lds + 34816);
  float* QK = KK + 64 * 65;
  float* gcs = QK + 64 * 65;
  float* bts = gcs + 128;
  const bf16_t* P = (const bf16_t*)(p.ws + OFF_P);
#pragma unroll
  for (int i = 0; i < 4; ++i) {
    const int q = tid + 256 * i, row = q >> 4, pc = q & 15;
    const bf16_t* rp = P + (size_t)(b * TT + c * 64 + row) * LDP + C_GQKV + h * 128 + pc * 8;
    *(u32x4*)(qt_ + row * 136 + pc * 8) = *(const u32x4*)rp;
    *(u32x4*)(kt_ + row * 136 + pc * 8) = *(const u32x4*)(rp + 512);
  }
  float* GSC = (float*)(p.ws + OFF_GSC);
  if (tid < 128) {
    const int d = wid, i = lane, tn = d ? 63 - i : i, r = b * TT + c * 64 + tn;
    const float* gba = (const float*)(p.ws + OFF_GBA) + (size_t)r * 16;
    const float gval = -expf(p.galog[(layer * 2 + d) * 4 + h]) * softplusf(gba[8 + d * 4 + h] + p.gdtb[(layer * 2 + d) * 4 + h]);
    const float beta = sigm(gba[d * 4 + h]);
    float v = gval;
#pragma unroll
    for (int o = 1; o < 64; o <<= 1) { const float t = __int_as_float(__builtin_amdgcn_ds_bpermute(((lane - o) & 63) << 2, __float_as_int(v))); if (lane >= o) v += t; }
    const float glast = __int_as_float(__builtin_amdgcn_readlane(__float_as_int(v), 63));
    gcs[d * 64 + i] = v;
    bts[d * 64 + i] = beta;
    float* gs = GSC + (size_t)(it * 2 + d) * 192;
    gs[i] = expf(v);
    gs[64 + i] = expf(glast - v);
    if (i == 0) gs[128] = expf(glast);
  }
  __syncthreads();
  {
    f32x4 akk[4], aqk[4];
#pragma unroll
    for (int j = 0; j < 4; ++j) { akk[j] = (f32x4){0.f, 0.f, 0.f, 0.f}; aqk[j] = (f32x4){0.f, 0.f, 0.f, 0.f}; }
#pragma unroll
    for (int ks = 0; ks < 4; ++ks) {
      const bf16x8 ak = *(const bf16x8*)(kt_ + (wid * 16 + l15) * 136 + ks * 32 + g * 8);
      const bf16x8 aq = *(const bf16x8*)(qt_ + (wid * 16 + l15) * 136 + ks * 32 + g * 8);
#pragma unroll
      for (int j = 0; j < 4; ++j) {
        const bf16x8 bk = *(const bf16x8*)(kt_ + (j * 16 + l15) * 136 + ks * 32 + g * 8);
        akk[j] = mfma16(ak, bk, akk[j]);
        aqk[j] = mfma16(aq, bk, aqk[j]);
      }
    }
#pragma unroll
    for (int j = 0; j < 4; ++j)
#pragma unroll
      for (int e = 0; e < 4; ++e) { KK[(wid * 16 + g * 4 + e) * 65 + j * 16 + l15] = akk[j][e]; QK[(wid * 16 + g * 4 + e) * 65 + j * 16 + l15] = aqk[j][e]; }
  }
  __syncthreads();
  bf16_t* M1 = (bf16_t*)(p.ws + OFF_H);
  bf16_t* AT = M1 + (size_t)4224 * 4096;
#pragma unroll 1
  for (int d = 0; d < 2; ++d) {
    bf16_t* atp = AT + (size_t)(it * 2 + d) * 4096;
#pragma unroll 4
    for (int id2 = tid; id2 < 2048; id2 += 256) {
      const int idx = 2 * id2, i = idx >> 6, j = idx & 63, ti = d ? 63 - i : i, tj0 = d ? 63 - j : j, tj1 = d ? 62 - j : j + 1;
      const float gi = gcs[d * 64 + i];
      const float dec0 = (j <= i) ? expf(gi - gcs[d * 64 + j]) : 0.f, dec1 = (j + 1 <= i) ? expf(gi - gcs[d * 64 + j + 1]) : 0.f;
      const float bi = bts[d * 64 + i];
      *(f32x2*)(Ld + d * 4096 + idx) = (f32x2){(j < i) ? bi * KK[ti * 65 + tj0] * dec0 : 0.f, (j + 1 < i) ? bi * KK[ti * 65 + tj1] * dec1 : 0.f};
      *(unsigned*)(atp + idx) = pk2(QK[ti * 65 + tj0] * dec0, QK[ti * 65 + tj1] * dec1);
    }
  }
  __syncthreads();
  if (wid < 2) {
    const int d = wid;
    const float* L = Ld + d * 4096;
    const float bc = bts[d * 64 + lane];
    bf16_t* mp = M1 + (size_t)(it * 2 + d) * 4096 + lane;
    float x[64];
#pragma unroll
    for (int i = 0; i < 64; ++i) {
      float s = (i == lane) ? 1.f : 0.f;
#pragma unroll
      for (int j = 0; j < i; ++j) s -= L[i * 64 + j] * x[j];
      x[i] = s;
      mp[i * 64] = f2bf(s * bc);
    }
  }
  __syncthreads();
}

struct GChunk { bf16x8 kf[4], qf[4], m1f[2], atf[2]; unsigned vr[2][4]; float eg[4], egl[4]; float ge; };
DI void gdn_load(GChunk& R, const Params& p, int b, int h, int d, int dvs, int c) {
  const int tid = otid(), lane = tid & 63, wid = tid >> 6, l15 = lane & 15, g = lane >> 4;
  const bf16_t* P = (const bf16_t*)(p.ws + OFF_P);
  const bf16_t* M1 = (const bf16_t*)(p.ws + OFF_H);
  const bf16_t* AT = M1 + (size_t)4224 * 4096;
  const float* GSC = (const float*)(p.ws + OFF_GSC);
  const int item = ((b * NCH + c) * 4 + h) * 2 + d;
  const int irow = 16 * wid + l15, tn = d ? 63 - irow : irow;
  const bf16_t* rowp = P + (size_t)(b * TT + c * 64 + tn) * LDP + C_GQKV + h * 128;
#pragma unroll
  for (int ks = 0; ks < 4; ++ks) { R.qf[ks] = *(const bf16x8*)(rowp + ks * 32 + g * 8); R.kf[ks] = *(const bf16x8*)(rowp + 512 + ks * 32 + g * 8); }
#pragma unroll
  for (int ks = 0; ks < 2; ++ks) {
    R.m1f[ks] = *(const bf16x8*)(M1 + (size_t)item * 4096 + irow * 64 + ks * 32 + g * 8);
    R.atf[ks] = *(const bf16x8*)(AT + (size_t)item * 4096 + irow * 64 + ks * 32 + g * 8);
  }
#pragma unroll
  for (int e = 0; e < 4; ++e) {
    const int i = 16 * wid + g * 4 + e, t2 = d ? 63 - i : i;
    R.vr[0][e] = *(const unsigned*)(P + (size_t)(b * TT + c * 64 + t2) * LDP + C_GQKV + 1024 + h * 128 + dvs * 32 + (l15 & ~1));
    R.vr[1][e] = *(const unsigned*)(P + (size_t)(b * TT + c * 64 + t2) * LDP + C_GQKV + 1024 + h * 128 + dvs * 32 + 16 + (l15 & ~1));
    R.eg[e] = GSC[(size_t)item * 192 + i];
    R.egl[e] = GSC[(size_t)item * 192 + 64 + i];
  }
  R.ge = GSC[(size_t)item * 192 + 128];
}
DI void gdn_put_kt(const GChunk& R, bf16_t* KT) {
  const int tid = otid(), lane = tid & 63, i = 16 * (tid >> 6) + (lane & 15), g = lane >> 4;
#pragma unroll
  for (int ks = 0; ks < 4; ++ks)
#pragma unroll
    for (int e = 0; e < 8; ++e) KT[(ks * 32 + g * 8 + e) * 72 + i] = (bf16_t)R.kf[ks][e];
}
DI int gdn_chunk_at(int d, int n) { return d == 0 ? n : (n < 4 ? 3 - n : NCH - 1 - (n - 4)); }
DI void job_gscan(const Params& p, int u, char* lds) {
  const int tid = otid(), lane = tid & 63, wid = tid >> 6, l15 = lane & 15, g = lane >> 4;
  const int seq = (u & 7) + 8 * (u >> 5), dvs = (u >> 3) & 3, d = seq & 1, h = (seq >> 1) & 3, b = seq >> 3;
  bf16_t* KT = (bf16_t*)lds;
  bf16_t* ST = KT + 2 * 128 * 72;
  bf16_t* XT = ST + 32 * 136;
  bf16_t* VnT = XT + 32 * 72;
  bf16_t* VsT = VnT + 32 * 72;
  bf16_t* OUT = d == 0 ? (bf16_t*)(p.ws + OFF_P) + C_DAV : (bf16_t*)(p.ws + OFF_OB);
  const int ldo = d == 0 ? LDP : 512;
  __builtin_amdgcn_s_setprio(3);
  f32x4 S[2][2];
#pragma unroll
  for (int a = 0; a < 2; ++a)
#pragma unroll
    for (int ct = 0; ct < 2; ++ct) S[a][ct] = (f32x4){0.f, 0.f, 0.f, 0.f};
  for (int i = tid; i < 32 * 136 / 2; i += 256) ((unsigned*)ST)[i] = 0u;
  GChunk cur, nxt;
  gdn_load(cur, p, b, h, d, dvs, gdn_chunk_at(d, 0));
  gdn_put_kt(cur, KT);
  __syncthreads();
#pragma unroll 1
  for (int n = 0; n < NCH; ++n) {
    const int c = gdn_chunk_at(d, n);
    if (n + 1 < NCH) gdn_load(nxt, p, b, h, d, dvs, gdn_chunk_at(d, n + 1));
    const bf16_t* KTc = KT + (n & 1) * 128 * 72;
    f32x4 ksa[2], qsa[2];
#pragma unroll
    for (int ct = 0; ct < 2; ++ct) { ksa[ct] = (f32x4){0.f, 0.f, 0.f, 0.f}; qsa[ct] = (f32x4){0.f, 0.f, 0.f, 0.f}; }
#pragma unroll
    for (int ks = 0; ks < 4; ++ks)
#pragma unroll
      for (int ct = 0; ct < 2; ++ct) {
        const bf16x8 bS = *(const bf16x8*)(ST + (ct * 16 + l15) * 136 + ks * 32 + g * 8);
        ksa[ct] = mfma16(cur.kf[ks], bS, ksa[ct]);
        qsa[ct] = mfma16(cur.qf[ks], bS, qsa[ct]);
      }
#pragma unroll
    for (int ct = 0; ct < 2; ++ct) {
      float x[4];
#pragma unroll
      for (int e = 0; e < 4; ++e) x[e] = ((l15 & 1) ? bfhi(cur.vr[ct][e]) : bflo(cur.vr[ct][e])) - cur.eg[e] * ksa[ct][e];
      *(u32x2*)(XT + (ct * 16 + l15) * 72 + 16 * wid + g * 4) = (u32x2){pk2(x[0], x[1]), pk2(x[2], x[3])};
    }
    __syncthreads();
#pragma unroll
    for (int ct = 0; ct < 2; ++ct) {
      f32x4 vn = {0.f, 0.f, 0.f, 0.f};
#pragma unroll
      for (int ks = 0; ks < 2; ++ks) vn = mfma16(cur.m1f[ks], *(const bf16x8*)(XT + (ct * 16 + l15) * 72 + ks * 32 + g * 8), vn);
      *(u32x2*)(VnT + (ct * 16 + l15) * 72 + 16 * wid + g * 4) = (u32x2){pk2(vn[0], vn[1]), pk2(vn[2], vn[3])};
      *(u32x2*)(VsT + (ct * 16 + l15) * 72 + 16 * wid + g * 4) = (u32x2){pk2(vn[0] * cur.egl[0], vn[1] * cur.egl[1]), pk2(vn[2] * cur.egl[2], vn[3] * cur.egl[3])};
    }
    __syncthreads();
#pragma unroll
    for (int ct = 0; ct < 2; ++ct) {
      f32x4 o;
#pragma unroll
      for (int e = 0; e < 4; ++e) o[e] = cur.eg[e] * qsa[ct][e];
#pragma unroll
      for (int ks = 0; ks < 2; ++ks) o = mfma16(cur.atf[ks], *(const bf16x8*)(VnT + (ct * 16 + l15) * 72 + ks * 32 + g * 8), o);
#pragma unroll
      for (int e = 0; e < 4; ++e) {
        const int i = 16 * wid + g * 4 + e, t2 = d ? 63 - i : i;
        OUT[(size_t)(b * TT + c * 64 + t2) * ldo + h * 128 + dvs * 32 + ct * 16 + l15] = f2bf(o[e]);
      }
    }
#pragma unroll
    for (int rt2 = 0; rt2 < 2; ++rt2) {
      const int rt = 2 * wid + rt2;
#pragma unroll
      for (int ct = 0; ct < 2; ++ct)
#pragma unroll
        for (int e = 0; e < 4; ++e) S[rt2][ct][e] *= cur.ge;
#pragma unroll
      for (int ks = 0; ks < 2; ++ks) {
        const bf16x8 ka = *(const bf16x8*)(KTc + (rt * 16 + l15) * 72 + ks * 32 + g * 8);
#pragma unroll
        for (int ct = 0; ct < 2; ++ct) S[rt2][ct] = mfma16(ka, *(const bf16x8*)(VsT + (ct * 16 + l15) * 72 + ks * 32 + g * 8), S[rt2][ct]);
      }
#pragma unroll
      for (int ct = 0; ct < 2; ++ct)
        *(u32x2*)(ST + (ct * 16 + l15) * 136 + rt * 16 + g * 4) = (u32x2){pk2(S[rt2][ct][0], S[rt2][ct][1]), pk2(S[rt2][ct][2], S[rt2][ct][3])};
    }
    if (n + 1 < NCH) { gdn_put_kt(nxt, KT + ((n + 1) & 1) * 128 * 72); cur = nxt; }
    __syncthreads();
  }
  __builtin_amdgcn_s_setprio(0);
}
DI void job_gpost1(const Params& p, int layer, int r) {
  const int lane = otid() & 63;
  if (layer == 1 && (r % TT) < TC) return;
  bf16_t* P = (bf16_t*)(p.ws + OFF_P) + (size_t)r * LDP;
  const bf16_t* OB = (const bf16_t*)(p.ws + OFF_OB) + (size_t)r * 512;
  const u32x4 of = *(const u32x4*)(P + C_DAV + lane * 8), ob = *(const u32x4*)(OB + lane * 8), z = *(const u32x4*)(P + C_GZ + lane * 8);
  float o[8], zz[8], ss = 0.f;
#pragma unroll
  for (int e = 0; e < 4; ++e) {
    o[2 * e] = bflo(of[e]) + bflo(ob[e]); o[2 * e + 1] = bfhi(of[e]) + bfhi(ob[e]);
    zz[2 * e] = bflo(z[e]); zz[2 * e + 1] = bfhi(z[e]);
  }
#pragma unroll
  for (int e = 0; e < 8; ++e) ss += o[e] * o[e];
  ss += shx<1>(ss); ss += shx<2>(ss); ss += shx<4>(ss); ss += shx<8>(ss);
  const float rstd = rsqrtf(ss * (1.f / 128.f) + EPS);
  const float* gn = p.gng + layer * 128 + (lane & 15) * 8;
  float y[8];
#pragma unroll
  for (int e = 0; e < 8; ++e) y[e] = o[e] * rstd * gn[e] * (zz[e] * sigm(zz[e]));
  *(u32x4*)(P + C_GZ + lane * 8) = (u32x4){pk2(y[0], y[1]), pk2(y[2], y[3]), pk2(y[4], y[5]), pk2(y[6], y[7])};
}

DI void job_gpost(const Params& p, int layer, int it) {
  const int wid = otid() >> 6;
#pragma unroll
  for (int rr = 0; rr < 2; ++rr) job_gpost1(p, layer, it * 8 + rr * 4 + wid);
}
#ifdef SK_JL1
#define JL1(x)
#else
#define JL1(x) x
#endif
#ifdef SK_JGC
#define JGC(x)
#else
#define JGC(x) x
#endif
#ifdef SK_JVT
#define JVT(x)
#else
#define JVT(x) x
#endif
#ifdef SK_JDP
#define JDP(x)
#else
#define JDP(x) x
#endif
#ifdef SK_JGP
#define JGP(x)
#else
#define JGP(x) x
#endif
#ifdef SK_JL3
#define JL3(x)
#else
#define JL3(x) x
#endif
#ifdef SK_JGS
#define JGS(x)
#else
#define JGS(x) x
#endif
#ifdef SK_JAT
#define JAT(x)
#else
#define JAT(x) x
#endif
#define LAS __attribute__((address_space(3)))
#define XB_TMO      128
#define XB_XCNT(j)  (256  + 64 * (j))
#define XB_XSUB(j)  (1280 + 64 * (j))
#define XB_XGEN(j)  (2304 + 64 * (j))
#define XB_TOP      3328
#define XB_TOPGEN   3392
#define XCD_BAR_WORDS 3456
#define XB_SPIN_CAP (1u << 18)

__device__ __forceinline__ unsigned xb_ld(unsigned* p)              { return __hip_atomic_load(p, __ATOMIC_RELAXED, __HIP_MEMORY_SCOPE_AGENT); }
__device__ __forceinline__ unsigned xb_add(unsigned* p, unsigned v) { return __hip_atomic_fetch_add(p, v, __ATOMIC_RELAXED, __HIP_MEMORY_SCOPE_AGENT); }
__device__ __forceinline__ unsigned xb_xcc_id() { return (unsigned)__builtin_amdgcn_s_getreg((3 << 11) | 20) & 0xFu; }
#define XB_SPIN(cond, bar) do { unsigned _sp = 0; while (cond) { __builtin_amdgcn_s_sleep(1); \
    if ((++_sp & 255u) == 0u) { if (xb_ld(&(bar)[XB_TMO])) break; if (_sp > XB_SPIN_CAP) { atomicAdd(&(bar)[XB_TMO], 1u); break; } } } } while (0)

struct XcdBarrier {
    unsigned* bar; unsigned x;
    volatile LAS unsigned* st;
};

__device__ __forceinline__ XcdBarrier xcd_barrier_post(unsigned* bar, volatile LAS unsigned* st) {
    XcdBarrier b; b.bar = bar; b.x = xb_xcc_id(); b.st = st;
    if (threadIdx.x == 0) (void)xb_add(&bar[XB_XCNT(b.x)], 1u);
    return b;
}
__device__ __forceinline__ void xcd_barrier_complete(unsigned* bar, unsigned x, unsigned& nloc, unsigned& nx) {
    const unsigned G = gridDim.x * gridDim.y * gridDim.z;
    unsigned sum, cnt, mine, sp = 0u;
    for (;;) {
        sum = 0u; cnt = 0u; mine = 0u;
#pragma unroll
        for (unsigned j = 0; j < 16; ++j) { const unsigned c = xb_ld(&bar[XB_XCNT(j)]); sum += c; cnt += (c > 0u) ? 1u : 0u; mine = (j == x) ? c : mine; }
        if (sum == G) break;
        __builtin_amdgcn_s_sleep(1);
        if ((++sp & 255u) == 0u) { if (xb_ld(&bar[XB_TMO])) break; if (sp > XB_SPIN_CAP) { atomicAdd(&bar[XB_TMO], 1u); break; } }
    }
    nloc = mine > 0u ? mine : 1u; nx = cnt > 0u ? cnt : 1u;
}

__device__ __forceinline__ void xcd_barrier(const XcdBarrier& b) {
    asm volatile("s_waitcnt vmcnt(0)" ::: "memory");
    __syncthreads();
    if (threadIdx.x == 0) {
        unsigned* bar = b.bar; unsigned bx_ = b.x;
        asm volatile("" : "+s"(bar), "+s"(bx_));
        __builtin_amdgcn_s_waitcnt(0);
        unsigned nloc = b.st[0], nx = b.st[1];
        if (nloc == 0u) { xcd_barrier_complete(bar, bx_, nloc, nx); b.st[0] = nloc; b.st[1] = nx; }
        const unsigned old = xb_add(&bar[XB_XSUB(bx_)], 1u);
        const unsigned gen = old / nloc;
        if (old + 1u == (gen + 1u) * nloc) {
            __builtin_amdgcn_fence(__ATOMIC_RELEASE, "agent");
            asm volatile("s_waitcnt vmcnt(0)" ::: "memory");
            const unsigned og = xb_add(&bar[XB_TOP], 1u);
            const unsigned tg = og / nx;
            if (og + 1u == (tg + 1u) * nx) xb_add(&bar[XB_TOPGEN], 1u);
            else XB_SPIN(xb_ld(&bar[XB_TOPGEN]) == tg, bar);
            __builtin_amdgcn_fence(__ATOMIC_ACQUIRE, "agent");
            xb_add(&bar[XB_XGEN(bx_)], 1u);
            asm volatile("s_waitcnt vmcnt(0)" ::: "memory");
        } else {
            XB_SPIN(xb_ld(&bar[XB_XGEN(bx_)]) == gen, bar);
            __builtin_amdgcn_fence(__ATOMIC_ACQUIRE, "agent");
            asm volatile("s_waitcnt vmcnt(0)" ::: "memory");
        }
    }
    __syncthreads();
}


#define PH_BEGIN(k) for (int rep_ = 0, nrep_ = 1 + (((p.probe >> (k)) & 1) | ((k) == 5 ? ((p.probe >> 12) | (p.probe >> 13)) & 1 : 0)); rep_ < nrep_; ++rep_) { const bool dup = rep_ > 0; (void)dup;
#define PH_END xcd_barrier(xb_); }
#ifndef PROBE_MASK
#define PROBE_MASK 0
#endif
__global__ void __launch_bounds__(256, 2) mega(Params p) {
  __shared__ __attribute__((aligned(16))) char lds[LDS_BYTES];
  __shared__ int s_item;
  __shared__ unsigned xb_st[2];
  if (otid() == 0) { xb_st[0] = 0u; xb_st[1] = 0u; }
  __syncthreads();
  const XcdBarrier xb_ = xcd_barrier_post((unsigned*)(p.ws + OFF_CTR) + 64, (volatile LAS unsigned*)xb_st);
  cg::grid_group grid = cg::this_grid();
  const int G = gridDim.x, B = blockIdx.x;
  bf16_t* P = (bf16_t*)(p.ws + OFF_P);
  bf16_t* H = (bf16_t*)(p.ws + OFF_H);
  for (int it = B; it < 192 + 1024 + N_CVT; it += G) {
    if (it < 192) job_mod(p, it, lds);
    else if (it < 1216) job_rope(p, it - 192);
    else job_cvt(p, 0, it - 1216, lds);
  }
  if (p.probe < 0) grid.sync();
  xcd_barrier(xb_);
#pragma unroll 1
  for (int layer = 0; layer < 2; ++layer) {
    bf16_t* MG = (bf16_t*)(p.ws + OFF_VT);
    bf16_t* HID = P;
    PH_BEGIN(1)
    {
      const int n1 = layer == 1 ? N_CVT : 0;
      for (int it = B; it < n1 + MR / 8; it += G) { if (it < n1) job_cvt(p, 1, it, lds); else job_norm(p, layer, 1, it - n1); }
    }
    PH_END
    PH_BEGIN(2)
    {
      bf16_t* HALO = (bf16_t*)(p.ws + OFF_HALO);
      float* GBA = (float*)(p.ws + OFF_GBA);
      gemm_phase(H, 32, MR * 32, (const bf16_t*)(p.ws + OFF_WIN), 32, 7808 * 32, 1024, 132, 37, lds, B, G, [&](int row, int col, f32x4 v) {
        if (col < C_GBA) {
          const u32x2 w = {pk2(v[0], v[1]), pk2(v[2], v[3])};
          *(u32x2*)(P + (size_t)row * LDP + col) = w;
          if (col >= C_GQKV && col < C_GZ) {
            const int sm = row & 63;
            if (sm <= 1 || sm == 63) *(u32x2*)(HALO + ((size_t)(row >> 6) * 3 + (sm == 63 ? 2 : sm)) * 1536 + (col - C_GQKV)) = w;
          }
        } else if (col < C_GBA + 16) {
          *(f32x4*)(GBA + (size_t)row * 16 + (col - C_GBA)) = v;
        }
      }, [&](int row, int col, f32x4 v0, f32x4 v1) {
        if (col < C_GBA) {
          const u32x4 w = (u32x4){pk2(v0[0], v0[1]), pk2(v0[2], v0[3]), pk2(v1[0], v1[1]), pk2(v1[2], v1[3])};
          __builtin_nontemporal_store(w, (u32x4*)(P + (size_t)row * LDP + col));
          if (col >= C_GQKV && col < C_GZ) {
            const int sm = row & 63;
            if (sm <= 1 || sm == 63) *(u32x4*)(HALO + ((size_t)(row >> 6) * 3 + (sm == 63 ? 2 : sm)) * 1536 + (col - C_GQKV)) = w;
          }
        } else if (col < C_GBA + 16) {
          *(f32x4*)(GBA + (size_t)row * 16 + (col - C_GBA)) = v0;
          *(f32x4*)(GBA + (size_t)row * 16 + (col - C_GBA) + 4) = v1;
        }
      });
    }
    PH_END
    PH_BEGIN(3)
    {
      const int nA = 8 * NCH * 4, nB = nA + 6336, nC = nB + 2112, nD = nC + MR / 8;
      for (int it = B; it < nD; it += G) {
        if (it < nA) JL1(job_lru<1>(p, layer, it, lds, dup));
        else if (it < nB) JGC(job_gconv(p, layer, it - nA, dup));
        else if (it < nC) JVT(job_vt(p, it - nB, lds));
        else JDP(job_daprep(p, layer, it - nC, dup));
      }
    }
    PH_END
    PH_BEGIN(4)
    for (int it = B; it < 2112; it += G) JGP(job_gprep(p, layer, it, lds));
    PH_END
    PH_BEGIN(5)
    {
      for (;;) {
        const int x = blockIdx.x & 7;
        if (otid() == 0) s_item = (int)__hip_atomic_fetch_add((unsigned*)(p.ws + OFF_CTR) + ((layer * 2 + rep_) * 8 + x), 1u, __ATOMIC_RELAXED, __HIP_MEMORY_SCOPE_AGENT);
        __syncthreads();
        const int j = __builtin_amdgcn_readfirstlane(s_item);
        __syncthreads();
        if (j >= 16 + 132 + 528) break;
        if (j < 16) { if (!(dup && ((p.probe >> 12) & 1))) JGS(job_gscan(p, j * 8 + x, lds)); }
        else if (j < 148) {
          const int k = j - 16, grp = k / 66, qq = k % 66, qb = qq < 64 ? qq + 2 : qq - 64;
          if (!(dup && ((p.probe >> 13) & 1))) JAT(job_attn(p, layer, grp * 528 + qb * 8 + x, lds, dup));
        } else { if (!(dup && (((p.probe >> 12) | (p.probe >> 13)) & 1))) JL3(job_lru<3>(p, layer, (j - 148) * 8 + x, lds, dup)); }
      }
    }
    PH_END
    PH_BEGIN(6)
    for (int it = B; it < MR / 8 + MR / 8; it += G) { if (it < MR / 8) job_gpost(p, layer, it); else job_norm(p, layer, 1, it - MR / 8, layer == 1); }
    PH_END
    PH_BEGIN(7)
    gemm_phase(H, 32, MR * 32, (const bf16_t*)(p.ws + OFF_WIN) + (size_t)4736 * 32, 32, 7808 * 32, 1024, 132, 24, lds, B, G, [&](int row, int col, f32x4 v) {
      *(u32x2*)(P + (size_t)row * LDP + sg_col(col)) = (u32x2){pk2(sigm(v[0]), sigm(v[1])), pk2(sigm(v[2]), sigm(v[3]))};
    }, [&](int row, int col, f32x4 v0, f32x4 v1) {
      *(u32x4*)(P + (size_t)row * LDP + sg_col(col)) = (u32x4){pk2(sigm(v0[0]), sigm(v0[1])), pk2(sigm(v0[2]), sigm(v0[3])), pk2(sigm(v1[0]), sigm(v1[1])), pk2(sigm(v1[2]), sigm(v1[3]))};
    }, layer == 1);
    PH_END
    PH_BEGIN(14)
    {
      const bf16_t* WBR = (const bf16_t*)(p.ws + OFF_WBR);
      const int nm14 = layer == 1 ? 256 : 264;
      for (int t = B; t < nm14 * 8; t += G) {
        int mi, ni; tile_mn(t, nm14, 8, mi, ni);
        if (layer == 1) mi += 2 * (mi >> 6) + 2;
        f32x4 mg[4][4]; zero_acc<4>(mg);
#pragma unroll 1
        for (int i = 0; i < 3; ++i) {
          f32x4 ay[4][4]; zero_acc<4>(ay);
          const int coff = i == 0 ? C_DAQ : (i == 1 ? C_LY : C_GZ);
          gemm_core<4>(P + (size_t)mi * 128 * LDP + coff, LDP, 32, WBR + (size_t)i * 1024 * 512 + (size_t)(ni * 128) * 32, 32, 1024 * 32, 512, ay, lds);
          const int lane = otid() & 63, wid = otid() >> 6, wr = wid >> 1, wc = wid & 1;
#pragma unroll
          for (int a2 = 0; a2 < 4; ++a2)
#pragma unroll
            for (int b2 = 0; b2 < 4; ++b2) {
              const int row = mi * 128 + wr * 64 + a2 * 16 + (lane & 15), col = ni * 128 + wc * 64 + b2 * 16 + (lane >> 4) * 4;
              const u32x2 sg = *(const u32x2*)(P + (size_t)row * LDP + sg_col(i * 1024 + col));
              mg[a2][b2] += (f32x4){bflo(sg.x), bfhi(sg.x), bflo(sg.y), bfhi(sg.y)} * ay[a2][b2];
            }
        }
        gemm_emit<4>(mg, mi * 128, ni * 128, [&](int row, int col, f32x4 v) { *(u32x2*)(MG + ((size_t)(col >> 5) * MR + row) * 32 + (col & 31)) = (u32x2){pk2(v[0], v[1]), pk2(v[2], v[3])}; });
      }
    }
    PH_END
    PH_BEGIN(8)
    gemm_phase(MG, 32, MR * 32, (const bf16_t*)(p.ws + OFF_WO), 32, 1024 * 32, 1024, 132, 8, lds, B, G, [&](int row, int col, f32x4 v) {
      const f32x4 xin = *(const f32x4*)(res_in_row(p, layer, row) + col);
      const f32x4 g1 = *(const f32x4*)(mod_vec(p, layer, row) + 2048 + col);
      if (!dup) *(f32x4*)(res_out_row(p, row) + col) = xin + g1 * v;
    }, [&](int row, int col, f32x4 v0, f32x4 v1) {
      const float* xi = res_in_row(p, layer, row) + col;
      const float* gm = mod_vec(p, layer, row) + 2048 + col;
      float* xo = res_out_row(p, row) + col;
      const f32x4 o0 = __builtin_nontemporal_load((const f32x4*)xi) + *(const f32x4*)gm * v0, o1 = __builtin_nontemporal_load((const f32x4*)(xi + 4)) + *(const f32x4*)(gm + 4) * v1;
      if (!dup) { *(f32x4*)xo = o0; *(f32x4*)(xo + 4) = o1; }
    }, layer == 1);
    PH_END
    PH_BEGIN(9)
    for (int it = B; it < MR / 8; it += G) job_norm(p, layer, 2, it, layer == 1);
    PH_END
    PH_BEGIN(10)
    gemm_phase(H, 32, MR * 32, (const bf16_t*)(p.ws + OFF_W1), 32, 4096 * 32, 1024, 132, 32, lds, B, G, [&](int row, int col, f32x4 v) {
      float r[4];
#pragma unroll
      for (int e = 0; e < 4; ++e) { const float q = fmaxf(v[e], 0.f); r[e] = q * q; }
      *(u32x2*)(HID + ((size_t)(col >> 5) * MR + row) * 32 + (col & 31)) = (u32x2){pk2(r[0], r[1]), pk2(r[2], r[3])};
    }, [&](int row, int col, f32x4 v0, f32x4 v1) {
      float r[8];
#pragma unroll
      for (int e = 0; e < 4; ++e) { const float q0 = fmaxf(v0[e], 0.f), q1 = fmaxf(v1[e], 0.f); r[e] = q0 * q0; r[4 + e] = q1 * q1; }
      __builtin_nontemporal_store(((u32x4){pk2(r[0], r[1]), pk2(r[2], r[3]), pk2(r[4], r[5]), pk2(r[6], r[7])}), (u32x4*)(HID + ((size_t)(col >> 5) * MR + row) * 32 + (col & 31)));
    }, layer == 1);
    PH_END
    PH_BEGIN(11)
    gemm_phase(HID, 32, MR * 32, (const bf16_t*)(p.ws + OFF_W2), 32, 1024 * 32, 4096, 132, 8, lds, B, G, [&](int row, int col, f32x4 v) {
      float* xo = res_out_row(p, row) + col;
      const f32x4 g2 = *(const f32x4*)(mod_vec(p, layer, row) + 5120 + col);
      if (!dup) *(f32x4*)xo = *(const f32x4*)xo + g2 * v;
    }, [&](int row, int col, f32x4 v0, f32x4 v1) {
      float* xo = res_out_row(p, row) + col;
      const float* gm = mod_vec(p, layer, row) + 5120 + col;
      const f32x4 o0 = __builtin_nontemporal_load((const f32x4*)xo) + *(const f32x4*)gm * v0, o1 = __builtin_nontemporal_load((const f32x4*)(xo + 4)) + *(const f32x4*)(gm + 4) * v1;
      if (!dup) { *(f32x4*)xo = o0; *(f32x4*)(xo + 4) = o1; }
    }, layer == 1);
    PH_END
  }
}

extern "C" void kernel_launch(void* const* d_in, const int* in_sizes, int n_in, void* d_out, int out_size, void* d_ws, size_t ws_size, hipStream_t stream) {
  static int grid_blocks = 0;
  if (!grid_blocks) {
    int dev = 0, cus = 0, per_cu = 0;
    hipGetDevice(&dev);
    hipDeviceGetAttribute(&cus, hipDeviceAttributeMultiprocessorCount, dev);
    hipOccupancyMaxActiveBlocksPerMultiprocessor(&per_cu, mega, 256, 0);
    if (per_cu > 2) per_cu = 2;
    grid_blocks = cus * per_cu;
    grid_blocks -= grid_blocks % 8;
  }
  Params p{};
  const float** f = (const float**)&p;
  for (int i = 0; i < 26; ++i) f[i] = (const float*)d_in[i];
  p.out = (float*)d_out;
  p.ws = (char*)d_ws;
  p.probe = PROBE_MASK;
  if (ws_size < WS_TOTAL) { fprintf(stderr, "workspace too small: %zu < %zu\n", ws_size, (size_t)WS_TOTAL); return; }
  hipMemsetAsync((char*)d_ws + OFF_CTR, 0, 256 + 16384, stream);
  void* args[] = {&p};
  hipError_t e = hipLaunchCooperativeKernel((void*)mega, dim3(grid_blocks), dim3(256), args, 0, stream);
  if (e != hipSuccess) fprintf(stderr, "cooperative launch failed: %s (grid %d)\n", hipGetErrorString(e), grid_blocks);
}
```

```cpp
#include <hip/hip_runtime.h>
#include <hip/hip_cooperative_groups.h>
#include <cstdint>
#include <cstdio>
namespace cg = cooperative_groups;

#define DI __device__ __forceinline__
typedef unsigned short bf16_t;
typedef short bf16x8 __attribute__((ext_vector_type(8)));
typedef float f32x4 __attribute__((ext_vector_type(4)));
typedef float f32x2 __attribute__((ext_vector_type(2)));
typedef unsigned u32x4 __attribute__((ext_vector_type(4)));
typedef unsigned u32x2 __attribute__((ext_vector_type(2)));
typedef __bf16 bf16x2_t __attribute__((ext_vector_type(2)));

constexpr int DM = 1024, NB = 4, TL = 8192, TC = 256, TT = 8448, MR = NB * TT;
constexpr int LDP = 4736;
constexpr int C_DAQ = 0, C_DAK = 512, C_DAV = 1024, C_LX = 1536, C_LY = 2048, C_GQKV = 2560, C_GZ = 4096, C_GBA = 4608;
constexpr int NCH = 132;
constexpr float EPS = 1e-6f;
constexpr int LDS_BYTES = 77824;

constexpr size_t al256(size_t x) { return (x + 255) & ~(size_t)255; }
constexpr size_t OFF_WIN = 0;
constexpr size_t OFF_WBR = OFF_WIN + al256((size_t)7808 * 1024 * 2);
constexpr size_t OFF_WO = OFF_WBR + al256((size_t)3 * 1024 * 512 * 2);
constexpr size_t OFF_W1 = OFF_WO + al256((size_t)1024 * 1024 * 2);
constexpr size_t OFF_W2 = OFF_W1 + al256((size_t)4096 * 1024 * 2);
constexpr size_t OFF_LG = OFF_W2 + al256((size_t)4096 * 1024 * 2);
constexpr size_t OFF_P = OFF_LG + al256((size_t)32 * 4096 * 2);
constexpr size_t OFF_H = OFF_P + al256((size_t)MR * LDP * 2);
constexpr size_t OFF_VT = OFF_H + al256((size_t)MR * 1024 * 2);
constexpr size_t OFF_OB = OFF_VT + al256((size_t)MR * 512 * 2);
constexpr size_t OFF_HALO = OFF_OB + al256((size_t)MR * 512 * 2);
constexpr size_t OFF_GBA = OFF_HALO + al256((size_t)528 * 3 * 1536 * 2);
constexpr size_t OFF_GSC = OFF_GBA + al256((size_t)MR * 16 * 4);
constexpr size_t OFF_LC = OFF_GSC + al256((size_t)4224 * 192 * 4);
constexpr size_t OFF_CTX = OFF_LC + al256((size_t)4 * NCH * 8 * 2 * 64 * 8);
constexpr size_t OFF_MOD = OFF_CTX + al256((size_t)4 * 256 * 1024 * 4);
constexpr size_t OFF_ROPE = OFF_MOD + al256((size_t)2 * 5 * 6144 * 4);
constexpr size_t OFF_CTR = OFF_ROPE + al256((size_t)8192 * 32 * 8);
constexpr size_t WS_TOTAL = OFF_CTR + 256 + 16384;
static_assert(WS_TOTAL <= (size_t)536870912, "workspace map too large");

struct Params {
  const float *x, *c, *ctx, *cctx, *ada_w, *ada_b, *n1g, *n2g, *w_in, *daqg, *dakg, *dalam, *dasub, *lcw, *lcb, *lgw, *lgb, *llam,
      *gcw, *galog, *gdtb, *gng, *wbr, *wout, *w1, *w2;
  float* out;
  char* ws;
  int probe;
  int pad_;
};

DI unsigned pk2(float lo, float hi) { f32x2 v = {lo, hi}; bf16x2_t b = __builtin_convertvector(v, bf16x2_t); return __builtin_bit_cast(unsigned, b); }
DI bf16_t f2bf(float f) { return (bf16_t)(pk2(f, 0.f) & 0xffffu); }
DI float bf2f(bf16_t u) { return __uint_as_float(((unsigned)u) << 16); }
DI float bflo(unsigned w) { return __uint_as_float(w << 16); }
DI float bfhi(unsigned w) { return __uint_as_float(w & 0xffff0000u); }
DI int otid() { int t = __builtin_amdgcn_workitem_id_x(); asm volatile("" : "+v"(t)); return t; }
template <int M> DI float shx(float v) { return __int_as_float(__builtin_amdgcn_ds_swizzle(__float_as_int(v), (M << 10) | 0x1f)); }
DI float add32(float v) { auto r = __builtin_amdgcn_permlane32_swap(__float_as_uint(v), __float_as_uint(v), false, false); return __uint_as_float(r[0]) + __uint_as_float(r[1]); }
DI float max32(float v) { auto r = __builtin_amdgcn_permlane32_swap(__float_as_uint(v), __float_as_uint(v), false, false); return fmaxf(__uint_as_float(r[0]), __uint_as_float(r[1])); }
DI float wsum(float v) { v += shx<1>(v); v += shx<2>(v); v += shx<4>(v); v += shx<8>(v); v += shx<16>(v); return add32(v); }
DI float wmax(float v) { v = fmaxf(v, shx<1>(v)); v = fmaxf(v, shx<2>(v)); v = fmaxf(v, shx<4>(v)); v = fmaxf(v, shx<8>(v)); v = fmaxf(v, shx<16>(v)); return max32(v); }
DI float sigm(float x) { return 1.f / (1.f + __expf(-x)); }
DI float softplusf(float x) { return x > 20.f ? x : log1pf(expf(x)); }
DI f32x4 mfma16(bf16x8 a, bf16x8 b, f32x4 c) { return __builtin_amdgcn_mfma_f32_16x16x32_bf16(a, b, c, 0, 0, 0); }

DI const float* res_in_row(const Params& p, int layer, int r) {
  const int b = r / TT, s = r % TT;
  if (layer == 0) return s < TC ? p.ctx + ((size_t)b * TC + s) * DM : p.x + ((size_t)b * TL + (s - TC)) * DM;
  return s < TC ? (const float*)(p.ws + OFF_CTX) + ((size_t)b * TC + s) * DM : p.out + ((size_t)b * TL + (s - TC)) * DM;
}
DI float* res_out_row(const Params& p, int r) {
  const int b = r / TT, s = r % TT;
  return s < TC ? (float*)(p.ws + OFF_CTX) + ((size_t)b * TC + s) * DM : p.out + ((size_t)b * TL + (s - TC)) * DM;
}
DI const float* mod_vec(const Params& p, int layer, int r) {
  const int b = r / TT, s = r % TT;
  return (const float*)(p.ws + OFF_MOD) + (size_t)(layer * 5 + (s < TC ? 4 : b)) * 6144;
}

template <int WN>
DI void gemm_core(const bf16_t* __restrict__ A, int lda, int a_ks, const bf16_t* __restrict__ Bt, int ldb, int b_ks, int K, f32x4 (&acc)[4][WN], char* lds) {
  constexpr int BN = 32 * WN, AST = 72, NBP = BN * 8 / 256;
  bf16_t* As = (bf16_t*)lds;
  bf16_t* Bs = As + 2 * 128 * AST;
  const int tid = otid(), lane = tid & 63, wid = tid >> 6, wr = wid >> 1, wc = wid & 1;
  u32x4 ra[4], rb[NBP];
  const int nk = K / 64;
#define GLOAD(k0)                                                                                                            \
  {                                                                                                                          \
    _Pragma("unroll") for (int i = 0; i < 4; ++i) { const int q = tid + 256 * i; ra[i] = *(const u32x4*)(A + (size_t)(q >> 3) * lda + (size_t)(((k0) >> 5) + ((q & 7) >> 2)) * a_ks + (q & 3) * 8); } \
    _Pragma("unroll") for (int i = 0; i < NBP; ++i) { const int q = tid + 256 * i; rb[i] = *(const u32x4*)(Bt + (size_t)(q >> 3) * ldb + (size_t)(((k0) >> 5) + ((q & 7) >> 2)) * b_ks + (q & 3) * 8); } \
  }
#define SSTORE(buf)                                                                                                          \
  {                                                                                                                          \
    _Pragma("unroll") for (int i = 0; i < 4; ++i) { const int q = tid + 256 * i; *(u32x4*)(As + ((buf) * 128 + (q >> 3)) * AST + (q & 7) * 8) = ra[i]; } \
    _Pragma("unroll") for (int i = 0; i < NBP; ++i) { const int q = tid + 256 * i; *(u32x4*)(Bs + ((buf) * BN + (q >> 3)) * AST + (q & 7) * 8) = rb[i]; } \
  }
  GLOAD(0);
  SSTORE(0);
  __syncthreads();
  for (int t = 0; t < nk; ++t) {
    if (t + 1 < nk) GLOAD((t + 1) * 64);
    const bf16_t* a = As + ((t & 1) * 128 + wr * 64 + (lane & 15)) * AST + (lane >> 4) * 8;
    const bf16_t* b = Bs + ((t & 1) * BN + wc * 16 * WN + (lane & 15)) * AST + (lane >> 4) * 8;
#pragma unroll
    for (int ks = 0; ks < 2; ++ks) {
      bf16x8 af[4], bfr[WN];
#pragma unroll
      for (int i = 0; i < 4; ++i) af[i] = *(const bf16x8*)(a + i * 16 * AST + ks * 32);
#pragma unroll
      for (int j = 0; j < WN; ++j) bfr[j] = *(const bf16x8*)(b + j * 16 * AST + ks * 32);
      __builtin_amdgcn_sched_barrier(0);
#pragma unroll
      for (int i = 0; i < 4; ++i)
#pragma unroll
        for (int j = 0; j < WN; ++j) acc[i][j] = mfma16(bfr[j], af[i], acc[i][j]);
      __builtin_amdgcn_sched_barrier(0);
    }
    if (t + 1 < nk) SSTORE((t + 1) & 1);
    __syncthreads();
  }
#undef GLOAD
#undef SSTORE
}
DI void tile_mn(int t, int nm, int nn, int& mi, int& ni) {
  const int nig = 16 * nn, g = t / nig, rem = t % nig, fm = g * 16;
  const int gsz = (nm - fm) < 16 ? (nm - fm) : 16;
  mi = fm + rem % gsz;
  ni = rem / gsz;
}
template <int WN, class Epi>
DI void gemm_emit(const f32x4 (&acc)[4][WN], int m0, int n0, Epi epi) {
  const int lane = otid() & 63, wid = otid() >> 6, wr = wid >> 1, wc = wid & 1;
#pragma unroll
  for (int i = 0; i < 4; ++i)
#pragma unroll
    for (int j = 0; j < WN; ++j) epi(m0 + wr * 64 + i * 16 + (lane & 15), n0 + wc * 16 * WN + j * 16 + (lane >> 4) * 4, acc[i][j]);
}
template <int WN>
DI void zero_acc(f32x4 (&acc)[4][WN]) {
#pragma unroll
  for (int i = 0; i < 4; ++i)
#pragma unroll
    for (int j = 0; j < WN; ++j) acc[i][j] = (f32x4){0.f, 0.f, 0.f, 0.f};
}

DI void gemm_core2(const bf16_t* __restrict__ A, int lda, int a_ks, const bf16_t* __restrict__ Bt, int ldb, int b_ks, int K, f32x4 (&acc)[8][4], char* lds) {
  constexpr int AST = 48;
  bf16_t* As = (bf16_t*)lds;
  bf16_t* Bs = As + 2 * 256 * AST;
  const int tid = otid(), lane = tid & 63, wid = tid >> 6, wr = wid >> 1, wc = wid & 1;
  u32x4 s0a[4], s0b[2], s1a[4], s1b[2];
  const int nk = K / 32;
  const bf16_t* ag = A + (size_t)(tid >> 2) * lda + (tid & 3) * 8;
  const bf16_t* bg = Bt + (size_t)(tid >> 2) * ldb + (tid & 3) * 8;
  const int bc_ = tid >> 2, brow = ((bc_ >> 5) * 2 + ((bc_ >> 2) & 1)) * 16 + ((bc_ >> 3) & 3) * 4 + (bc_ & 3);
#define LBAR() { asm volatile("s_waitcnt lgkmcnt(0)" ::: "memory"); __builtin_amdgcn_s_barrier(); asm volatile("" ::: "memory"); }
#define GLOAD2(ra, rb, k0)                                                                                                   \
  {                                                                                                                          \
    _Pragma("unroll") for (int i = 0; i < 4; ++i) ra[i] = *(const u32x4*)(ag + (size_t)(64 * i) * lda + (size_t)((k0) >> 5) * a_ks);               \
    _Pragma("unroll") for (int i = 0; i < 2; ++i) rb[i] = *(const u32x4*)(bg + (size_t)(64 * i) * ldb + (size_t)((k0) >> 5) * b_ks);               \
  }
#define SSTORE2(ra, rb, buf)                                                                                                 \
  {                                                                                                                          \
    _Pragma("unroll") for (int i = 0; i < 4; ++i) *(u32x4*)(As + ((buf) * 256 + 64 * i + (tid >> 2)) * AST + (tid & 3) * 8) = ra[i]; \
    _Pragma("unroll") for (int i = 0; i < 2; ++i) *(u32x4*)(Bs + ((buf) * 128 + 64 * i + brow) * AST + (tid & 3) * 8) = rb[i]; \
  }
#define STEP2(t, la, lb, sa, sb)                                                                                             \
  {                                                                                                                          \
    if ((t) + 2 < nk) GLOAD2(la, lb, ((t) + 2) * 32);                                                                        \
    const bf16_t* a = As + (((t) & 1) * 256 + wr * 128 + (lane & 15)) * AST + (lane >> 4) * 8;                               \
    const bf16_t* b = Bs + (((t) & 1) * 128 + wc * 64 + (lane & 15)) * AST + (lane >> 4) * 8;                                \
    bf16x8 bfr[4], a0[4], a1[4];                                                                                             \
    _Pragma("unroll") for (int j = 0; j < 4; ++j) bfr[j] = *(const bf16x8*)(b + j * 16 * AST);                               \
    _Pragma("unroll") for (int i = 0; i < 4; ++i) a0[i] = *(const bf16x8*)(a + i * 16 * AST);                                \
    __builtin_amdgcn_sched_barrier(0);                                                                                       \
    _Pragma("unroll") for (int i = 0; i < 4; ++i) a1[i] = *(const bf16x8*)(a + (4 + i) * 16 * AST);                          \
    __builtin_amdgcn_sched_barrier(0);                                                                                       \
    _Pragma("unroll") for (int i = 0; i < 4; ++i) _Pragma("unroll") for (int j = 0; j < 4; ++j) acc[i][j] = mfma16(bfr[j], a0[i], acc[i][j]); \
    __builtin_amdgcn_sched_barrier(0);                                                                                       \
    _Pragma("unroll") for (int i = 0; i < 4; ++i) _Pragma("unroll") for (int j = 0; j < 4; ++j) acc[4 + i][j] = mfma16(bfr[j], a1[i], acc[4 + i][j]); \
    __builtin_amdgcn_sched_barrier(0);                                                                                       \
    if ((t) + 1 < nk) SSTORE2(sa, sb, ((t) + 1) & 1);                                                                        \
    LBAR();                                                                                                                  \
  }
  GLOAD2(s0a, s0b, 0);
  SSTORE2(s0a, s0b, 0);
  GLOAD2(s1a, s1b, 32);
  LBAR();
  int t = 0;
  for (;;) {
    STEP2(t, s0a, s0b, s1a, s1b);
    if (++t >= nk) break;
    STEP2(t, s1a, s1b, s0a, s0b);
    if (++t >= nk) break;
  }
#undef GLOAD2
#undef SSTORE2
#undef STEP2
}
DI void tile_mn8(int t, int nm, int nn, int& mi, int& ni) {
  const int nig = 8 * nn, g = t / nig, rem = t % nig, fm = g * 8;
  const int gsz = (nm - fm) < 8 ? (nm - fm) : 8;
  mi = fm + rem % gsz;
  ni = rem / gsz;
}
template <class Epi, class Epi8>
DI void gemm_phase(const bf16_t* A, int lda, int a_ks, const bf16_t* Bt, int ldb, int b_ks, int K, int nm, int nn, char* lds, int B, int G, Epi epi, Epi8 epi8, bool skipctx = false) {
  if (skipctx) nm -= 4;
  const int NT = nm * nn;
  int nfull = (NT / G) * G, R = NT - nfull;
  if (4 * R > 2 * G) { nfull = NT; R = 0; }
  for (int t = B; t < nfull + 4 * R; t += G) {
    int mi, ni;
    if (t < nfull) {
      tile_mn8(t, nm, nn, mi, ni);
      if (skipctx) mi += (mi >> 5) + 1;
      f32x4 acc[8][4];
#pragma unroll
      for (int i = 0; i < 8; ++i)
#pragma unroll
        for (int j = 0; j < 4; ++j) acc[i][j] = (f32x4){0.f, 0.f, 0.f, 0.f};
      gemm_core2(A + (size_t)mi * 256 * lda, lda, a_ks, Bt + (size_t)ni * 128 * ldb, ldb, b_ks, K, acc, lds);
      const int lane = otid() & 63, wid = otid() >> 6, wr = wid >> 1, wc = wid & 1;
#pragma unroll
      for (int i = 0; i < 8; ++i)
#pragma unroll
        for (int jp = 0; jp < 2; ++jp) epi8(mi * 256 + wr * 128 + i * 16 + (lane & 15), ni * 128 + wc * 64 + jp * 32 + (lane >> 4) * 8, acc[i][2 * jp], acc[i][2 * jp + 1]);
    } else {
      const int u = t - nfull, sub = u & 3;
      tile_mn8(nfull + (u >> 2), nm, nn, mi, ni);
      if (skipctx) mi += (mi >> 5) + 1;
      const int m0 = mi * 256 + (sub >> 1) * 128, n0 = ni * 128 + (sub & 1) * 64;
      f32x4 acc[4][2]; zero_acc<2>(acc);
      gemm_core<2>(A + (size_t)m0 * lda, lda, a_ks, Bt + (size_t)n0 * ldb, ldb, b_ks, K, acc, lds);
      gemm_emit<2>(acc, m0, n0, epi);
    }
  }
}
DI int sg_col(int gc) { const int j = gc >> 7; return (j < 12 ? 512 + 128 * j : 2560 + 128 * (j - 12)) + (gc & 127); }

constexpr int N_CVT = 1152 + 32 + 768 + 384 + 256 + 1024 + 1024 + 32;
DI void job_cvt(const Params& p, int layer, int t, char* lds) {
  const float* src; int ld, ncol0 = 0, nlim, K, ntot, nrow0 = 0; bf16_t* dst;
  char* ws = p.ws;
  if (t < 1152) { src = p.w_in + (size_t)layer * 1024 * 7696; ld = 7696; ncol0 = 0; nlim = 4608; dst = (bf16_t*)(ws + OFF_WIN); K = 1024; ntot = 7808; nrow0 = 0; }
  else if ((t -= 1152) < 32) { src = p.w_in + (size_t)layer * 1024 * 7696; ld = 7696; ncol0 = 4608; nlim = 4624; dst = (bf16_t*)(ws + OFF_WIN); K = 1024; ntot = 7808; nrow0 = 4608; }
  else if ((t -= 32) < 768) { src = p.w_in + (size_t)layer * 1024 * 7696; ld = 7696; ncol0 = 4624; nlim = 7696; dst = (bf16_t*)(ws + OFF_WIN); K = 1024; ntot = 7808; nrow0 = 4736; }
  else if ((t -= 768) < 384) { const int i = t / 128; t %= 128; src = p.wbr + ((size_t)layer * 3 + i) * 512 * 1024; ld = 1024; nlim = 1024; dst = (bf16_t*)(ws + OFF_WBR) + (size_t)i * 1024 * 512; K = 512; ntot = 1024; }
  else if ((t -= 384) < 256) { src = p.wout + (size_t)layer * 1024 * 1024; ld = 1024; nlim = 1024; dst = (bf16_t*)(ws + OFF_WO); K = 1024; ntot = 1024; }
  else if ((t -= 256) < 1024) { src = p.w1 + (size_t)layer * 1024 * 4096; ld = 4096; nlim = 4096; dst = (bf16_t*)(ws + OFF_W1); K = 1024; ntot = 4096; }
  else if ((t -= 1024) < 1024) { src = p.w2 + (size_t)layer * 4096 * 1024; ld = 1024; nlim = 1024; dst = (bf16_t*)(ws + OFF_W2); K = 4096; ntot = 1024; }
  else { t -= 1024; src = p.lgw + ((size_t)layer * 32 + t) * 4096; ld = 64; nlim = 64; dst = (bf16_t*)(ws + OFF_LG) + (size_t)t * 4096; K = 64; ntot = 0; t = 0; }
  const int nkt = K / 64, nt = t / nkt, kt = t % nkt;
  float* tl = (float*)lds;
  const int tid = otid();
  {
    const int c4 = (tid & 15) * 4, ncol = ncol0 + nt * 64 + c4;
#pragma unroll
    for (int i = 0; i < 4; ++i) {
      const int kk = i * 16 + (tid >> 4);
      f32x4 v = {0.f, 0.f, 0.f, 0.f};
      if (ncol + 3 < nlim) v = __builtin_nontemporal_load((const f32x4*)(src + (size_t)(kt * 64 + kk) * ld + ncol));
      tl[kk * 65 + c4] = v[0]; tl[kk * 65 + c4 + 1] = v[1]; tl[kk * 65 + c4 + 2] = v[2]; tl[kk * 65 + c4 + 3] = v[3];
    }
  }
  __syncthreads();
  {
    const int n = tid >> 2, kq = tid & 3;
    float v[16];
#pragma unroll
    for (int e = 0; e < 16; ++e) v[e] = tl[(kq * 16 + e) * 65 + n];
    u32x4 w0 = {pk2(v[0], v[1]), pk2(v[2], v[3]), pk2(v[4], v[5]), pk2(v[6], v[7])};
    u32x4 w1 = {pk2(v[8], v[9]), pk2(v[10], v[11]), pk2(v[12], v[13]), pk2(v[14], v[15])};
    const int nd = nrow0 + nt * 64 + n, kd = kt * 64 + kq * 16;
    bf16_t* d = ntot ? dst + ((size_t)(kd >> 5) * ntot + nd) * 32 + (kd & 31) : dst + (size_t)nd * K + kd;
    *(u32x4*)d = w0;
    *(u32x4*)(d + 8) = w1;
  }
  __syncthreads();
}
DI void job_mod(const Params& p, int it, char* lds) {
  const int nc = it % 96, l = it / 96, tid = otid();
  float* sc = (float*)lds;
  float* red = sc + 5 * 1024;
  for (int i = tid; i < 5 * 1024; i += 256) {
    const int v = i >> 10, k = i & 1023;
    const float cv = v < 4 ? p.c[v * 1024 + k] : p.cctx[k];
    sc[i] = cv * sigm(cv);
  }
  __syncthreads();
  const int cq = tid & 15, kg = tid >> 4, n = nc * 64 + cq * 4;
  const float* w = p.ada_w + ((size_t)l * 1024 + kg * 64) * 6144 + n;
  const float* s0 = sc + kg * 64;
  f32x4 a[5];
#pragma unroll
  for (int v = 0; v < 5; ++v) a[v] = (f32x4){0.f, 0.f, 0.f, 0.f};
#pragma unroll 8
  for (int k = 0; k < 64; ++k) {
    const f32x4 wv = __builtin_nontemporal_load((const f32x4*)(w + (size_t)k * 6144));
#pragma unroll
    for (int v = 0; v < 5; ++v) a[v] += wv * s0[v * 1024 + k];
  }
#pragma unroll
  for (int v = 0; v < 5; ++v)
#pragma unroll
    for (int e = 0; e < 4; ++e) red[(kg * 5 + v) * 64 + cq * 4 + e] = a[v][e];
  __syncthreads();
  for (int i = tid; i < 320; i += 256) {
    const int v = i >> 6, cc = i & 63;
    float r = p.ada_b[l * 6144 + nc * 64 + cc];
#pragma unroll
    for (int q = 0; q < 16; ++q) r += red[(q * 5 + v) * 64 + cc];
    ((float*)(p.ws + OFF_MOD))[(size_t)(l * 5 + v) * 6144 + nc * 64 + cc] = r;
  }
  __syncthreads();
}
DI void job_rope(const Params& p, int it) {
  const int idx = it * 256 + otid(), t = idx >> 5, ax = (idx >> 4) & 1, f = idx & 15;
  const float inv = powf(10000.f, -(float)f / 16.f);
  const float pos = (float)(ax ? (t & 63) : (t >> 6));
  float s, c;
  sincosf(pos * inv, &s, &c);
  ((f32x2*)(p.ws + OFF_ROPE))[idx] = (f32x2){c, s};
}
DI void job_norm(const Params& p, int layer, int which, int it, bool skipctx = false) {
  const int lane = otid() & 63, wid = otid() >> 6, r = it * 8 + wid;
  if (skipctx && (r % TT) < TC) return;
  const float* xr0 = (which == 1) ? res_in_row(p, layer, r) : (const float*)res_out_row(p, r);
  const float* xr1 = (which == 1) ? res_in_row(p, layer, r + 4) : (const float*)res_out_row(p, r + 4);
  const float* mv = mod_vec(p, layer, r);
  const float* sh = mv + (which == 1 ? 0 : 3072);
  const float* sc = mv + (which == 1 ? 1024 : 4096);
  const float* g = (which == 1 ? p.n1g : p.n2g) + layer * 1024;
  f32x4 xa[4], xb[4];
#pragma unroll
  for (int i = 0; i < 2; ++i)
#pragma unroll
    for (int hf = 0; hf < 2; ++hf) {
      xa[2 * i + hf] = __builtin_nontemporal_load((const f32x4*)(xr0 + i * 512 + lane * 8 + hf * 4));
      xb[2 * i + hf] = __builtin_nontemporal_load((const f32x4*)(xr1 + i * 512 + lane * 8 + hf * 4));
    }
  float sa = 0.f, sb = 0.f;
#pragma unroll
  for (int i = 0; i < 4; ++i) {
    sa += xa[i][0] * xa[i][0] + xa[i][1] * xa[i][1] + xa[i][2] * xa[i][2] + xa[i][3] * xa[i][3];
    sb += xb[i][0] * xb[i][0] + xb[i][1] * xb[i][1] + xb[i][2] * xb[i][2] + xb[i][3] * xb[i][3];
  }
  sa = wsum(sa); sb = wsum(sb);
  const float ra = rsqrtf(sa * (1.f / 1024.f) + EPS), rb = rsqrtf(sb * (1.f / 1024.f) + EPS);
  bf16_t* H0 = (bf16_t*)(p.ws + OFF_H) + (size_t)r * 32;
  bf16_t* H1 = H0 + 4 * 32;
#pragma unroll
  for (int i = 0; i < 2; ++i) {
    const int c = i * 512 + lane * 8;
    float o[8], q[8];
#pragma unroll
    for (int hf = 0; hf < 2; ++hf) {
      const f32x4 gv = *(const f32x4*)(g + c + hf * 4), sv = *(const f32x4*)(sc + c + hf * 4), hv = *(const f32x4*)(sh + c + hf * 4);
#pragma unroll
      for (int e = 0; e < 4; ++e) { const float m = gv[e] * (1.f + sv[e]); o[hf * 4 + e] = xa[2 * i + hf][e] * ra * m + hv[e]; q[hf * 4 + e] = xb[2 * i + hf][e] * rb * m + hv[e]; }
    }
    const size_t so = (size_t)(c >> 5) * MR * 32 + (c & 31);
    *(u32x4*)(H0 + so) = (u32x4){pk2(o[0], o[1]), pk2(o[2], o[3]), pk2(o[4], o[5]), pk2(o[6], o[7])};
    *(u32x4*)(H1 + so) = (u32x4){pk2(q[0], q[1]), pk2(q[2], q[3]), pk2(q[4], q[5]), pk2(q[6], q[7])};
  }
}

DI void job_daprep1(const Params& p, int layer, int r, bool dup) {
  const int lane = otid() & 63, s = r % TT;
  const int G = lane >> 2, quarter = lane & 3;
  bf16_t* ptr = (bf16_t*)(p.ws + OFF_P) + (size_t)r * LDP + (G < 8 ? C_DAQ + G * 64 : C_DAK + (G - 8) * 64) + quarter * 16;
  const u32x4 w0 = *(const u32x4*)ptr, w1 = *(const u32x4*)(ptr + 8);
  float y[16];
#pragma unroll
  for (int e = 0; e < 4; ++e) { y[2 * e] = bflo(w0[e]); y[2 * e + 1] = bfhi(w0[e]); y[8 + 2 * e] = bflo(w1[e]); y[9 + 2 * e] = bfhi(w1[e]); }
  float ss = 0.f;
#pragma unroll
  for (int e = 0; e < 16; ++e) ss += y[e] * y[e];
  ss += shx<1>(ss);
  ss += shx<2>(ss);
  float rstd = rsqrtf(ss * (1.f / 64.f) + EPS);
  const float* g = (G < 8 ? p.daqg : p.dakg) + layer * 64 + quarter * 16;
#pragma unroll
  for (int e = 0; e < 16; ++e) y[e] = y[e] * rstd * g[e];
  if (s >= TC) {
    const f32x2* tb = (const f32x2*)(p.ws + OFF_ROPE) + ((size_t)(s - TC) * 2 + (quarter >> 1)) * 16;
#pragma unroll
    for (int e = 0; e < 16; ++e) {
      const float yp = shx<1>(y[e]);
      const f32x2 cs = tb[e];
      y[e] = (quarter & 1) ? (y[e] * cs.x + yp * cs.y) : (y[e] * cs.x - yp * cs.y);
    }
  }
  if (G < 8) {
#pragma unroll
    for (int e = 0; e < 16; ++e) y[e] *= 0.125f * 1.4426950408889634f;
  }
  if (dup) return;
  *(u32x4*)ptr = (u32x4){pk2(y[0], y[1]), pk2(y[2], y[3]), pk2(y[4], y[5]), pk2(y[6], y[7])};
  *(u32x4*)(ptr + 8) = (u32x4){pk2(y[8], y[9]), pk2(y[10], y[11]), pk2(y[12], y[13]), pk2(y[14], y[15])};
}
DI void job_daprep(const Params& p, int layer, int it, bool dup) {
  const int wid = otid() >> 6;
#pragma unroll
  for (int rr = 0; rr < 2; ++rr) job_daprep1(p, layer, it * 8 + rr * 4 + wid, dup);
}
DI void job_vt(const Params& p, int it, char* lds) {
  const int h = it & 3, c = (it >> 2) % NCH, b = it / (4 * NCH), tid = otid();
  bf16_t* tl = (bf16_t*)lds;
  const bf16_t* P = (const bf16_t*)(p.ws + OFF_P);
#pragma unroll
  for (int i = 0; i < 4; ++i) {
    const int q = tid + 256 * i, row = q >> 4, pc = q & 15;
    const u32x4 w = *(const u32x4*)(P + (size_t)(b * TT + c * 64 + row) * LDP + C_DAV + h * 128 + pc * 8);
    unsigned* d = (unsigned*)(tl + row * 130 + pc * 8);
    d[0] = w[0]; d[1] = w[1]; d[2] = w[2]; d[3] = w[3];
  }
  __syncthreads();
  {
    const int dv = tid >> 1, half = tid & 1;
    unsigned o[16];
#pragma unroll
    for (int e = 0; e < 16; ++e) o[e] = (unsigned)tl[(half * 32 + 2 * e) * 130 + dv] | ((unsigned)tl[(half * 32 + 2 * e + 1) * 130 + dv] << 16);
    bf16_t* d = (bf16_t*)(p.ws + OFF_VT) + ((size_t)(b * 4 + h) * 128 + dv) * TT + c * 64 + half * 32;
#pragma unroll
#define VTW(w) o[(((w) & 3) >> 1) * 8 + ((w) >> 2) * 2 + ((w) & 1)]
    for (int e = 0; e < 4; ++e) *(u32x4*)(d + e * 8) = (u32x4){VTW(4 * e), VTW(4 * e + 1), VTW(4 * e + 2), VTW(4 * e + 3)};
#undef VTW
  }
  __syncthreads();
}

constexpr int N_ATT = 1056;
DI void job_attn(const Params& p, int layer, int a, char* lds, bool dup) {
  const int tid = otid(), lane = tid & 63, wid = tid >> 6, l15 = lane & 15, g = lane >> 4;
  const int grp = a / 528, within = a % 528, bh = grp * 8 + (within & 7), qb = within >> 3, b = bh >> 2, h = bh & 3;
  if (layer == 1 && qb < 2) return;
  const int nt = qb < 2 ? 4 : NCH;
  bf16_t* P = (bf16_t*)(p.ws + OFF_P);
  const bf16_t* VT = (const bf16_t*)(p.ws + OFF_VT) + (size_t)(b * 4 + h) * 128 * TT;
  int ly_ = layer; asm volatile("" : "+s"(ly_));
  const float lam_init = __uint_as_float(ly_ == 0 ? 0x3e4ccccdu : 0x3eb60549u);
  const float* lv = p.dalam + layer * 256;
  const float lam = __uint_as_float(__builtin_amdgcn_readfirstlane(__float_as_uint(expf(wsum(lv[lane] * lv[64 + lane])) - expf(wsum(lv[128 + lane] * lv[192 + lane])) + lam_init)));
  const float mq = wmax(fabsf(p.daqg[layer * 64 + lane])), mk = wmax(fabsf(p.dakg[layer * 64 + lane]));
  const float negMb = __uint_as_float(__builtin_amdgcn_readfirstlane(__float_as_uint(-(8.f * mq * mk * 1.03f * 1.4426950408889634f + 0.5f))));
  const int r0 = b * TT + qb * 128 + wid * 32;
  bf16x8 qf[2][2][2];
#pragma unroll
  for (int c = 0; c < 2; ++c)
#pragma unroll
    for (int i = 0; i < 2; ++i)
#pragma unroll
      for (int ks = 0; ks < 2; ++ks) qf[c][i][ks] = *(const bf16x8*)(P + (size_t)(r0 + i * 16 + l15) * LDP + C_DAQ + h * 128 + c * 64 + ks * 32 + g * 8);
  bf16_t* Ks = (bf16_t*)lds;
  bf16_t* Vs = Ks + 2 * 64 * 144;
  u32x4 rk[4], rv[4];
  const bf16_t* kg = P + (size_t)(b * TT) * LDP + C_DAK + h * 128;
#define KLOAD(t) { _Pragma("unroll") for (int i = 0; i < 4; ++i) { const int q = tid + 256 * i; rk[i] = *(const u32x4*)(kg + (size_t)((t) * 64 + (q >> 4)) * LDP + (q & 15) * 8); } }
#define VLOAD(t) { _Pragma("unroll") for (int i = 0; i < 4; ++i) { const int q = tid + 256 * i; rv[i] = *(const u32x4*)(VT + (size_t)(q >> 3) * TT + (t) * 64 + (q & 7) * 8); } }
#define KSTORE(buf) { _Pragma("unroll") for (int i = 0; i < 4; ++i) { const int q = tid + 256 * i; *(u32x4*)(Ks + ((buf) * 64 + (q >> 4)) * 144 + (q & 15) * 8) = rk[i]; } }
#define VSTORE(buf) { _Pragma("unroll") for (int i = 0; i < 4; ++i) { const int q = tid + 256 * i; *(u32x4*)(Vs + ((buf) * 128 + (q >> 3)) * 80 + (q & 7) * 8) = rv[i]; } }
#define QK_INTO(S, Kb, half, CI)                                                                                       \
  _Pragma("unroll") for (int c = 0; c < 2; ++c) {                                                                      \
    bf16x8 kf[2][2];                                                                                                   \
    _Pragma("unroll") for (int k2 = 0; k2 < 2; ++k2) _Pragma("unroll") for (int ks = 0; ks < 2; ++ks)                  \
      kf[k2][ks] = *(const bf16x8*)((Kb) + ((half) * 32 + k2 * 16 + l15) * 144 + c * 64 + ks * 32 + g * 8);             \
    __builtin_amdgcn_sched_barrier(0);                                                                                 \
    _Pragma("unroll") for (int k2 = 0; k2 < 2; ++k2) _Pragma("unroll") for (int i = 0; i < 2; ++i) {                   \
      S[c][i][k2] = mfma16(kf[k2][0], qf[c][i][0], CI(c, i));     \
      S[c][i][k2] = mfma16(kf[k2][1], qf[c][i][1], S[c][i][k2]); }                                                     \
  }                                                                                                                    \
  __builtin_amdgcn_sched_barrier(0);
#define EXPSUM(S)                                                                                                      \
  _Pragma("unroll") for (int c = 0; c < 2; ++c) _Pragma("unroll") for (int i = 0; i < 2; ++i) {                        \
    _Pragma("unroll") for (int k2 = 0; k2 < 2; ++k2) _Pragma("unroll") for (int e = 0; e < 4; ++e) S[c][i][k2][e] = __builtin_amdgcn_exp2f(S[c][i][k2][e]); \
    lsum[c][i] += ((S[c][i][0][0] + S[c][i][0][1]) + (S[c][i][0][2] + S[c][i][0][3])) + ((S[c][i][1][0] + S[c][i][1][1]) + (S[c][i][1][2] + S[c][i][1][3])); }
#define EXP_S() _Pragma("unroll") for (int c = 0; c < 2; ++c) _Pragma("unroll") for (int i = 0; i < 2; ++i) _Pragma("unroll") for (int k2 = 0; k2 < 2; ++k2) _Pragma("unroll") for (int e = 0; e < 4; ++e) S[c][i][k2][e] = __builtin_amdgcn_exp2f(S[c][i][k2][e]);
  float lsum[2][2] = {{0.f, 0.f}, {0.f, 0.f}};
  KLOAD(0);
  KSTORE(0);
  __syncthreads();
  const f32x4 negMv = {negMb, negMb, negMb, negMb};
#define CI1(c, i) negMv
  f32x4 SA[2][2][2], SB[2][2][2];
#pragma unroll 1
  for (int t = 0; t < nt; ++t) {
    if (t + 1 < nt) KLOAD(t + 1);
    const bf16_t* Kb = Ks + (t & 1) * 64 * 144;
    QK_INTO(SA, Kb, 0, CI1)
    if (t > 0) { EXPSUM(SB) }
    __builtin_amdgcn_sched_barrier(0);
    QK_INTO(SB, Kb, 1, CI1)
    EXPSUM(SA)
    if (t + 1 < nt) KSTORE((t + 1) & 1);
    __syncthreads();
  }
  EXPSUM(SB)
  f32x4 ci2[2][2];
#pragma unroll
  for (int i = 0; i < 2; ++i) {
    float l0 = lsum[0][i], l1 = lsum[1][i];
    l0 += shx<16>(l0); l0 = add32(l0);
    l1 += shx<16>(l1); l1 = add32(l1);
    const float c0 = negMb - __log2f(l0), c1 = negMb + __log2f(fabsf(lam)) - __log2f(l1);
    ci2[0][i] = (f32x4){c0, c0, c0, c0}; ci2[1][i] = (f32x4){c1, c1, c1, c1};
  }
  const float nsl = lam < 0.f ? 1.f : -1.f;
#define CI2(c, i) ci2[c][i]
  f32x4 O[2][8];
#pragma unroll
  for (int i = 0; i < 2; ++i)
#pragma unroll
    for (int n = 0; n < 8; ++n) O[i][n] = (f32x4){0.f, 0.f, 0.f, 0.f};
  KLOAD(0); VLOAD(0);
  KSTORE(0); VSTORE(0);
  __syncthreads();
#pragma unroll 1
  for (int t = 0; t < nt; ++t) {
    if (t + 1 < nt) KLOAD(t + 1);
    const bf16_t* Kb = Ks + (t & 1) * 64 * 144;
    const bf16_t* Vb = Vs + (t & 1) * 128 * 80;
#pragma unroll
    for (int half = 0; half < 2; ++half) {
      bf16x8 pf[2], vfa[4], vfb[4];
#define VREAD(dst, n0) _Pragma("unroll") for (int n = 0; n < 4; ++n) dst[n] = *(const bf16x8*)(Vb + (((n0) + n) * 16 + l15) * 80 + half * 32 + g * 8);
      {
        f32x4 S[2][2][2];
        QK_INTO(S, Kb, half, CI2)
        VREAD(vfa, 0)
        EXP_S()
#pragma unroll
        for (int i = 0; i < 2; ++i) {
          float w[8];
#pragma unroll
          for (int k2 = 0; k2 < 2; ++k2)
#pragma unroll
            for (int e = 0; e < 4; ++e) w[k2 * 4 + e] = __builtin_fmaf(nsl, S[1][i][k2][e], S[0][i][k2][e]);
          const u32x4 ww = {pk2(w[0], w[1]), pk2(w[2], w[3]), pk2(w[4], w[5]), pk2(w[6], w[7])};
          pf[i] = __builtin_bit_cast(bf16x8, ww);
        }
      }
      __builtin_amdgcn_sched_barrier(0);
      VREAD(vfb, 4)
#pragma unroll
      for (int n = 0; n < 4; ++n)
#pragma unroll
        for (int i = 0; i < 2; ++i) O[i][n] = mfma16(pf[i], vfa[n], O[i][n]);
      __builtin_amdgcn_sched_barrier(0);
#pragma unroll
      for (int n = 0; n < 4; ++n)
#pragma unroll
        for (int i = 0; i < 2; ++i) O[i][4 + n] = mfma16(pf[i], vfb[n], O[i][4 + n]);
      __builtin_amdgcn_sched_barrier(0);
#undef VREAD
      if (half == 0 && t + 1 < nt) VLOAD(t + 1);
    }
    if (t + 1 < nt) { KSTORE((t + 1) & 1); VSTORE((t + 1) & 1); }
    __syncthreads();
  }
#undef KLOAD
#undef VLOAD
#undef KSTORE
#undef VSTORE
#undef CI1
#undef CI2
#undef QK_INTO
#undef EXPSUM
#undef EXP_S
  const int lane_e = otid() & 63, l15e = lane_e & 15, ge = lane_e >> 4;
  const float* sg = p.dasub + layer * 128;
#pragma unroll
  for (int i = 0; i < 2; ++i)
#pragma unroll
    for (int e = 0; e < 4; ++e) {
      float ss = 0.f;
#pragma unroll
      for (int n = 0; n < 8; ++n) ss += O[i][n][e] * O[i][n][e];
      ss += shx<1>(ss); ss += shx<2>(ss); ss += shx<4>(ss); ss += shx<8>(ss);
      const float rstd = rsqrtf(ss * (1.f / 128.f) + EPS) * (1.f - lam_init);
      bf16_t* op = P + (size_t)(r0 + i * 16 + ge * 4 + e) * LDP + C_DAQ + h * 128 + l15e;
#pragma unroll
      for (int n = 0; n < 8; ++n) if (!dup) op[n * 16] = f2bf(O[i][n][e] * rstd * sg[n * 16 + l15e]);
    }
}

DI float gelu_tanh(float x) { const float u = 0.7978845608028654f * (x + 0.044715f * x * x * x); return 0.5f * x * (1.f + tanhf(u)); }
template <int PASS>
DI void job_lru(const Params& p, int layer, int it, char* lds, bool dup) {
  const int tid = otid(), lane = tid & 63, wid = tid >> 6, l15 = lane & 15, g = lane >> 4;
  const int n = it & 7, c = (it >> 3) % NCH, b = it / (8 * NCH);
  if (PASS == 3 && layer == 1 && c < 4) return;
  float* xc32 = (float*)lds;
  bf16_t* xcb = (bf16_t*)(lds + 16384);
  f32x2* ab = (f32x2*)(lds + 16384 + 9216);
  f32x2* segtot = (f32x2*)(lds + 16384 + 9216 + 32768);
  float* carry = (float*)(lds + 16384 + 9216 + 32768 + 2048);
  bf16_t* P = (bf16_t*)(p.ws + OFF_P);
  f32x2* LC = (f32x2*)(p.ws + OFF_LC);
  const int ch = tid & 63, seg = tid >> 6;
  bf16x8 gwf[2][2][2];
  {
    const bf16_t* LG = (const bf16_t*)(p.ws + OFF_LG);
#pragma unroll
    for (int d = 0; d < 2; ++d)
#pragma unroll
      for (int gt = 0; gt < 2; ++gt)
#pragma unroll
        for (int ks = 0; ks < 2; ++ks) gwf[d][gt][ks] = *(const bf16x8*)(LG + ((size_t)((d * 2 + gt) * 8 + n)) * 4096 + (wid * 16 + l15) * 64 + g * 8 + ks * 32);
  }
  {
    const int segLo = c < 4 ? 0 : TC, segHi = c < 4 ? TC : TT;
    const int cp2 = (tid & 31) * 2, tg = tid >> 5;
    const int s0 = c * 64 + tg * 8;
    float cw0[4], cw1[4];
#pragma unroll
    for (int k = 0; k < 4; ++k) { cw0[k] = p.lcw[(size_t)(layer * 4 + k) * 512 + n * 64 + cp2]; cw1[k] = p.lcw[(size_t)(layer * 4 + k) * 512 + n * 64 + cp2 + 1]; }
    const float cb0 = p.lcb[layer * 512 + n * 64 + cp2], cb1 = p.lcb[layer * 512 + n * 64 + cp2 + 1];
    unsigned xw[11];
#pragma unroll
    for (int j = 0; j < 11; ++j) {
      const int s = s0 - 1 + j;
      xw[j] = (s >= segLo && s < segHi) ? *(const unsigned*)(P + (size_t)(b * TT + s) * LDP + C_LX + n * 64 + cp2) : 0u;
    }
#pragma unroll
    for (int u = 0; u < 8; ++u) {
      const float v0 = cw0[0] * bflo(xw[u]) + cw0[1] * bflo(xw[u + 1]) + cw0[2] * bflo(xw[u + 2]) + cw0[3] * bflo(xw[u + 3]) + cb0;
      const float v1 = cw1[0] * bfhi(xw[u]) + cw1[1] * bfhi(xw[u + 1]) + cw1[2] * bfhi(xw[u + 2]) + cw1[3] * bfhi(xw[u + 3]) + cb1;
      *(f32x2*)(xc32 + (tg * 8 + u) * 64 + cp2) = (f32x2){v0, v1};
      *(unsigned*)(xcb + (tg * 8 + u) * 72 + cp2) = pk2(v0, v1);
    }
  }
  if (PASS == 3 && tid < 128) {
    const int d = tid >> 6;
    const int pos = d == 0 ? c : (c < 4 ? 3 - c : 4 + (NCH - 1 - c));
    float hh = 0.f;
    for (int q0 = 0; q0 < pos; q0 += 16) {
      f32x2 AB[16];
#pragma unroll
      for (int j = 0; j < 16; ++j) {
        const int q = q0 + j, qq = q < pos ? q : pos - 1;
        const int cc = d == 0 ? qq : (qq < 4 ? 3 - qq : NCH - 1 - (qq - 4));
        AB[j] = LC[((((size_t)b * NCH + cc) * 8 + n) * 2 + d) * 64 + ch];
      }
#pragma unroll
      for (int j = 0; j < 16; ++j) if (q0 + j < pos) hh = AB[j].x * hh + AB[j].y;
    }
    carry[d * 64 + ch] = hh;
  }
  __syncthreads();
  float hacc[16];
#pragma unroll
  for (int u = 0; u < 16; ++u) hacc[u] = 0.f;
#pragma unroll
  for (int d = 0; d < 2; ++d) {
    {
      f32x4 ar[4], ai[4];
#pragma unroll
      for (int i = 0; i < 4; ++i) { ar[i] = (f32x4){0.f, 0.f, 0.f, 0.f}; ai[i] = (f32x4){0.f, 0.f, 0.f, 0.f}; }
#pragma unroll
      for (int ks = 0; ks < 2; ++ks) {
        const bf16x8 br = gwf[d][0][ks], bi = gwf[d][1][ks];
#pragma unroll
        for (int i = 0; i < 4; ++i) {
          const bf16x8 af = *(const bf16x8*)(xcb + (i * 16 + l15) * 72 + ks * 32 + g * 8);
          ar[i] = mfma16(br, af, ar[i]);
          ai[i] = mfma16(bi, af, ai[i]);
        }
      }
#pragma unroll
      for (int e = 0; e < 4; ++e) {
        const int che = wid * 16 + g * 4 + e, cg_ = n * 64 + che;
        const float br = p.lgb[(size_t)((layer * 2 + d) * 2 + 0) * 512 + cg_], bi = p.lgb[(size_t)((layer * 2 + d) * 2 + 1) * 512 + cg_];
        const float sp = softplusf(-p.llam[(size_t)(layer * 2 + d) * 512 + cg_]);
#pragma unroll
        for (int i = 0; i < 4; ++i) {
          const int tok = i * 16 + l15;
          const float r = sigm(ar[i][e] + br), ig = sigm(ai[i][e] + bi);
          const float la = -8.f * r * sp;
          const float av = __expf(la);
          const float bv = __builtin_sqrtf(fmaxf(1.f - __expf(2.f * la), 0.f)) * ig * xc32[tok * 64 + che];
          ab[tok * 64 + che] = (f32x2){av, bv};
        }
      }
    }
    __syncthreads();
    float hloc[16], cploc[16];
    {
      float hp = 0.f, cp = 1.f;
#pragma unroll
      for (int uu = 0; uu < 16; ++uu) {
        const int u = d == 0 ? uu : 15 - uu;
        const f32x2 v = ab[(seg * 16 + u) * 64 + ch];
        hp = v.x * hp + v.y;
        cp *= v.x;
        hloc[uu] = hp; cploc[uu] = cp;
      }
      segtot[seg * 64 + ch] = (f32x2){cp, hp};
    }
    __syncthreads();
    if (PASS == 1) {
      if (tid < 64) {
        float A = 1.f, Bv = 0.f;
#pragma unroll
        for (int q = 0; q < 4; ++q) {
          const f32x2 v = segtot[(d == 0 ? q : 3 - q) * 64 + ch];
          Bv = v.x * Bv + v.y; A *= v.x;
        }
        LC[((((size_t)b * NCH + c) * 8 + n) * 2 + d) * 64 + ch] = (f32x2){A, Bv};
      }
    } else {
      float hh = carry[d * 64 + ch];
      const int npre = d == 0 ? seg : 3 - seg;
      for (int q = 0; q < npre; ++q) {
        const f32x2 v = segtot[(d == 0 ? q : 3 - q) * 64 + ch];
        hh = v.x * hh + v.y;
      }
#pragma unroll
      for (int uu = 0; uu < 16; ++uu) {
        const int u = d == 0 ? uu : 15 - uu;
        const float hv = hloc[uu] + cploc[uu] * hh;
        hacc[d == 0 ? uu : 15 - uu] += hv;
        (void)u;
      }
    }
    __syncthreads();
  }
  if (PASS == 3) {
#pragma unroll
    for (int u = 0; u < 16; ++u) xc32[(seg * 16 + u) * 64 + ch] = hacc[u];
    __syncthreads();
    const int cp2 = (tid & 31) * 2, tg = tid >> 5;
#pragma unroll
    for (int u = 0; u < 8; ++u) {
      const int tok = tg * 8 + u;
      unsigned* yp = (unsigned*)(P + (size_t)(b * TT + c * 64 + tok) * LDP + C_LY + n * 64 + cp2);
      const f32x2 hv = *(const f32x2*)(xc32 + tok * 64 + cp2);
      const unsigned y = *yp;
      if (!dup) *yp = pk2(gelu_tanh(bflo(y)) * hv.x, gelu_tanh(bfhi(y)) * hv.y);
    }
    __syncthreads();
  }
}

DI void job_gconv(const Params& p, int layer, int it, bool dup) {
  const int tid = otid(), grp = it % 12, cg_ = it / 12, cp = tid & 15, rg = tid >> 4;
  const int cin = cg_ % NCH;
  const bool first = (cin == 0 || cin == 4), last = (cin == 3 || cin == NCH - 1);
  bf16_t* P = (bf16_t*)(p.ws + OFF_P);
  const bf16_t* HALO = (const bf16_t*)(p.ws + OFF_HALO);
  const int col = grp * 128 + cp * 8;
  u32x4 xr[7];
#pragma unroll
  for (int j = 0; j < 7; ++j) {
    const int q = rg * 4 - 1 + j;
    u32x4 v = {0u, 0u, 0u, 0u};
    if (q >= 0 && q < 64) v = *(const u32x4*)(P + (size_t)(cg_ * 64 + q) * LDP + C_GQKV + col);
    else if (q < 0) { if (!first) v = *(const u32x4*)(HALO + ((size_t)(cg_ - 1) * 3 + 2) * 1536 + col); }
    else { if (!last) v = *(const u32x4*)(HALO + ((size_t)(cg_ + 1) * 3 + (q - 64)) * 1536 + col); }
    xr[j] = v;
  }
  float w[4][8];
#pragma unroll
  for (int k = 0; k < 4; ++k) {
    const f32x4 a = *(const f32x4*)(p.gcw + (size_t)(layer * 4 + k) * 1536 + col), bq = *(const f32x4*)(p.gcw + (size_t)(layer * 4 + k) * 1536 + col + 4);
#pragma unroll
    for (int e = 0; e < 4; ++e) { w[k][e] = a[e]; w[k][4 + e] = bq[e]; }
  }
  __syncthreads();
#pragma unroll
  for (int jr = 0; jr < 4; ++jr) {
    float y[8];
#pragma unroll
    for (int e = 0; e < 8; ++e) y[e] = 0.f;
#pragma unroll
    for (int k = 0; k < 4; ++k)
#pragma unroll
      for (int e = 0; e < 4; ++e) { y[2 * e] += w[k][2 * e] * bflo(xr[jr + k][e]); y[2 * e + 1] += w[k][2 * e + 1] * bfhi(xr[jr + k][e]); }
    float ss = 0.f;
#pragma unroll
    for (int e = 0; e < 8; ++e) { y[e] = y[e] * sigm(y[e]); ss += y[e] * y[e]; }
    if (grp < 8) {
      ss += shx<1>(ss); ss += shx<2>(ss); ss += shx<4>(ss); ss += shx<8>(ss);
      const float sc = rsqrtf(ss + EPS) * (grp < 4 ? 0.08838834764831845f : 1.f);
#pragma unroll
      for (int e = 0; e < 8; ++e) y[e] *= sc;
    }
    if (!dup) *(u32x4*)(P + (size_t)(cg_ * 64 + rg * 4 + jr) * LDP + C_GQKV + col) = (u32x4){pk2(y[0], y[1]), pk2(y[2], y[3]), pk2(y[4], y[5]), pk2(y[6], y[7])};
  }
  __syncthreads();
}

DI void job_gprep(const Params& p, int layer, int it, char* lds) {
  const int tid = otid(), lane = tid & 63, wid = tid >> 6, l15 = lane & 15, g = lane >> 4;
  const int h = it & 3, c = (it >> 2) % NCH, b = it / (4 * NCH);
  bf16_t* kt_ = (bf16_t*)lds;
  bf16_t* qt_ = kt_ + 64 * 136;
  float* Ld = (float*)lds;
  float* KK = (float*)(lds + 34816);
  float* QK = KK + 64 * 65;
  float* gcs = QK + 64 * 65;
  float* bts = gcs + 128;
  const bf16_t* P = (const bf16_t*)(p.ws + OFF_P);
#pragma unroll
  for (int i = 0; i < 4; ++i) {
    const int q = tid + 256 * i, row = q >> 4, pc = q & 15;
    const bf16_t* rp = P + (size_t)(b * TT + c * 64 + row) * LDP + C_GQKV + h * 128 + pc * 8;
    *(u32x4*)(qt_ + row * 136 + pc * 8) = *(const u32x4*)rp;
    *(u32x4*)(kt_ + row * 136 + pc * 8) = *(const u32x4*)(rp + 512);
  }
  float* GSC = (float*)(p.ws + OFF_GSC);
  if (tid < 128) {
    const int d = wid, i = lane, tn = d ? 63 - i : i, r = b * TT + c * 64 + tn;
    const float* gba = (const float*)(p.ws + OFF_GBA) + (size_t)r * 16;
    const float gval = -expf(p.galog[(layer * 2 + d) * 4 + h]) * softplusf(gba[8 + d * 4 + h] + p.gdtb[(layer * 2 + d) * 4 + h]);
    const float beta = sigm(gba[d * 4 + h]);
    float v = gval;
#pragma unroll
    for (int o = 1; o < 64; o <<= 1) { const float t = __int_as_float(__builtin_amdgcn_ds_bpermute(((lane - o) & 63) << 2, __float_as_int(v))); if (lane >= o) v += t; }
    const float glast = __int_as_float(__builtin_amdgcn_readlane(__float_as_int(v), 63));
    gcs[d * 64 + i] = v;
    bts[d * 64 + i] = beta;
    float* gs = GSC + (size_t)(it * 2 + d) * 192;
    gs[i] = expf(v);
    gs[64 + i] = expf(glast - v);
    if (i == 0) gs[128] = expf(glast);
  }
  __syncthreads();
  {
    f32x4 akk[4], aqk[4];
#pragma unroll
    for (int j = 0; j < 4; ++j) { akk[j] = (f32x4){0.f, 0.f, 0.f, 0.f}; aqk[j] = (f32x4){0.f, 0.f, 0.f, 0.f}; }
#pragma unroll
    for (int ks = 0; ks < 4; ++ks) {
      const bf16x8 ak = *(const bf16x8*)(kt_ + (wid * 16 + l15) * 136 + ks * 32 + g * 8);
      const bf16x8 aq = *(const bf16x8*)(qt_ + (wid * 16 + l15) * 136 + ks * 32 + g * 8);
#pragma unroll
      for (int j = 0; j < 4; ++j) {
        const bf16x8 bk = *(const bf16x8*)(kt_ + (j * 16 + l15) * 136 + ks * 32 + g * 8);
        akk[j] = mfma16(ak, bk, akk[j]);
        aqk[j] = mfma16(aq, bk, aqk[j]);
      }
    }
#pragma unroll
    for (int j = 0; j < 4; ++j)
#pragma unroll
      for (int e = 0; e < 4; ++e) { KK[(wid * 16 + g * 4 + e) * 65 + j * 16 + l15] = akk[j][e]; QK[(wid * 16 + g * 4 + e) * 65 + j * 16 + l15] = aqk[j][e]; }
  }
  __syncthreads();
  bf16_t* M1 = (bf16_t*)(p.ws + OFF_H);
  bf16_t* AT = M1 + (size_t)4224 * 4096;
#pragma unroll 1
  for (int d = 0; d < 2; ++d) {
    bf16_t* atp = AT + (size_t)(it * 2 + d) * 4096;
#pragma unroll 4
    for (int id2 = tid; id2 < 2048; id2 += 256) {
      const int idx = 2 * id2, i = idx >> 6, j = idx & 63, ti = d ? 63 - i : i, tj0 = d ? 63 - j : j, tj1 = d ? 62 - j : j + 1;
      const float gi = gcs[d * 64 + i];
      const float dec0 = (j <= i) ? expf(gi - gcs[d * 64 + j]) : 0.f, dec1 = (j + 1 <= i) ? expf(gi - gcs[d * 64 + j + 1]) : 0.f;
      const float bi = bts[d * 64 + i];
      *(f32x2*)(Ld + d * 4096 + idx) = (f32x2){(j < i) ? bi * KK[ti * 65 + tj0] * dec0 : 0.f, (j + 1 < i) ? bi * KK[ti * 65 + tj1] * dec1 : 0.f};
      *(unsigned*)(atp + idx) = pk2(QK[ti * 65 + tj0] * dec0, QK[ti * 65 + tj1] * dec1);
    }
  }
  __syncthreads();
  if (wid < 2) {
    const int d = wid;
    const float* L = Ld + d * 4096;
    const float bc = bts[d * 64 + lane];
    bf16_t* mp = M1 + (size_t)(it * 2 + d) * 4096 + lane;
    float x[64];
#pragma unroll
    for (int i = 0; i < 64; ++i) {
      float s = (i == lane) ? 1.f : 0.f;
#pragma unroll
      for (int j = 0; j < i; ++j) s -= L[i * 64 + j] * x[j];
      x[i] = s;
      mp[i * 64] = f2bf(s * bc);
    }
  }
  __syncthreads();
}

struct GChunk { bf16x8 kf[4], qf[4], m1f[2], atf[2]; unsigned vr[2][4]; float eg[4], egl[4]; float ge; };
DI void gdn_load(GChunk& R, const Params& p, int b, int h, int d, int dvs, int c) {
  const int tid = otid(), lane = tid & 63, wid = tid >> 6, l15 = lane & 15, g = lane >> 4;
  const bf16_t* P = (const bf16_t*)(p.ws + OFF_P);
  const bf16_t* M1 = (const bf16_t*)(p.ws + OFF_H);
  const bf16_t* AT = M1 + (size_t)4224 * 4096;
  const float* GSC = (const float*)(p.ws + OFF_GSC);
  const int item = ((b * NCH + c) * 4 + h) * 2 + d;
  const int irow = 16 * wid + l15, tn = d ? 63 - irow : irow;
  const bf16_t* rowp = P + (size_t)(b * TT + c * 64 + tn) * LDP + C_GQKV + h * 128;
#pragma unroll
  for (int ks = 0; ks < 4; ++ks) { R.qf[ks] = *(const bf16x8*)(rowp + ks * 32 + g * 8); R.kf[ks] = *(const bf16x8*)(rowp + 512 + ks * 32 + g * 8); }
#pragma unroll
  for (int ks = 0; ks < 2; ++ks) {
    R.m1f[ks] = *(const bf16x8*)(M1 + (size_t)item * 4096 + irow * 64 + ks * 32 + g * 8);
    R.atf[ks] = *(const bf16x8*)(AT + (size_t)item * 4096 + irow * 64 + ks * 32 + g * 8);
  }
#pragma unroll
  for (int e = 0; e < 4; ++e) {
    const int i = 16 * wid + g * 4 + e, t2 = d ? 63 - i : i;
    R.vr[0][e] = *(const unsigned*)(P + (size_t)(b * TT + c * 64 + t2) * LDP + C_GQKV + 1024 + h * 128 + dvs * 32 + (l15 & ~1));
    R.vr[1][e] = *(const unsigned*)(P + (size_t)(b * TT + c * 64 + t2) * LDP + C_GQKV + 1024 + h * 128 + dvs * 32 + 16 + (l15 & ~1));
    R.eg[e] = GSC[(size_t)item * 192 + i];
    R.egl[e] = GSC[(size_t)item * 192 + 64 + i];
  }
  R.ge = GSC[(size_t)item * 192 + 128];
}
DI void gdn_put_kt(const GChunk& R, bf16_t* KT) {
  const int tid = otid(), lane = tid & 63, i = 16 * (tid >> 6) + (lane & 15), g = lane >> 4;
#pragma unroll
  for (int ks = 0; ks < 4; ++ks)
#pragma unroll
    for (int e = 0; e < 8; ++e) KT[(ks * 32 + g * 8 + e) * 72 + i] = (bf16_t)R.kf[ks][e];
}
DI int gdn_chunk_at(int d, int n) { return d == 0 ? n : (n < 4 ? 3 - n : NCH - 1 - (n - 4)); }
DI void job_gscan(const Params& p, int u, char* lds) {
  const int tid = otid(), lane = tid & 63, wid = tid >> 6, l15 = lane & 15, g = lane >> 4;
  const int seq = (u & 7) + 8 * (u >> 5), dvs = (u >> 3) & 3, d = seq & 1, h = (seq >> 1) & 3, b = seq >> 3;
  bf16_t* KT = (bf16_t*)lds;
  bf16_t* ST = KT + 2 * 128 * 72;
  bf16_t* XT = ST + 32 * 136;
  bf16_t* VnT = XT + 32 * 72;
  bf16_t* VsT = VnT + 32 * 72;
  bf16_t* OUT = d == 0 ? (bf16_t*)(p.ws + OFF_P) + C_DAV : (bf16_t*)(p.ws + OFF_OB);
  const int ldo = d == 0 ? LDP : 512;
  __builtin_amdgcn_s_setprio(3);
  f32x4 S[2][2];
#pragma unroll
  for (int a = 0; a < 2; ++a)
#pragma unroll
    for (int ct = 0; ct < 2; ++ct) S[a][ct] = (f32x4){0.f, 0.f, 0.f, 0.f};
  for (int i = tid; i < 32 * 136 / 2; i += 256) ((unsigned*)ST)[i] = 0u;
  GChunk cur, nxt;
  gdn_load(cur, p, b, h, d, dvs, gdn_chunk_at(d, 0));
  gdn_put_kt(cur, KT);
  __syncthreads();
#pragma unroll 1
  for (int n = 0; n < NCH; ++n) {
    const int c = gdn_chunk_at(d, n);
    if (n + 1 < NCH) gdn_load(nxt, p, b, h, d, dvs, gdn_chunk_at(d, n + 1));
    const bf16_t* KTc = KT + (n & 1) * 128 * 72;
    f32x4 ksa[2], qsa[2];
#pragma unroll
    for (int ct = 0; ct < 2; ++ct) { ksa[ct] = (f32x4){0.f, 0.f, 0.f, 0.f}; qsa[ct] = (f32x4){0.f, 0.f, 0.f, 0.f}; }
#pragma unroll
    for (int ks = 0; ks < 4; ++ks)
#pragma unroll
      for (int ct = 0; ct < 2; ++ct) {
        const bf16x8 bS = *(const bf16x8*)(ST + (ct * 16 + l15) * 136 + ks * 32 + g * 8);
        ksa[ct] = mfma16(cur.kf[ks], bS, ksa[ct]);
        qsa[ct] = mfma16(cur.qf[ks], bS, qsa[ct]);
      }
#pragma unroll
    for (int ct = 0; ct < 2; ++ct) {
      float x[4];
#pragma unroll
      for (int e = 0; e < 4; ++e) x[e] = ((l15 & 1) ? bfhi(cur.vr[ct][e]) : bflo(cur.vr[ct][e])) - cur.eg[e] * ksa[ct][e];
      *(u32x2*)(XT + (ct * 16 + l15) * 72 + 16 * wid + g * 4) = (u32x2){pk2(x[0], x[1]), pk2(x[2], x[3])};
    }
    __syncthreads();
#pragma unroll
    for (int ct = 0; ct < 2; ++ct) {
      f32x4 vn = {0.f, 0.f, 0.f, 0.f};
#pragma unroll
      for (int ks = 0; ks < 2; ++ks) vn = mfma16(cur.m1f[ks], *(const bf16x8*)(XT + (ct * 16 + l15) * 72 + ks * 32 + g * 8), vn);
      *(u32x2*)(VnT + (ct * 16 + l15) * 72 + 16 * wid + g * 4) = (u32x2){pk2(vn[0], vn[1]), pk2(vn[2], vn[3])};
      *(u32x2*)(VsT + (ct * 16 + l15) * 72 + 16 * wid + g * 4) = (u32x2){pk2(vn[0] * cur.egl[0], vn[1] * cur.egl[1]), pk2(vn[2] * cur.egl[2], vn[3] * cur.egl[3])};
    }
    __syncthreads();
#pragma unroll
    for (int ct = 0; ct < 2; ++ct) {
      f32x4 o;
#pragma unroll
      for (int e = 0; e < 4; ++e) o[e] = cur.eg[e] * qsa[ct][e];
#pragma unroll
      for (int ks = 0; ks < 2; ++ks) o = mfma16(cur.atf[ks], *(const bf16x8*)(VnT + (ct * 16 + l15) * 72 + ks * 32 + g * 8), o);
      {
        const bool odd = l15 & 1;
        const float r0 = shx<1>(odd ? o[0] : o[2]), r1 = shx<1>(odd ? o[1] : o[3]);
#pragma unroll
        for (int q = 0; q < 2; ++q) {
          const int e = (odd ? 2 : 0) + q, i = 16 * wid + g * 4 + e, t2 = d ? 63 - i : i;
          const float mine = odd ? (q ? o[3] : o[2]) : (q ? o[1] : o[0]), other = q ? r1 : r0;
          *(unsigned*)(OUT + (size_t)(b * TT + c * 64 + t2) * ldo + h * 128 + dvs * 32 + ct * 16 + (l15 & ~1)) = odd ? pk2(other, mine) : pk2(mine, other);
        }
      }
    }
#pragma unroll
    for (int rt2 = 0; rt2 < 2; ++rt2) {
      const int rt = 2 * wid + rt2;
#pragma unroll
      for (int ct = 0; ct < 2; ++ct)
#pragma unroll
        for (int e = 0; e < 4; ++e) S[rt2][ct][e] *= cur.ge;
#pragma unroll
      for (int ks = 0; ks < 2; ++ks) {
        const bf16x8 ka = *(const bf16x8*)(KTc + (rt * 16 + l15) * 72 + ks * 32 + g * 8);
#pragma unroll
        for (int ct = 0; ct < 2; ++ct) S[rt2][ct] = mfma16(ka, *(const bf16x8*)(VsT + (ct * 16 + l15) * 72 + ks * 32 + g * 8), S[rt2][ct]);
      }
#pragma unroll
      for (int ct = 0; ct < 2; ++ct)
        *(u32x2*)(ST + (ct * 16 + l15) * 136 + rt * 16 + g * 4) = (u32x2){pk2(S[rt2][ct][0], S[rt2][ct][1]), pk2(S[rt2][ct][2], S[rt2][ct][3])};
    }
    if (n + 1 < NCH) { gdn_put_kt(nxt, KT + ((n + 1) & 1) * 128 * 72); cur = nxt; }
    __syncthreads();
  }
  __builtin_amdgcn_s_setprio(0);
}
DI void job_gpost1(const Params& p, int layer, int r) {
  const int lane = otid() & 63;
  if (layer == 1 && (r % TT) < TC) return;
  bf16_t* P = (bf16_t*)(p.ws + OFF_P) + (size_t)r * LDP;
  const bf16_t* OB = (const bf16_t*)(p.ws + OFF_OB) + (size_t)r * 512;
  const u32x4 of = *(const u32x4*)(P + C_DAV + lane * 8), ob = *(const u32x4*)(OB + lane * 8), z = *(const u32x4*)(P + C_GZ + lane * 8);
  float o[8], zz[8], ss = 0.f;
#pragma unroll
  for (int e = 0; e < 4; ++e) {
    o[2 * e] = bflo(of[e]) + bflo(ob[e]); o[2 * e + 1] = bfhi(of[e]) + bfhi(ob[e]);
    zz[2 * e] = bflo(z[e]); zz[2 * e + 1] = bfhi(z[e]);
  }
#pragma unroll
  for (int e = 0; e < 8; ++e) ss += o[e] * o[e];
  ss += shx<1>(ss); ss += shx<2>(ss); ss += shx<4>(ss); ss += shx<8>(ss);
  const float rstd = rsqrtf(ss * (1.f / 128.f) + EPS);
  const float* gn = p.gng + layer * 128 + (lane & 15) * 8;
  float y[8];
#pragma unroll
  for (int e = 0; e < 8; ++e) y[e] = o[e] * rstd * gn[e] * (zz[e] * sigm(zz[e]));
  *(u32x4*)(P + C_GZ + lane * 8) = (u32x4){pk2(y[0], y[1]), pk2(y[2], y[3]), pk2(y[4], y[5]), pk2(y[6], y[7])};
}

DI void job_gpost(const Params& p, int layer, int it) {
  const int wid = otid() >> 6;
#pragma unroll
  for (int rr = 0; rr < 2; ++rr) job_gpost1(p, layer, it * 8 + rr * 4 + wid);
}
#ifdef SK_JL1
#define JL1(x)
#else
#define JL1(x) x
#endif
#ifdef SK_JGC
#define JGC(x)
#else
#define JGC(x) x
#endif
#ifdef SK_JVT
#define JVT(x)
#else
#define JVT(x) x
#endif
#ifdef SK_JDP
#define JDP(x)
#else
#define JDP(x) x
#endif
#ifdef SK_JGP
#define JGP(x)
#else
#define JGP(x) x
#endif
#ifdef SK_JL3
#define JL3(x)
#else
#define JL3(x) x
#endif
#ifdef SK_JGS
#define JGS(x)
#else
#define JGS(x) x
#endif
#ifdef SK_JAT
#define JAT(x)
#else
#define JAT(x) x
#endif
#define LAS __attribute__((address_space(3)))
#define XB_TMO      128
#define XB_XCNT(j)  (256  + 64 * (j))
#define XB_XSUB(j)  (1280 + 64 * (j))
#define XB_XGEN(j)  (2304 + 64 * (j))
#define XB_TOP      3328
#define XB_TOPGEN   3392
#define XCD_BAR_WORDS 3456
#define XB_SPIN_CAP (1u << 18)

__device__ __forceinline__ unsigned xb_ld(unsigned* p)              { return __hip_atomic_load(p, __ATOMIC_RELAXED, __HIP_MEMORY_SCOPE_AGENT); }
__device__ __forceinline__ unsigned xb_add(unsigned* p, unsigned v) { return __hip_atomic_fetch_add(p, v, __ATOMIC_RELAXED, __HIP_MEMORY_SCOPE_AGENT); }
__device__ __forceinline__ unsigned xb_xcc_id() { return (unsigned)__builtin_amdgcn_s_getreg((3 << 11) | 20) & 0xFu; }
#define XB_SPIN(cond, bar) do { unsigned _sp = 0; while (cond) { __builtin_amdgcn_s_sleep(1); \
    if ((++_sp & 255u) == 0u) { if (xb_ld(&(bar)[XB_TMO])) break; if (_sp > XB_SPIN_CAP) { atomicAdd(&(bar)[XB_TMO], 1u); break; } } } } while (0)

struct XcdBarrier {
    unsigned* bar; unsigned x;
    volatile LAS unsigned* st;
};

__device__ __forceinline__ XcdBarrier xcd_barrier_post(unsigned* bar, volatile LAS unsigned* st) {
    XcdBarrier b; b.bar = bar; b.x = xb_xcc_id(); b.st = st;
    if (threadIdx.x == 0) (void)xb_add(&bar[XB_XCNT(b.x)], 1u);
    return b;
}
__device__ __forceinline__ void xcd_barrier_complete(unsigned* bar, unsigned x, unsigned& nloc, unsigned& nx) {
    const unsigned G = gridDim.x * gridDim.y * gridDim.z;
    unsigned sum, cnt, mine, sp = 0u;
    for (;;) {
        sum = 0u; cnt = 0u; mine = 0u;
#pragma unroll
        for (unsigned j = 0; j < 16; ++j) { const unsigned c = xb_ld(&bar[XB_XCNT(j)]); sum += c; cnt += (c > 0u) ? 1u : 0u; mine = (j == x) ? c : mine; }
        if (sum == G) break;
        __builtin_amdgcn_s_sleep(1);
        if ((++sp & 255u) == 0u) { if (xb_ld(&bar[XB_TMO])) break; if (sp > XB_SPIN_CAP) { atomicAdd(&bar[XB_TMO], 1u); break; } }
    }
    nloc = mine > 0u ? mine : 1u; nx = cnt > 0u ? cnt : 1u;
}

__device__ __forceinline__ void xcd_barrier(const XcdBarrier& b) {
    asm volatile("s_waitcnt vmcnt(0)" ::: "memory");
    __syncthreads();
    if (threadIdx.x == 0) {
        unsigned* bar = b.bar; unsigned bx_ = b.x;
        asm volatile("" : "+s"(bar), "+s"(bx_));
        __builtin_amdgcn_s_waitcnt(0);
        unsigned nloc = b.st[0], nx = b.st[1];
        if (nloc == 0u) { xcd_barrier_complete(bar, bx_, nloc, nx); b.st[0] = nloc; b.st[1] = nx; }
        const unsigned old = xb_add(&bar[XB_XSUB(bx_)], 1u);
        const unsigned gen = old / nloc;
        if (old + 1u == (gen + 1u) * nloc) {
            __builtin_amdgcn_fence(__ATOMIC_RELEASE, "agent");
            asm volatile("s_waitcnt vmcnt(0)" ::: "memory");
            const unsigned og = xb_add(&bar[XB_TOP], 1u);
            const unsigned tg = og / nx;
            if (og + 1u == (tg + 1u) * nx) xb_add(&bar[XB_TOPGEN], 1u);
            else XB_SPIN(xb_ld(&bar[XB_TOPGEN]) == tg, bar);
            __builtin_amdgcn_fence(__ATOMIC_ACQUIRE, "agent");
            xb_add(&bar[XB_XGEN(bx_)], 1u);
            asm volatile("s_waitcnt vmcnt(0)" ::: "memory");
        } else {
            XB_SPIN(xb_ld(&bar[XB_XGEN(bx_)]) == gen, bar);
            __builtin_amdgcn_fence(__ATOMIC_ACQUIRE, "agent");
            asm volatile("s_waitcnt vmcnt(0)" ::: "memory");
        }
    }
    __syncthreads();
}


#define PH_BEGIN(k) for (int rep_ = 0, nrep_ = 1 + (((p.probe >> (k)) & 1) | ((k) == 5 ? ((p.probe >> 12) | (p.probe >> 13)) & 1 : 0)); rep_ < nrep_; ++rep_) { const bool dup = rep_ > 0; (void)dup;
#define PH_END xcd_barrier(xb_); }
#ifndef PROBE_MASK
#define PROBE_MASK 0
#endif
__global__ void __launch_bounds__(256, 2) mega(Params p) {
  __shared__ __attribute__((aligned(16))) char lds[LDS_BYTES];
  __shared__ int s_item;
  __shared__ unsigned xb_st[2];
  if (otid() == 0) { xb_st[0] = 0u; xb_st[1] = 0u; }
  __syncthreads();
  const XcdBarrier xb_ = xcd_barrier_post((unsigned*)(p.ws + OFF_CTR) + 64, (volatile LAS unsigned*)xb_st);
  cg::grid_group grid = cg::this_grid();
  const int G = gridDim.x, B = blockIdx.x;
  bf16_t* P = (bf16_t*)(p.ws + OFF_P);
  bf16_t* H = (bf16_t*)(p.ws + OFF_H);
  for (int it = B; it < 192 + 1024 + N_CVT; it += G) {
    if (it < 192) job_mod(p, it, lds);
    else if (it < 1216) job_rope(p, it - 192);
    else job_cvt(p, 0, it - 1216, lds);
  }
  if (p.probe < 0) grid.sync();
  xcd_barrier(xb_);
#pragma unroll 1
  for (int layer = 0; layer < 2; ++layer) {
    bf16_t* MG = (bf16_t*)(p.ws + OFF_VT);
    bf16_t* HID = P;
    PH_BEGIN(1)
    {
      const int n1 = layer == 1 ? N_CVT : 0;
      for (int it = B; it < n1 + MR / 8; it += G) { if (it < n1) job_cvt(p, 1, it, lds); else job_norm(p, layer, 1, it - n1); }
    }
    PH_END
    PH_BEGIN(2)
    {
      bf16_t* HALO = (bf16_t*)(p.ws + OFF_HALO);
      float* GBA = (float*)(p.ws + OFF_GBA);
      gemm_phase(H, 32, MR * 32, (const bf16_t*)(p.ws + OFF_WIN), 32, 7808 * 32, 1024, 132, 37, lds, B, G, [&](int row, int col, f32x4 v) {
        if (col < C_GBA) {
          const u32x2 w = {pk2(v[0], v[1]), pk2(v[2], v[3])};
          *(u32x2*)(P + (size_t)row * LDP + col) = w;
          if (col >= C_GQKV && col < C_GZ) {
            const int sm = row & 63;
            if (sm <= 1 || sm == 63) *(u32x2*)(HALO + ((size_t)(row >> 6) * 3 + (sm == 63 ? 2 : sm)) * 1536 + (col - C_GQKV)) = w;
          }
        } else if (col < C_GBA + 16) {
          *(f32x4*)(GBA + (size_t)row * 16 + (col - C_GBA)) = v;
        }
      }, [&](int row, int col, f32x4 v0, f32x4 v1) {
        if (col < C_GBA) {
          const u32x4 w = (u32x4){pk2(v0[0], v0[1]), pk2(v0[2], v0[3]), pk2(v1[0], v1[1]), pk2(v1[2], v1[3])};
          __builtin_nontemporal_store(w, (u32x4*)(P + (size_t)row * LDP + col));
          if (col >= C_GQKV && col < C_GZ) {
            const int sm = row & 63;
            if (sm <= 1 || sm == 63) *(u32x4*)(HALO + ((size_t)(row >> 6) * 3 + (sm == 63 ? 2 : sm)) * 1536 + (col - C_GQKV)) = w;
          }
        } else if (col < C_GBA + 16) {
          *(f32x4*)(GBA + (size_t)row * 16 + (col - C_GBA)) = v0;
          *(f32x4*)(GBA + (size_t)row * 16 + (col - C_GBA) + 4) = v1;
        }
      });
    }
    PH_END
    PH_BEGIN(3)
    {
      const int nA = 8 * NCH * 4, nB = nA + 6336, nC = nB + 2112, nD = nC + MR / 8;
      for (int it = B; it < nD; it += G) {
        if (it < nA) JL1(job_lru<1>(p, layer, it, lds, dup));
        else if (it < nB) JGC(job_gconv(p, layer, it - nA, dup));
        else if (it < nC) JVT(job_vt(p, it - nB, lds));
        else JDP(job_daprep(p, layer, it - nC, dup));
      }
    }
    PH_END
    PH_BEGIN(4)
    for (int it = B; it < 2112; it += G) JGP(job_gprep(p, layer, it, lds));
    PH_END
    PH_BEGIN(5)
    {
      for (;;) {
        const int x = blockIdx.x & 7;
        if (otid() == 0) s_item = (int)__hip_atomic_fetch_add((unsigned*)(p.ws + OFF_CTR) + ((layer * 2 + rep_) * 8 + x), 1u, __ATOMIC_RELAXED, __HIP_MEMORY_SCOPE_AGENT);
        __syncthreads();
        const int j = __builtin_amdgcn_readfirstlane(s_item);
        __syncthreads();
        if (j >= 16 + 132 + 528) break;
        if (j < 16) { if (!(dup && ((p.probe >> 12) & 1))) JGS(job_gscan(p, j * 8 + x, lds)); }
        else if (j < 148) {
          const int k = j - 16, grp = k / 66, qq = k % 66, qb = qq < 64 ? qq + 2 : qq - 64;
          if (!(dup && ((p.probe >> 13) & 1))) JAT(job_attn(p, layer, grp * 528 + qb * 8 + x, lds, dup));
        } else { if (!(dup && (((p.probe >> 12) | (p.probe >> 13)) & 1))) JL3(job_lru<3>(p, layer, (j - 148) * 8 + x, lds, dup)); }
      }
    }
    PH_END
    PH_BEGIN(6)
    for (int it = B; it < MR / 8 + MR / 8; it += G) { if (it < MR / 8) job_gpost(p, layer, it); else job_norm(p, layer, 1, it - MR / 8, layer == 1); }
    PH_END
    PH_BEGIN(7)
    gemm_phase(H, 32, MR * 32, (const bf16_t*)(p.ws + OFF_WIN) + (size_t)4736 * 32, 32, 7808 * 32, 1024, 132, 24, lds, B, G, [&](int row, int col, f32x4 v) {
      *(u32x2*)(P + (size_t)row * LDP + sg_col(col)) = (u32x2){pk2(sigm(v[0]), sigm(v[1])), pk2(sigm(v[2]), sigm(v[3]))};
    }, [&](int row, int col, f32x4 v0, f32x4 v1) {
      *(u32x4*)(P + (size_t)row * LDP + sg_col(col)) = (u32x4){pk2(sigm(v0[0]), sigm(v0[1])), pk2(sigm(v0[2]), sigm(v0[3])), pk2(sigm(v1[0]), sigm(v1[1])), pk2(sigm(v1[2]), sigm(v1[3]))};
    }, layer == 1);
    PH_END
    PH_BEGIN(14)
    {
      const bf16_t* WBR = (const bf16_t*)(p.ws + OFF_WBR);
      const int nm14 = layer == 1 ? 256 : 264;
      for (int t = B; t < nm14 * 8; t += G) {
        int mi, ni; tile_mn(t, nm14, 8, mi, ni);
        if (layer == 1) mi += 2 * (mi >> 6) + 2;
        f32x4 mg[4][4]; zero_acc<4>(mg);
#pragma unroll 1
        for (int i = 0; i < 3; ++i) {
          f32x4 ay[4][4]; zero_acc<4>(ay);
          const int coff = i == 0 ? C_DAQ : (i == 1 ? C_LY : C_GZ);
          gemm_core<4>(P + (size_t)mi * 128 * LDP + coff, LDP, 32, WBR + (size_t)i * 1024 * 512 + (size_t)(ni * 128) * 32, 32, 1024 * 32, 512, ay, lds);
          const int lane = otid() & 63, wid = otid() >> 6, wr = wid >> 1, wc = wid & 1;
#pragma unroll
          for (int a2 = 0; a2 < 4; ++a2)
#pragma unroll
            for (int b2 = 0; b2 < 4; ++b2) {
              const int row = mi * 128 + wr * 64 + a2 * 16 + (lane & 15), col = ni * 128 + wc * 64 + b2 * 16 + (lane >> 4) * 4;
              const u32x2 sg = *(const u32x2*)(P + (size_t)row * LDP + sg_col(i * 1024 + col));
              mg[a2][b2] += (f32x4){bflo(sg.x), bfhi(sg.x), bflo(sg.y), bfhi(sg.y)} * ay[a2][b2];
            }
        }
        gemm_emit<4>(mg, mi * 128, ni * 128, [&](int row, int col, f32x4 v) { *(u32x2*)(MG + ((size_t)(col >> 5) * MR + row) * 32 + (col & 31)) = (u32x2){pk2(v[0], v[1]), pk2(v[2], v[3])}; });
      }
    }
    PH_END
    PH_BEGIN(8)
    gemm_phase(MG, 32, MR * 32, (const bf16_t*)(p.ws + OFF_WO), 32, 1024 * 32, 1024, 132, 8, lds, B, G, [&](int row, int col, f32x4 v) {
      const f32x4 xin = *(const f32x4*)(res_in_row(p, layer, row) + col);
      const f32x4 g1 = *(const f32x4*)(mod_vec(p, layer, row) + 2048 + col);
      if (!dup) *(f32x4*)(res_out_row(p, row) + col) = xin + g1 * v;
    }, [&](int row, int col, f32x4 v0, f32x4 v1) {
      const float* xi = res_in_row(p, layer, row) + col;
      const float* gm = mod_vec(p, layer, row) + 2048 + col;
      float* xo = res_out_row(p, row) + col;
      const f32x4 o0 = __builtin_nontemporal_load((const f32x4*)xi) + *(const f32x4*)gm * v0, o1 = __builtin_nontemporal_load((const f32x4*)(xi + 4)) + *(const f32x4*)(gm + 4) * v1;
      if (!dup) { *(f32x4*)xo = o0; *(f32x4*)(xo + 4) = o1; }
    }, layer == 1);
    PH_END
    PH_BEGIN(9)
    for (int it = B; it < MR / 8; it += G) job_norm(p, layer, 2, it, layer == 1);
    PH_END
    PH_BEGIN(10)
    gemm_phase(H, 32, MR * 32, (const bf16_t*)(p.ws + OFF_W1), 32, 4096 * 32, 1024, 132, 32, lds, B, G, [&](int row, int col, f32x4 v) {
      float r[4];
#pragma unroll
      for (int e = 0; e < 4; ++e) { const float q = fmaxf(v[e], 0.f); r[e] = q * q; }
      *(u32x2*)(HID + ((size_t)(col >> 5) * MR + row) * 32 + (col & 31)) = (u32x2){pk2(r[0], r[1]), pk2(r[2], r[3])};
    }, [&](int row, int col, f32x4 v0, f32x4 v1) {
      float r[8];
#pragma unroll
      for (int e = 0; e < 4; ++e) { const float q0 = fmaxf(v0[e], 0.f), q1 = fmaxf(v1[e], 0.f); r[e] = q0 * q0; r[4 + e] = q1 * q1; }
      __builtin_nontemporal_store(((u32x4){pk2(r[0], r[1]), pk2(r[2], r[3]), pk2(r[4], r[5]), pk2(r[6], r[7])}), (u32x4*)(HID + ((size_t)(col >> 5) * MR + row) * 32 + (col & 31)));
    }, layer == 1);
    PH_END
    PH_BEGIN(11)
    gemm_phase(HID, 32, MR * 32, (const bf16_t*)(p.ws + OFF_W2), 32, 1024 * 32, 4096, 132, 8, lds, B, G, [&](int row, int col, f32x4 v) {
      float* xo = res_out_row(p, row) + col;
      const f32x4 g2 = *(const f32x4*)(mod_vec(p, layer, row) + 5120 + col);
      if (!dup) *(f32x4*)xo = *(const f32x4*)xo + g2 * v;
    }, [&](int row, int col, f32x4 v0, f32x4 v1) {
      float* xo = res_out_row(p, row) + col;
      const float* gm = mod_vec(p, layer, row) + 5120 + col;
      const f32x4 o0 = __builtin_nontemporal_load((const f32x4*)xo) + *(const f32x4*)gm * v0, o1 = __builtin_nontemporal_load((const f32x4*)(xo + 4)) + *(const f32x4*)(gm + 4) * v1;
      if (!dup) { *(f32x4*)xo = o0; *(f32x4*)(xo + 4) = o1; }
    }, layer == 1);
    PH_END
  }
}

extern "C" void kernel_launch(void* const* d_in, const int* in_sizes, int n_in, void* d_out, int out_size, void* d_ws, size_t ws_size, hipStream_t stream) {
  static int grid_blocks = 0;
  if (!grid_blocks) {
    int dev = 0, cus = 0, per_cu = 0;
    hipGetDevice(&dev);
    hipDeviceGetAttribute(&cus, hipDeviceAttributeMultiprocessorCount, dev);
    hipOccupancyMaxActiveBlocksPerMultiprocessor(&per_cu, mega, 256, 0);
    if (per_cu > 2) per_cu = 2;
    grid_blocks = cus * per_cu;
    grid_blocks -= grid_blocks % 8;
  }
  Params p{};
  const float** f = (const float**)&p;
  for (int i = 0; i < 26; ++i) f[i] = (const float*)d_in[i];
  p.out = (float*)d_out;
  p.ws = (char*)d_ws;
  p.probe = PROBE_MASK;
  if (ws_size < WS_TOTAL) { fprintf(stderr, "workspace too small: %zu < %zu\n", ws_size, (size_t)WS_TOTAL); return; }
  hipMemsetAsync((char*)d_ws + OFF_CTR, 0, 256 + 16384, stream);
  void* args[] = {&p};
  hipError_t e = hipLaunchCooperativeKernel((void*)mega, dim3(grid_blocks), dim3(256), args, 0, stream);
  if (e != hipSuccess) fprintf(stderr, "cooperative launch failed: %s (grid %d)\n", hipGetErrorString(e), grid_blocks);
}
```
